# Optimizing an MI355X kernel written in HIP

```python
import math
import jax, jax.numpy as jnp
from jax import lax
import numpy as np

D_MODEL = 1024
BATCH = 2
SEQ = 8192
DEPTH = 4

CTX_LEN = 256
GRID_W = 64
EPS = 1e-6
ROPE_BASE = 10000.0
ROPE_DIM = 32
Q_BLOCK = 128
CHUNK = 64

MLA_HEADS = 4
MLA_Q_RANK = 256
MLA_KV_RANK = 128
MLA_NOPE = 64
MLA_ROPE = ROPE_DIM
MLA_V = 64
MLA_SCALE = (MLA_NOPE + MLA_ROPE) ** -0.5

DIFF_HEADS = 4
DIFF_DK = ROPE_DIM
DIFF_DV = 2 * DIFF_DK
DIFF_SCALE = DIFF_DK ** -0.5

HGRN_HEADS = 8
HGRN_DK = 64
HGRN_DV = 64

MLA_WIDTH = MLA_HEADS * MLA_V
DIFF_WIDTH = DIFF_HEADS * DIFF_DV
HGRN_WIDTH = HGRN_HEADS * HGRN_DV
MIX_WIDTH = MLA_WIDTH + DIFF_WIDTH + HGRN_WIDTH

D_FF = (((8 * D_MODEL + 2) // 3 + 255) // 256) * 256

IN_SIZES = (
    MLA_Q_RANK, MLA_KV_RANK, MLA_ROPE,
    DIFF_HEADS * 2 * DIFF_DK, DIFF_HEADS * 2 * DIFF_DK, DIFF_WIDTH,
    HGRN_HEADS * HGRN_DK, HGRN_HEADS * HGRN_DK, HGRN_HEADS * HGRN_DK,
    HGRN_WIDTH, HGRN_WIDTH,
)
IN_WIDTH = sum(IN_SIZES)
IN_OFFSETS = tuple(int(o) for o in np.cumsum(IN_SIZES)[:-1])

kernel_name = 'hybrid_mla_diffattn_hgrn2_flow_block'


def rms_norm(x, g):
    xf = x.astype(jnp.float32)
    y = xf * lax.rsqrt(jnp.mean(xf * xf, axis=-1, keepdims=True) + EPS)
    return (y * g.astype(jnp.float32)).astype(x.dtype)


def modulate(x, shift, scale):
    return x * (1 + scale) + shift


def heads(a, n_heads):
    b, t, _ = a.shape
    return a.reshape(b, t, n_heads, -1).transpose(0, 2, 1, 3)


def merge_heads(a):
    b, h, t, d = a.shape
    return a.transpose(0, 2, 1, 3).reshape(b, t, h * d)


def axial_rope_tables(rows):
    t = jnp.arange(rows * GRID_W)
    row = (t // GRID_W).astype(jnp.float32)
    col = (t % GRID_W).astype(jnp.float32)
    n_freq = ROPE_DIM // 4
    freqs = ROPE_BASE ** (-jnp.arange(n_freq, dtype=jnp.float32) / n_freq)
    ang_r = row[:, None] * freqs
    ang_c = col[:, None] * freqs
    return (jnp.cos(ang_r), jnp.sin(ang_r), jnp.cos(ang_c), jnp.sin(ang_c))


def rope_1d(x, cos, sin):
    x1, x2 = jnp.split(x, 2, axis=-1)
    cos = cos.astype(x.dtype)
    sin = sin.astype(x.dtype)
    return jnp.concatenate([x1 * cos - x2 * sin, x2 * cos + x1 * sin], axis=-1)


def rope_2d(x, rope):
    cos_r, sin_r, cos_c, sin_c = rope
    x_row, x_col = jnp.split(x, 2, axis=-1)
    return jnp.concatenate([rope_1d(x_row, cos_r, sin_r), rope_1d(x_col, cos_c, sin_c)], axis=-1)


def layer_lower_bounds(raw):
    p = jax.nn.softmax(raw.astype(jnp.float32), axis=0)
    cum = jnp.cumsum(p, axis=0)
    return cum - cum[0:1]


def log_forget(z, lb):
    z = z.astype(jnp.float32)
    return jnp.logaddexp(jnp.log(lb), jnp.log1p(-lb) + jax.nn.log_sigmoid(z))


def sweep_query_blocks(fn, *qs):
    b, h, t = qs[0].shape[:3]
    nb = t // Q_BLOCK
    blocks = tuple(jnp.moveaxis(a.reshape(b, h, nb, Q_BLOCK, a.shape[-1]), 2, 0) for a in qs)
    o = lax.map(lambda xs: fn(*xs), blocks)
    return jnp.moveaxis(o, 0, 2).reshape(b, h, t, o.shape[-1])


def softmax_attention(q, k, v, scale):
    def one(qb):
        s = jnp.einsum('bhqd,bhkd->bhqk', qb, k).astype(jnp.float32) * scale
        p = jax.nn.softmax(s, axis=-1).astype(v.dtype)
        return jnp.einsum('bhqk,bhkd->bhqd', p, v)
    return sweep_query_blocks(one, q)


def differential_attention(q1, q2, k1, k2, v, lam):
    def one(qb1, qb2):
        s1 = jnp.einsum('bhqd,bhkd->bhqk', qb1, k1).astype(jnp.float32) * DIFF_SCALE
        s2 = jnp.einsum('bhqd,bhkd->bhqk', qb2, k2).astype(jnp.float32) * DIFF_SCALE
        p = jax.nn.softmax(s1, axis=-1) - lam * jax.nn.softmax(s2, axis=-1)
        return jnp.einsum('bhqk,bhkd->bhqd', p.astype(v.dtype), v)
    return sweep_query_blocks(one, q1, q2)


def diff_head_out(o, g, lam_init):
    return merge_heads(rms_norm(o, g) * (1 - lam_init))


def gla_chunk_scan(q, k, v, log_f, s0):
    b, h, t, dk = q.shape
    n = t // CHUNK

    def chunks(a):
        return jnp.moveaxis(a.reshape(b, h, n, CHUNK, a.shape[-1]), 2, 0)

    incl = jnp.tril(jnp.ones((CHUNK, CHUNK), dtype=bool))[:, :, None]

    def step(state, xs):
        qc, kc, vc, gc = xs
        cum = jnp.cumsum(gc, axis=2)
        o_inter = jnp.einsum('bhtk,bhkv->bhtv', qc * jnp.exp(cum), state)
        rel = cum[:, :, :, None, :] - cum[:, :, None, :, :]
        decay = jnp.exp(jnp.where(incl, rel, -jnp.inf))
        scores = jnp.einsum('bhtk,bhsk,bhtsk->bhts', qc, kc, decay)
        o_intra = jnp.einsum('bhts,bhsv->bhtv', scores, vc)
        last = cum[:, :, -1, :]
        k_to_end = kc * jnp.exp(last[:, :, None, :] - cum)
        new_state = jnp.exp(last)[..., None] * state + jnp.einsum('bhsk,bhsv->bhkv', k_to_end, vc)
        return new_state, o_inter + o_intra

    final, o = lax.scan(step, s0, (chunks(q), chunks(k), chunks(v), chunks(log_f)))
    o = jnp.moveaxis(o, 0, 2).reshape(b, h, t, v.shape[-1])
    return o, final


def hgrn_bidirectional(f, s0_fwd, s0_bwd):
    q, v = f['hgrn_q'], f['hgrn_v']
    lf_f, lf_b = f['hgrn_lf_fwd'], f['hgrn_lf_bwd']
    o_f, s_f = gla_chunk_scan(q, -jnp.expm1(lf_f), v, lf_f, s0_fwd)
    flip = lambda a: jnp.flip(a, axis=2)
    o_b, s_b = gla_chunk_scan(flip(q), flip(-jnp.expm1(lf_b)), flip(v), flip(lf_b), s0_bwd)
    return o_f + flip(o_b), s_f, s_b


def hgrn_head_out(o, g, gain):
    return merge_heads(rms_norm(o, gain)).astype(g.dtype) * jax.nn.silu(g)


def stream_features(h, lw, rope):
    proj = h @ lw['w_in']
    cq, ckv, kr, dq, dk, dv, hq, hf_fwd, hf_bwd, hi, hg = jnp.split(proj, IN_OFFSETS, axis=-1)
    b, t, _ = h.shape
    q = heads(rms_norm(cq, lw['g_q_norm']) @ lw['w_uq'], MLA_HEADS)
    kv = heads(rms_norm(ckv, lw['g_kv_norm']) @ lw['w_ukv'], MLA_HEADS)
    q_nope, q_rope = jnp.split(q, [MLA_NOPE], axis=-1)
    k_nope, mla_v = jnp.split(kv, [MLA_NOPE], axis=-1)
    k_rope = kr[:, None]
    dq = dq.reshape(b, t, DIFF_HEADS, 2, DIFF_DK).transpose(0, 2, 3, 1, 4)
    dk = dk.reshape(b, t, DIFF_HEADS, 2, DIFF_DK).transpose(0, 2, 3, 1, 4)
    if rope is not None:
        q_rope = rope_2d(q_rope, rope)
        k_rope = rope_2d(k_rope, rope)
        dq = rope_2d(dq, rope)
        dk = rope_2d(dk, rope)
    mla_q = jnp.concatenate([q_nope, q_rope], axis=-1)
    mla_k = jnp.concatenate([k_nope, jnp.broadcast_to(k_rope, (b, MLA_HEADS, t, MLA_ROPE))], axis=-1)
    lf_fwd = heads(log_forget(hf_fwd, lw['lb'][0]), HGRN_HEADS)
    lf_bwd = heads(log_forget(hf_bwd, lw['lb'][1]), HGRN_HEADS)
    return {
        'mla_q': mla_q, 'mla_k': mla_k, 'mla_v': mla_v,
        'diff_q1': dq[:, :, 0], 'diff_q2': dq[:, :, 1],
        'diff_k1': dk[:, :, 0], 'diff_k2': dk[:, :, 1],
        'diff_v': heads(dv, DIFF_HEADS),
        'hgrn_q': heads(jax.nn.silu(hq), HGRN_HEADS).astype(jnp.float32),
        'hgrn_v': heads(hi, HGRN_HEADS).astype(jnp.float32),
        'hgrn_lf_fwd': lf_fwd, 'hgrn_lf_bwd': lf_bwd,
        'hgrn_g': hg,
    }


def token_mixers(fl, fc, lw, lam, lam_init, with_ctx_out):
    cat = lambda a, b_: jnp.concatenate([a, b_], axis=2)
    mla_l = merge_heads(softmax_attention(fl['mla_q'], cat(fc['mla_k'], fl['mla_k']),
                                          cat(fc['mla_v'], fl['mla_v']), MLA_SCALE))
    diff_l = diff_head_out(differential_attention(
        fl['diff_q1'], fl['diff_q2'], cat(fc['diff_k1'], fl['diff_k1']), cat(fc['diff_k2'], fl['diff_k2']),
        cat(fc['diff_v'], fl['diff_v']), lam), lw['g_diff_norm'], lam_init)
    b = fc['hgrn_q'].shape[0]
    zeros = jnp.zeros((b, HGRN_HEADS, HGRN_DK, HGRN_DV), jnp.float32)
    o_c, s_cf, s_cb = hgrn_bidirectional(fc, zeros, zeros)
    o_l, _, _ = hgrn_bidirectional(fl, s_cf, s_cb)
    hgrn_l = hgrn_head_out(o_l, fl['hgrn_g'], lw['g_hgrn_norm'])
    mix_l = jnp.concatenate([mla_l, diff_l, hgrn_l], axis=-1)
    if not with_ctx_out:
        return mix_l, None
    mla_c = merge_heads(softmax_attention(fc['mla_q'], fc['mla_k'], fc['mla_v'], MLA_SCALE))
    diff_c = diff_head_out(differential_attention(
        fc['diff_q1'], fc['diff_q2'], fc['diff_k1'], fc['diff_k2'], fc['diff_v'], lam),
        lw['g_diff_norm'], lam_init)
    hgrn_c = hgrn_head_out(o_c, fc['hgrn_g'], lw['g_hgrn_norm'])
    mix_c = jnp.concatenate([mla_c, diff_c, hgrn_c], axis=-1)
    return mix_l, mix_c


def swiglu(h, w_gate, w_up, w_down):
    return (jax.nn.silu(h @ w_gate) * (h @ w_up)) @ w_down


def setup_inputs(seed: int = 0) -> dict:
    key = jax.random.key(seed)
    ks = jax.random.split(key, 24)
    f32 = jnp.float32

    def nrm(k, shape, scale):
        return jax.random.normal(k, shape, f32) * scale

    def gain(k, shape):
        return 1.0 + 0.05 * jax.random.normal(k, shape, f32)

    return {
        'x': nrm(ks[0], (BATCH, SEQ, D_MODEL), 1.0),
        'c': nrm(ks[1], (BATCH, D_MODEL), 1.0),
        'ctx': nrm(ks[2], (BATCH, CTX_LEN, D_MODEL), 1.0),
        'c_ctx': nrm(ks[3], (D_MODEL,), 1.0),
        'w_ada': nrm(ks[4], (DEPTH, D_MODEL, 6 * D_MODEL), 0.5 * D_MODEL ** -0.5),
        'b_ada': nrm(ks[5], (DEPTH, 6 * D_MODEL), 0.02),
        'g_norm1': gain(ks[6], (DEPTH, D_MODEL)),
        'g_norm2': gain(ks[7], (DEPTH, D_MODEL)),
        'w_in': nrm(ks[8], (DEPTH, D_MODEL, IN_WIDTH), D_MODEL ** -0.5),
        'g_q_norm': gain(ks[9], (DEPTH, MLA_Q_RANK)),
        'w_uq': nrm(ks[10], (DEPTH, MLA_Q_RANK, MLA_HEADS * (MLA_NOPE + MLA_ROPE)), MLA_Q_RANK ** -0.5),
        'g_kv_norm': gain(ks[11], (DEPTH, MLA_KV_RANK)),
        'w_ukv': nrm(ks[12], (DEPTH, MLA_KV_RANK, MLA_HEADS * (MLA_NOPE + MLA_V)), MLA_KV_RANK ** -0.5),
        'diff_lambda': nrm(ks[13], (DEPTH, 4, DIFF_DK), 0.1),
        'g_diff_norm': gain(ks[14], (DEPTH, DIFF_DV)),
        'hgrn_lower_bounds': nrm(ks[15], (DEPTH, 2, HGRN_HEADS * HGRN_DK), 0.1),
        'g_hgrn_norm': gain(ks[16], (DEPTH, HGRN_DV)),
        'w_out': nrm(ks[17], (DEPTH, MIX_WIDTH, D_MODEL), MIX_WIDTH ** -0.5),
        'w_ffn_gate': nrm(ks[18], (DEPTH, D_MODEL, D_FF), D_MODEL ** -0.5),
        'w_ffn_up': nrm(ks[19], (DEPTH, D_MODEL, D_FF), D_MODEL ** -0.5),
        'w_ffn_down': nrm(ks[20], (DEPTH, D_FF, D_MODEL), D_FF ** -0.5),
        'g_final': gain(ks[21], (D_MODEL,)),
    }


def reference(x, c, ctx, c_ctx, w_ada, b_ada, g_norm1, g_norm2, w_in, g_q_norm, w_uq, g_kv_norm, w_ukv,
              diff_lambda, g_diff_norm, hgrn_lower_bounds, g_hgrn_norm, w_out, w_ffn_gate, w_ffn_up,
              w_ffn_down, g_final):
    ROWS = x.shape[1] // GRID_W
    rope = axial_rope_tables(ROWS)
    lb_all = layer_lower_bounds(hgrn_lower_bounds)
    silu_c = jax.nn.silu(c)
    silu_cc = jax.nn.silu(c_ctx)
    for l in range(DEPTH):
        with_ctx_out = l < DEPTH - 1
        mod_l = silu_c @ w_ada[l] + b_ada[l]
        mod_c = silu_cc @ w_ada[l] + b_ada[l]
        sh1, sc1, gt1, sh2, sc2, gt2 = jnp.split(mod_l[:, None, :], 6, axis=-1)
        csh1, csc1, cgt1, csh2, csc2, cgt2 = jnp.split(mod_c, 6, axis=-1)
        lw = {
            'w_in': w_in[l], 'g_q_norm': g_q_norm[l], 'w_uq': w_uq[l], 'g_kv_norm': g_kv_norm[l],
            'w_ukv': w_ukv[l], 'lb': lb_all[l], 'g_diff_norm': g_diff_norm[l], 'g_hgrn_norm': g_hgrn_norm[l],
        }
        lq1, lk1, lq2, lk2 = diff_lambda[l].astype(jnp.float32)
        lam_init = 0.8 - 0.6 * math.exp(-0.3 * l)
        lam = jnp.exp(jnp.sum(lq1 * lk1)) - jnp.exp(jnp.sum(lq2 * lk2)) + lam_init

        h = modulate(rms_norm(x, g_norm1[l]), sh1, sc1)
        hc = modulate(rms_norm(ctx, g_norm1[l]), csh1, csc1)
        fl = stream_features(h, lw, rope)
        fc = stream_features(hc, lw, None)
        mix_l, mix_c = token_mixers(fl, fc, lw, lam, lam_init, with_ctx_out)
        x = x + gt1 * (mix_l @ w_out[l])
        h2 = modulate(rms_norm(x, g_norm2[l]), sh2, sc2)
        x = x + gt2 * swiglu(h2, w_ffn_gate[l], w_ffn_up[l], w_ffn_down[l])
        if with_ctx_out:
            ctx = ctx + cgt1 * (mix_c @ w_out[l])
            h2c = modulate(rms_norm(ctx, g_norm2[l]), csh2, csc2)
            ctx = ctx + cgt2 * swiglu(h2c, w_ffn_gate[l], w_ffn_up[l], w_ffn_down[l])
    return rms_norm(x, g_final)
```

```cpp
#include <hip/hip_runtime.h>
#include <hip/hip_cooperative_groups.h>
#include <cstdio>
namespace cg = cooperative_groups;

typedef __attribute__((ext_vector_type(8))) __bf16 bf8;
typedef __attribute__((ext_vector_type(4))) __bf16 bf4;
typedef __attribute__((ext_vector_type(4))) float f4;

#define XCD_BAR_WORDS_C 3456
#define NB 2
#define SEQ 8192
#define CTXL 256
#define PT 8448
#define NTOK 16896
#define DM 1024
#define INW 3744
#define INWP 3840
#define DFF 2816
#define NCH 132
#define LDH 1088
#define LDF 2880
#define LOG2E 1.4426950408889634f
#define EPSN 1e-6f
#define SMEM_BYTES 66064

constexpr size_t al256(size_t x) { return (x + 255) & ~(size_t)255; }
constexpr size_t OFF_xc = 0;
constexpr size_t OFF_mod = OFF_xc + al256((size_t)NB*CTXL*DM*4);
constexpr size_t OFF_rope = OFF_mod + al256((size_t)4*3*6144*4);
constexpr size_t OFF_llb = OFF_rope + al256(128*8*2*4);
constexpr size_t OFF_l1mlb = OFF_llb + al256(4*1024*4);
constexpr size_t OFF_lam = OFF_l1mlb + al256(4*1024*4);
constexpr size_t OFF_wt_in = OFF_lam + al256(256);
constexpr size_t OFF_wt_uq = OFF_wt_in + al256((size_t)INWP*LDH*2);
constexpr size_t OFF_wt_ukv = OFF_wt_uq + al256((size_t)384*256*2);
constexpr size_t OFF_wt_out = OFF_wt_ukv + al256((size_t)512*128*2);
constexpr size_t OFF_wt_gu = OFF_wt_out + al256((size_t)DM*LDH*2);
constexpr size_t OFF_wt_down = OFF_wt_gu + al256((size_t)2*DFF*LDH*2);
constexpr size_t OFF_hb = OFF_wt_down + al256((size_t)DM*LDF*2);
constexpr size_t OFF_cq = OFF_hb + al256((size_t)NTOK*LDH*2);
constexpr size_t OFF_ckv = OFF_cq + al256((size_t)NTOK*256*2);
constexpr size_t OFF_qm = OFF_ckv + al256((size_t)NTOK*128*2);
constexpr size_t OFF_km = OFF_qm + al256((size_t)NB*4*PT*96*2);
constexpr size_t OFF_vmt = OFF_km + al256((size_t)NB*4*PT*96*2);
constexpr size_t OFF_qd = OFF_vmt + al256((size_t)NB*4*64*PT*2);
constexpr size_t OFF_kd = OFF_qd + al256((size_t)NB*4*2*PT*32*2);
constexpr size_t OFF_vdt = OFF_kd + al256((size_t)NB*4*2*PT*32*2);
constexpr size_t OFF_hq = OFF_vdt + al256((size_t)NB*4*64*PT*2);
constexpr size_t OFF_hvt = OFF_hq + al256((size_t)NTOK*512*2);
constexpr size_t OFF_hg = OFF_hvt + al256((size_t)NB*8*64*PT*2);
constexpr size_t OFF_dk = OFF_hg + al256((size_t)NTOK*512*2);
constexpr size_t OFF_st = OFF_dk + al256((size_t)NB*8*2*NCH*64*4);
constexpr size_t OFF_lf = OFF_st + al256((size_t)NB*8*2*NCH*4096*2);
constexpr size_t OFF_ut = OFF_lf + al256((size_t)2*NTOK*512*4);
constexpr size_t OFF_xbar = OFF_ut + al256((size_t)NB*8*2*NCH*4096*4);
constexpr size_t WS_TOTAL_OLD = OFF_ut + al256((size_t)NB*8*2*NCH*4096*4);
constexpr size_t WS_TOTAL = OFF_xbar + al256((size_t)XCD_BAR_WORDS_C*4);
struct Params {
  const float *x, *c, *ctx, *c_ctx, *w_ada, *b_ada, *g_norm1, *g_norm2, *w_in, *g_q_norm, *w_uq, *g_kv_norm, *w_ukv,
      *diff_lambda, *g_diff_norm, *hgrn_lb, *g_hgrn_norm, *w_out, *w_gate, *w_up, *w_down, *g_final;
  float* out;
  char* ws;
  __device__ __forceinline__ float* xc() const { return (float*)(ws + OFF_xc); }
  __device__ __forceinline__ float* mod() const { return (float*)(ws + OFF_mod); }
  __device__ __forceinline__ float* rope() const { return (float*)(ws + OFF_rope); }
  __device__ __forceinline__ float* llb() const { return (float*)(ws + OFF_llb); }
  __device__ __forceinline__ float* l1mlb() const { return (float*)(ws + OFF_l1mlb); }
  __device__ __forceinline__ float* lam() const { return (float*)(ws + OFF_lam); }
  __device__ __forceinline__ __bf16* wt_in() const { return (__bf16*)(ws + OFF_wt_in); }
  __device__ __forceinline__ __bf16* wt_uq() const { return (__bf16*)(ws + OFF_wt_uq); }
  __device__ __forceinline__ __bf16* wt_ukv() const { return (__bf16*)(ws + OFF_wt_ukv); }
  __device__ __forceinline__ __bf16* wt_out() const { return (__bf16*)(ws + OFF_wt_out); }
  __device__ __forceinline__ __bf16* wt_gu() const { return (__bf16*)(ws + OFF_wt_gu); }
  __device__ __forceinline__ __bf16* wt_down() const { return (__bf16*)(ws + OFF_wt_down); }
  __device__ __forceinline__ __bf16* hb() const { return (__bf16*)(ws + OFF_hb); }
  __device__ __forceinline__ __bf16* cq() const { return (__bf16*)(ws + OFF_cq); }
  __device__ __forceinline__ __bf16* ckv() const { return (__bf16*)(ws + OFF_ckv); }
  __device__ __forceinline__ __bf16* qm() const { return (__bf16*)(ws + OFF_qm); }
  __device__ __forceinline__ __bf16* km() const { return (__bf16*)(ws + OFF_km); }
  __device__ __forceinline__ __bf16* vmt() const { return (__bf16*)(ws + OFF_vmt); }
  __device__ __forceinline__ __bf16* qd() const { return (__bf16*)(ws + OFF_qd); }
  __device__ __forceinline__ __bf16* kd() const { return (__bf16*)(ws + OFF_kd); }
  __device__ __forceinline__ __bf16* vdt() const { return (__bf16*)(ws + OFF_vdt); }
  __device__ __forceinline__ __bf16* hq() const { return (__bf16*)(ws + OFF_hq); }
  __device__ __forceinline__ __bf16* hvt() const { return (__bf16*)(ws + OFF_hvt); }
  __device__ __forceinline__ __bf16* hg() const { return (__bf16*)(ws + OFF_hg); }
  __device__ __forceinline__ float* dk() const { return (float*)(ws + OFF_dk); }
  __device__ __forceinline__ __bf16* st() const { return (__bf16*)(ws + OFF_st); }
  __device__ __forceinline__ float* lf() const { return (float*)(ws + OFF_lf); }
  __device__ __forceinline__ float* ut() const { return (float*)(ws + OFF_ut); }
  __device__ __forceinline__ __bf16* mix() const { return hb(); }
  __device__ __forceinline__ __bf16* act() const { return (__bf16*)lf(); }
};

__device__ __forceinline__ int tid_() { int t = __builtin_amdgcn_workitem_id_x(); asm volatile("" : "+v"(t)); return t; }
__device__ __forceinline__ int bid_() { int t = __builtin_amdgcn_workgroup_id_x(); asm volatile("" : "+s"(t)); return t; }
__device__ __forceinline__ float silu_f(float x) { return x * __builtin_amdgcn_rcpf(1.f + __expf(-x)); }
__device__ __forceinline__ float wave_sum(float v) {
  v += __uint_as_float(__builtin_amdgcn_update_dpp(0u, __float_as_uint(v), 0x128, 0xf, 0xf, false));
  v += __uint_as_float(__builtin_amdgcn_update_dpp(0u, __float_as_uint(v), 0x124, 0xf, 0xf, false));
  v += __uint_as_float(__builtin_amdgcn_update_dpp(0u, __float_as_uint(v), 0x122, 0xf, 0xf, false));
  v += __uint_as_float(__builtin_amdgcn_update_dpp(0u, __float_as_uint(v), 0x121, 0xf, 0xf, false));
  unsigned u = __float_as_uint(v);
  auto a = __builtin_amdgcn_permlane16_swap(u, u, false, false);
  float m = __uint_as_float(a[0]) + __uint_as_float(a[1]);
  unsigned w = __float_as_uint(m);
  auto b = __builtin_amdgcn_permlane32_swap(w, w, false, false);
  return __uint_as_float(b[0]) + __uint_as_float(b[1]);
}
__device__ __forceinline__ float* xrow(const Params& p, int tok) {
  int b = tok / PT, pp = tok - b * PT;
  return pp < CTXL ? p.xc() + (size_t)(b * CTXL + pp) * DM : p.out + (size_t)(b * SEQ + pp - CTXL) * DM;
}
__device__ __forceinline__ float log_forget(float z, float lb, float oml) {
  const float sg = __builtin_amdgcn_rcpf(1.f + __expf(-fmaxf(z, -80.f)));
  return __logf(lb + oml * sg);
}
__device__ __forceinline__ float rows_max(float x) {
  unsigned u = __float_as_uint(x);
  auto a = __builtin_amdgcn_permlane16_swap(u, u, false, false);
  float m = fmaxf(__uint_as_float(a[0]), __uint_as_float(a[1]));
  unsigned v = __float_as_uint(m);
  auto b = __builtin_amdgcn_permlane32_swap(v, v, false, false);
  return fmaxf(__uint_as_float(b[0]), __uint_as_float(b[1]));
}
__device__ __forceinline__ float rows_sum(float x) {
  unsigned u = __float_as_uint(x);
  auto a = __builtin_amdgcn_permlane16_swap(u, u, false, false);
  float m = __uint_as_float(a[0]) + __uint_as_float(a[1]);
  unsigned v = __float_as_uint(m);
  auto b = __builtin_amdgcn_permlane32_swap(v, v, false, false);
  return __uint_as_float(b[0]) + __uint_as_float(b[1]);
}
__device__ __forceinline__ f4 mfma16(bf8 a, bf8 b, f4 c) { return __builtin_amdgcn_mfma_f32_16x16x32_bf16(a, b, c, 0, 0, 0); }

__device__ __forceinline__ void phase0(const Params& p, char* smem) {
  const int tid = tid_();
  const int gsz = gridDim.x * 256, gtid = bid_() * 256 + tid;
  {
    const float4* xs = (const float4*)p.x; float4* xo = (float4*)p.out;
    for (int i = gtid; i < NB * SEQ * DM / 4; i += gsz) xo[i] = xs[i];
    const float4* cs = (const float4*)p.ctx; float4* co = (float4*)p.xc();
    for (int i = gtid; i < NB * CTXL * DM / 4; i += gsz) co[i] = cs[i];
  }
  if (gtid < 1024) {
    int pos = gtid >> 3, f = gtid & 7;
    float freq = powf(10000.f, -(float)f / 8.f);
    float ang = (float)pos * freq, s, c;
    sincosf(ang, &s, &c);
    p.rope()[gtid * 2] = c; p.rope()[gtid * 2 + 1] = s;
  } else if (gtid < 2048) {
    int n = gtid - 1024;
    float r0 = p.hgrn_lb[n], r1 = p.hgrn_lb[1024 + n], r2 = p.hgrn_lb[2048 + n], r3 = p.hgrn_lb[3072 + n];
    float m = fmaxf(fmaxf(r0, r1), fmaxf(r2, r3));
    float e0 = expf(r0 - m), e1 = expf(r1 - m), e2 = expf(r2 - m), e3 = expf(r3 - m);
    float s = e0 + e1 + e2 + e3;
    float p0 = e0 / s, p1 = e1 / s, p2 = e2 / s, p3 = e3 / s;
    float c0 = p0, c1 = c0 + p1, c2 = c1 + p2, c3 = c2 + p3;
    p.llb()[n] = 0.f; p.l1mlb()[n] = 1.f;
    p.llb()[1024 + n] = c1 - c0; p.l1mlb()[1024 + n] = 1.f - (c1 - c0);
    p.llb()[2048 + n] = c2 - c0; p.l1mlb()[2048 + n] = 1.f - (c2 - c0);
    p.llb()[3072 + n] = c3 - c0; p.l1mlb()[3072 + n] = 1.f - (c3 - c0);
  } else if (gtid >= 4096 && gtid < 4096 + XCD_BAR_WORDS_C) {
    ((unsigned*)(p.ws + OFF_xbar))[gtid - 4096] = 0u;
  } else if (gtid == 2052) {
    *(unsigned*)(p.ws + OFF_lam + 128) = 0u;
  } else if (gtid < 2052) {
    int l = gtid - 2048;
    const float* d = p.diff_lambda + l * 128;
    float s1 = 0.f, s2 = 0.f;
    for (int i = 0; i < 32; ++i) { s1 += d[i] * d[32 + i]; s2 += d[64 + i] * d[96 + i]; }
    float li = 0.8f - 0.6f * expf(-0.3f * (float)l);
    p.lam()[l] = expf(s1) - expf(s2) + li;
  }
  float* sl = (float*)smem;
  float* red = sl + 3072;
  bool have = false;
  for (int item = bid_(); item < 768; item += gridDim.x) {
    if (!have) {
      for (int i = tid; i < 1024; i += 256) {
        sl[i] = silu_f(p.c[i]); sl[1024 + i] = silu_f(p.c[1024 + i]); sl[2048 + i] = silu_f(p.c_ctx[i]);
      }
      have = true;
      __syncthreads();
    }
    int l = item / 192, n0 = (item % 192) * 32;
    int col = tid & 31, kg = tid >> 5;
    const float* W = p.w_ada + (size_t)l * DM * 6144 + n0 + col;
    float a0 = 0.f, a1 = 0.f, a2 = 0.f;
#pragma unroll 8
    for (int k = kg * 128; k < kg * 128 + 128; ++k) {
      float w = W[(size_t)k * 6144];
      a0 += sl[k] * w; a1 += sl[1024 + k] * w; a2 += sl[2048 + k] * w;
    }
    red[(kg * 3 + 0) * 32 + col] = a0; red[(kg * 3 + 1) * 32 + col] = a1; red[(kg * 3 + 2) * 32 + col] = a2;
    __syncthreads();
    if (tid < 96) {
      int v = tid >> 5, cc = tid & 31;
      float s = p.b_ada[l * 6144 + n0 + cc];
#pragma unroll
      for (int q = 0; q < 8; ++q) s += red[(q * 3 + v) * 32 + cc];
      p.mod()[(size_t)(l * 3 + v) * 6144 + n0 + cc] = s;
    }
    __syncthreads();
  }
}

__device__ __forceinline__ void conv_tile(const float* __restrict__ src, int K, int N, int kt, int nt, __bf16* __restrict__ dst, int dld, int mode,
                          const float* __restrict__ kscale, char* smem) {
  float* tile = (float*)smem;
  const int tid = tid_();
  __syncthreads();
  {
    int r = tid >> 3, c4 = tid & 7;
#pragma unroll
    for (int i = 0; i < 2; ++i) {
      float4 v = *(const float4*)(src + (size_t)(kt * 64 + r + 32 * i) * N + nt * 32 + c4 * 4);
      float* t = tile + (r + 32 * i) * 33 + c4 * 4;
      t[0] = v.x; t[1] = v.y; t[2] = v.z; t[3] = v.w;
    }
  }
  __syncthreads();
  {
    int nr = tid >> 3, kc = tid & 7;
    int n = nt * 32 + nr;
    int row = n;
    if (mode == 1) row = (n >> 4) * 32 + (n & 15);
    else if (mode == 2) row = (n >> 4) * 32 + 16 + (n & 15);
    bf8 o;
#pragma unroll
    for (int j = 0; j < 8; ++j) {
      float v = tile[(kc * 8 + j) * 33 + nr];
      if (kscale) v *= kscale[kt * 64 + kc * 8 + j];
      o[j] = (__bf16)v;
    }
    *(bf8*)(dst + (size_t)row * dld + kt * 64 + kc * 8) = o;
  }
}

__device__ __forceinline__ void conv_item(const Params& p, int l, int it, char* smem) {
  const float* src; int K, N, ntn, mode = 0, dld; __bf16* dst; const float* ks = nullptr;
  if (it < 1872) { src = p.w_in + (size_t)l * DM * INW; K = DM; N = INW; ntn = 117; dst = p.wt_in(); dld = LDH; }
  else if (it < 1920) { it -= 1872; src = p.w_uq + (size_t)l * 256 * 384; K = 256; N = 384; ntn = 12; dst = p.wt_uq(); dld = 256; ks = p.g_q_norm + l * 256; }
  else if (it < 1952) { it -= 1920; src = p.w_ukv + (size_t)l * 128 * 512; K = 128; N = 512; ntn = 16; dst = p.wt_ukv(); dld = 128; ks = p.g_kv_norm + l * 128; }
  else if (it < 2464) { it -= 1952; src = p.w_out + (size_t)l * DM * DM; K = DM; N = DM; ntn = 32; dst = p.wt_out(); dld = LDH; }
  else if (it < 3872) { it -= 2464; src = p.w_gate + (size_t)l * DM * DFF; K = DM; N = DFF; ntn = 88; dst = p.wt_gu(); mode = 1; dld = LDH; }
  else if (it < 5280) { it -= 3872; src = p.w_up + (size_t)l * DM * DFF; K = DM; N = DFF; ntn = 88; dst = p.wt_gu(); mode = 2; dld = LDH; }
  else { it -= 5280; src = p.w_down + (size_t)l * DFF * DM; K = DFF; N = DM; ntn = 32; dst = p.wt_down(); dld = LDF; }
  conv_tile(src, K, N, it / ntn, it % ntn, dst, dld, mode, ks, smem);
}

__device__ __forceinline__ void norm_item(const Params& p, int l, int which, int item) {
  const int lane = tid_() & 63, wave = tid_() >> 6;
  const int tok0 = item * 16 + wave * 4;
  const int b = tok0 / PT, pp = tok0 - b * PT;
  const int v = pp < CTXL ? 2 : b;
  const float* g = (which ? p.g_norm2 : p.g_norm1) + l * DM;
  const float* md = p.mod() + (size_t)(l * 3 + v) * 6144 + (which ? 3072 : 0);
  f4 a[4], sh[4];
#pragma unroll
  for (int i = 0; i < 4; ++i) {
    int k = i * 256 + lane * 4;
    f4 gg = *(const f4*)(g + k), sc = *(const f4*)(md + 1024 + k);
    sh[i] = *(const f4*)(md + k);
    a[i] = gg * (1.f + sc);
  }
  f4 xv[4][4];
#pragma unroll
  for (int r = 0; r < 4; ++r) {
    const float* xr = xrow(p, tok0 + r);
#pragma unroll
    for (int i = 0; i < 4; ++i) xv[r][i] = *(const f4*)(xr + i * 256 + lane * 4);
  }
#pragma unroll
  for (int r = 0; r < 4; ++r) {
    float ss = 0.f;
#pragma unroll
    for (int i = 0; i < 4; ++i)
      ss += xv[r][i][0] * xv[r][i][0] + xv[r][i][1] * xv[r][i][1] + xv[r][i][2] * xv[r][i][2] + xv[r][i][3] * xv[r][i][3];
    ss = wave_sum(ss);
    float rstd = rsqrtf(ss * (1.f / DM) + EPSN);
#pragma unroll
    for (int i = 0; i < 4; ++i) {
      f4 h = xv[r][i] * rstd * a[i] + sh[i];
      bf4 o; o[0] = (__bf16)h[0]; o[1] = (__bf16)h[1]; o[2] = (__bf16)h[2]; o[3] = (__bf16)h[3];
      *(bf4*)(p.hb() + (size_t)(tok0 + r) * LDH + i * 256 + lane * 4) = o;
    }
  }
}

__device__ __forceinline__ void final_norm_item(const Params& p, int item) {
  const int lane = tid_() & 63, wave = tid_() >> 6;
  const int row0 = item * 16 + wave * 4;
  f4 g[4];
#pragma unroll
  for (int i = 0; i < 4; ++i) g[i] = *(const f4*)(p.g_final + i * 256 + lane * 4);
  f4 xv[4][4];
#pragma unroll
  for (int r = 0; r < 4; ++r)
#pragma unroll
    for (int i = 0; i < 4; ++i) xv[r][i] = *(const f4*)(p.out + (size_t)(row0 + r) * DM + i * 256 + lane * 4);
#pragma unroll
  for (int r = 0; r < 4; ++r) {
    float ss = 0.f;
#pragma unroll
    for (int i = 0; i < 4; ++i)
      ss += xv[r][i][0] * xv[r][i][0] + xv[r][i][1] * xv[r][i][1] + xv[r][i][2] * xv[r][i][2] + xv[r][i][3] * xv[r][i][3];
    ss = wave_sum(ss);
    float rstd = rsqrtf(ss * (1.f / DM) + EPSN);
#pragma unroll
    for (int i = 0; i < 4; ++i) *(f4*)(p.out + (size_t)(row0 + r) * DM + i * 256 + lane * 4) = xv[r][i] * rstd * g[i];
  }
}

#define GLD 72
enum { EPI_IN = 0, EPI_UQ, EPI_UKV, EPI_OUT, EPI_UP, EPI_DOWN, EPI_OUT_AT, EPI_DOWN_AT };

__device__ __forceinline__ f4 rope4(const Params& p, f4 a, int prow, int axis, int r) {
  f4 o;
#pragma unroll
  for (int reg = 0; reg < 4; ++reg) {
    float pv = __uint_as_float(__builtin_amdgcn_update_dpp(0u, __float_as_uint(a[reg]), 0x128, 0xf, 0xf, false));
    int t = prow + reg - CTXL;
    int pos = axis ? (t & 63) : (t >> 6);
    float2 cs = ((const float2*)p.rope())[pos * 8 + (r & 7)];
    o[reg] = (r & 8) ? a[reg] * cs.x + pv * cs.y : a[reg] * cs.x - pv * cs.y;
  }
  return o;
}
__device__ __forceinline__ bf4 pack4(f4 a) {
  bf4 o; o[0] = (__bf16)a[0]; o[1] = (__bf16)a[1]; o[2] = (__bf16)a[2]; o[3] = (__bf16)a[3];
  return o;
}

template <int EPI>
__device__ __forceinline__ void gemm_epilogue(const Params& p, int l, f4 (&acc)[4][4], int m0, int n0, int wm, int wn, int lane,
                                              const float* rowss) {
  const int r = lane & 15, g = lane >> 4;
  const int b = m0 / PT;
  const int pp0 = m0 - b * PT;
  const bool lat = pp0 >= CTXL;
  const int v = lat ? b : 2;
  const float* md = p.mod() + (size_t)(l * 3 + v) * 6144;
  const int prow0 = pp0 + wm * 64 + 4 * g;
  const int tok0 = b * PT + prow0;
  constexpr int STEP = (EPI == EPI_UP) ? 2 : 1;
  if constexpr (EPI == EPI_OUT || EPI == EPI_DOWN) {
    const int prow_t = pp0 + wm * 64 + r;
    float* xb = (lat ? p.out + (size_t)(b * SEQ + prow_t - CTXL) * DM : p.xc() + (size_t)(b * CTXL + prow_t) * DM) + n0 + wn * 64 + 4 * g;
    f4 gt[4], xin[4][4];
#pragma unroll
    for (int ni = 0; ni < 4; ++ni) gt[ni] = *(const f4*)(md + (EPI == EPI_OUT ? 2048 : 5120) + n0 + wn * 64 + ni * 16 + 4 * g);
#pragma unroll
    for (int mi = 0; mi < 4; ++mi)
#pragma unroll
      for (int ni = 0; ni < 4; ++ni) xin[mi][ni] = *(const f4*)(xb + (size_t)(mi * 16) * DM + ni * 16);
#pragma unroll
    for (int mi = 0; mi < 4; ++mi)
#pragma unroll
      for (int ni = 0; ni < 4; ++ni) *(f4*)(xb + (size_t)(mi * 16) * DM + ni * 16) = xin[mi][ni] + gt[ni] * acc[mi][ni];
    return;
  }
  float tla[4] = {0.f, 0.f, 0.f, 0.f}, tl1[4] = {0.f, 0.f, 0.f, 0.f};
  if constexpr (EPI == EPI_IN) {
#pragma unroll
    for (int ni = 0; ni < 4; ++ni) {
      const int c0 = n0 + wn * 64 + ni * 16;
      if (c0 >= 1696 && c0 < 2720) {
        const int dir = c0 >= 2208;
        const int n1 = c0 + r - (dir ? 2208 : 1696);
        tla[ni] = p.llb()[(l * 2 + dir) * 512 + n1];
        tl1[ni] = p.l1mlb()[(l * 2 + dir) * 512 + n1];
      }
    }
  }
#pragma unroll 1
  for (int ni = 0; ni < 4; ni += STEP) {
    const int col0 = n0 + wn * 64 + ni * 16;
    const int col = col0 + r;
    if constexpr (EPI == EPI_IN) {
      if (col0 < 384) {
        __bf16* dst = col0 < 256 ? p.cq() + col : p.ckv() + (col - 256);
        const int ld = col0 < 256 ? 256 : 128;
#pragma unroll
        for (int mi = 0; mi < 4; ++mi)
#pragma unroll
          for (int q = 0; q < 4; ++q) dst[(size_t)(tok0 + mi * 16 + q) * ld] = (__bf16)acc[mi][0][q];
      } else if (col0 < 416) {
        f4 v[4];
#pragma unroll
        for (int mi = 0; mi < 4; ++mi) {
          v[mi] = acc[mi][0];
          if (lat) v[mi] = rope4(p, v[mi], prow0 + mi * 16, (col0 - 384) >> 4, r);
        }
#pragma unroll
        for (int mi = 0; mi < 4; ++mi)
#pragma unroll
          for (int h = 0; h < 4; ++h)
#pragma unroll
            for (int q = 0; q < 4; ++q) p.km()[((size_t)(b * 4 + h) * PT + prow0 + mi * 16 + q) * 96 + 64 + col - 384] = (__bf16)v[mi][q];
      } else if (col0 < 928) {
        const bool isq = col0 < 672;
        const int n1 = col - (isq ? 416 : 672);
        const int head = n1 >> 6, map = (n1 >> 5) & 1, d = n1 & 31;
        __bf16* dst = (isq ? p.qd() : p.kd()) + ((size_t)((b * 4 + head) * 2 + map) * PT) * 32 + d;
        const float sc = isq ? 0.17677669529663687f * LOG2E : 1.f;
        f4 v[4];
#pragma unroll
        for (int mi = 0; mi < 4; ++mi) {
          v[mi] = acc[mi][0];
          if (lat) v[mi] = rope4(p, v[mi], prow0 + mi * 16, (n1 >> 4) & 1, r);
        }
#pragma unroll
        for (int mi = 0; mi < 4; ++mi)
#pragma unroll
          for (int q = 0; q < 4; ++q) dst[(size_t)(prow0 + mi * 16 + q) * 32] = (__bf16)(v[mi][q] * sc);
      } else if (col0 < 1184 || (col0 >= 2720 && col0 < 3232)) {
        const bool isd = col0 < 1184;
        const int n1 = col - (isd ? 928 : 2720);
        __bf16* dst = isd ? p.vdt() + ((size_t)(b * 4 + (n1 >> 6)) * 64 + (n1 & 63)) * PT
                          : p.hvt() + ((size_t)(b * 8 + (n1 >> 6)) * 64 + (n1 & 63)) * PT;
#pragma unroll
        for (int mi = 0; mi < 4; ++mi) *(bf4*)(dst + prow0 + mi * 16) = pack4(acc[mi][0]);
      } else if (col0 < 1696 || (col0 >= 3232 && col0 < INW)) {
        const bool ish = col0 < 1696;
        __bf16* dst = ish ? p.hq() + (col - 1184) : p.hg() + (col - 3232);
#pragma unroll
        for (int mi = 0; mi < 4; ++mi)
#pragma unroll
          for (int q = 0; q < 4; ++q) dst[(size_t)(tok0 + mi * 16 + q) * 512] = (__bf16)silu_f(acc[mi][0][q]);
      } else if (col0 < 2720) {
        const int dir = col0 >= 2208;
        const int n1 = col - (dir ? 2208 : 1696);
        const float la = tla[0], l1m = tl1[0];
        float* dst = p.lf() + (size_t)dir * NTOK * 512 + n1;
#pragma unroll
        for (int mi = 0; mi < 4; ++mi)
#pragma unroll
          for (int q = 0; q < 4; ++q) dst[(size_t)(tok0 + mi * 16 + q) * 512] = log_forget(acc[mi][0][q], la, l1m);
      }
    } else if constexpr (EPI == EPI_UQ) {
      const int head = col0 / 96, d0 = col0 - head * 96;
      const float sc = 0.10206207261596577f * LOG2E;
      __bf16* dst = p.qm() + ((size_t)(b * 4 + head) * PT) * 96 + d0 + r;
      f4 v[4];
#pragma unroll
      for (int mi = 0; mi < 4; ++mi) {
        f4 a = acc[mi][0];
#pragma unroll
        for (int q = 0; q < 4; ++q) a[q] *= rsqrtf(rowss[wm * 64 + mi * 16 + 4 * g + q] * (1.f / 256.f) + EPSN);
        if (d0 >= 64 && lat) a = rope4(p, a, prow0 + mi * 16, (d0 - 64) >> 4, r);
        v[mi] = a;
      }
#pragma unroll
      for (int mi = 0; mi < 4; ++mi)
#pragma unroll
        for (int q = 0; q < 4; ++q) dst[(size_t)(prow0 + mi * 16 + q) * 96] = (__bf16)(v[mi][q] * sc);
    } else if constexpr (EPI == EPI_UKV) {
      const int head = col >> 7, d = col & 127;
#pragma unroll
      for (int mi = 0; mi < 4; ++mi) {
        f4 a = acc[mi][0];
        const int prow = prow0 + mi * 16;
#pragma unroll
        for (int q = 0; q < 4; ++q) a[q] *= rsqrtf(rowss[wm * 64 + mi * 16 + 4 * g + q] * (1.f / 128.f) + EPSN);
        if ((col0 & 127) < 64) {
#pragma unroll
          for (int q = 0; q < 4; ++q) p.km()[((size_t)(b * 4 + head) * PT + prow + q) * 96 + d] = (__bf16)a[q];
        } else {
          *(bf4*)(p.vmt() + ((size_t)(b * 4 + head) * 64 + d - 64) * PT + prow) = pack4(a);
        }
      }
    } else if constexpr (EPI == EPI_OUT || EPI == EPI_DOWN) {
    } else if constexpr (EPI == EPI_OUT_AT || EPI == EPI_DOWN_AT) {
      const float gt = md[(EPI == EPI_OUT_AT ? 2048 : 5120) + col];
      float* xb = (lat ? p.out + (size_t)(b * SEQ + prow0 - CTXL) * DM : p.xc() + (size_t)(b * CTXL + prow0) * DM) + col;
#pragma unroll
      for (int mi = 0; mi < 4; ++mi)
#pragma unroll
        for (int q = 0; q < 4; ++q) atomicAdd(xb + (size_t)(mi * 16 + q) * DM, gt * acc[mi][0][q]);
    } else if constexpr (EPI == EPI_UP) {
      const int n = (col0 >> 5) * 16 + r;
#pragma unroll
      for (int mi = 0; mi < 4; ++mi)
#pragma unroll
        for (int q = 0; q < 4; ++q)
          p.act()[(size_t)(tok0 + mi * 16 + q) * LDF + n] = (__bf16)(silu_f(acc[mi][0][q]) * acc[mi][1][q]);
    }
#pragma unroll
    for (int mi = 0; mi < 4; ++mi) {
      if constexpr (STEP == 1) { acc[mi][0] = acc[mi][1]; acc[mi][1] = acc[mi][2]; acc[mi][2] = acc[mi][3]; }
      else { acc[mi][0] = acc[mi][2]; acc[mi][1] = acc[mi][3]; }
    }
    tla[0] = tla[1]; tla[1] = tla[2]; tla[2] = tla[3]; tl1[0] = tl1[1]; tl1[1] = tl1[2]; tl1[2] = tl1[3];
  }
}

#define RAW_BARRIER() do { asm volatile("s_waitcnt lgkmcnt(0)" ::: "memory"); __builtin_amdgcn_s_barrier(); } while (0)

template <int EPI, bool ROWSS>
__device__ __forceinline__ void gemm_tile(const Params& p, int l, const __bf16* __restrict__ A, int lda, const __bf16* __restrict__ Bt, int ldb, int K,
                          int m0, int n0, char* smem, bool pre = false, bool has_next = false, int m0n = 0, int n0n = 0) {
  __bf16* S0 = (__bf16*)smem;
  float* rowss = (float*)(smem + 65536);
  const int tid = tid_(), lane = tid & 63, wave = tid >> 6;
  const int wm = wave >> 1, wn = wave & 1, r = lane & 15, g = lane >> 4;
  f4 acc[4][4];
#pragma unroll
  for (int i = 0; i < 4; ++i)
#pragma unroll
    for (int j = 0; j < 4; ++j) acc[i][j] = f4{0.f, 0.f, 0.f, 0.f};
  if constexpr (ROWSS) {
    const int row = tid >> 1, half = tid & 1;
    const __bf16* rp = A + (size_t)(m0 + row) * lda + half * (K >> 1);
    float sq = 0.f;
    for (int c = 0; c < (K >> 4); ++c) {
      bf8 v = *(const bf8*)(rp + c * 8);
#pragma unroll
      for (int j = 0; j < 8; ++j) { float f = (float)v[j]; sq += f * f; }
    }
    sq += __shfl_xor(sq, 1);
    __syncthreads();
    if (!half) rowss[row] = sq;
  }
  const int lrow = lane >> 3;
  const int sz = (lane >> 4);
  const __bf16* gaw[4]; const __bf16* gbw[4];
#pragma unroll
  for (int i = 0; i < 4; ++i) {
    const int rg = wave + 4 * i;
    const int row = rg * 8 + lrow;
    const int cl = (lane & 7) ^ (((rg & 1) * 4 + sz) & 7);
    gaw[i] = A + (size_t)(m0 + row) * lda + cl * 8;
    gbw[i] = Bt + (size_t)(n0 + row) * ldb + cl * 8;
  }
  const int aoff = (wm * 64 + r) * 64, boff = 8192 + (wn * 64 + r) * 64;
  const int sw = r >> 1;
  const int KT = K / 64;
  if (!pre) {
    __syncthreads();
#pragma unroll
    for (int i = 0; i < 4; ++i) {
      __builtin_amdgcn_global_load_lds((const unsigned*)(gaw[i]), (unsigned*)(S0 + (wave + 4 * i) * 512), 16, 0, 0);
      __builtin_amdgcn_global_load_lds((const unsigned*)(gbw[i]), (unsigned*)(S0 + 8192 + (wave + 4 * i) * 512), 16, 0, 0);
    }
  }
  asm volatile("s_waitcnt vmcnt(0)" ::: "memory");
  RAW_BARRIER();
  for (int kt = 0; kt < KT; ++kt) {
    const __bf16* Sc = S0 + (kt & 1) * 16384;
    __bf16* Sn = S0 + ((kt + 1) & 1) * 16384;
    if (kt + 1 < KT) {
#pragma unroll
      for (int i = 0; i < 4; ++i) {
        __builtin_amdgcn_global_load_lds((const unsigned*)(gaw[i] + (kt + 1) * 64), (unsigned*)(Sn + (wave + 4 * i) * 512), 16, 0, 0);
        __builtin_amdgcn_global_load_lds((const unsigned*)(gbw[i] + (kt + 1) * 64), (unsigned*)(Sn + 8192 + (wave + 4 * i) * 512), 16, 0, 0);
      }
    }
#pragma unroll
    for (int ks = 0; ks < 2; ++ks) {
      bf8 af[4], bfr[4];
      const int ch = ((ks * 4 + g) ^ sw) * 8;
#pragma unroll
      for (int i = 0; i < 4; ++i) {
        af[i] = *(const bf8*)(Sc + aoff + i * 1024 + ch);
        bfr[i] = *(const bf8*)(Sc + boff + i * 1024 + ch);
      }
#pragma unroll
      for (int i = 0; i < 4; ++i)
#pragma unroll
        for (int j = 0; j < 4; ++j) {
          if constexpr (EPI == EPI_OUT || EPI == EPI_DOWN) acc[i][j] = mfma16(bfr[j], af[i], acc[i][j]);
          else acc[i][j] = mfma16(af[i], bfr[j], acc[i][j]);
        }
    }
    asm volatile("s_waitcnt vmcnt(0)" ::: "memory");
    RAW_BARRIER();
  }
  if (has_next) {
#pragma unroll
    for (int i = 0; i < 4; ++i) {
      const int rg = wave + 4 * i;
      const int row = rg * 8 + lrow;
      const int cl = (lane & 7) ^ (((rg & 1) * 4 + sz) & 7);
      __builtin_amdgcn_global_load_lds((const unsigned*)(A + (size_t)(m0n + row) * lda + cl * 8), (unsigned*)(S0 + rg * 512), 16, 0, 0);
      __builtin_amdgcn_global_load_lds((const unsigned*)(Bt + (size_t)(n0n + row) * ldb + cl * 8), (unsigned*)(S0 + 8192 + rg * 512), 16, 0, 0);
    }
  }
  gemm_epilogue<EPI>(p, l, acc, m0, n0, wm, wn, lane, rowss);
}

__device__ __forceinline__ int mtile_count(int l) { return l < 3 ? 132 : 128; }
__device__ __forceinline__ int mtile_index(int l, int i) { return l < 3 ? i : (i >> 6) * 66 + 2 + (i & 63); }

__device__ __forceinline__ bool gemm_pick(int step, int bid, int G, int MT, int NT, int W, int& mt, int& nt) {
  const int C = G >> 3;
  const int L = (step * 8 + (bid & 7)) * C + (bid >> 3);
  if (L >= MT * NT) return false;
  const int s = L / (W * MT), rem = L - s * W * MT;
  mt = rem / W; nt = s * W + (rem - mt * W);
  return true;
}

template <int DQK, int NMAP>
__device__ __forceinline__ void attn_item(const Params& p, int l, const __bf16* __restrict__ Q, const __bf16* __restrict__ Kp,
                          const __bf16* __restrict__ Vt, int b, int h, int q0, int nkeys, char* smem) {
  constexpr int KLD = DQK + 8;
  constexpr int KCH = DQK / 8;
  constexpr int NKC = NMAP * 64 * KCH / 256;
  constexpr int NKS = DQK / 32;
  __bf16* Ks = (__bf16*)smem;
  __bf16* Vs = Ks + NMAP * 64 * KLD;
  const int tid = tid_(), lane = tid & 63, wave = tid >> 6, r = lane & 15, g = lane >> 4;
  const __bf16* Qb = Q + (size_t)((b * 4 + h) * NMAP) * PT * DQK;
  const __bf16* Kb = Kp + (size_t)((b * 4 + h) * NMAP) * PT * DQK;
  const __bf16* Vb = Vt + (size_t)((b * 4 + h) * 64) * PT;

  bf8 qf[NMAP][2][NKS];
#pragma unroll
  for (int mp = 0; mp < NMAP; ++mp)
#pragma unroll
    for (int qt = 0; qt < 2; ++qt)
#pragma unroll
      for (int ks = 0; ks < NKS; ++ks)
        qf[mp][qt][ks] = *(const bf8*)(Qb + ((size_t)mp * PT + q0 + wave * 32 + qt * 16 + r) * DQK + ks * 32 + g * 8);

  f4 o[NMAP][2][4];
  float mrun[NMAP][2], lsum[NMAP][2];
  f4 negm[NMAP][2];
#pragma unroll
  for (int mp = 0; mp < NMAP; ++mp)
#pragma unroll
    for (int qt = 0; qt < 2; ++qt) {
      mrun[mp][qt] = 0.f; lsum[mp][qt] = 0.f; negm[mp][qt] = f4{0.f, 0.f, 0.f, 0.f};
#pragma unroll
      for (int d = 0; d < 4; ++d) o[mp][qt][d] = f4{0.f, 0.f, 0.f, 0.f};
    }

  int koff_g[NKC], koff_s[NKC];
#pragma unroll
  for (int i = 0; i < NKC; ++i) {
    int c = tid + 256 * i;
    int mp = c / (64 * KCH), rem = c - mp * 64 * KCH;
    int row = rem / KCH, kc = rem - row * KCH;
    koff_g[i] = (mp * PT + row) * DQK + kc * 8;
    koff_s[i] = (mp * 64 + row) * KLD + kc * 8;
  }
  bf8 rk[NKC], rv[2];
  const int nkb = nkeys / 64;
#pragma unroll
  for (int i = 0; i < NKC; ++i) rk[i] = *(const bf8*)(Kb + koff_g[i]);
#pragma unroll
  for (int i = 0; i < 2; ++i) rv[i] = *(const bf8*)(Vb + (size_t)((tid >> 3) + 32 * i) * PT + (tid & 7) * 8);

  for (int kb = 0; kb < nkb; ++kb) {
    __syncthreads();
#pragma unroll
    for (int i = 0; i < NKC; ++i) *(bf8*)(Ks + koff_s[i]) = rk[i];
#pragma unroll
    for (int i = 0; i < 2; ++i) *(bf8*)(Vs + ((tid >> 3) + 32 * i) * 72 + (tid & 7) * 8) = rv[i];
    __syncthreads();
    if (kb + 1 < nkb) {
#pragma unroll
      for (int i = 0; i < NKC; ++i) rk[i] = *(const bf8*)(Kb + koff_g[i] + (size_t)(kb + 1) * 64 * DQK);
#pragma unroll
      for (int i = 0; i < 2; ++i) rv[i] = *(const bf8*)(Vb + (size_t)((tid >> 3) + 32 * i) * PT + (kb + 1) * 64 + (tid & 7) * 8);
    }
    f4 s[NMAP][2][2][2];
    __builtin_amdgcn_s_setprio(1);
#pragma unroll
    for (int mp = 0; mp < NMAP; ++mp)
#pragma unroll
      for (int m = 0; m < 2; ++m)
#pragma unroll
        for (int tp = 0; tp < 2; ++tp) {
          f4 s0 = negm[mp][0], s1 = negm[mp][1];
          const int krow = 32 * m + 8 * (r >> 2) + 4 * tp + (r & 3);
#pragma unroll
          for (int ks = 0; ks < NKS; ++ks) {
            bf8 kf = *(const bf8*)(Ks + (mp * 64 + krow) * KLD + ks * 32 + g * 8);
            s0 = mfma16(kf, qf[mp][0][ks], s0);
            s1 = mfma16(kf, qf[mp][1][ks], s1);
          }
          s[mp][0][m][tp] = s0; s[mp][1][m][tp] = s1;
        }
    __builtin_amdgcn_s_setprio(0);
    bf8 pf[NMAP][2][2];
#pragma unroll
    for (int mp = 0; mp < NMAP; ++mp)
#pragma unroll
      for (int qt = 0; qt < 2; ++qt) {
        float ps = 0.f;
#pragma unroll
        for (int m = 0; m < 2; ++m) {
          bf8 pk;
#pragma unroll
          for (int tp = 0; tp < 2; ++tp)
#pragma unroll
            for (int q = 0; q < 4; ++q) {
              float e = __builtin_amdgcn_exp2f(s[mp][qt][m][tp][q]);
              ps += e;
              pk[tp * 4 + q] = (__bf16)e;
            }
          pf[mp][qt][m] = pk;
        }
        const bool hi = __builtin_amdgcn_ballot_w64(!(ps < 65536.f)) != 0ull;
        const bool lo = __builtin_amdgcn_ballot_w64(ps > 0.f || lsum[mp][qt] > 0.f) == 0ull;
        if (hi || lo) {
          float bm = -INFINITY;
#pragma unroll
          for (int m = 0; m < 2; ++m)
#pragma unroll
            for (int tp = 0; tp < 2; ++tp)
#pragma unroll
              for (int q = 0; q < 4; ++q) bm = fmaxf(bm, s[mp][qt][m][tp][q]);
          bm = rows_max(bm);
          const float sh = lo ? bm : fmaxf(bm, 0.f);
          const float alpha = lo ? 1.f : __builtin_amdgcn_exp2f(-sh);
          mrun[mp][qt] += sh;
          const float nm = -mrun[mp][qt];
          negm[mp][qt] = f4{nm, nm, nm, nm};
          lsum[mp][qt] *= alpha;
#pragma unroll
          for (int d = 0; d < 4; ++d) o[mp][qt][d] *= alpha;
          ps = 0.f;
#pragma unroll
          for (int m = 0; m < 2; ++m) {
            bf8 pk;
#pragma unroll
            for (int tp = 0; tp < 2; ++tp)
#pragma unroll
              for (int q = 0; q < 4; ++q) {
                float e = __builtin_amdgcn_exp2f(s[mp][qt][m][tp][q] - sh);
                ps += e;
                pk[tp * 4 + q] = (__bf16)e;
              }
            pf[mp][qt][m] = pk;
          }
        }
        lsum[mp][qt] += ps;
      }
    __builtin_amdgcn_s_setprio(1);
#pragma unroll
    for (int d = 0; d < 4; ++d)
#pragma unroll
      for (int m = 0; m < 2; ++m) {
        bf8 vf = *(const bf8*)(Vs + (d * 16 + r) * 72 + 32 * m + 8 * g);
#pragma unroll
        for (int mp = 0; mp < NMAP; ++mp)
#pragma unroll
          for (int qt = 0; qt < 2; ++qt) o[mp][qt][d] = mfma16(vf, pf[mp][qt][m], o[mp][qt][d]);
      }
    __builtin_amdgcn_s_setprio(0);
  }
#pragma unroll
  for (int qt = 0; qt < 2; ++qt) {
    const int tok = b * PT + q0 + wave * 32 + qt * 16 + r;
    float inv[NMAP];
#pragma unroll
    for (int mp = 0; mp < NMAP; ++mp) {
      float ls = lsum[mp][qt];
      ls = rows_sum(ls);
      inv[mp] = 1.f / ls;
    }
    if constexpr (NMAP == 1) {
#pragma unroll
      for (int d = 0; d < 4; ++d)
        *(bf4*)(p.mix() + (size_t)tok * LDH + h * 64 + d * 16 + 4 * g) = pack4(o[0][qt][d] * inv[0]);
    } else {
      const float lam = p.lam()[l];
      const float li = 0.8f - 0.6f * expf(-0.3f * (float)l);
      f4 val[4];
      float ss = 0.f;
#pragma unroll
      for (int d = 0; d < 4; ++d) {
        val[d] = o[0][qt][d] * inv[0] - o[NMAP - 1][qt][d] * (lam * inv[NMAP - 1]);
        ss += val[d][0] * val[d][0] + val[d][1] * val[d][1] + val[d][2] * val[d][2] + val[d][3] * val[d][3];
      }
      ss = rows_sum(ss);
      const float rs = rsqrtf(ss * (1.f / 64.f) + EPSN) * (1.f - li);
      f4 gd[4];
#pragma unroll
      for (int d = 0; d < 4; ++d) gd[d] = *(const f4*)(p.g_diff_norm + l * 64 + d * 16 + 4 * g);
#pragma unroll
      for (int d = 0; d < 4; ++d) *(bf4*)(p.mix() + (size_t)tok * LDH + 256 + h * 64 + d * 16 + 4 * g) = pack4(val[d] * rs * gd[d]);
    }
  }
}

template <int DQK, int NMAP>
__device__ __forceinline__ void attn_dispatch(const Params& p, int l, int item, const __bf16* Q, const __bf16* K, const __bf16* Vt, char* smem) {
  int b, h, q0, nk;
  if (item < 512) { b = (item >> 2) & 1; h = item & 3; q0 = CTXL + (item >> 3) * 128; nk = PT; }
  else { int it = item - 512; b = it >> 3; h = (it >> 1) & 3; q0 = (it & 1) * 128; nk = CTXL; }
  attn_item<DQK, NMAP>(p, l, Q, K, Vt, b, h, q0, nk, smem);
}

__device__ __forceinline__ void hgrn1_item(const Params& p, int item, char* smem) {
  __bf16* kteT = (__bf16*)smem;
  __bf16* vT = kteT + 64 * 72;
  float* ptot = (float*)(vT + 64 * 72);
  const int tid = tid_(), lane = tid & 63, wave = tid >> 6, r = lane & 15, g = lane >> 4;
  const int c = item % NCH, bh = item / NCH;
  const int b = bh >> 3, h = bh & 7;
  const int tok0 = b * PT + c * 64;
  __syncthreads();
#pragma unroll
  for (int i = 0; i < 2; ++i) {
    int dv = (tid >> 3) + 32 * i;
    *(bf8*)(vT + dv * 72 + (tid & 7) * 8) = *(const bf8*)(p.hvt() + ((size_t)bh * 64 + dv) * PT + c * 64 + (tid & 7) * 8);
  }
  const int k = tid & 63, part = tid >> 6;
  for (int dir = 0; dir < 2; ++dir) {
    float lfv[16], cl[16];
    const float* lfp = p.lf() + ((size_t)dir * NTOK + tok0 + part * 16) * 512 + h * 64 + k;
#pragma unroll
    for (int i = 0; i < 16; ++i) lfv[i] = lfp[(size_t)i * 512];
    float run = 0.f;
    if (dir == 0) {
#pragma unroll
      for (int i = 0; i < 16; ++i) { run += lfv[i]; cl[i] = run; }
    } else {
#pragma unroll
      for (int i = 15; i >= 0; --i) { run += lfv[i]; cl[i] = run; }
    }
    __syncthreads();
    ptot[part * 64 + k] = run;
    __syncthreads();
    float off = 0.f, total = 0.f;
#pragma unroll
    for (int q = 0; q < 4; ++q) {
      float t = ptot[q * 64 + k];
      total += t;
      if (dir == 0 ? (q < part) : (q > part)) off += t;
    }
#pragma unroll
    for (int i = 0; i < 16; ++i) {
      float cum = cl[i] + off;
      float kte = (1.f - __expf(lfv[i])) * __expf(total - cum);
      kteT[k * 72 + part * 16 + i] = (__bf16)kte;
    }
    const size_t sidx = ((size_t)bh * 2 + dir) * NCH + c;
    if (part == 0) p.dk()[sidx * 64 + k] = __expf(total);
    __syncthreads();
    f4 acc[4];
#pragma unroll
    for (int nt = 0; nt < 4; ++nt) acc[nt] = f4{0.f, 0.f, 0.f, 0.f};
#pragma unroll
    for (int ks = 0; ks < 2; ++ks) {
      bf8 af = *(const bf8*)(vT + (wave * 16 + r) * 72 + ks * 32 + g * 8);
#pragma unroll
      for (int nt = 0; nt < 4; ++nt) {
        bf8 bfr = *(const bf8*)(kteT + (nt * 16 + r) * 72 + ks * 32 + g * 8);
        acc[nt] = mfma16(af, bfr, acc[nt]);
      }
    }
    float* up = p.ut() + sidx * 4096;
#pragma unroll
    for (int nt = 0; nt < 4; ++nt)
#pragma unroll
      for (int q = 0; q < 4; ++q) up[(wave * 16 + 4 * g + q) * 64 + nt * 16 + r] = acc[nt][q];
  }
}

__device__ __forceinline__ void hgrn2_item(const Params& p, int item) {
  const int idx = item * 256 + tid_();
  const int e = idx & 4095, sd = idx >> 12;
  const int dir = sd & 1, kk = e & 63;
  const float* up = p.ut() + (size_t)sd * NCH * 4096 + e;
  const float* dp = p.dk() + (size_t)sd * NCH * 64 + kk;
  __bf16* sp = p.st() + (size_t)sd * NCH * 4096 + e;
  float S = 0.f;
  for (int jb = 0; jb < NCH; jb += 22) {
    float u[22], d[22];
    int cc[22];
#pragma unroll
    for (int q = 0; q < 22; ++q) {
      int j = jb + q;
      int c = dir == 0 ? j : (j < 4 ? 3 - j : 135 - j);
      cc[q] = c;
      u[q] = up[(size_t)c * 4096];
      d[q] = dp[c * 64];
    }
#pragma unroll
    for (int q = 0; q < 22; ++q) {
      sp[(size_t)cc[q] * 4096] = (__bf16)S;
      S = d[q] * S + u[q];
    }
  }
}

__device__ __forceinline__ void hgrn3_item(const Params& p, int l, int item, char* smem) {
  __bf16* qS = (__bf16*)smem;
  __bf16* kS = qS + 64 * 72;
  __bf16* vT = kS + 64 * 72;
  __bf16* stS = vT + 64 * 72;
  float* cumS = (float*)(stS + 64 * 72);
  float* ptot = cumS + 64 * 68;
  const int tid = tid_(), lane = tid & 63, wave = tid >> 6, r = lane & 15, g = lane >> 4;
  const int c = item % NCH, bh = item / NCH;
  const int b = bh >> 3, h = bh & 7;
  const int tok0 = b * PT + c * 64;
  __syncthreads();
#pragma unroll
  for (int i = 0; i < 2; ++i) {
    int row = (tid >> 3) + 32 * i;
    *(bf8*)(vT + row * 72 + (tid & 7) * 8) = *(const bf8*)(p.hvt() + ((size_t)bh * 64 + row) * PT + c * 64 + (tid & 7) * 8);
    *(bf8*)(qS + row * 72 + (tid & 7) * 8) = *(const bf8*)(p.hq() + (size_t)(tok0 + row) * 512 + h * 64 + (tid & 7) * 8);
  }
  f4 o[4];
#pragma unroll
  for (int d = 0; d < 4; ++d) o[d] = f4{0.f, 0.f, 0.f, 0.f};
  const int k = tid & 63, part = tid >> 6;
  const int t = 16 * wave + r;
  for (int dir = 0; dir < 2; ++dir) {
    float lfv[16], cl[16];
    const float* lfp = p.lf() + ((size_t)dir * NTOK + tok0 + part * 16) * 512 + h * 64 + k;
#pragma unroll
    for (int i = 0; i < 16; ++i) lfv[i] = lfp[(size_t)i * 512];
    float run = 0.f;
    if (dir == 0) {
#pragma unroll
      for (int i = 0; i < 16; ++i) { run += lfv[i]; cl[i] = run; }
    } else {
#pragma unroll
      for (int i = 15; i >= 0; --i) { run += lfv[i]; cl[i] = run; }
    }
    __syncthreads();
    ptot[part * 64 + k] = run;
#pragma unroll
    for (int i = 0; i < 16; ++i) kS[(part * 16 + i) * 72 + k] = (__bf16)((1.f - __expf(lfv[i])));
    {
      const __bf16* sp = p.st() + (((size_t)bh * 2 + dir) * NCH + c) * 4096;
#pragma unroll
      for (int i = 0; i < 2; ++i) {
        int row = (tid >> 3) + 32 * i;
        *(bf8*)(stS + row * 72 + (tid & 7) * 8) = *(const bf8*)(sp + row * 64 + (tid & 7) * 8);
      }
    }
    __syncthreads();
    float off = 0.f;
#pragma unroll
    for (int q = 0; q < 4; ++q) {
      float tt = ptot[q * 64 + k];
      if (dir == 0 ? (q < part) : (q > part)) off += tt;
    }
#pragma unroll
    for (int i = 0; i < 16; ++i) cumS[(part * 16 + i) * 68 + k] = cl[i] + off;
    __syncthreads();
    float cs[2][8];
    bf8 qtf[2], qhf[2];
#pragma unroll
    for (int ks = 0; ks < 2; ++ks) {
      const int dk0 = ks * 32 + 8 * g;
      bf8 qv = *(const bf8*)(qS + t * 72 + dk0);
#pragma unroll
      for (int j = 0; j < 8; ++j) {
        float cst;
        if (dir == 0) cst = wave > 0 ? cumS[(16 * wave - 1) * 68 + dk0 + j] : 0.f;
        else cst = wave < 3 ? cumS[(16 * wave + 16) * 68 + dk0 + j] : 0.f;
        cs[ks][j] = cst;
        float cv = cumS[t * 68 + dk0 + j];
        float qf_ = (float)qv[j];
        qtf[ks][j] = (__bf16)(qf_ * __expf(cv - cst));
        qhf[ks][j] = (__bf16)(qf_ * __expf(cv));
      }
    }
#pragma unroll
    for (int m = 0; m < 2; ++m) {
      const bool need = dir == 0 ? (m <= (wave >> 1)) : (m >= (wave >> 1));
      if (need) {
        bf8 pf;
#pragma unroll
        for (int tp = 0; tp < 2; ++tp) {
          const int srow = 32 * m + 8 * (r >> 2) + 4 * tp + (r & 3);
          f4 sc = f4{0.f, 0.f, 0.f, 0.f};
#pragma unroll
          for (int ks = 0; ks < 2; ++ks) {
            const int dk0 = ks * 32 + 8 * g;
            bf8 kv = *(const bf8*)(kS + srow * 72 + dk0);
            bf8 ktf;
#pragma unroll
            for (int j = 0; j < 8; ++j) {
              float ex = fminf(cs[ks][j] - cumS[srow * 68 + dk0 + j], 80.f);
              ktf[j] = (__bf16)((float)kv[j] * __expf(ex));
            }
            sc = mfma16(ktf, qtf[ks], sc);
          }
#pragma unroll
          for (int q = 0; q < 4; ++q) {
            const int s = 32 * m + 8 * g + 4 * tp + q;
            const bool keep = dir == 0 ? (s <= t) : (s >= t);
            pf[tp * 4 + q] = keep ? (__bf16)sc[q] : (__bf16)0.f;
          }
        }
#pragma unroll
        for (int d = 0; d < 4; ++d) {
          bf8 vf = *(const bf8*)(vT + (d * 16 + r) * 72 + 32 * m + 8 * g);
          o[d] = mfma16(vf, pf, o[d]);
        }
      }
    }
#pragma unroll
    for (int d = 0; d < 4; ++d)
#pragma unroll
      for (int ks = 0; ks < 2; ++ks) {
        bf8 sf = *(const bf8*)(stS + (d * 16 + r) * 72 + ks * 32 + 8 * g);
        o[d] = mfma16(sf, qhf[ks], o[d]);
      }
  }
  float ss = 0.f;
#pragma unroll
  for (int d = 0; d < 4; ++d) ss += o[d][0] * o[d][0] + o[d][1] * o[d][1] + o[d][2] * o[d][2] + o[d][3] * o[d][3];
  ss = rows_sum(ss);
  const float rs = rsqrtf(ss * (1.f / 64.f) + EPSN);
  f4 gn[4]; bf4 gate[4];
#pragma unroll
  for (int d = 0; d < 4; ++d) {
    gn[d] = *(const f4*)(p.g_hgrn_norm + l * 64 + d * 16 + 4 * g);
    gate[d] = *(const bf4*)(p.hg() + (size_t)(tok0 + t) * 512 + h * 64 + d * 16 + 4 * g);
  }
#pragma unroll
  for (int d = 0; d < 4; ++d) {
    f4 res;
#pragma unroll
    for (int q = 0; q < 4; ++q) res[q] = o[d][q] * rs * gn[d][q] * (float)gate[d][q];
    *(bf4*)(p.mix() + (size_t)(tok0 + t) * LDH + 512 + h * 64 + d * 16 + 4 * g) = pack4(res);
  }
}

#define NPHASE 38
#ifndef ONLY
#define ONLY -1
#endif
#define PHEN(x) (ONLY < 0 || ONLY == (x))
__device__ __forceinline__ void run_phase(const Params& p, int ph, char* smem) {
  const int bid = bid_(), G = gridDim.x;
  if (ph == 0) { if (PHEN(100)) phase0(p, smem); return; }
  if (ph == NPHASE - 1) {
    for (int it = bid; it < NB * SEQ / 16; it += G) final_norm_item(p, it);
    return;
  }
  const int l = (ph - 1) / 9, sp = (ph - 1) % 9;
  const int nmt = mtile_count(l);
  switch (sp) {
    case 0: if (PHEN(0)) {
      for (int i = bid * 256 + tid_(); i < (INWP - INW) * DM / 8; i += G * 256) {
        bf8 z;
#pragma unroll
        for (int j = 0; j < 8; ++j) z[j] = (__bf16)0.f;
        *(bf8*)(p.wt_in() + (size_t)(INW + (i >> 7)) * LDH + (size_t)(i & 127) * 8) = z;
      }
      for (int it = bid; it < 1056 + 6688; it += G) {
        if (it < 1056) norm_item(p, l, 0, it);
        else conv_item(p, l, it - 1056, smem);
      }
    } break;
    case 1: if (PHEN(1)) {
      {
        int mt, nt, mtn = 0, ntn = 0;
        bool have = gemm_pick(0, bid, G, 132, 30, 10, mt, nt), pre = false;
        for (int st = 0; have; ++st) {
          const bool hn = gemm_pick(st + 1, bid, G, 132, 30, 10, mtn, ntn);
          gemm_tile<EPI_IN, false>(p, l, p.hb(), LDH, p.wt_in(), LDH, DM, mt * 128, nt * 128, smem, pre, hn, mtn * 128, ntn * 128);
          pre = hn; have = hn; mt = mtn; nt = ntn;
        }
      }
    } break;
    case 2: if (PHEN(2)) {
      for (int it = bid; it < 396 + 528 + 2112; it += G) {
        if (it < 396) gemm_tile<EPI_UQ, true>(p, l, p.cq(), 256, p.wt_uq(), 256, 256, (it / 3) * 128, (it % 3) * 128, smem);
        else if (it < 924) { int j = it - 396; gemm_tile<EPI_UKV, true>(p, l, p.ckv(), 128, p.wt_ukv(), 128, 128, (j / 4) * 128, (j % 4) * 128, smem); }
        else hgrn1_item(p, it - 924, smem);
      }
    } break;
    case 3: if (PHEN(3)) {
      const int natt = l < 3 ? 528 : 512;
      const int total = 512 + natt, K = (total + G - 1) / G;
      const bool flip = (bid >> 3) & 1;
      for (int kk = 0; kk < K; ++kk) {
        const int k = flip ? (kk + 1 == K ? 0 : kk + 1) : kk;
        const int it = bid + k * G;
        if (it >= total) continue;
        if (it < 512) hgrn2_item(p, it);
        else attn_dispatch<32, 2>(p, l, it - 512, p.qd(), p.kd(), p.vdt(), smem);
      }
    } break;
    case 4: if (PHEN(4)) {
      const int natt = l < 3 ? 528 : 512;
      const int total = natt + 2112, K = (total + G - 1) / G;
      const bool flip = (bid >> 3) & 1;
      for (int kk = 0; kk < K; ++kk) {
        const int k = flip ? (kk + 1 == K ? 0 : kk + 1) : kk;
        const int it = bid + k * G;
        if (it >= total) continue;
        if (it < natt) attn_dispatch<96, 1>(p, l, it, p.qm(), p.km(), p.vmt(), smem);
        else {
          int j = it - natt;
          if (l == 3 && (j % NCH) < 4) continue;
          hgrn3_item(p, l, j, smem);
        }
      }
    } break;
    case 5: if (PHEN(5)) {
      {
        int mt, nt, mtn = 0, ntn = 0;
        bool have = gemm_pick(0, bid, G, 128, 8, 8, mt, nt), pre = false;
        for (int st = 0; have; ++st) {
          const bool hn = gemm_pick(st + 1, bid, G, 128, 8, 8, mtn, ntn);
          gemm_tile<EPI_OUT, false>(p, l, p.mix(), LDH, p.wt_out(), LDH, DM, mtile_index(3, mt) * 128, nt * 128, smem, pre, hn,
                                    mtile_index(3, mtn) * 128, ntn * 128);
          pre = hn; have = hn; mt = mtn; nt = ntn;
        }
      }
      if (l < 3) {
        for (int u = bid; u < 32 * 8; u += G) {
          const int tile = u >> 3, sp = u & 7;
          const int cm = tile >> 3, nt = tile & 7;
          const int mt = (cm >> 1) * 66 + (cm & 1);
          gemm_tile<EPI_OUT_AT, false>(p, l, p.mix() + sp * 128, LDH, p.wt_out() + sp * 128, LDH, 128, mt * 128, nt * 128, smem);
        }
      }
    } break;
    case 6: if (PHEN(6)) {
      for (int it = bid; it < 1056; it += G) norm_item(p, l, 1, it);
    } break;
    case 7: if (PHEN(7)) {
      {
        int mt, nt, mtn = 0, ntn = 0;
        bool have = gemm_pick(0, bid, G, nmt, 44, 11, mt, nt), pre = false;
        for (int st = 0; have; ++st) {
          const bool hn = gemm_pick(st + 1, bid, G, nmt, 44, 11, mtn, ntn);
          gemm_tile<EPI_UP, false>(p, l, p.hb(), LDH, p.wt_gu(), LDH, DM, mtile_index(l, mt) * 128, nt * 128, smem, pre, hn,
                                   mtile_index(l, mtn) * 128, ntn * 128);
          pre = hn; have = hn; mt = mtn; nt = ntn;
        }
      }
    } break;
    case 8: if (PHEN(8)) {
      {
        int mt, nt, mtn = 0, ntn = 0;
        bool have = gemm_pick(0, bid, G, 128, 8, 8, mt, nt), pre = false;
        for (int st = 0; have; ++st) {
          const bool hn = gemm_pick(st + 1, bid, G, 128, 8, 8, mtn, ntn);
          gemm_tile<EPI_DOWN, false>(p, l, p.act(), LDF, p.wt_down(), LDF, DFF, mtile_index(3, mt) * 128, nt * 128, smem, pre, hn,
                                     mtile_index(3, mtn) * 128, ntn * 128);
          pre = hn; have = hn; mt = mtn; nt = ntn;
        }
      }
      if (l < 3) {
        for (int u = bid; u < 32 * 11; u += G) {
          const int tile = u / 11, sp = u - tile * 11;
          const int cm = tile >> 3, nt = tile & 7;
          const int mt = (cm >> 1) * 66 + (cm & 1);
          gemm_tile<EPI_DOWN_AT, false>(p, l, p.act() + sp * 256, LDF, p.wt_down() + sp * 256, LDF, 256, mt * 128, nt * 128, smem);
        }
      }
    } break;
  }
}

#define XB_TMO      128
#define XB_XCNT(j)  (256  + 64 * (j))
#define XB_XSUB(j)  (1280 + 64 * (j))
#define XB_XGEN(j)  (2304 + 64 * (j))
#define XB_TOP      3328
#define XB_TOPGEN   3392
#define XCD_BAR_WORDS 3456
#define XB_SPIN_CAP (1u << 22)
#define LAS __attribute__((address_space(3)))

__device__ __forceinline__ unsigned xb_ld(unsigned* p)              { return __hip_atomic_load(p, __ATOMIC_RELAXED, __HIP_MEMORY_SCOPE_AGENT); }
__device__ __forceinline__ unsigned xb_add(unsigned* p, unsigned v) { return __hip_atomic_fetch_add(p, v, __ATOMIC_RELAXED, __HIP_MEMORY_SCOPE_AGENT); }
__device__ __forceinline__ unsigned xb_xcc_id() { return (unsigned)__builtin_amdgcn_s_getreg((3 << 11) | 20) & 0xFu; }
#define XB_SPIN(cond, bar) do { unsigned _sp = 0; while (cond) { __builtin_amdgcn_s_sleep(1); \
    if ((++_sp & 255u) == 0u) { if (xb_ld(&(bar)[XB_TMO])) break; if (_sp > XB_SPIN_CAP) { atomicAdd(&(bar)[XB_TMO], 1u); break; } } } } while (0)

struct XcdBarrier {
    unsigned* bar; unsigned x;
    volatile LAS unsigned* st;
};

__device__ __forceinline__ XcdBarrier xcd_barrier_post(unsigned* bar, volatile LAS unsigned* st) {
    XcdBarrier b; b.bar = bar; b.x = xb_xcc_id(); b.st = st;
    if (threadIdx.x == 0) (void)xb_add(&bar[XB_XCNT(b.x)], 1u);
    return b;
}
__device__ __forceinline__ void xcd_barrier_complete(unsigned* bar, unsigned x, unsigned& nloc, unsigned& nx) {
    const unsigned G = gridDim.x * gridDim.y * gridDim.z;
    unsigned sum, cnt, mine, sp = 0u;
    for (;;) {
        sum = 0u; cnt = 0u; mine = 0u;
#pragma unroll
        for (unsigned j = 0; j < 16; ++j) { const unsigned c = xb_ld(&bar[XB_XCNT(j)]); sum += c; cnt += (c > 0u) ? 1u : 0u; mine = (j == x) ? c : mine; }
        if (sum == G) break;
        __builtin_amdgcn_s_sleep(1);
        if ((++sp & 255u) == 0u) { if (xb_ld(&bar[XB_TMO])) break; if (sp > XB_SPIN_CAP) { atomicAdd(&bar[XB_TMO], 1u); break; } }
    }
    nloc = mine > 0u ? mine : 1u; nx = cnt > 0u ? cnt : 1u;
}

__device__ __forceinline__ void xcd_barrier(const XcdBarrier& b) {
    asm volatile("s_waitcnt vmcnt(0)" ::: "memory");
    __syncthreads();
    if (threadIdx.x == 0) {
        unsigned* bar = b.bar;
        __builtin_amdgcn_s_waitcnt(0);
        unsigned nloc = b.st[0], nx = b.st[1];
        if (nloc == 0u) { xcd_barrier_complete(bar, b.x, nloc, nx); b.st[0] = nloc; b.st[1] = nx; }
        const unsigned old = xb_add(&bar[XB_XSUB(b.x)], 1u);
        const unsigned gen = old / nloc;
        if (old + 1u == (gen + 1u) * nloc) {
            __builtin_amdgcn_fence(__ATOMIC_RELEASE, "agent");
            asm volatile("s_waitcnt vmcnt(0)" ::: "memory");
            const unsigned og = xb_add(&bar[XB_TOP], 1u);
            const unsigned tg = og / nx;
            if (og + 1u == (tg + 1u) * nx) xb_add(&bar[XB_TOPGEN], 1u);
            else XB_SPIN(xb_ld(&bar[XB_TOPGEN]) == tg, bar);
            __builtin_amdgcn_fence(__ATOMIC_ACQUIRE, "agent");
            xb_add(&bar[XB_XGEN(b.x)], 1u);
            asm volatile("s_waitcnt vmcnt(0)" ::: "memory");
        } else {
            XB_SPIN(xb_ld(&bar[XB_XGEN(b.x)]) == gen, bar);
            __builtin_amdgcn_fence(__ATOMIC_ACQUIRE, "agent");
            asm volatile("s_waitcnt vmcnt(0)" ::: "memory");
        }
    }
    __syncthreads();
}


__device__ __forceinline__ void grid_barrier(unsigned* cnt, unsigned target) {
  asm volatile("s_waitcnt vmcnt(0)" ::: "memory");
  __syncthreads();
  if (tid_() == 0) {
    __builtin_amdgcn_fence(__ATOMIC_RELEASE, "agent");
    asm volatile("s_waitcnt vmcnt(0)" ::: "memory");
    __hip_atomic_fetch_add(cnt, 1u, __ATOMIC_RELAXED, __HIP_MEMORY_SCOPE_AGENT);
    unsigned spins = 0;
    while (__hip_atomic_load(cnt, __ATOMIC_RELAXED, __HIP_MEMORY_SCOPE_AGENT) < target) {
      __builtin_amdgcn_s_sleep(2);
      if (++spins > (1u << 24)) break;
    }
    __builtin_amdgcn_fence(__ATOMIC_ACQUIRE, "agent");
    asm volatile("s_waitcnt vmcnt(0)" ::: "memory");
  }
  __syncthreads();
}

__global__ void __launch_bounds__(256, 2) hybrid_megakernel(Params p, int ph0, int ph1) {
  __shared__ __attribute__((aligned(16))) char smem[SMEM_BYTES];
  cg::grid_group grid = cg::this_grid();
  volatile LAS unsigned* xst = (volatile LAS unsigned*)(smem + 66048);
  if (__builtin_amdgcn_workitem_id_x() == 0) { xst[0] = 0u; xst[1] = 0u; }
  __syncthreads();
  XcdBarrier xb; xb.bar = nullptr; xb.x = 0; xb.st = xst;
  for (int ph = ph0; ph < ph1; ++ph) {
    Params q = p;
    size_t zoff = 0;
    asm volatile("" : "+s"(zoff));
    q.ws = p.ws + zoff; q.out = p.out + zoff;
    run_phase(q, ph, smem);
#ifdef REPMASK
    if (ph > 0 && ph < NPHASE - 1 && ((REPMASK >> ((ph - 1) % 9)) & 1)) { grid.sync(); run_phase(q, ph, smem); }
#endif
    if (ph + 1 < ph1) {
      if (ph == ph0) { grid.sync(); xb = xcd_barrier_post((unsigned*)(p.ws + OFF_xbar), xst); }
      else xcd_barrier(xb);
    }
  }
}

extern "C" void kernel_launch(void* const* d_in, const int* in_sizes, int n_in, void* d_out, int out_size, void* d_ws,
                              size_t ws_size, hipStream_t stream) {
  static int grid_blocks = 0;
  if (!grid_blocks) {
    int dev = 0, cus = 0, per_cu = 0;
    hipGetDevice(&dev);
    hipDeviceGetAttribute(&cus, hipDeviceAttributeMultiprocessorCount, dev);
    hipOccupancyMaxActiveBlocksPerMultiprocessor(&per_cu, hybrid_megakernel, 256, 0);
    if (per_cu > 2) per_cu = 2;
    if (per_cu < 1) per_cu = 1;
    grid_blocks = cus * per_cu;
  }
  Params p{};
  const float* const* in = (const float* const*)d_in;
  p.x = in[0]; p.c = in[1]; p.ctx = in[2]; p.c_ctx = in[3]; p.w_ada = in[4]; p.b_ada = in[5]; p.g_norm1 = in[6];
  p.g_norm2 = in[7]; p.w_in = in[8]; p.g_q_norm = in[9]; p.w_uq = in[10]; p.g_kv_norm = in[11]; p.w_ukv = in[12];
  p.diff_lambda = in[13]; p.g_diff_norm = in[14]; p.hgrn_lb = in[15]; p.g_hgrn_norm = in[16]; p.w_out = in[17];
  p.w_gate = in[18]; p.w_up = in[19]; p.w_down = in[20]; p.g_final = in[21];
  p.out = (float*)d_out;
  p.ws = (char*)d_ws;
  if (WS_TOTAL > ws_size) { fprintf(stderr, "workspace too small: need %zu have %zu\n", (size_t)WS_TOTAL, ws_size); return; }
  int ph0 = 0, ph1 = NPHASE;
  void* args[] = {&p, &ph0, &ph1};
  hipError_t e = hipLaunchCooperativeKernel((void*)hybrid_megakernel, dim3(grid_blocks), dim3(256), args, 0, stream);
  if (e != hipSuccess) fprintf(stderr, "cooperative launch failed: %s (grid %d)\n", hipGetErrorString(e), grid_blocks);
}
```

```cpp
#include <hip/hip_runtime.h>
#include <hip/hip_cooperative_groups.h>
#include <cstdio>
namespace cg = cooperative_groups;

typedef __attribute__((ext_vector_type(8))) __bf16 bf8;
typedef __attribute__((ext_vector_type(4))) __bf16 bf4;
typedef __attribute__((ext_vector_type(4))) float f4;

#define XCD_BAR_WORDS_C 3456
#define NB 2
#define SEQ 8192
#define CTXL 256
#define PT 8448
#define NTOK 16896
#define DM 1024
#define INW 3744
#define INWP 3840
#define DFF 2816
#define NCH 132
#define LDH 1088
#define LDF 2880
#define LOG2E 1.4426950408889634f
#define EPSN 1e-6f
#define SMEM_BYTES 66064

constexpr size_t al256(size_t x) { return (x + 255) & ~(size_t)255; }
constexpr size_t OFF_xc = 0;
constexpr size_t OFF_mod = OFF_xc + al256((size_t)NB*CTXL*DM*4);
constexpr size_t OFF_rope = OFF_mod + al256((size_t)4*3*6144*4);
constexpr size_t OFF_llb = OFF_rope + al256(128*8*2*4);
constexpr size_t OFF_l1mlb = OFF_llb + al256(4*1024*4);
constexpr size_t OFF_lam = OFF_l1mlb + al256(4*1024*4);
constexpr size_t OFF_wt_in = OFF_lam + al256(256);
constexpr size_t OFF_wt_uq = OFF_wt_in + al256((size_t)INWP*LDH*2);
constexpr size_t OFF_wt_ukv = OFF_wt_uq + al256((size_t)384*256*2);
constexpr size_t OFF_wt_out = OFF_wt_ukv + al256((size_t)512*128*2);
constexpr size_t OFF_wt_gu = OFF_wt_out + al256((size_t)DM*LDH*2);
constexpr size_t OFF_wt_down = OFF_wt_gu + al256((size_t)2*DFF*LDH*2);
constexpr size_t OFF_hb = OFF_wt_down + al256((size_t)DM*LDF*2);
constexpr size_t OFF_cq = OFF_hb + al256((size_t)NTOK*LDH*2);
constexpr size_t OFF_ckv = OFF_cq + al256((size_t)NTOK*256*2);
constexpr size_t OFF_qm = OFF_ckv + al256((size_t)NTOK*128*2);
constexpr size_t OFF_km = OFF_qm + al256((size_t)NB*4*PT*96*2);
constexpr size_t OFF_vmt = OFF_km + al256((size_t)NB*4*PT*96*2);
constexpr size_t OFF_qd = OFF_vmt + al256((size_t)NB*4*64*PT*2);
constexpr size_t OFF_kd = OFF_qd + al256((size_t)NB*4*2*PT*32*2);
constexpr size_t OFF_vdt = OFF_kd + al256((size_t)NB*4*2*PT*32*2);
constexpr size_t OFF_hq = OFF_vdt + al256((size_t)NB*4*64*PT*2);
constexpr size_t OFF_hvt = OFF_hq + al256((size_t)NTOK*512*2);
constexpr size_t OFF_hg = OFF_hvt + al256((size_t)NB*8*64*PT*2);
constexpr size_t OFF_dk = OFF_hg + al256((size_t)NTOK*512*2);
constexpr size_t OFF_st = OFF_dk + al256((size_t)NB*8*2*NCH*64*4);
constexpr size_t OFF_lf = OFF_st + al256((size_t)NB*8*2*NCH*4096*2);
constexpr size_t OFF_ut = OFF_lf + al256((size_t)2*NTOK*512*4);
constexpr size_t OFF_xbar = OFF_ut + al256((size_t)NB*8*2*NCH*4096*4);
constexpr size_t WS_TOTAL_OLD = OFF_ut + al256((size_t)NB*8*2*NCH*4096*4);
constexpr size_t WS_TOTAL = OFF_xbar + al256((size_t)XCD_BAR_WORDS_C*4);
struct Params {
  const float *x, *c, *ctx, *c_ctx, *w_ada, *b_ada, *g_norm1, *g_norm2, *w_in, *g_q_norm, *w_uq, *g_kv_norm, *w_ukv,
      *diff_lambda, *g_diff_norm, *hgrn_lb, *g_hgrn_norm, *w_out, *w_gate, *w_up, *w_down, *g_final;
  float* out;
  char* ws;
  __device__ __forceinline__ float* xc() const { return (float*)(ws + OFF_xc); }
  __device__ __forceinline__ float* mod() const { return (float*)(ws + OFF_mod); }
  __device__ __forceinline__ float* rope() const { return (float*)(ws + OFF_rope); }
  __device__ __forceinline__ float* llb() const { return (float*)(ws + OFF_llb); }
  __device__ __forceinline__ float* l1mlb() const { return (float*)(ws + OFF_l1mlb); }
  __device__ __forceinline__ float* lam() const { return (float*)(ws + OFF_lam); }
  __device__ __forceinline__ __bf16* wt_in() const { return (__bf16*)(ws + OFF_wt_in); }
  __device__ __forceinline__ __bf16* wt_uq() const { return (__bf16*)(ws + OFF_wt_uq); }
  __device__ __forceinline__ __bf16* wt_ukv() const { return (__bf16*)(ws + OFF_wt_ukv); }
  __device__ __forceinline__ __bf16* wt_out() const { return (__bf16*)(ws + OFF_wt_out); }
  __device__ __forceinline__ __bf16* wt_gu() const { return (__bf16*)(ws + OFF_wt_gu); }
  __device__ __forceinline__ __bf16* wt_down() const { return (__bf16*)(ws + OFF_wt_down); }
  __device__ __forceinline__ __bf16* hb() const { return (__bf16*)(ws + OFF_hb); }
  __device__ __forceinline__ __bf16* cq() const { return (__bf16*)(ws + OFF_cq); }
  __device__ __forceinline__ __bf16* ckv() const { return (__bf16*)(ws + OFF_ckv); }
  __device__ __forceinline__ __bf16* qm() const { return (__bf16*)(ws + OFF_qm); }
  __device__ __forceinline__ __bf16* km() const { return (__bf16*)(ws + OFF_km); }
  __device__ __forceinline__ __bf16* vmt() const { return (__bf16*)(ws + OFF_vmt); }
  __device__ __forceinline__ __bf16* qd() const { return (__bf16*)(ws + OFF_qd); }
  __device__ __forceinline__ __bf16* kd() const { return (__bf16*)(ws + OFF_kd); }
  __device__ __forceinline__ __bf16* vdt() const { return (__bf16*)(ws + OFF_vdt); }
  __device__ __forceinline__ __bf16* hq() const { return (__bf16*)(ws + OFF_hq); }
  __device__ __forceinline__ __bf16* hvt() const { return (__bf16*)(ws + OFF_hvt); }
  __device__ __forceinline__ __bf16* hg() const { return (__bf16*)(ws + OFF_hg); }
  __device__ __forceinline__ float* dk() const { return (float*)(ws + OFF_dk); }
  __device__ __forceinline__ __bf16* st() const { return (__bf16*)(ws + OFF_st); }
  __device__ __forceinline__ float* lf() const { return (float*)(ws + OFF_lf); }
  __device__ __forceinline__ float* ut() const { return (float*)(ws + OFF_ut); }
  __device__ __forceinline__ __bf16* mix() const { return hb(); }
  __device__ __forceinline__ __bf16* act() const { return (__bf16*)lf(); }
};

__device__ __forceinline__ int tid_() { int t = __builtin_amdgcn_workitem_id_x(); asm volatile("" : "+v"(t)); return t; }
__device__ __forceinline__ int bid_() { int t = __builtin_amdgcn_workgroup_id_x(); asm volatile("" : "+s"(t)); return t; }
__device__ __forceinline__ float silu_f(float x) { return x * __builtin_amdgcn_rcpf(1.f + __expf(-x)); }
__device__ __forceinline__ float wave_sum(float v) {
  v += __uint_as_float(__builtin_amdgcn_update_dpp(0u, __float_as_uint(v), 0x128, 0xf, 0xf, false));
  v += __uint_as_float(__builtin_amdgcn_update_dpp(0u, __float_as_uint(v), 0x124, 0xf, 0xf, false));
  v += __uint_as_float(__builtin_amdgcn_update_dpp(0u, __float_as_uint(v), 0x122, 0xf, 0xf, false));
  v += __uint_as_float(__builtin_amdgcn_update_dpp(0u, __float_as_uint(v), 0x121, 0xf, 0xf, false));
  unsigned u = __float_as_uint(v);
  auto a = __builtin_amdgcn_permlane16_swap(u, u, false, false);
  float m = __uint_as_float(a[0]) + __uint_as_float(a[1]);
  unsigned w = __float_as_uint(m);
  auto b = __builtin_amdgcn_permlane32_swap(w, w, false, false);
  return __uint_as_float(b[0]) + __uint_as_float(b[1]);
}
__device__ __forceinline__ float* xrow(const Params& p, int tok) {
  int b = tok / PT, pp = tok - b * PT;
  return pp < CTXL ? p.xc() + (size_t)(b * CTXL + pp) * DM : p.out + (size_t)(b * SEQ + pp - CTXL) * DM;
}
__device__ __forceinline__ float log_forget(float z, float lb, float oml) {
  const float sg = __builtin_amdgcn_rcpf(1.f + __expf(-fmaxf(z, -80.f)));
  return __logf(lb + oml * sg);
}
__device__ __forceinline__ float rows_max(float x) {
  unsigned u = __float_as_uint(x);
  auto a = __builtin_amdgcn_permlane16_swap(u, u, false, false);
  float m = fmaxf(__uint_as_float(a[0]), __uint_as_float(a[1]));
  unsigned v = __float_as_uint(m);
  auto b = __builtin_amdgcn_permlane32_swap(v, v, false, false);
  return fmaxf(__uint_as_float(b[0]), __uint_as_float(b[1]));
}
__device__ __forceinline__ float rows_sum(float x) {
  unsigned u = __float_as_uint(x);
  auto a = __builtin_amdgcn_permlane16_swap(u, u, false, false);
  float m = __uint_as_float(a[0]) + __uint_as_float(a[1]);
  unsigned v = __float_as_uint(m);
  auto b = __builtin_amdgcn_permlane32_swap(v, v, false, false);
  return __uint_as_float(b[0]) + __uint_as_float(b[1]);
}
__device__ __forceinline__ f4 mfma16(bf8 a, bf8 b, f4 c) { return __builtin_amdgcn_mfma_f32_16x16x32_bf16(a, b, c, 0, 0, 0); }

__device__ __forceinline__ void phase0(const Params& p, char* smem) {
  const int tid = tid_();
  const int gsz = gridDim.x * 256, gtid = bid_() * 256 + tid;
  {
    const float4* xs = (const float4*)p.x; float4* xo = (float4*)p.out;
    for (int i = gtid; i < NB * SEQ * DM / 4; i += gsz) xo[i] = xs[i];
    const float4* cs = (const float4*)p.ctx; float4* co = (float4*)p.xc();
    for (int i = gtid; i < NB * CTXL * DM / 4; i += gsz) co[i] = cs[i];
  }
  if (gtid < 1024) {
    int pos = gtid >> 3, f = gtid & 7;
    float freq = powf(10000.f, -(float)f / 8.f);
    float ang = (float)pos * freq, s, c;
    sincosf(ang, &s, &c);
    p.rope()[gtid * 2] = c; p.rope()[gtid * 2 + 1] = s;
  } else if (gtid < 2048) {
    int n = gtid - 1024;
    float r0 = p.hgrn_lb[n], r1 = p.hgrn_lb[1024 + n], r2 = p.hgrn_lb[2048 + n], r3 = p.hgrn_lb[3072 + n];
    float m = fmaxf(fmaxf(r0, r1), fmaxf(r2, r3));
    float e0 = expf(r0 - m), e1 = expf(r1 - m), e2 = expf(r2 - m), e3 = expf(r3 - m);
    float s = e0 + e1 + e2 + e3;
    float p0 = e0 / s, p1 = e1 / s, p2 = e2 / s, p3 = e3 / s;
    float c0 = p0, c1 = c0 + p1, c2 = c1 + p2, c3 = c2 + p3;
    p.llb()[n] = 0.f; p.l1mlb()[n] = 1.f;
    p.llb()[1024 + n] = c1 - c0; p.l1mlb()[1024 + n] = 1.f - (c1 - c0);
    p.llb()[2048 + n] = c2 - c0; p.l1mlb()[2048 + n] = 1.f - (c2 - c0);
    p.llb()[3072 + n] = c3 - c0; p.l1mlb()[3072 + n] = 1.f - (c3 - c0);
  } else if (gtid >= 4096 && gtid < 4096 + XCD_BAR_WORDS_C) {
    ((unsigned*)(p.ws + OFF_xbar))[gtid - 4096] = 0u;
  } else if (gtid == 2052) {
    *(unsigned*)(p.ws + OFF_lam + 128) = 0u;
  } else if (gtid < 2052) {
    int l = gtid - 2048;
    const float* d = p.diff_lambda + l * 128;
    float s1 = 0.f, s2 = 0.f;
    for (int i = 0; i < 32; ++i) { s1 += d[i] * d[32 + i]; s2 += d[64 + i] * d[96 + i]; }
    float li = 0.8f - 0.6f * expf(-0.3f * (float)l);
    p.lam()[l] = expf(s1) - expf(s2) + li;
  }
  float* sl = (float*)smem;
  float* red = sl + 3072;
  bool have = false;
  for (int item = bid_(); item < 768; item += gridDim.x) {
    if (!have) {
      for (int i = tid; i < 1024; i += 256) {
        sl[i] = silu_f(p.c[i]); sl[1024 + i] = silu_f(p.c[1024 + i]); sl[2048 + i] = silu_f(p.c_ctx[i]);
      }
      have = true;
      __syncthreads();
    }
    int l = item / 192, n0 = (item % 192) * 32;
    int col = tid & 31, kg = tid >> 5;
    const float* W = p.w_ada + (size_t)l * DM * 6144 + n0 + col;
    float a0 = 0.f, a1 = 0.f, a2 = 0.f;
#pragma unroll 8
    for (int k = kg * 128; k < kg * 128 + 128; ++k) {
      float w = W[(size_t)k * 6144];
      a0 += sl[k] * w; a1 += sl[1024 + k] * w; a2 += sl[2048 + k] * w;
    }
    red[(kg * 3 + 0) * 32 + col] = a0; red[(kg * 3 + 1) * 32 + col] = a1; red[(kg * 3 + 2) * 32 + col] = a2;
    __syncthreads();
    if (tid < 96) {
      int v = tid >> 5, cc = tid & 31;
      float s = p.b_ada[l * 6144 + n0 + cc];
#pragma unroll
      for (int q = 0; q < 8; ++q) s += red[(q * 3 + v) * 32 + cc];
      p.mod()[(size_t)(l * 3 + v) * 6144 + n0 + cc] = s;
    }
    __syncthreads();
  }
}

__device__ __forceinline__ void conv_tile(const float* __restrict__ src, int K, int N, int kt, int nt, __bf16* __restrict__ dst, int dld, int mode,
                          const float* __restrict__ kscale, char* smem) {
  float* tile = (float*)smem;
  const int tid = tid_();
  __syncthreads();
  {
    int r = tid >> 3, c4 = tid & 7;
#pragma unroll
    for (int i = 0; i < 2; ++i) {
      float4 v = *(const float4*)(src + (size_t)(kt * 64 + r + 32 * i) * N + nt * 32 + c4 * 4);
      float* t = tile + (r + 32 * i) * 33 + c4 * 4;
      t[0] = v.x; t[1] = v.y; t[2] = v.z; t[3] = v.w;
    }
  }
  __syncthreads();
  {
    int nr = tid >> 3, kc = tid & 7;
    int n = nt * 32 + nr;
    int row = n;
    if (mode == 1) row = (n >> 4) * 32 + (n & 15);
    else if (mode == 2) row = (n >> 4) * 32 + 16 + (n & 15);
    bf8 o;
#pragma unroll
    for (int j = 0; j < 8; ++j) {
      float v = tile[(kc * 8 + j) * 33 + nr];
      if (kscale) v *= kscale[kt * 64 + kc * 8 + j];
      o[j] = (__bf16)v;
    }
    *(bf8*)(dst + (size_t)row * dld + kt * 64 + kc * 8) = o;
  }
}

__device__ __forceinline__ void conv_item(const Params& p, int l, int it, char* smem) {
  const float* src; int K, N, ntn, mode = 0, dld; __bf16* dst; const float* ks = nullptr;
  if (it < 1872) { src = p.w_in + (size_t)l * DM * INW; K = DM; N = INW; ntn = 117; dst = p.wt_in(); dld = LDH; }
  else if (it < 1920) { it -= 1872; src = p.w_uq + (size_t)l * 256 * 384; K = 256; N = 384; ntn = 12; dst = p.wt_uq(); dld = 256; ks = p.g_q_norm + l * 256; }
  else if (it < 1952) { it -= 1920; src = p.w_ukv + (size_t)l * 128 * 512; K = 128; N = 512; ntn = 16; dst = p.wt_ukv(); dld = 128; ks = p.g_kv_norm + l * 128; }
  else if (it < 2464) { it -= 1952; src = p.w_out + (size_t)l * DM * DM; K = DM; N = DM; ntn = 32; dst = p.wt_out(); dld = LDH; }
  else if (it < 3872) { it -= 2464; src = p.w_gate + (size_t)l * DM * DFF; K = DM; N = DFF; ntn = 88; dst = p.wt_gu(); mode = 1; dld = LDH; }
  else if (it < 5280) { it -= 3872; src = p.w_up + (size_t)l * DM * DFF; K = DM; N = DFF; ntn = 88; dst = p.wt_gu(); mode = 2; dld = LDH; }
  else { it -= 5280; src = p.w_down + (size_t)l * DFF * DM; K = DFF; N = DM; ntn = 32; dst = p.wt_down(); dld = LDF; }
  conv_tile(src, K, N, it / ntn, it % ntn, dst, dld, mode, ks, smem);
}

__device__ __forceinline__ void norm_item(const Params& p, int l, int which, int item) {
  const int lane = tid_() & 63, wave = tid_() >> 6;
  const int tok0 = item * 16 + wave * 4;
  const int b = tok0 / PT, pp = tok0 - b * PT;
  const int v = pp < CTXL ? 2 : b;
  const float* g = (which ? p.g_norm2 : p.g_norm1) + l * DM;
  const float* md = p.mod() + (size_t)(l * 3 + v) * 6144 + (which ? 3072 : 0);
  f4 a[4], sh[4];
#pragma unroll
  for (int i = 0; i < 4; ++i) {
    int k = i * 256 + lane * 4;
    f4 gg = *(const f4*)(g + k), sc = *(const f4*)(md + 1024 + k);
    sh[i] = *(const f4*)(md + k);
    a[i] = gg * (1.f + sc);
  }
  f4 xv[4][4];
#pragma unroll
  for (int r = 0; r < 4; ++r) {
    const float* xr = xrow(p, tok0 + r);
#pragma unroll
    for (int i = 0; i < 4; ++i) xv[r][i] = *(const f4*)(xr + i * 256 + lane * 4);
  }
#pragma unroll
  for (int r = 0; r < 4; ++r) {
    float ss = 0.f;
#pragma unroll
    for (int i = 0; i < 4; ++i)
      ss += xv[r][i][0] * xv[r][i][0] + xv[r][i][1] * xv[r][i][1] + xv[r][i][2] * xv[r][i][2] + xv[r][i][3] * xv[r][i][3];
    ss = wave_sum(ss);
    float rstd = rsqrtf(ss * (1.f / DM) + EPSN);
#pragma unroll
    for (int i = 0; i < 4; ++i) {
      f4 h = xv[r][i] * rstd * a[i] + sh[i];
      bf4 o; o[0] = (__bf16)h[0]; o[1] = (__bf16)h[1]; o[2] = (__bf16)h[2]; o[3] = (__bf16)h[3];
      *(bf4*)(p.hb() + (size_t)(tok0 + r) * LDH + i * 256 + lane * 4) = o;
    }
  }
}

__device__ __forceinline__ void final_norm_item(const Params& p, int item) {
  const int lane = tid_() & 63, wave = tid_() >> 6;
  const int row0 = item * 16 + wave * 4;
  f4 g[4];
#pragma unroll
  for (int i = 0; i < 4; ++i) g[i] = *(const f4*)(p.g_final + i * 256 + lane * 4);
  f4 xv[4][4];
#pragma unroll
  for (int r = 0; r < 4; ++r)
#pragma unroll
    for (int i = 0; i < 4; ++i) xv[r][i] = *(const f4*)(p.out + (size_t)(row0 + r) * DM + i * 256 + lane * 4);
#pragma unroll
  for (int r = 0; r < 4; ++r) {
    float ss = 0.f;
#pragma unroll
    for (int i = 0; i < 4; ++i)
      ss += xv[r][i][0] * xv[r][i][0] + xv[r][i][1] * xv[r][i][1] + xv[r][i][2] * xv[r][i][2] + xv[r][i][3] * xv[r][i][3];
    ss = wave_sum(ss);
    float rstd = rsqrtf(ss * (1.f / DM) + EPSN);
#pragma unroll
    for (int i = 0; i < 4; ++i) *(f4*)(p.out + (size_t)(row0 + r) * DM + i * 256 + lane * 4) = xv[r][i] * rstd * g[i];
  }
}

#define GLD 72
enum { EPI_IN = 0, EPI_UQ, EPI_UKV, EPI_OUT, EPI_UP, EPI_DOWN, EPI_OUT_AT, EPI_DOWN_AT };

__device__ __forceinline__ f4 rope4(const Params& p, f4 a, int prow, int axis, int r) {
  f4 o;
#pragma unroll
  for (int reg = 0; reg < 4; ++reg) {
    float pv = __uint_as_float(__builtin_amdgcn_update_dpp(0u, __float_as_uint(a[reg]), 0x128, 0xf, 0xf, false));
    int t = prow + reg - CTXL;
    int pos = axis ? (t & 63) : (t >> 6);
    float2 cs = ((const float2*)p.rope())[pos * 8 + (r & 7)];
    o[reg] = (r & 8) ? a[reg] * cs.x + pv * cs.y : a[reg] * cs.x - pv * cs.y;
  }
  return o;
}
__device__ __forceinline__ bf4 pack4(f4 a) {
  bf4 o; o[0] = (__bf16)a[0]; o[1] = (__bf16)a[1]; o[2] = (__bf16)a[2]; o[3] = (__bf16)a[3];
  return o;
}

template <int EPI>
__device__ __forceinline__ void gemm_epilogue(const Params& p, int l, f4 (&acc)[4][4], int m0, int n0, int wm, int wn, int lane,
                                              const float* rowss) {
  const int r = lane & 15, g = lane >> 4;
  const int b = m0 / PT;
  const int pp0 = m0 - b * PT;
  const bool lat = pp0 >= CTXL;
  const int v = lat ? b : 2;
  const float* md = p.mod() + (size_t)(l * 3 + v) * 6144;
  const int prow0 = pp0 + wm * 64 + 4 * g;
  const int tok0 = b * PT + prow0;
  constexpr int STEP = (EPI == EPI_UP) ? 2 : 1;
  if constexpr (EPI == EPI_OUT || EPI == EPI_DOWN) {
    float* xb = (lat ? p.out + (size_t)(b * SEQ + prow0 - CTXL) * DM : p.xc() + (size_t)(b * CTXL + prow0) * DM) + n0 + wn * 64 + r;
    float gt[4];
    f4 xin[4][4];
#pragma unroll
    for (int ni = 0; ni < 4; ++ni) gt[ni] = md[(EPI == EPI_OUT ? 2048 : 5120) + n0 + wn * 64 + ni * 16 + r];
#pragma unroll
    for (int mi = 0; mi < 4; ++mi)
#pragma unroll
      for (int ni = 0; ni < 4; ++ni)
#pragma unroll
        for (int q = 0; q < 4; ++q) xin[mi][ni][q] = xb[(size_t)(mi * 16 + q) * DM + ni * 16];
#pragma unroll
    for (int mi = 0; mi < 4; ++mi)
#pragma unroll
      for (int ni = 0; ni < 4; ++ni)
#pragma unroll
        for (int q = 0; q < 4; ++q) xb[(size_t)(mi * 16 + q) * DM + ni * 16] = xin[mi][ni][q] + gt[ni] * acc[mi][ni][q];
    return;
  }
  float tla[4] = {0.f, 0.f, 0.f, 0.f}, tl1[4] = {0.f, 0.f, 0.f, 0.f};
  if constexpr (EPI == EPI_IN) {
#pragma unroll
    for (int ni = 0; ni < 4; ++ni) {
      const int c0 = n0 + wn * 64 + ni * 16;
      if (c0 >= 1696 && c0 < 2720) {
        const int dir = c0 >= 2208;
        const int n1 = c0 + r - (dir ? 2208 : 1696);
        tla[ni] = p.llb()[(l * 2 + dir) * 512 + n1];
        tl1[ni] = p.l1mlb()[(l * 2 + dir) * 512 + n1];
      }
    }
  }
#pragma unroll 1
  for (int ni = 0; ni < 4; ni += STEP) {
    const int col0 = n0 + wn * 64 + ni * 16;
    const int col = col0 + r;
    if constexpr (EPI == EPI_IN) {
      if (col0 < 384) {
        __bf16* dst = col0 < 256 ? p.cq() + col : p.ckv() + (col - 256);
        const int ld = col0 < 256 ? 256 : 128;
#pragma unroll
        for (int mi = 0; mi < 4; ++mi)
#pragma unroll
          for (int q = 0; q < 4; ++q) dst[(size_t)(tok0 + mi * 16 + q) * ld] = (__bf16)acc[mi][0][q];
      } else if (col0 < 416) {
        f4 v[4];
#pragma unroll
        for (int mi = 0; mi < 4; ++mi) {
          v[mi] = acc[mi][0];
          if (lat) v[mi] = rope4(p, v[mi], prow0 + mi * 16, (col0 - 384) >> 4, r);
        }
#pragma unroll
        for (int mi = 0; mi < 4; ++mi)
#pragma unroll
          for (int h = 0; h < 4; ++h)
#pragma unroll
            for (int q = 0; q < 4; ++q) p.km()[((size_t)(b * 4 + h) * PT + prow0 + mi * 16 + q) * 96 + 64 + col - 384] = (__bf16)v[mi][q];
      } else if (col0 < 928) {
        const bool isq = col0 < 672;
        const int n1 = col - (isq ? 416 : 672);
        const int head = n1 >> 6, map = (n1 >> 5) & 1, d = n1 & 31;
        __bf16* dst = (isq ? p.qd() : p.kd()) + ((size_t)((b * 4 + head) * 2 + map) * PT) * 32 + d;
        const float sc = isq ? 0.17677669529663687f * LOG2E : 1.f;
        f4 v[4];
#pragma unroll
        for (int mi = 0; mi < 4; ++mi) {
          v[mi] = acc[mi][0];
          if (lat) v[mi] = rope4(p, v[mi], prow0 + mi * 16, (n1 >> 4) & 1, r);
        }
#pragma unroll
        for (int mi = 0; mi < 4; ++mi)
#pragma unroll
          for (int q = 0; q < 4; ++q) dst[(size_t)(prow0 + mi * 16 + q) * 32] = (__bf16)(v[mi][q] * sc);
      } else if (col0 < 1184 || (col0 >= 2720 && col0 < 3232)) {
        const bool isd = col0 < 1184;
        const int n1 = col - (isd ? 928 : 2720);
        __bf16* dst = isd ? p.vdt() + ((size_t)(b * 4 + (n1 >> 6)) * 64 + (n1 & 63)) * PT
                          : p.hvt() + ((size_t)(b * 8 + (n1 >> 6)) * 64 + (n1 & 63)) * PT;
#pragma unroll
        for (int mi = 0; mi < 4; ++mi) *(bf4*)(dst + prow0 + mi * 16) = pack4(acc[mi][0]);
      } else if (col0 < 1696 || (col0 >= 3232 && col0 < INW)) {
        const bool ish = col0 < 1696;
        __bf16* dst = ish ? p.hq() + (col - 1184) : p.hg() + (col - 3232);
#pragma unroll
        for (int mi = 0; mi < 4; ++mi)
#pragma unroll
          for (int q = 0; q < 4; ++q) dst[(size_t)(tok0 + mi * 16 + q) * 512] = (__bf16)silu_f(acc[mi][0][q]);
      } else if (col0 < 2720) {
        const int dir = col0 >= 2208;
        const int n1 = col - (dir ? 2208 : 1696);
        const float la = tla[0], l1m = tl1[0];
        float* dst = p.lf() + (size_t)dir * NTOK * 512 + n1;
#pragma unroll
        for (int mi = 0; mi < 4; ++mi)
#pragma unroll
          for (int q = 0; q < 4; ++q) dst[(size_t)(tok0 + mi * 16 + q) * 512] = log_forget(acc[mi][0][q], la, l1m);
      }
    } else if constexpr (EPI == EPI_UQ) {
      const int head = col0 / 96, d0 = col0 - head * 96;
      const float sc = 0.10206207261596577f * LOG2E;
      __bf16* dst = p.qm() + ((size_t)(b * 4 + head) * PT) * 96 + d0 + r;
      f4 v[4];
#pragma unroll
      for (int mi = 0; mi < 4; ++mi) {
        f4 a = acc[mi][0];
#pragma unroll
        for (int q = 0; q < 4; ++q) a[q] *= rsqrtf(rowss[wm * 64 + mi * 16 + 4 * g + q] * (1.f / 256.f) + EPSN);
        if (d0 >= 64 && lat) a = rope4(p, a, prow0 + mi * 16, (d0 - 64) >> 4, r);
        v[mi] = a;
      }
#pragma unroll
      for (int mi = 0; mi < 4; ++mi)
#pragma unroll
        for (int q = 0; q < 4; ++q) dst[(size_t)(prow0 + mi * 16 + q) * 96] = (__bf16)(v[mi][q] * sc);
    } else if constexpr (EPI == EPI_UKV) {
      const int head = col >> 7, d = col & 127;
#pragma unroll
      for (int mi = 0; mi < 4; ++mi) {
        f4 a = acc[mi][0];
        const int prow = prow0 + mi * 16;
#pragma unroll
        for (int q = 0; q < 4; ++q) a[q] *= rsqrtf(rowss[wm * 64 + mi * 16 + 4 * g + q] * (1.f / 128.f) + EPSN);
        if ((col0 & 127) < 64) {
#pragma unroll
          for (int q = 0; q < 4; ++q) p.km()[((size_t)(b * 4 + head) * PT + prow + q) * 96 + d] = (__bf16)a[q];
        } else {
          *(bf4*)(p.vmt() + ((size_t)(b * 4 + head) * 64 + d - 64) * PT + prow) = pack4(a);
        }
      }
    } else if constexpr (EPI == EPI_OUT || EPI == EPI_DOWN) {
    } else if constexpr (EPI == EPI_OUT_AT || EPI == EPI_DOWN_AT) {
      const float gt = md[(EPI == EPI_OUT_AT ? 2048 : 5120) + col];
      float* xb = (lat ? p.out + (size_t)(b * SEQ + prow0 - CTXL) * DM : p.xc() + (size_t)(b * CTXL + prow0) * DM) + col;
#pragma unroll
      for (int mi = 0; mi < 4; ++mi)
#pragma unroll
        for (int q = 0; q < 4; ++q) atomicAdd(xb + (size_t)(mi * 16 + q) * DM, gt * acc[mi][0][q]);
    } else if constexpr (EPI == EPI_UP) {
      const int n = (col0 >> 5) * 16 + r;
#pragma unroll
      for (int mi = 0; mi < 4; ++mi)
#pragma unroll
        for (int q = 0; q < 4; ++q)
          p.act()[(size_t)(tok0 + mi * 16 + q) * LDF + n] = (__bf16)(silu_f(acc[mi][0][q]) * acc[mi][1][q]);
    }
#pragma unroll
    for (int mi = 0; mi < 4; ++mi) {
      if constexpr (STEP == 1) { acc[mi][0] = acc[mi][1]; acc[mi][1] = acc[mi][2]; acc[mi][2] = acc[mi][3]; }
      else { acc[mi][0] = acc[mi][2]; acc[mi][1] = acc[mi][3]; }
    }
    tla[0] = tla[1]; tla[1] = tla[2]; tla[2] = tla[3]; tl1[0] = tl1[1]; tl1[1] = tl1[2]; tl1[2] = tl1[3];
  }
}

#define RAW_BARRIER() do { asm volatile("s_waitcnt lgkmcnt(0)" ::: "memory"); __builtin_amdgcn_s_barrier(); } while (0)

template <int EPI, bool ROWSS>
__device__ __forceinline__ void gemm_tile(const Params& p, int l, const __bf16* __restrict__ A, int lda, const __bf16* __restrict__ Bt, int ldb, int K,
                          int m0, int n0, char* smem, bool pre = false, bool has_next = false, int m0n = 0, int n0n = 0) {
  __bf16* S0 = (__bf16*)smem;
  float* rowss = (float*)(smem + 65536);
  const int tid = tid_(), lane = tid & 63, wave = tid >> 6;
  const int wm = wave >> 1, wn = wave & 1, r = lane & 15, g = lane >> 4;
  f4 acc[4][4];
#pragma unroll
  for (int i = 0; i < 4; ++i)
#pragma unroll
    for (int j = 0; j < 4; ++j) acc[i][j] = f4{0.f, 0.f, 0.f, 0.f};
  if constexpr (ROWSS) {
    const int row = tid >> 1, half = tid & 1;
    const __bf16* rp = A + (size_t)(m0 + row) * lda + half * (K >> 1);
    float sq = 0.f;
    for (int c = 0; c < (K >> 4); ++c) {
      bf8 v = *(const bf8*)(rp + c * 8);
#pragma unroll
      for (int j = 0; j < 8; ++j) { float f = (float)v[j]; sq += f * f; }
    }
    sq += __shfl_xor(sq, 1);
    __syncthreads();
    if (!half) rowss[row] = sq;
  }
  const int lrow = lane >> 3;
  const int sz = (lane >> 4);
  const __bf16* gaw[4]; const __bf16* gbw[4];
#pragma unroll
  for (int i = 0; i < 4; ++i) {
    const int rg = wave + 4 * i;
    const int row = rg * 8 + lrow;
    const int cl = (lane & 7) ^ (((rg & 1) * 4 + sz) & 7);
    gaw[i] = A + (size_t)(m0 + row) * lda + cl * 8;
    gbw[i] = Bt + (size_t)(n0 + row) * ldb + cl * 8;
  }
  const int aoff = (wm * 64 + r) * 64, boff = 8192 + (wn * 64 + r) * 64;
  const int sw = r >> 1;
  const int KT = K / 64;
  if (!pre) {
    __syncthreads();
#pragma unroll
    for (int i = 0; i < 4; ++i) {
      __builtin_amdgcn_global_load_lds((const unsigned*)(gaw[i]), (unsigned*)(S0 + (wave + 4 * i) * 512), 16, 0, 0);
      __builtin_amdgcn_global_load_lds((const unsigned*)(gbw[i]), (unsigned*)(S0 + 8192 + (wave + 4 * i) * 512), 16, 0, 0);
    }
  }
  asm volatile("s_waitcnt vmcnt(0)" ::: "memory");
  RAW_BARRIER();
  for (int kt = 0; kt < KT; ++kt) {
    const __bf16* Sc = S0 + (kt & 1) * 16384;
    __bf16* Sn = S0 + ((kt + 1) & 1) * 16384;
    if (kt + 1 < KT) {
#pragma unroll
      for (int i = 0; i < 4; ++i) {
        __builtin_amdgcn_global_load_lds((const unsigned*)(gaw[i] + (kt + 1) * 64), (unsigned*)(Sn + (wave + 4 * i) * 512), 16, 0, 0);
        __builtin_amdgcn_global_load_lds((const unsigned*)(gbw[i] + (kt + 1) * 64), (unsigned*)(Sn + 8192 + (wave + 4 * i) * 512), 16, 0, 0);
      }
    }
#pragma unroll
    for (int ks = 0; ks < 2; ++ks) {
      bf8 af[4], bfr[4];
      const int ch = ((ks * 4 + g) ^ sw) * 8;
#pragma unroll
      for (int i = 0; i < 4; ++i) {
        af[i] = *(const bf8*)(Sc + aoff + i * 1024 + ch);
        bfr[i] = *(const bf8*)(Sc + boff + i * 1024 + ch);
      }
#pragma unroll
      for (int i = 0; i < 4; ++i)
#pragma unroll
        for (int j = 0; j < 4; ++j) acc[i][j] = mfma16(af[i], bfr[j], acc[i][j]);
    }
    asm volatile("s_waitcnt vmcnt(0)" ::: "memory");
    RAW_BARRIER();
  }
  if (has_next) {
#pragma unroll
    for (int i = 0; i < 4; ++i) {
      const int rg = wave + 4 * i;
      const int row = rg * 8 + lrow;
      const int cl = (lane & 7) ^ (((rg & 1) * 4 + sz) & 7);
      __builtin_amdgcn_global_load_lds((const unsigned*)(A + (size_t)(m0n + row) * lda + cl * 8), (unsigned*)(S0 + rg * 512), 16, 0, 0);
      __builtin_amdgcn_global_load_lds((const unsigned*)(Bt + (size_t)(n0n + row) * ldb + cl * 8), (unsigned*)(S0 + 8192 + rg * 512), 16, 0, 0);
    }
  }
  gemm_epilogue<EPI>(p, l, acc, m0, n0, wm, wn, lane, rowss);
}

__device__ __forceinline__ int mtile_count(int l) { return l < 3 ? 132 : 128; }
__device__ __forceinline__ int mtile_index(int l, int i) { return l < 3 ? i : (i >> 6) * 66 + 2 + (i & 63); }

__device__ __forceinline__ bool gemm_pick(int step, int bid, int G, int MT, int NT, int W, int& mt, int& nt) {
  const int C = G >> 3;
  const int L = (step * 8 + (bid & 7)) * C + (bid >> 3);
  if (L >= MT * NT) return false;
  const int s = L / (W * MT), rem = L - s * W * MT;
  mt = rem / W; nt = s * W + (rem - mt * W);
  return true;
}

template <int DQK, int NMAP>
__device__ __forceinline__ void attn_item(const Params& p, int l, const __bf16* __restrict__ Q, const __bf16* __restrict__ Kp,
                          const __bf16* __restrict__ Vt, int b, int h, int q0, int nkeys, char* smem) {
  constexpr int KLD = DQK + 8;
  constexpr int KCH = DQK / 8;
  constexpr int NKC = NMAP * 64 * KCH / 256;
  constexpr int NKS = DQK / 32;
  __bf16* Ks = (__bf16*)smem;
  __bf16* Vs = Ks + NMAP * 64 * KLD;
  const int tid = tid_(), lane = tid & 63, wave = tid >> 6, r = lane & 15, g = lane >> 4;
  const __bf16* Qb = Q + (size_t)((b * 4 + h) * NMAP) * PT * DQK;
  const __bf16* Kb = Kp + (size_t)((b * 4 + h) * NMAP) * PT * DQK;
  const __bf16* Vb = Vt + (size_t)((b * 4 + h) * 64) * PT;

  bf8 qf[NMAP][2][NKS];
#pragma unroll
  for (int mp = 0; mp < NMAP; ++mp)
#pragma unroll
    for (int qt = 0; qt < 2; ++qt)
#pragma unroll
      for (int ks = 0; ks < NKS; ++ks)
        qf[mp][qt][ks] = *(const bf8*)(Qb + ((size_t)mp * PT + q0 + wave * 32 + qt * 16 + r) * DQK + ks * 32 + g * 8);

  f4 o[NMAP][2][4];
  float mrun[NMAP][2], lsum[NMAP][2];
  f4 negm[NMAP][2];
#pragma unroll
  for (int mp = 0; mp < NMAP; ++mp)
#pragma unroll
    for (int qt = 0; qt < 2; ++qt) {
      mrun[mp][qt] = 0.f; lsum[mp][qt] = 0.f; negm[mp][qt] = f4{0.f, 0.f, 0.f, 0.f};
#pragma unroll
      for (int d = 0; d < 4; ++d) o[mp][qt][d] = f4{0.f, 0.f, 0.f, 0.f};
    }

  int koff_g[NKC], koff_s[NKC];
#pragma unroll
  for (int i = 0; i < NKC; ++i) {
    int c = tid + 256 * i;
    int mp = c / (64 * KCH), rem = c - mp * 64 * KCH;
    int row = rem / KCH, kc = rem - row * KCH;
    koff_g[i] = (mp * PT + row) * DQK + kc * 8;
    koff_s[i] = (mp * 64 + row) * KLD + kc * 8;
  }
  bf8 rk[NKC], rv[2];
  const int nkb = nkeys / 64;
#pragma unroll
  for (int i = 0; i < NKC; ++i) rk[i] = *(const bf8*)(Kb + koff_g[i]);
#pragma unroll
  for (int i = 0; i < 2; ++i) rv[i] = *(const bf8*)(Vb + (size_t)((tid >> 3) + 32 * i) * PT + (tid & 7) * 8);

  for (int kb = 0; kb < nkb; ++kb) {
    __syncthreads();
#pragma unroll
    for (int i = 0; i < NKC; ++i) *(bf8*)(Ks + koff_s[i]) = rk[i];
#pragma unroll
    for (int i = 0; i < 2; ++i) *(bf8*)(Vs + ((tid >> 3) + 32 * i) * 72 + (tid & 7) * 8) = rv[i];
    __syncthreads();
    if (kb + 1 < nkb) {
#pragma unroll
      for (int i = 0; i < NKC; ++i) rk[i] = *(const bf8*)(Kb + koff_g[i] + (size_t)(kb + 1) * 64 * DQK);
#pragma unroll
      for (int i = 0; i < 2; ++i) rv[i] = *(const bf8*)(Vb + (size_t)((tid >> 3) + 32 * i) * PT + (kb + 1) * 64 + (tid & 7) * 8);
    }
    f4 s[NMAP][2][2][2];
    __builtin_amdgcn_s_setprio(1);
#pragma unroll
    for (int mp = 0; mp < NMAP; ++mp)
#pragma unroll
      for (int m = 0; m < 2; ++m)
#pragma unroll
        for (int tp = 0; tp < 2; ++tp) {
          f4 s0 = negm[mp][0], s1 = negm[mp][1];
          const int krow = 32 * m + 8 * (r >> 2) + 4 * tp + (r & 3);
#pragma unroll
          for (int ks = 0; ks < NKS; ++ks) {
            bf8 kf = *(const bf8*)(Ks + (mp * 64 + krow) * KLD + ks * 32 + g * 8);
            s0 = mfma16(kf, qf[mp][0][ks], s0);
            s1 = mfma16(kf, qf[mp][1][ks], s1);
          }
          s[mp][0][m][tp] = s0; s[mp][1][m][tp] = s1;
        }
    __builtin_amdgcn_s_setprio(0);
    bf8 pf[NMAP][2][2];
#pragma unroll
    for (int mp = 0; mp < NMAP; ++mp)
#pragma unroll
      for (int qt = 0; qt < 2; ++qt) {
        float ps = 0.f;
#pragma unroll
        for (int m = 0; m < 2; ++m) {
          bf8 pk;
#pragma unroll
          for (int tp = 0; tp < 2; ++tp)
#pragma unroll
            for (int q = 0; q < 4; ++q) {
              float e = __builtin_amdgcn_exp2f(s[mp][qt][m][tp][q]);
              ps += e;
              pk[tp * 4 + q] = (__bf16)e;
            }
          pf[mp][qt][m] = pk;
        }
        const bool hi = __builtin_amdgcn_ballot_w64(!(ps < 65536.f)) != 0ull;
        const bool lo = __builtin_amdgcn_ballot_w64(ps > 0.f || lsum[mp][qt] > 0.f) == 0ull;
        if (hi || lo) {
          float bm = -INFINITY;
#pragma unroll
          for (int m = 0; m < 2; ++m)
#pragma unroll
            for (int tp = 0; tp < 2; ++tp)
#pragma unroll
              for (int q = 0; q < 4; ++q) bm = fmaxf(bm, s[mp][qt][m][tp][q]);
          bm = rows_max(bm);
          const float sh = lo ? bm : fmaxf(bm, 0.f);
          const float alpha = lo ? 1.f : __builtin_amdgcn_exp2f(-sh);
          mrun[mp][qt] += sh;
          const float nm = -mrun[mp][qt];
          negm[mp][qt] = f4{nm, nm, nm, nm};
          lsum[mp][qt] *= alpha;
#pragma unroll
          for (int d = 0; d < 4; ++d) o[mp][qt][d] *= alpha;
          ps = 0.f;
#pragma unroll
          for (int m = 0; m < 2; ++m) {
            bf8 pk;
#pragma unroll
            for (int tp = 0; tp < 2; ++tp)
#pragma unroll
              for (int q = 0; q < 4; ++q) {
                float e = __builtin_amdgcn_exp2f(s[mp][qt][m][tp][q] - sh);
                ps += e;
                pk[tp * 4 + q] = (__bf16)e;
              }
            pf[mp][qt][m] = pk;
          }
        }
        lsum[mp][qt] += ps;
      }
    __builtin_amdgcn_s_setprio(1);
#pragma unroll
    for (int d = 0; d < 4; ++d)
#pragma unroll
      for (int m = 0; m < 2; ++m) {
        bf8 vf = *(const bf8*)(Vs + (d * 16 + r) * 72 + 32 * m + 8 * g);
#pragma unroll
        for (int mp = 0; mp < NMAP; ++mp)
#pragma unroll
          for (int qt = 0; qt < 2; ++qt) o[mp][qt][d] = mfma16(vf, pf[mp][qt][m], o[mp][qt][d]);
      }
    __builtin_amdgcn_s_setprio(0);
  }
#pragma unroll
  for (int qt = 0; qt < 2; ++qt) {
    const int tok = b * PT + q0 + wave * 32 + qt * 16 + r;
    float inv[NMAP];
#pragma unroll
    for (int mp = 0; mp < NMAP; ++mp) {
      float ls = lsum[mp][qt];
      ls = rows_sum(ls);
      inv[mp] = 1.f / ls;
    }
    if constexpr (NMAP == 1) {
#pragma unroll
      for (int d = 0; d < 4; ++d)
        *(bf4*)(p.mix() + (size_t)tok * LDH + h * 64 + d * 16 + 4 * g) = pack4(o[0][qt][d] * inv[0]);
    } else {
      const float lam = p.lam()[l];
      const float li = 0.8f - 0.6f * expf(-0.3f * (float)l);
      f4 val[4];
      float ss = 0.f;
#pragma unroll
      for (int d = 0; d < 4; ++d) {
        val[d] = o[0][qt][d] * inv[0] - o[NMAP - 1][qt][d] * (lam * inv[NMAP - 1]);
        ss += val[d][0] * val[d][0] + val[d][1] * val[d][1] + val[d][2] * val[d][2] + val[d][3] * val[d][3];
      }
      ss = rows_sum(ss);
      const float rs = rsqrtf(ss * (1.f / 64.f) + EPSN) * (1.f - li);
      f4 gd[4];
#pragma unroll
      for (int d = 0; d < 4; ++d) gd[d] = *(const f4*)(p.g_diff_norm + l * 64 + d * 16 + 4 * g);
#pragma unroll
      for (int d = 0; d < 4; ++d) *(bf4*)(p.mix() + (size_t)tok * LDH + 256 + h * 64 + d * 16 + 4 * g) = pack4(val[d] * rs * gd[d]);
    }
  }
}

template <int DQK, int NMAP>
__device__ __forceinline__ void attn_dispatch(const Params& p, int l, int item, const __bf16* Q, const __bf16* K, const __bf16* Vt, char* smem) {
  int b, h, q0, nk;
  if (item < 512) { b = (item >> 2) & 1; h = item & 3; q0 = CTXL + (item >> 3) * 128; nk = PT; }
  else { int it = item - 512; b = it >> 3; h = (it >> 1) & 3; q0 = (it & 1) * 128; nk = CTXL; }
  attn_item<DQK, NMAP>(p, l, Q, K, Vt, b, h, q0, nk, smem);
}

__device__ __forceinline__ void hgrn1_item(const Params& p, int item, char* smem) {
  __bf16* kteT = (__bf16*)smem;
  __bf16* vT = kteT + 64 * 72;
  float* ptot = (float*)(vT + 64 * 72);
  const int tid = tid_(), lane = tid & 63, wave = tid >> 6, r = lane & 15, g = lane >> 4;
  const int c = item % NCH, bh = item / NCH;
  const int b = bh >> 3, h = bh & 7;
  const int tok0 = b * PT + c * 64;
  __syncthreads();
#pragma unroll
  for (int i = 0; i < 2; ++i) {
    int dv = (tid >> 3) + 32 * i;
    *(bf8*)(vT + dv * 72 + (tid & 7) * 8) = *(const bf8*)(p.hvt() + ((size_t)bh * 64 + dv) * PT + c * 64 + (tid & 7) * 8);
  }
  const int k = tid & 63, part = tid >> 6;
  for (int dir = 0; dir < 2; ++dir) {
    float lfv[16], cl[16];
    const float* lfp = p.lf() + ((size_t)dir * NTOK + tok0 + part * 16) * 512 + h * 64 + k;
#pragma unroll
    for (int i = 0; i < 16; ++i) lfv[i] = lfp[(size_t)i * 512];
    float run = 0.f;
    if (dir == 0) {
#pragma unroll
      for (int i = 0; i < 16; ++i) { run += lfv[i]; cl[i] = run; }
    } else {
#pragma unroll
      for (int i = 15; i >= 0; --i) { run += lfv[i]; cl[i] = run; }
    }
    __syncthreads();
    ptot[part * 64 + k] = run;
    __syncthreads();
    float off = 0.f, total = 0.f;
#pragma unroll
    for (int q = 0; q < 4; ++q) {
      float t = ptot[q * 64 + k];
      total += t;
      if (dir == 0 ? (q < part) : (q > part)) off += t;
    }
#pragma unroll
    for (int i = 0; i < 16; ++i) {
      float cum = cl[i] + off;
      float kte = (1.f - __expf(lfv[i])) * __expf(total - cum);
      kteT[k * 72 + part * 16 + i] = (__bf16)kte;
    }
    const size_t sidx = ((size_t)bh * 2 + dir) * NCH + c;
    if (part == 0) p.dk()[sidx * 64 + k] = __expf(total);
    __syncthreads();
    f4 acc[4];
#pragma unroll
    for (int nt = 0; nt < 4; ++nt) acc[nt] = f4{0.f, 0.f, 0.f, 0.f};
#pragma unroll
    for (int ks = 0; ks < 2; ++ks) {
      bf8 af = *(const bf8*)(vT + (wave * 16 + r) * 72 + ks * 32 + g * 8);
#pragma unroll
      for (int nt = 0; nt < 4; ++nt) {
        bf8 bfr = *(const bf8*)(kteT + (nt * 16 + r) * 72 + ks * 32 + g * 8);
        acc[nt] = mfma16(af, bfr, acc[nt]);
      }
    }
    float* up = p.ut() + sidx * 4096;
#pragma unroll
    for (int nt = 0; nt < 4; ++nt)
#pragma unroll
      for (int q = 0; q < 4; ++q) up[(wave * 16 + 4 * g + q) * 64 + nt * 16 + r] = acc[nt][q];
  }
}

__device__ __forceinline__ void hgrn2_item(const Params& p, int item) {
  const int idx = item * 256 + tid_();
  const int e = idx & 4095, sd = idx >> 12;
  const int dir = sd & 1, kk = e & 63;
  const float* up = p.ut() + (size_t)sd * NCH * 4096 + e;
  const float* dp = p.dk() + (size_t)sd * NCH * 64 + kk;
  __bf16* sp = p.st() + (size_t)sd * NCH * 4096 + e;
  float S = 0.f;
  for (int jb = 0; jb < NCH; jb += 22) {
    float u[22], d[22];
    int cc[22];
#pragma unroll
    for (int q = 0; q < 22; ++q) {
      int j = jb + q;
      int c = dir == 0 ? j : (j < 4 ? 3 - j : 135 - j);
      cc[q] = c;
      u[q] = up[(size_t)c * 4096];
      d[q] = dp[c * 64];
    }
#pragma unroll
    for (int q = 0; q < 22; ++q) {
      sp[(size_t)cc[q] * 4096] = (__bf16)S;
      S = d[q] * S + u[q];
    }
  }
}

__device__ __forceinline__ void hgrn3_item(const Params& p, int l, int item, char* smem) {
  __bf16* qS = (__bf16*)smem;
  __bf16* kS = qS + 64 * 72;
  __bf16* vT = kS + 64 * 72;
  __bf16* stS = vT + 64 * 72;
  float* cumS = (float*)(stS + 64 * 72);
  float* ptot = cumS + 64 * 68;
  const int tid = tid_(), lane = tid & 63, wave = tid >> 6, r = lane & 15, g = lane >> 4;
  const int c = item % NCH, bh = item / NCH;
  const int b = bh >> 3, h = bh & 7;
  const int tok0 = b * PT + c * 64;
  __syncthreads();
#pragma unroll
  for (int i = 0; i < 2; ++i) {
    int row = (tid >> 3) + 32 * i;
    *(bf8*)(vT + row * 72 + (tid & 7) * 8) = *(const bf8*)(p.hvt() + ((size_t)bh * 64 + row) * PT + c * 64 + (tid & 7) * 8);
    *(bf8*)(qS + row * 72 + (tid & 7) * 8) = *(const bf8*)(p.hq() + (size_t)(tok0 + row) * 512 + h * 64 + (tid & 7) * 8);
  }
  f4 o[4];
#pragma unroll
  for (int d = 0; d < 4; ++d) o[d] = f4{0.f, 0.f, 0.f, 0.f};
  const int k = tid & 63, part = tid >> 6;
  const int t = 16 * wave + r;
  for (int dir = 0; dir < 2; ++dir) {
    float lfv[16], cl[16];
    const float* lfp = p.lf() + ((size_t)dir * NTOK + tok0 + part * 16) * 512 + h * 64 + k;
#pragma unroll
    for (int i = 0; i < 16; ++i) lfv[i] = lfp[(size_t)i * 512];
    float run = 0.f;
    if (dir == 0) {
#pragma unroll
      for (int i = 0; i < 16; ++i) { run += lfv[i]; cl[i] = run; }
    } else {
#pragma unroll
      for (int i = 15; i >= 0; --i) { run += lfv[i]; cl[i] = run; }
    }
    __syncthreads();
    ptot[part * 64 + k] = run;
#pragma unroll
    for (int i = 0; i < 16; ++i) kS[(part * 16 + i) * 72 + k] = (__bf16)((1.f - __expf(lfv[i])));
    {
      const __bf16* sp = p.st() + (((size_t)bh * 2 + dir) * NCH + c) * 4096;
#pragma unroll
      for (int i = 0; i < 2; ++i) {
        int row = (tid >> 3) + 32 * i;
        *(bf8*)(stS + row * 72 + (tid & 7) * 8) = *(const bf8*)(sp + row * 64 + (tid & 7) * 8);
      }
    }
    __syncthreads();
    float off = 0.f;
#pragma unroll
    for (int q = 0; q < 4; ++q) {
      float tt = ptot[q * 64 + k];
      if (dir == 0 ? (q < part) : (q > part)) off += tt;
    }
#pragma unroll
    for (int i = 0; i < 16; ++i) cumS[(part * 16 + i) * 68 + k] = cl[i] + off;
    __syncthreads();
    float cs[2][8];
    bf8 qtf[2], qhf[2];
#pragma unroll
    for (int ks = 0; ks < 2; ++ks) {
      const int dk0 = ks * 32 + 8 * g;
      bf8 qv = *(const bf8*)(qS + t * 72 + dk0);
#pragma unroll
      for (int j = 0; j < 8; ++j) {
        float cst;
        if (dir == 0) cst = wave > 0 ? cumS[(16 * wave - 1) * 68 + dk0 + j] : 0.f;
        else cst = wave < 3 ? cumS[(16 * wave + 16) * 68 + dk0 + j] : 0.f;
        cs[ks][j] = cst;
        float cv = cumS[t * 68 + dk0 + j];
        float qf_ = (float)qv[j];
        qtf[ks][j] = (__bf16)(qf_ * __expf(cv - cst));
        qhf[ks][j] = (__bf16)(qf_ * __expf(cv));
      }
    }
#pragma unroll
    for (int m = 0; m < 2; ++m) {
      const bool need = dir == 0 ? (m <= (wave >> 1)) : (m >= (wave >> 1));
      if (need) {
        bf8 pf;
#pragma unroll
        for (int tp = 0; tp < 2; ++tp) {
          const int srow = 32 * m + 8 * (r >> 2) + 4 * tp + (r & 3);
          f4 sc = f4{0.f, 0.f, 0.f, 0.f};
#pragma unroll
          for (int ks = 0; ks < 2; ++ks) {
            const int dk0 = ks * 32 + 8 * g;
            bf8 kv = *(const bf8*)(kS + srow * 72 + dk0);
            bf8 ktf;
#pragma unroll
            for (int j = 0; j < 8; ++j) {
              float ex = fminf(cs[ks][j] - cumS[srow * 68 + dk0 + j], 80.f);
              ktf[j] = (__bf16)((float)kv[j] * __expf(ex));
            }
            sc = mfma16(ktf, qtf[ks], sc);
          }
#pragma unroll
          for (int q = 0; q < 4; ++q) {
            const int s = 32 * m + 8 * g + 4 * tp + q;
            const bool keep = dir == 0 ? (s <= t) : (s >= t);
            pf[tp * 4 + q] = keep ? (__bf16)sc[q] : (__bf16)0.f;
          }
        }
#pragma unroll
        for (int d = 0; d < 4; ++d) {
          bf8 vf = *(const bf8*)(vT + (d * 16 + r) * 72 + 32 * m + 8 * g);
          o[d] = mfma16(vf, pf, o[d]);
        }
      }
    }
#pragma unroll
    for (int d = 0; d < 4; ++d)
#pragma unroll
      for (int ks = 0; ks < 2; ++ks) {
        bf8 sf = *(const bf8*)(stS + (d * 16 + r) * 72 + ks * 32 + 8 * g);
        o[d] = mfma16(sf, qhf[ks], o[d]);
      }
  }
  float ss = 0.f;
#pragma unroll
  for (int d = 0; d < 4; ++d) ss += o[d][0] * o[d][0] + o[d][1] * o[d][1] + o[d][2] * o[d][2] + o[d][3] * o[d][3];
  ss = rows_sum(ss);
  const float rs = rsqrtf(ss * (1.f / 64.f) + EPSN);
  f4 gn[4]; bf4 gate[4];
#pragma unroll
  for (int d = 0; d < 4; ++d) {
    gn[d] = *(const f4*)(p.g_hgrn_norm + l * 64 + d * 16 + 4 * g);
    gate[d] = *(const bf4*)(p.hg() + (size_t)(tok0 + t) * 512 + h * 64 + d * 16 + 4 * g);
  }
#pragma unroll
  for (int d = 0; d < 4; ++d) {
    f4 res;
#pragma unroll
    for (int q = 0; q < 4; ++q) res[q] = o[d][q] * rs * gn[d][q] * (float)gate[d][q];
    *(bf4*)(p.mix() + (size_t)(tok0 + t) * LDH + 512 + h * 64 + d * 16 + 4 * g) = pack4(res);
  }
}

#define NPHASE 38
#ifndef ONLY
#define ONLY -1
#endif
#define PHEN(x) (ONLY < 0 || ONLY == (x))
__device__ __forceinline__ void run_phase(const Params& p, int ph, char* smem) {
  const int bid = bid_(), G = gridDim.x;
  if (ph == 0) { if (PHEN(100)) phase0(p, smem); return; }
  if (ph == NPHASE - 1) {
    for (int it = bid; it < NB * SEQ / 16; it += G) final_norm_item(p, it);
    return;
  }
  const int l = (ph - 1) / 9, sp = (ph - 1) % 9;
  const int nmt = mtile_count(l);
  switch (sp) {
    case 0: if (PHEN(0)) {
      for (int i = bid * 256 + tid_(); i < (INWP - INW) * DM / 8; i += G * 256) {
        bf8 z;
#pragma unroll
        for (int j = 0; j < 8; ++j) z[j] = (__bf16)0.f;
        *(bf8*)(p.wt_in() + (size_t)(INW + (i >> 7)) * LDH + (size_t)(i & 127) * 8) = z;
      }
      for (int it = bid; it < 1056 + 6688; it += G) {
        if (it < 1056) norm_item(p, l, 0, it);
        else conv_item(p, l, it - 1056, smem);
      }
    } break;
    case 1: if (PHEN(1)) {
      {
        int mt, nt, mtn = 0, ntn = 0;
        bool have = gemm_pick(0, bid, G, 132, 30, 10, mt, nt), pre = false;
        for (int st = 0; have; ++st) {
          const bool hn = gemm_pick(st + 1, bid, G, 132, 30, 10, mtn, ntn);
          gemm_tile<EPI_IN, false>(p, l, p.hb(), LDH, p.wt_in(), LDH, DM, mt * 128, nt * 128, smem, pre, hn, mtn * 128, ntn * 128);
          pre = hn; have = hn; mt = mtn; nt = ntn;
        }
      }
    } break;
    case 2: if (PHEN(2)) {
      const int natt = l < 3 ? 528 : 512;
      const int total = natt + 396 + 528 + 2112, K = (total + G - 1) / G;
      const bool flip = (bid >> 3) & 1;
      for (int kk = 0; kk < K; ++kk) {
        const int k = flip ? (kk + 1 == K ? 0 : kk + 1) : kk;
        const int it0 = bid + k * G;
        if (it0 >= total) continue;
        if (it0 < natt) { attn_dispatch<32, 2>(p, l, it0, p.qd(), p.kd(), p.vdt(), smem); continue; }
        const int it = it0 - natt;
        if (it < 396) gemm_tile<EPI_UQ, true>(p, l, p.cq(), 256, p.wt_uq(), 256, 256, (it / 3) * 128, (it % 3) * 128, smem);
        else if (it < 924) { int j = it - 396; gemm_tile<EPI_UKV, true>(p, l, p.ckv(), 128, p.wt_ukv(), 128, 128, (j / 4) * 128, (j % 4) * 128, smem); }
        else hgrn1_item(p, it - 924, smem);
      }
    } break;
    case 3: if (PHEN(3)) {
      const int natt = l < 3 ? 528 : 512;
      const int total = 512 + natt, K = (total + G - 1) / G;
      const bool flip = (bid >> 3) & 1;
      for (int kk = 0; kk < K; ++kk) {
        const int k = flip ? (kk + 1 == K ? 0 : kk + 1) : kk;
        const int it = bid + k * G;
        if (it >= total) continue;
        if (it < 512) hgrn2_item(p, it);
        else attn_dispatch<96, 1>(p, l, it - 512, p.qm(), p.km(), p.vmt(), smem);
      }
    } break;
    case 4: if (PHEN(4)) {
      for (int j = bid; j < 2112; j += G) {
        if (l == 3 && (j % NCH) < 4) continue;
        hgrn3_item(p, l, j, smem);
      }
    } break;
    case 5: if (PHEN(5)) {
      {
        int mt, nt, mtn = 0, ntn = 0;
        bool have = gemm_pick(0, bid, G, 128, 8, 8, mt, nt), pre = false;
        for (int st = 0; have; ++st) {
          const bool hn = gemm_pick(st + 1, bid, G, 128, 8, 8, mtn, ntn);
          gemm_tile<EPI_OUT, false>(p, l, p.mix(), LDH, p.wt_out(), LDH, DM, mtile_index(3, mt) * 128, nt * 128, smem, pre, hn,
                                    mtile_index(3, mtn) * 128, ntn * 128);
          pre = hn; have = hn; mt = mtn; nt = ntn;
        }
      }
      if (l < 3) {
        for (int u = bid; u < 32 * 8; u += G) {
          const int tile = u >> 3, sp = u & 7;
          const int cm = tile >> 3, nt = tile & 7;
          const int mt = (cm >> 1) * 66 + (cm & 1);
          gemm_tile<EPI_OUT_AT, false>(p, l, p.mix() + sp * 128, LDH, p.wt_out() + sp * 128, LDH, 128, mt * 128, nt * 128, smem);
        }
      }
    } break;
    case 6: if (PHEN(6)) {
      for (int it = bid; it < 1056; it += G) norm_item(p, l, 1, it);
    } break;
    case 7: if (PHEN(7)) {
      {
        int mt, nt, mtn = 0, ntn = 0;
        bool have = gemm_pick(0, bid, G, nmt, 44, 11, mt, nt), pre = false;
        for (int st = 0; have; ++st) {
          const bool hn = gemm_pick(st + 1, bid, G, nmt, 44, 11, mtn, ntn);
          gemm_tile<EPI_UP, false>(p, l, p.hb(), LDH, p.wt_gu(), LDH, DM, mtile_index(l, mt) * 128, nt * 128, smem, pre, hn,
                                   mtile_index(l, mtn) * 128, ntn * 128);
          pre = hn; have = hn; mt = mtn; nt = ntn;
        }
      }
    } break;
    case 8: if (PHEN(8)) {
      {
        int mt, nt, mtn = 0, ntn = 0;
        bool have = gemm_pick(0, bid, G, 128, 8, 8, mt, nt), pre = false;
        for (int st = 0; have; ++st) {
          const bool hn = gemm_pick(st + 1, bid, G, 128, 8, 8, mtn, ntn);
          gemm_tile<EPI_DOWN, false>(p, l, p.act(), LDF, p.wt_down(), LDF, DFF, mtile_index(3, mt) * 128, nt * 128, smem, pre, hn,
                                     mtile_index(3, mtn) * 128, ntn * 128);
          pre = hn; have = hn; mt = mtn; nt = ntn;
        }
      }
      if (l < 3) {
        for (int u = bid; u < 32 * 11; u += G) {
          const int tile = u / 11, sp = u - tile * 11;
          const int cm = tile >> 3, nt = tile & 7;
          const int mt = (cm >> 1) * 66 + (cm & 1);
          gemm_tile<EPI_DOWN_AT, false>(p, l, p.act() + sp * 256, LDF, p.wt_down() + sp * 256, LDF, 256, mt * 128, nt * 128, smem);
        }
      }
    } break;
  }
}

#define XB_TMO      128
#define XB_XCNT(j)  (256  + 64 * (j))
#define XB_XSUB(j)  (1280 + 64 * (j))
#define XB_XGEN(j)  (2304 + 64 * (j))
#define XB_TOP      3328
#define XB_TOPGEN   3392
#define XCD_BAR_WORDS 3456
#define XB_SPIN_CAP (1u << 22)
#define LAS __attribute__((address_space(3)))

__device__ __forceinline__ unsigned xb_ld(unsigned* p)              { return __hip_atomic_load(p, __ATOMIC_RELAXED, __HIP_MEMORY_SCOPE_AGENT); }
__device__ __forceinline__ unsigned xb_add(unsigned* p, unsigned v) { return __hip_atomic_fetch_add(p, v, __ATOMIC_RELAXED, __HIP_MEMORY_SCOPE_AGENT); }
__device__ __forceinline__ unsigned xb_xcc_id() { return (unsigned)__builtin_amdgcn_s_getreg((3 << 11) | 20) & 0xFu; }
#define XB_SPIN(cond, bar) do { unsigned _sp = 0; while (cond) { __builtin_amdgcn_s_sleep(1); \
    if ((++_sp & 255u) == 0u) { if (xb_ld(&(bar)[XB_TMO])) break; if (_sp > XB_SPIN_CAP) { atomicAdd(&(bar)[XB_TMO], 1u); break; } } } } while (0)

struct XcdBarrier {
    unsigned* bar; unsigned x;
    volatile LAS unsigned* st;
};

__device__ __forceinline__ XcdBarrier xcd_barrier_post(unsigned* bar, volatile LAS unsigned* st) {
    XcdBarrier b; b.bar = bar; b.x = xb_xcc_id(); b.st = st;
    if (threadIdx.x == 0) (void)xb_add(&bar[XB_XCNT(b.x)], 1u);
    return b;
}
__device__ __forceinline__ void xcd_barrier_complete(unsigned* bar, unsigned x, unsigned& nloc, unsigned& nx) {
    const unsigned G = gridDim.x * gridDim.y * gridDim.z;
    unsigned sum, cnt, mine, sp = 0u;
    for (;;) {
        sum = 0u; cnt = 0u; mine = 0u;
#pragma unroll
        for (unsigned j = 0; j < 16; ++j) { const unsigned c = xb_ld(&bar[XB_XCNT(j)]); sum += c; cnt += (c > 0u) ? 1u : 0u; mine = (j == x) ? c : mine; }
        if (sum == G) break;
        __builtin_amdgcn_s_sleep(1);
        if ((++sp & 255u) == 0u) { if (xb_ld(&bar[XB_TMO])) break; if (sp > XB_SPIN_CAP) { atomicAdd(&bar[XB_TMO], 1u); break; } }
    }
    nloc = mine > 0u ? mine : 1u; nx = cnt > 0u ? cnt : 1u;
}

__device__ __forceinline__ void xcd_barrier(const XcdBarrier& b) {
    asm volatile("s_waitcnt vmcnt(0)" ::: "memory");
    __syncthreads();
    if (threadIdx.x == 0) {
        unsigned* bar = b.bar;
        __builtin_amdgcn_s_waitcnt(0);
        unsigned nloc = b.st[0], nx = b.st[1];
        if (nloc == 0u) { xcd_barrier_complete(bar, b.x, nloc, nx); b.st[0] = nloc; b.st[1] = nx; }
        const unsigned old = xb_add(&bar[XB_XSUB(b.x)], 1u);
        const unsigned gen = old / nloc;
        if (old + 1u == (gen + 1u) * nloc) {
            __builtin_amdgcn_fence(__ATOMIC_RELEASE, "agent");
            asm volatile("s_waitcnt vmcnt(0)" ::: "memory");
            const unsigned og = xb_add(&bar[XB_TOP], 1u);
            const unsigned tg = og / nx;
            if (og + 1u == (tg + 1u) * nx) xb_add(&bar[XB_TOPGEN], 1u);
            else XB_SPIN(xb_ld(&bar[XB_TOPGEN]) == tg, bar);
            __builtin_amdgcn_fence(__ATOMIC_ACQUIRE, "agent");
            xb_add(&bar[XB_XGEN(b.x)], 1u);
            asm volatile("s_waitcnt vmcnt(0)" ::: "memory");
        } else {
            XB_SPIN(xb_ld(&bar[XB_XGEN(b.x)]) == gen, bar);
            __builtin_amdgcn_fence(__ATOMIC_ACQUIRE, "agent");
            asm volatile("s_waitcnt vmcnt(0)" ::: "memory");
        }
    }
    __syncthreads();
}


__device__ __forceinline__ void grid_barrier(unsigned* cnt, unsigned target) {
  asm volatile("s_waitcnt vmcnt(0)" ::: "memory");
  __syncthreads();
  if (tid_() == 0) {
    __builtin_amdgcn_fence(__ATOMIC_RELEASE, "agent");
    asm volatile("s_waitcnt vmcnt(0)" ::: "memory");
    __hip_atomic_fetch_add(cnt, 1u, __ATOMIC_RELAXED, __HIP_MEMORY_SCOPE_AGENT);
    unsigned spins = 0;
    while (__hip_atomic_load(cnt, __ATOMIC_RELAXED, __HIP_MEMORY_SCOPE_AGENT) < target) {
      __builtin_amdgcn_s_sleep(2);
      if (++spins > (1u << 24)) break;
    }
    __builtin_amdgcn_fence(__ATOMIC_ACQUIRE, "agent");
    asm volatile("s_waitcnt vmcnt(0)" ::: "memory");
  }
  __syncthreads();
}

__global__ void __launch_bounds__(256, 2) hybrid_megakernel(Params p, int ph0, int ph1) {
  __shared__ __attribute__((aligned(16))) char smem[SMEM_BYTES];
  cg::grid_group grid = cg::this_grid();
  volatile LAS unsigned* xst = (volatile LAS unsigned*)(smem + 66048);
  if (__builtin_amdgcn_workitem_id_x() == 0) { xst[0] = 0u; xst[1] = 0u; }
  __syncthreads();
  XcdBarrier xb; xb.bar = nullptr; xb.x = 0; xb.st = xst;
  for (int ph = ph0; ph < ph1; ++ph) {
    Params q = p;
    size_t zoff = 0;
    asm volatile("" : "+s"(zoff));
    q.ws = p.ws + zoff; q.out = p.out + zoff;
    run_phase(q, ph, smem);
#ifdef REPMASK
    if (ph > 0 && ph < NPHASE - 1 && ((REPMASK >> ((ph - 1) % 9)) & 1)) { grid.sync(); run_phase(q, ph, smem); }
#endif
    if (ph + 1 < ph1) {
      if (ph == ph0) { grid.sync(); xb = xcd_barrier_post((unsigned*)(p.ws + OFF_xbar), xst); }
      else xcd_barrier(xb);
    }
  }
}

extern "C" void kernel_launch(void* const* d_in, const int* in_sizes, int n_in, void* d_out, int out_size, void* d_ws,
                              size_t ws_size, hipStream_t stream) {
  static int grid_blocks = 0;
  if (!grid_blocks) {
    int dev = 0, cus = 0, per_cu = 0;
    hipGetDevice(&dev);
    hipDeviceGetAttribute(&cus, hipDeviceAttributeMultiprocessorCount, dev);
    hipOccupancyMaxActiveBlocksPerMultiprocessor(&per_cu, hybrid_megakernel, 256, 0);
    if (per_cu > 2) per_cu = 2;
    if (per_cu < 1) per_cu = 1;
    grid_blocks = cus * per_cu;
  }
  Params p{};
  const float* const* in = (const float* const*)d_in;
  p.x = in[0]; p.c = in[1]; p.ctx = in[2]; p.c_ctx = in[3]; p.w_ada = in[4]; p.b_ada = in[5]; p.g_norm1 = in[6];
  p.g_norm2 = in[7]; p.w_in = in[8]; p.g_q_norm = in[9]; p.w_uq = in[10]; p.g_kv_norm = in[11]; p.w_ukv = in[12];
  p.diff_lambda = in[13]; p.g_diff_norm = in[14]; p.hgrn_lb = in[15]; p.g_hgrn_norm = in[16]; p.w_out = in[17];
  p.w_gate = in[18]; p.w_up = in[19]; p.w_down = in[20]; p.g_final = in[21];
  p.out = (float*)d_out;
  p.ws = (char*)d_ws;
  if (WS_TOTAL > ws_size) { fprintf(stderr, "workspace too small: need %zu have %zu\n", (size_t)WS_TOTAL, ws_size); return; }
  int ph0 = 0, ph1 = NPHASE;
  void* args[] = {&p, &ph0, &ph1};
  hipError_t e = hipLaunchCooperativeKernel((void*)hybrid_megakernel, dim3(grid_blocks), dim3(256), args, 0, stream);
  if (e != hipSuccess) fprintf(stderr, "cooperative launch failed: %s (grid %d)\n", hipGetErrorString(e), grid_blocks);
}
```

```cpp
#include <hip/hip_runtime.h>
#include <hip/hip_cooperative_groups.h>
#include <cstdio>
namespace cg = cooperative_groups;

typedef __attribute__((ext_vector_type(8))) __bf16 bf8;
typedef __attribute__((ext_vector_type(4))) __bf16 bf4;
typedef __attribute__((ext_vector_type(4))) float f4;

#define XCD_BAR_WORDS_C 3456
#define NB 2
#define SEQ 8192
#define CTXL 256
#define PT 8448
#define NTOK 16896
#define DM 1024
#define INW 3744
#define INWP 3840
#define DFF 2816
#define NCH 132
#define LDH 1088
#define LDF 2880
#define LOG2E 1.4426950408889634f
#define EPSN 1e-6f
#define SMEM_BYTES 66064

constexpr size_t al256(size_t x) { return (x + 255) & ~(size_t)255; }
constexpr size_t OFF_xc = 0;
constexpr size_t OFF_mod = OFF_xc + al256((size_t)NB*CTXL*DM*4);
constexpr size_t OFF_rope = OFF_mod + al256((size_t)4*3*6144*4);
constexpr size_t OFF_llb = OFF_rope + al256(128*8*2*4);
constexpr size_t OFF_l1mlb = OFF_llb + al256(4*1024*4);
constexpr size_t OFF_lam = OFF_l1mlb + al256(4*1024*4);
constexpr size_t OFF_wt_in = OFF_lam + al256(256);
constexpr size_t OFF_wt_uq = OFF_wt_in + al256((size_t)INWP*LDH*2);
constexpr size_t OFF_wt_ukv = OFF_wt_uq + al256((size_t)384*256*2);
constexpr size_t OFF_wt_out = OFF_wt_ukv + al256((size_t)512*128*2);
constexpr size_t OFF_wt_gu = OFF_wt_out + al256((size_t)DM*LDH*2);
constexpr size_t OFF_wt_down = OFF_wt_gu + al256((size_t)2*DFF*LDH*2);
constexpr size_t OFF_hb = OFF_wt_down + al256((size_t)DM*LDF*2);
constexpr size_t OFF_cq = OFF_hb + al256((size_t)NTOK*LDH*2);
constexpr size_t OFF_ckv = OFF_cq + al256((size_t)NTOK*256*2);
constexpr size_t OFF_qm = OFF_ckv + al256((size_t)NTOK*128*2);
constexpr size_t OFF_km = OFF_qm + al256((size_t)NB*4*PT*96*2);
constexpr size_t OFF_vmt = OFF_km + al256((size_t)NB*4*PT*96*2);
constexpr size_t OFF_qd = OFF_vmt + al256((size_t)NB*4*64*PT*2);
constexpr size_t OFF_kd = OFF_qd + al256((size_t)NB*4*2*PT*32*2);
constexpr size_t OFF_vdt = OFF_kd + al256((size_t)NB*4*2*PT*32*2);
constexpr size_t OFF_hq = OFF_vdt + al256((size_t)NB*4*64*PT*2);
constexpr size_t OFF_hvt = OFF_hq + al256((size_t)NTOK*512*2);
constexpr size_t OFF_hg = OFF_hvt + al256((size_t)NB*8*64*PT*2);
constexpr size_t OFF_dk = OFF_hg + al256((size_t)NTOK*512*2);
constexpr size_t OFF_st = OFF_dk + al256((size_t)NB*8*2*NCH*64*4);
constexpr size_t OFF_lf = OFF_st + al256((size_t)NB*8*2*NCH*4096*2);
constexpr size_t OFF_ut = OFF_lf + al256((size_t)2*NTOK*512*4);
constexpr size_t OFF_xbar = OFF_ut + al256((size_t)NB*8*2*NCH*4096*4);
constexpr size_t WS_TOTAL_OLD = OFF_ut + al256((size_t)NB*8*2*NCH*4096*4);
constexpr size_t WS_TOTAL = OFF_xbar + al256((size_t)XCD_BAR_WORDS_C*4);
struct Params {
  const float *x, *c, *ctx, *c_ctx, *w_ada, *b_ada, *g_norm1, *g_norm2, *w_in, *g_q_norm, *w_uq, *g_kv_norm, *w_ukv,
      *diff_lambda, *g_diff_norm, *hgrn_lb, *g_hgrn_norm, *w_out, *w_gate, *w_up, *w_down, *g_final;
  float* out;
  char* ws;
  __device__ __forceinline__ float* xc() const { return (float*)(ws + OFF_xc); }
  __device__ __forceinline__ float* mod() const { return (float*)(ws + OFF_mod); }
  __device__ __forceinline__ float* rope() const { return (float*)(ws + OFF_rope); }
  __device__ __forceinline__ float* llb() const { return (float*)(ws + OFF_llb); }
  __device__ __forceinline__ float* l1mlb() const { return (float*)(ws + OFF_l1mlb); }
  __device__ __forceinline__ float* lam() const { return (float*)(ws + OFF_lam); }
  __device__ __forceinline__ __bf16* wt_in() const { return (__bf16*)(ws + OFF_wt_in); }
  __device__ __forceinline__ __bf16* wt_uq() const { return (__bf16*)(ws + OFF_wt_uq); }
  __device__ __forceinline__ __bf16* wt_ukv() const { return (__bf16*)(ws + OFF_wt_ukv); }
  __device__ __forceinline__ __bf16* wt_out() const { return (__bf16*)(ws + OFF_wt_out); }
  __device__ __forceinline__ __bf16* wt_gu() const { return (__bf16*)(ws + OFF_wt_gu); }
  __device__ __forceinline__ __bf16* wt_down() const { return (__bf16*)(ws + OFF_wt_down); }
  __device__ __forceinline__ __bf16* hb() const { return (__bf16*)(ws + OFF_hb); }
  __device__ __forceinline__ __bf16* cq() const { return (__bf16*)(ws + OFF_cq); }
  __device__ __forceinline__ __bf16* ckv() const { return (__bf16*)(ws + OFF_ckv); }
  __device__ __forceinline__ __bf16* qm() const { return (__bf16*)(ws + OFF_qm); }
  __device__ __forceinline__ __bf16* km() const { return (__bf16*)(ws + OFF_km); }
  __device__ __forceinline__ __bf16* vmt() const { return (__bf16*)(ws + OFF_vmt); }
  __device__ __forceinline__ __bf16* qd() const { return (__bf16*)(ws + OFF_qd); }
  __device__ __forceinline__ __bf16* kd() const { return (__bf16*)(ws + OFF_kd); }
  __device__ __forceinline__ __bf16* vdt() const { return (__bf16*)(ws + OFF_vdt); }
  __device__ __forceinline__ __bf16* hq() const { return (__bf16*)(ws + OFF_hq); }
  __device__ __forceinline__ __bf16* hvt() const { return (__bf16*)(ws + OFF_hvt); }
  __device__ __forceinline__ __bf16* hg() const { return (__bf16*)(ws + OFF_hg); }
  __device__ __forceinline__ float* dk() const { return (float*)(ws + OFF_dk); }
  __device__ __forceinline__ __bf16* st() const { return (__bf16*)(ws + OFF_st); }
  __device__ __forceinline__ float* lf() const { return (float*)(ws + OFF_lf); }
  __device__ __forceinline__ float* ut() const { return (float*)(ws + OFF_ut); }
  __device__ __forceinline__ __bf16* mix() const { return hb(); }
  __device__ __forceinline__ __bf16* act() const { return (__bf16*)lf(); }
};

__device__ __forceinline__ int tid_() { int t = __builtin_amdgcn_workitem_id_x(); asm volatile("" : "+v"(t)); return t; }
__device__ __forceinline__ int bid_() { int t = __builtin_amdgcn_workgroup_id_x(); asm volatile("" : "+s"(t)); return t; }
__device__ __forceinline__ float silu_f(float x) { return x * __builtin_amdgcn_rcpf(1.f + __expf(-x)); }
__device__ __forceinline__ float wave_sum(float v) {
  v += __uint_as_float(__builtin_amdgcn_update_dpp(0u, __float_as_uint(v), 0x128, 0xf, 0xf, false));
  v += __uint_as_float(__builtin_amdgcn_update_dpp(0u, __float_as_uint(v), 0x124, 0xf, 0xf, false));
  v += __uint_as_float(__builtin_amdgcn_update_dpp(0u, __float_as_uint(v), 0x122, 0xf, 0xf, false));
  v += __uint_as_float(__builtin_amdgcn_update_dpp(0u, __float_as_uint(v), 0x121, 0xf, 0xf, false));
  unsigned u = __float_as_uint(v);
  auto a = __builtin_amdgcn_permlane16_swap(u, u, false, false);
  float m = __uint_as_float(a[0]) + __uint_as_float(a[1]);
  unsigned w = __float_as_uint(m);
  auto b = __builtin_amdgcn_permlane32_swap(w, w, false, false);
  return __uint_as_float(b[0]) + __uint_as_float(b[1]);
}
__device__ __forceinline__ float* xrow(const Params& p, int tok) {
  int b = tok / PT, pp = tok - b * PT;
  return pp < CTXL ? p.xc() + (size_t)(b * CTXL + pp) * DM : p.out + (size_t)(b * SEQ + pp - CTXL) * DM;
}
__device__ __forceinline__ float log_forget(float z, float lb, float oml) {
  const float sg = __builtin_amdgcn_rcpf(1.f + __expf(-fmaxf(z, -80.f)));
  return __logf(lb + oml * sg);
}
__device__ __forceinline__ float rows_max(float x) {
  unsigned u = __float_as_uint(x);
  auto a = __builtin_amdgcn_permlane16_swap(u, u, false, false);
  float m = fmaxf(__uint_as_float(a[0]), __uint_as_float(a[1]));
  unsigned v = __float_as_uint(m);
  auto b = __builtin_amdgcn_permlane32_swap(v, v, false, false);
  return fmaxf(__uint_as_float(b[0]), __uint_as_float(b[1]));
}
__device__ __forceinline__ float rows_sum(float x) {
  unsigned u = __float_as_uint(x);
  auto a = __builtin_amdgcn_permlane16_swap(u, u, false, false);
  float m = __uint_as_float(a[0]) + __uint_as_float(a[1]);
  unsigned v = __float_as_uint(m);
  auto b = __builtin_amdgcn_permlane32_swap(v, v, false, false);
  return __uint_as_float(b[0]) + __uint_as_float(b[1]);
}
__device__ __forceinline__ f4 mfma16(bf8 a, bf8 b, f4 c) { return __builtin_amdgcn_mfma_f32_16x16x32_bf16(a, b, c, 0, 0, 0); }

__device__ __forceinline__ void phase0(const Params& p, char* smem) {
  const int tid = tid_();
  const int gsz = gridDim.x * 256, gtid = bid_() * 256 + tid;
  {
    const float4* xs = (const float4*)p.x; float4* xo = (float4*)p.out;
    for (int i = gtid; i < NB * SEQ * DM / 4; i += gsz) xo[i] = xs[i];
    const float4* cs = (const float4*)p.ctx; float4* co = (float4*)p.xc();
    for (int i = gtid; i < NB * CTXL * DM / 4; i += gsz) co[i] = cs[i];
  }
  if (gtid < 1024) {
    int pos = gtid >> 3, f = gtid & 7;
    float freq = powf(10000.f, -(float)f / 8.f);
    float ang = (float)pos * freq, s, c;
    sincosf(ang, &s, &c);
    p.rope()[gtid * 2] = c; p.rope()[gtid * 2 + 1] = s;
  } else if (gtid < 2048) {
    int n = gtid - 1024;
    float r0 = p.hgrn_lb[n], r1 = p.hgrn_lb[1024 + n], r2 = p.hgrn_lb[2048 + n], r3 = p.hgrn_lb[3072 + n];
    float m = fmaxf(fmaxf(r0, r1), fmaxf(r2, r3));
    float e0 = expf(r0 - m), e1 = expf(r1 - m), e2 = expf(r2 - m), e3 = expf(r3 - m);
    float s = e0 + e1 + e2 + e3;
    float p0 = e0 / s, p1 = e1 / s, p2 = e2 / s, p3 = e3 / s;
    float c0 = p0, c1 = c0 + p1, c2 = c1 + p2, c3 = c2 + p3;
    p.llb()[n] = 0.f; p.l1mlb()[n] = 1.f;
    p.llb()[1024 + n] = c1 - c0; p.l1mlb()[1024 + n] = 1.f - (c1 - c0);
    p.llb()[2048 + n] = c2 - c0; p.l1mlb()[2048 + n] = 1.f - (c2 - c0);
    p.llb()[3072 + n] = c3 - c0; p.l1mlb()[3072 + n] = 1.f - (c3 - c0);
  } else if (gtid >= 4096 && gtid < 4096 + XCD_BAR_WORDS_C) {
    ((unsigned*)(p.ws + OFF_xbar))[gtid - 4096] = 0u;
  } else if (gtid == 2052) {
    *(unsigned*)(p.ws + OFF_lam + 128) = 0u;
  } else if (gtid < 2052) {
    int l = gtid - 2048;
    const float* d = p.diff_lambda + l * 128;
    float s1 = 0.f, s2 = 0.f;
    for (int i = 0; i < 32; ++i) { s1 += d[i] * d[32 + i]; s2 += d[64 + i] * d[96 + i]; }
    float li = 0.8f - 0.6f * expf(-0.3f * (float)l);
    p.lam()[l] = expf(s1) - expf(s2) + li;
  }
  float* sl = (float*)smem;
  float* red = sl + 3072;
  bool have = false;
  for (int item = bid_(); item < 768; item += gridDim.x) {
    if (!have) {
      for (int i = tid; i < 1024; i += 256) {
        sl[i] = silu_f(p.c[i]); sl[1024 + i] = silu_f(p.c[1024 + i]); sl[2048 + i] = silu_f(p.c_ctx[i]);
      }
      have = true;
      __syncthreads();
    }
    int l = item / 192, n0 = (item % 192) * 32;
    int col = tid & 31, kg = tid >> 5;
    const float* W = p.w_ada + (size_t)l * DM * 6144 + n0 + col;
    float a0 = 0.f, a1 = 0.f, a2 = 0.f;
#pragma unroll 8
    for (int k = kg * 128; k < kg * 128 + 128; ++k) {
      float w = W[(size_t)k * 6144];
      a0 += sl[k] * w; a1 += sl[1024 + k] * w; a2 += sl[2048 + k] * w;
    }
    red[(kg * 3 + 0) * 32 + col] = a0; red[(kg * 3 + 1) * 32 + col] = a1; red[(kg * 3 + 2) * 32 + col] = a2;
    __syncthreads();
    if (tid < 96) {
      int v = tid >> 5, cc = tid & 31;
      float s = p.b_ada[l * 6144 + n0 + cc];
#pragma unroll
      for (int q = 0; q < 8; ++q) s += red[(q * 3 + v) * 32 + cc];
      p.mod()[(size_t)(l * 3 + v) * 6144 + n0 + cc] = s;
    }
    __syncthreads();
  }
}

__device__ __forceinline__ void conv_tile(const float* __restrict__ src, int K, int N, int kt, int nt, __bf16* __restrict__ dst, int dld, int mode,
                          const float* __restrict__ kscale, char* smem) {
  float* tile = (float*)smem;
  const int tid = tid_();
  __syncthreads();
  {
    int r = tid >> 3, c4 = tid & 7;
#pragma unroll
    for (int i = 0; i < 2; ++i) {
      float4 v = *(const float4*)(src + (size_t)(kt * 64 + r + 32 * i) * N + nt * 32 + c4 * 4);
      float* t = tile + (r + 32 * i) * 33 + c4 * 4;
      t[0] = v.x; t[1] = v.y; t[2] = v.z; t[3] = v.w;
    }
  }
  __syncthreads();
  {
    int nr = tid >> 3, kc = tid & 7;
    int n = nt * 32 + nr;
    int row = n;
    if (mode == 1) row = (n >> 4) * 32 + (n & 15);
    else if (mode == 2) row = (n >> 4) * 32 + 16 + (n & 15);
    bf8 o;
#pragma unroll
    for (int j = 0; j < 8; ++j) {
      float v = tile[(kc * 8 + j) * 33 + nr];
      if (kscale) v *= kscale[kt * 64 + kc * 8 + j];
      o[j] = (__bf16)v;
    }
    *(bf8*)(dst + (size_t)row * dld + kt * 64 + kc * 8) = o;
  }
}

__device__ __forceinline__ void conv_item(const Params& p, int l, int it, char* smem) {
  const float* src; int K, N, ntn, mode = 0, dld; __bf16* dst; const float* ks = nullptr;
  if (it < 1872) { src = p.w_in + (size_t)l * DM * INW; K = DM; N = INW; ntn = 117; dst = p.wt_in(); dld = LDH; }
  else if (it < 1920) { it -= 1872; src = p.w_uq + (size_t)l * 256 * 384; K = 256; N = 384; ntn = 12; dst = p.wt_uq(); dld = 256; ks = p.g_q_norm + l * 256; }
  else if (it < 1952) { it -= 1920; src = p.w_ukv + (size_t)l * 128 * 512; K = 128; N = 512; ntn = 16; dst = p.wt_ukv(); dld = 128; ks = p.g_kv_norm + l * 128; }
  else if (it < 2464) { it -= 1952; src = p.w_out + (size_t)l * DM * DM; K = DM; N = DM; ntn = 32; dst = p.wt_out(); dld = LDH; }
  else if (it < 3872) { it -= 2464; src = p.w_gate + (size_t)l * DM * DFF; K = DM; N = DFF; ntn = 88; dst = p.wt_gu(); mode = 1; dld = LDH; }
  else if (it < 5280) { it -= 3872; src = p.w_up + (size_t)l * DM * DFF; K = DM; N = DFF; ntn = 88; dst = p.wt_gu(); mode = 2; dld = LDH; }
  else { it -= 5280; src = p.w_down + (size_t)l * DFF * DM; K = DFF; N = DM; ntn = 32; dst = p.wt_down(); dld = LDF; }
  conv_tile(src, K, N, it / ntn, it % ntn, dst, dld, mode, ks, smem);
}

__device__ __forceinline__ void norm_item(const Params& p, int l, int which, int item) {
  const int lane = tid_() & 63, wave = tid_() >> 6;
  const int tok0 = item * 16 + wave * 4;
  const int b = tok0 / PT, pp = tok0 - b * PT;
  const int v = pp < CTXL ? 2 : b;
  const float* g = (which ? p.g_norm2 : p.g_norm1) + l * DM;
  const float* md = p.mod() + (size_t)(l * 3 + v) * 6144 + (which ? 3072 : 0);
  f4 a[4], sh[4];
#pragma unroll
  for (int i = 0; i < 4; ++i) {
    int k = i * 256 + lane * 4;
    f4 gg = *(const f4*)(g + k), sc = *(const f4*)(md + 1024 + k);
    sh[i] = *(const f4*)(md + k);
    a[i] = gg * (1.f + sc);
  }
  f4 xv[4][4];
#pragma unroll
  for (int r = 0; r < 4; ++r) {
    const float* xr = xrow(p, tok0 + r);
#pragma unroll
    for (int i = 0; i < 4; ++i) xv[r][i] = *(const f4*)(xr + i * 256 + lane * 4);
  }
#pragma unroll
  for (int r = 0; r < 4; ++r) {
    float ss = 0.f;
#pragma unroll
    for (int i = 0; i < 4; ++i)
      ss += xv[r][i][0] * xv[r][i][0] + xv[r][i][1] * xv[r][i][1] + xv[r][i][2] * xv[r][i][2] + xv[r][i][3] * xv[r][i][3];
    ss = wave_sum(ss);
    float rstd = rsqrtf(ss * (1.f / DM) + EPSN);
#pragma unroll
    for (int i = 0; i < 4; ++i) {
      f4 h = xv[r][i] * rstd * a[i] + sh[i];
      bf4 o; o[0] = (__bf16)h[0]; o[1] = (__bf16)h[1]; o[2] = (__bf16)h[2]; o[3] = (__bf16)h[3];
      *(bf4*)(p.hb() + (size_t)(tok0 + r) * LDH + i * 256 + lane * 4) = o;
    }
  }
}

__device__ __forceinline__ void final_norm_item(const Params& p, int item) {
  const int lane = tid_() & 63, wave = tid_() >> 6;
  const int row0 = item * 16 + wave * 4;
  f4 g[4];
#pragma unroll
  for (int i = 0; i < 4; ++i) g[i] = *(const f4*)(p.g_final + i * 256 + lane * 4);
  f4 xv[4][4];
#pragma unroll
  for (int r = 0; r < 4; ++r)
#pragma unroll
    for (int i = 0; i < 4; ++i) xv[r][i] = *(const f4*)(p.out + (size_t)(row0 + r) * DM + i * 256 + lane * 4);
#pragma unroll
  for (int r = 0; r < 4; ++r) {
    float ss = 0.f;
#pragma unroll
    for (int i = 0; i < 4; ++i)
      ss += xv[r][i][0] * xv[r][i][0] + xv[r][i][1] * xv[r][i][1] + xv[r][i][2] * xv[r][i][2] + xv[r][i][3] * xv[r][i][3];
    ss = wave_sum(ss);
    float rstd = rsqrtf(ss * (1.f / DM) + EPSN);
#pragma unroll
    for (int i = 0; i < 4; ++i) *(f4*)(p.out + (size_t)(row0 + r) * DM + i * 256 + lane * 4) = xv[r][i] * rstd * g[i];
  }
}

#define GLD 72
enum { EPI_IN = 0, EPI_UQ, EPI_UKV, EPI_OUT, EPI_UP, EPI_DOWN, EPI_OUT_AT, EPI_DOWN_AT };

__device__ __forceinline__ f4 rope4(const Params& p, f4 a, int prow, int axis, int r) {
  f4 o;
#pragma unroll
  for (int reg = 0; reg < 4; ++reg) {
    float pv = __uint_as_float(__builtin_amdgcn_update_dpp(0u, __float_as_uint(a[reg]), 0x128, 0xf, 0xf, false));
    int t = prow + reg - CTXL;
    int pos = axis ? (t & 63) : (t >> 6);
    float2 cs = ((const float2*)p.rope())[pos * 8 + (r & 7)];
    o[reg] = (r & 8) ? a[reg] * cs.x + pv * cs.y : a[reg] * cs.x - pv * cs.y;
  }
  return o;
}
__device__ __forceinline__ bf4 pack4(f4 a) {
  bf4 o; o[0] = (__bf16)a[0]; o[1] = (__bf16)a[1]; o[2] = (__bf16)a[2]; o[3] = (__bf16)a[3];
  return o;
}

template <int EPI>
__device__ __forceinline__ void gemm_epilogue(const Params& p, int l, f4 (&acc)[4][4], int m0, int n0, int wm, int wn, int lane,
                                              const float* rowss) {
  const int r = lane & 15, g = lane >> 4;
  const int b = m0 / PT;
  const int pp0 = m0 - b * PT;
  const bool lat = pp0 >= CTXL;
  const int v = lat ? b : 2;
  const float* md = p.mod() + (size_t)(l * 3 + v) * 6144;
  const int prow0 = pp0 + wm * 64 + 4 * g;
  const int tok0 = b * PT + prow0;
  constexpr int STEP = (EPI == EPI_UP) ? 2 : 1;
  if constexpr (EPI == EPI_OUT || EPI == EPI_DOWN) {
    float* xb = (lat ? p.out + (size_t)(b * SEQ + prow0 - CTXL) * DM : p.xc() + (size_t)(b * CTXL + prow0) * DM) + n0 + wn * 64 + r;
    float gt[4];
    f4 xin[4][4];
#pragma unroll
    for (int ni = 0; ni < 4; ++ni) gt[ni] = md[(EPI == EPI_OUT ? 2048 : 5120) + n0 + wn * 64 + ni * 16 + r];
#pragma unroll
    for (int mi = 0; mi < 4; ++mi)
#pragma unroll
      for (int ni = 0; ni < 4; ++ni)
#pragma unroll
        for (int q = 0; q < 4; ++q) xin[mi][ni][q] = xb[(size_t)(mi * 16 + q) * DM + ni * 16];
#pragma unroll
    for (int mi = 0; mi < 4; ++mi)
#pragma unroll
      for (int ni = 0; ni < 4; ++ni)
#pragma unroll
        for (int q = 0; q < 4; ++q) xb[(size_t)(mi * 16 + q) * DM + ni * 16] = xin[mi][ni][q] + gt[ni] * acc[mi][ni][q];
    return;
  }
  float tla[4] = {0.f, 0.f, 0.f, 0.f}, tl1[4] = {0.f, 0.f, 0.f, 0.f};
  if constexpr (EPI == EPI_IN) {
#pragma unroll
    for (int ni = 0; ni < 4; ++ni) {
      const int c0 = n0 + wn * 64 + ni * 16;
      if (c0 >= 1696 && c0 < 2720) {
        const int dir = c0 >= 2208;
        const int n1 = c0 + r - (dir ? 2208 : 1696);
        tla[ni] = p.llb()[(l * 2 + dir) * 512 + n1];
        tl1[ni] = p.l1mlb()[(l * 2 + dir) * 512 + n1];
      }
    }
  }
#pragma unroll 1
  for (int ni = 0; ni < 4; ni += STEP) {
    const int col0 = n0 + wn * 64 + ni * 16;
    const int col = col0 + r;
    if constexpr (EPI == EPI_IN) {
      if (col0 < 384) {
        __bf16* dst = col0 < 256 ? p.cq() + col : p.ckv() + (col - 256);
        const int ld = col0 < 256 ? 256 : 128;
#pragma unroll
        for (int mi = 0; mi < 4; ++mi)
#pragma unroll
          for (int q = 0; q < 4; ++q) dst[(size_t)(tok0 + mi * 16 + q) * ld] = (__bf16)acc[mi][0][q];
      } else if (col0 < 416) {
        f4 v[4];
#pragma unroll
        for (int mi = 0; mi < 4; ++mi) {
          v[mi] = acc[mi][0];
          if (lat) v[mi] = rope4(p, v[mi], prow0 + mi * 16, (col0 - 384) >> 4, r);
        }
#pragma unroll
        for (int mi = 0; mi < 4; ++mi)
#pragma unroll
          for (int h = 0; h < 4; ++h)
#pragma unroll
            for (int q = 0; q < 4; ++q) p.km()[((size_t)(b * 4 + h) * PT + prow0 + mi * 16 + q) * 96 + 64 + col - 384] = (__bf16)v[mi][q];
      } else if (col0 < 928) {
        const bool isq = col0 < 672;
        const int n1 = col - (isq ? 416 : 672);
        const int head = n1 >> 6, map = (n1 >> 5) & 1, d = n1 & 31;
        __bf16* dst = (isq ? p.qd() : p.kd()) + ((size_t)((b * 4 + head) * 2 + map) * PT) * 32 + d;
        const float sc = isq ? 0.17677669529663687f * LOG2E : 1.f;
        f4 v[4];
#pragma unroll
        for (int mi = 0; mi < 4; ++mi) {
          v[mi] = acc[mi][0];
          if (lat) v[mi] = rope4(p, v[mi], prow0 + mi * 16, (n1 >> 4) & 1, r);
        }
#pragma unroll
        for (int mi = 0; mi < 4; ++mi)
#pragma unroll
          for (int q = 0; q < 4; ++q) dst[(size_t)(prow0 + mi * 16 + q) * 32] = (__bf16)(v[mi][q] * sc);
      } else if (col0 < 1184 || (col0 >= 2720 && col0 < 3232)) {
        const bool isd = col0 < 1184;
        const int n1 = col - (isd ? 928 : 2720);
        __bf16* dst = isd ? p.vdt() + ((size_t)(b * 4 + (n1 >> 6)) * 64 + (n1 & 63)) * PT
                          : p.hvt() + ((size_t)(b * 8 + (n1 >> 6)) * 64 + (n1 & 63)) * PT;
#pragma unroll
        for (int mi = 0; mi < 4; ++mi) *(bf4*)(dst + prow0 + mi * 16) = pack4(acc[mi][0]);
      } else if (col0 < 1696 || (col0 >= 3232 && col0 < INW)) {
        const bool ish = col0 < 1696;
        __bf16* dst = ish ? p.hq() + (col - 1184) : p.hg() + (col - 3232);
#pragma unroll
        for (int mi = 0; mi < 4; ++mi)
#pragma unroll
          for (int q = 0; q < 4; ++q) dst[(size_t)(tok0 + mi * 16 + q) * 512] = (__bf16)silu_f(acc[mi][0][q]);
      } else if (col0 < 2720) {
        const int dir = col0 >= 2208;
        const int n1 = col - (dir ? 2208 : 1696);
        const float la = tla[0], l1m = tl1[0];
        float* dst = p.lf() + (size_t)dir * NTOK * 512 + n1;
#pragma unroll
        for (int mi = 0; mi < 4; ++mi)
#pragma unroll
          for (int q = 0; q < 4; ++q) dst[(size_t)(tok0 + mi * 16 + q) * 512] = log_forget(acc[mi][0][q], la, l1m);
      }
    } else if constexpr (EPI == EPI_UQ) {
      const int head = col0 / 96, d0 = col0 - head * 96;
      const float sc = 0.10206207261596577f * LOG2E;
      __bf16* dst = p.qm() + ((size_t)(b * 4 + head) * PT) * 96 + d0 + r;
      f4 v[4];
#pragma unroll
      for (int mi = 0; mi < 4; ++mi) {
        f4 a = acc[mi][0];
#pragma unroll
        for (int q = 0; q < 4; ++q) a[q] *= rsqrtf(rowss[wm * 64 + mi * 16 + 4 * g + q] * (1.f / 256.f) + EPSN);
        if (d0 >= 64 && lat) a = rope4(p, a, prow0 + mi * 16, (d0 - 64) >> 4, r);
        v[mi] = a;
      }
#pragma unroll
      for (int mi = 0; mi < 4; ++mi)
#pragma unroll
        for (int q = 0; q < 4; ++q) dst[(size_t)(prow0 + mi * 16 + q) * 96] = (__bf16)(v[mi][q] * sc);
    } else if constexpr (EPI == EPI_UKV) {
      const int head = col >> 7, d = col & 127;
#pragma unroll
      for (int mi = 0; mi < 4; ++mi) {
        f4 a = acc[mi][0];
        const int prow = prow0 + mi * 16;
#pragma unroll
        for (int q = 0; q < 4; ++q) a[q] *= rsqrtf(rowss[wm * 64 + mi * 16 + 4 * g + q] * (1.f / 128.f) + EPSN);
        if ((col0 & 127) < 64) {
#pragma unroll
          for (int q = 0; q < 4; ++q) p.km()[((size_t)(b * 4 + head) * PT + prow + q) * 96 + d] = (__bf16)a[q];
        } else {
          *(bf4*)(p.vmt() + ((size_t)(b * 4 + head) * 64 + d - 64) * PT + prow) = pack4(a);
        }
      }
    } else if constexpr (EPI == EPI_OUT || EPI == EPI_DOWN) {
    } else if constexpr (EPI == EPI_OUT_AT || EPI == EPI_DOWN_AT) {
      const float gt = md[(EPI == EPI_OUT_AT ? 2048 : 5120) + col];
      float* xb = (lat ? p.out + (size_t)(b * SEQ + prow0 - CTXL) * DM : p.xc() + (size_t)(b * CTXL + prow0) * DM) + col;
#pragma unroll
      for (int mi = 0; mi < 4; ++mi)
#pragma unroll
        for (int q = 0; q < 4; ++q) atomicAdd(xb + (size_t)(mi * 16 + q) * DM, gt * acc[mi][0][q]);
    } else if constexpr (EPI == EPI_UP) {
      const int n = (col0 >> 5) * 16 + r;
#pragma unroll
      for (int mi = 0; mi < 4; ++mi)
#pragma unroll
        for (int q = 0; q < 4; ++q)
          p.act()[(size_t)(tok0 + mi * 16 + q) * LDF + n] = (__bf16)(silu_f(acc[mi][0][q]) * acc[mi][1][q]);
    }
#pragma unroll
    for (int mi = 0; mi < 4; ++mi) {
      if constexpr (STEP == 1) { acc[mi][0] = acc[mi][1]; acc[mi][1] = acc[mi][2]; acc[mi][2] = acc[mi][3]; }
      else { acc[mi][0] = acc[mi][2]; acc[mi][1] = acc[mi][3]; }
    }
    tla[0] = tla[1]; tla[1] = tla[2]; tla[2] = tla[3]; tl1[0] = tl1[1]; tl1[1] = tl1[2]; tl1[2] = tl1[3];
  }
}

#define RAW_BARRIER() do { asm volatile("s_waitcnt lgkmcnt(0)" ::: "memory"); __builtin_amdgcn_s_barrier(); } while (0)

template <int EPI, bool ROWSS>
__device__ __forceinline__ void gemm_tile(const Params& p, int l, const __bf16* __restrict__ A, int lda, const __bf16* __restrict__ Bt, int ldb, int K,
                          int m0, int n0, char* smem, bool pre = false, bool has_next = false, int m0n = 0, int n0n = 0) {
  __bf16* S0 = (__bf16*)smem;
  float* rowss = (float*)(smem + 65536);
  const int tid = tid_(), lane = tid & 63, wave = tid >> 6;
  const int wm = wave >> 1, wn = wave & 1, r = lane & 15, g = lane >> 4;
  f4 acc[4][4];
#pragma unroll
  for (int i = 0; i < 4; ++i)
#pragma unroll
    for (int j = 0; j < 4; ++j) acc[i][j] = f4{0.f, 0.f, 0.f, 0.f};
  if constexpr (ROWSS) {
    const int row = tid >> 1, half = tid & 1;
    const __bf16* rp = A + (size_t)(m0 + row) * lda + half * (K >> 1);
    float sq = 0.f;
    for (int c = 0; c < (K >> 4); ++c) {
      bf8 v = *(const bf8*)(rp + c * 8);
#pragma unroll
      for (int j = 0; j < 8; ++j) { float f = (float)v[j]; sq += f * f; }
    }
    sq += __shfl_xor(sq, 1);
    __syncthreads();
    if (!half) rowss[row] = sq;
  }
  const int lrow = lane >> 3;
  const int sz = (lane >> 4);
  const __bf16* gaw[4]; const __bf16* gbw[4];
#pragma unroll
  for (int i = 0; i < 4; ++i) {
    const int rg = wave + 4 * i;
    const int row = rg * 8 + lrow;
    const int cl = (lane & 7) ^ (((rg & 1) * 4 + sz) & 7);
    gaw[i] = A + (size_t)(m0 + row) * lda + cl * 8;
    gbw[i] = Bt + (size_t)(n0 + row) * ldb + cl * 8;
  }
  const int aoff = (wm * 64 + r) * 64, boff = 8192 + (wn * 64 + r) * 64;
  const int sw = r >> 1;
  const int KT = K / 64;
  if (!pre) {
    __syncthreads();
#pragma unroll
    for (int i = 0; i < 4; ++i) {
      __builtin_amdgcn_global_load_lds((const unsigned*)(gaw[i]), (unsigned*)(S0 + (wave + 4 * i) * 512), 16, 0, 0);
      __builtin_amdgcn_global_load_lds((const unsigned*)(gbw[i]), (unsigned*)(S0 + 8192 + (wave + 4 * i) * 512), 16, 0, 0);
    }
  }
  asm volatile("s_waitcnt vmcnt(0)" ::: "memory");
  RAW_BARRIER();
  for (int kt = 0; kt < KT; ++kt) {
    const __bf16* Sc = S0 + (kt & 1) * 16384;
    __bf16* Sn = S0 + ((kt + 1) & 1) * 16384;
    if (kt + 1 < KT) {
#pragma unroll
      for (int i = 0; i < 4; ++i) {
        __builtin_amdgcn_global_load_lds((const unsigned*)(gaw[i] + (kt + 1) * 64), (unsigned*)(Sn + (wave + 4 * i) * 512), 16, 0, 0);
        __builtin_amdgcn_global_load_lds((const unsigned*)(gbw[i] + (kt + 1) * 64), (unsigned*)(Sn + 8192 + (wave + 4 * i) * 512), 16, 0, 0);
      }
    }
#pragma unroll
    for (int ks = 0; ks < 2; ++ks) {
      bf8 af[4], bfr[4];
      const int ch = ((ks * 4 + g) ^ sw) * 8;
#pragma unroll
      for (int i = 0; i < 4; ++i) {
        af[i] = *(const bf8*)(Sc + aoff + i * 1024 + ch);
        bfr[i] = *(const bf8*)(Sc + boff + i * 1024 + ch);
      }
#pragma unroll
      for (int i = 0; i < 4; ++i)
#pragma unroll
        for (int j = 0; j < 4; ++j) acc[i][j] = mfma16(af[i], bfr[j], acc[i][j]);
    }
    asm volatile("s_waitcnt vmcnt(0)" ::: "memory");
    RAW_BARRIER();
  }
  if (has_next) {
#pragma unroll
    for (int i = 0; i < 4; ++i) {
      const int rg = wave + 4 * i;
      const int row = rg * 8 + lrow;
      const int cl = (lane & 7) ^ (((rg & 1) * 4 + sz) & 7);
      __builtin_amdgcn_global_load_lds((const unsigned*)(A + (size_t)(m0n + row) * lda + cl * 8), (unsigned*)(S0 + rg * 512), 16, 0, 0);
      __builtin_amdgcn_global_load_lds((const unsigned*)(Bt + (size_t)(n0n + row) * ldb + cl * 8), (unsigned*)(S0 + 8192 + rg * 512), 16, 0, 0);
    }
  }
  gemm_epilogue<EPI>(p, l, acc, m0, n0, wm, wn, lane, rowss);
}

__device__ __forceinline__ int mtile_count(int l) { return l < 3 ? 132 : 128; }
__device__ __forceinline__ int mtile_index(int l, int i) { return l < 3 ? i : (i >> 6) * 66 + 2 + (i & 63); }

__device__ __forceinline__ bool gemm_pick(int step, int bid, int G, int MT, int NT, int W, int& mt, int& nt) {
  const int C = G >> 3;
  const int L = (step * 8 + (bid & 7)) * C + (bid >> 3);
  if (L >= MT * NT) return false;
  const int s = L / (W * MT), rem = L - s * W * MT;
  mt = rem / W; nt = s * W + (rem - mt * W);
  return true;
}

template <int DQK, int NMAP>
__device__ __forceinline__ void attn_item(const Params& p, int l, const __bf16* __restrict__ Q, const __bf16* __restrict__ Kp,
                          const __bf16* __restrict__ Vt, int b, int h, int q0, int nkeys, char* smem) {
  constexpr int KLD = DQK + 8;
  constexpr int KCH = DQK / 8;
  constexpr int NKC = NMAP * 64 * KCH / 256;
  constexpr int NKS = DQK / 32;
  __bf16* Ks = (__bf16*)smem;
  __bf16* Vs = Ks + NMAP * 64 * KLD;
  const int tid = tid_(), lane = tid & 63, wave = tid >> 6, r = lane & 15, g = lane >> 4;
  const __bf16* Qb = Q + (size_t)((b * 4 + h) * NMAP) * PT * DQK;
  const __bf16* Kb = Kp + (size_t)((b * 4 + h) * NMAP) * PT * DQK;
  const __bf16* Vb = Vt + (size_t)((b * 4 + h) * 64) * PT;

  bf8 qf[NMAP][2][NKS];
#pragma unroll
  for (int mp = 0; mp < NMAP; ++mp)
#pragma unroll
    for (int qt = 0; qt < 2; ++qt)
#pragma unroll
      for (int ks = 0; ks < NKS; ++ks)
        qf[mp][qt][ks] = *(const bf8*)(Qb + ((size_t)mp * PT + q0 + wave * 32 + qt * 16 + r) * DQK + ks * 32 + g * 8);

  f4 o[NMAP][2][4];
  float mrun[NMAP][2], lsum[NMAP][2];
  f4 negm[NMAP][2];
#pragma unroll
  for (int mp = 0; mp < NMAP; ++mp)
#pragma unroll
    for (int qt = 0; qt < 2; ++qt) {
      mrun[mp][qt] = 0.f; lsum[mp][qt] = 0.f; negm[mp][qt] = f4{0.f, 0.f, 0.f, 0.f};
#pragma unroll
      for (int d = 0; d < 4; ++d) o[mp][qt][d] = f4{0.f, 0.f, 0.f, 0.f};
    }

  int koff_g[NKC], koff_s[NKC];
#pragma unroll
  for (int i = 0; i < NKC; ++i) {
    int c = tid + 256 * i;
    int mp = c / (64 * KCH), rem = c - mp * 64 * KCH;
    int row = rem / KCH, kc = rem - row * KCH;
    koff_g[i] = (mp * PT + row) * DQK + kc * 8;
    koff_s[i] = (mp * 64 + row) * KLD + kc * 8;
  }
  bf8 rk[NKC], rv[2];
  const int nkb = nkeys / 64;
#pragma unroll
  for (int i = 0; i < NKC; ++i) rk[i] = *(const bf8*)(Kb + koff_g[i]);
#pragma unroll
  for (int i = 0; i < 2; ++i) rv[i] = *(const bf8*)(Vb + (size_t)((tid >> 3) + 32 * i) * PT + (tid & 7) * 8);

  for (int kb = 0; kb < nkb; ++kb) {
    __syncthreads();
#pragma unroll
    for (int i = 0; i < NKC; ++i) *(bf8*)(Ks + koff_s[i]) = rk[i];
#pragma unroll
    for (int i = 0; i < 2; ++i) *(bf8*)(Vs + ((tid >> 3) + 32 * i) * 72 + (tid & 7) * 8) = rv[i];
    __syncthreads();
    if (kb + 1 < nkb) {
#pragma unroll
      for (int i = 0; i < NKC; ++i) rk[i] = *(const bf8*)(Kb + koff_g[i] + (size_t)(kb + 1) * 64 * DQK);
#pragma unroll
      for (int i = 0; i < 2; ++i) rv[i] = *(const bf8*)(Vb + (size_t)((tid >> 3) + 32 * i) * PT + (kb + 1) * 64 + (tid & 7) * 8);
    }
    f4 s[NMAP][2][2][2];
    __builtin_amdgcn_s_setprio(1);
#pragma unroll
    for (int mp = 0; mp < NMAP; ++mp)
#pragma unroll
      for (int m = 0; m < 2; ++m)
#pragma unroll
        for (int tp = 0; tp < 2; ++tp) {
          f4 s0 = negm[mp][0], s1 = negm[mp][1];
          const int krow = 32 * m + 8 * (r >> 2) + 4 * tp + (r & 3);
#pragma unroll
          for (int ks = 0; ks < NKS; ++ks) {
            bf8 kf = *(const bf8*)(Ks + (mp * 64 + krow) * KLD + ks * 32 + g * 8);
            s0 = mfma16(kf, qf[mp][0][ks], s0);
            s1 = mfma16(kf, qf[mp][1][ks], s1);
          }
          s[mp][0][m][tp] = s0; s[mp][1][m][tp] = s1;
        }
    __builtin_amdgcn_s_setprio(0);
    bf8 pf[NMAP][2][2];
#pragma unroll
    for (int mp = 0; mp < NMAP; ++mp)
#pragma unroll
      for (int qt = 0; qt < 2; ++qt) {
        float ps = 0.f;
#pragma unroll
        for (int m = 0; m < 2; ++m) {
          bf8 pk;
#pragma unroll
          for (int tp = 0; tp < 2; ++tp)
#pragma unroll
            for (int q = 0; q < 4; ++q) {
              float e = __builtin_amdgcn_exp2f(s[mp][qt][m][tp][q]);
              ps += e;
              pk[tp * 4 + q] = (__bf16)e;
            }
          pf[mp][qt][m] = pk;
        }
        const bool hi = __builtin_amdgcn_ballot_w64(!(ps < 65536.f)) != 0ull;
        const bool lo = __builtin_amdgcn_ballot_w64(ps > 0.f || lsum[mp][qt] > 0.f) == 0ull;
        if (hi || lo) {
          float bm = -INFINITY;
#pragma unroll
          for (int m = 0; m < 2; ++m)
#pragma unroll
            for (int tp = 0; tp < 2; ++tp)
#pragma unroll
              for (int q = 0; q < 4; ++q) bm = fmaxf(bm, s[mp][qt][m][tp][q]);
          bm = rows_max(bm);
          const float sh = lo ? bm : fmaxf(bm, 0.f);
          const float alpha = lo ? 1.f : __builtin_amdgcn_exp2f(-sh);
          mrun[mp][qt] += sh;
          const float nm = -mrun[mp][qt];
          negm[mp][qt] = f4{nm, nm, nm, nm};
          lsum[mp][qt] *= alpha;
#pragma unroll
          for (int d = 0; d < 4; ++d) o[mp][qt][d] *= alpha;
          ps = 0.f;
#pragma unroll
          for (int m = 0; m < 2; ++m) {
            bf8 pk;
#pragma unroll
            for (int tp = 0; tp < 2; ++tp)
#pragma unroll
              for (int q = 0; q < 4; ++q) {
                float e = __builtin_amdgcn_exp2f(s[mp][qt][m][tp][q] - sh);
                ps += e;
                pk[tp * 4 + q] = (__bf16)e;
              }
            pf[mp][qt][m] = pk;
          }
        }
        lsum[mp][qt] += ps;
      }
    __builtin_amdgcn_s_setprio(1);
#pragma unroll
    for (int d = 0; d < 4; ++d)
#pragma unroll
      for (int m = 0; m < 2; ++m) {
        bf8 vf = *(const bf8*)(Vs + (d * 16 + r) * 72 + 32 * m + 8 * g);
#pragma unroll
        for (int mp = 0; mp < NMAP; ++mp)
#pragma unroll
          for (int qt = 0; qt < 2; ++qt) o[mp][qt][d] = mfma16(vf, pf[mp][qt][m], o[mp][qt][d]);
      }
    __builtin_amdgcn_s_setprio(0);
  }
#pragma unroll
  for (int qt = 0; qt < 2; ++qt) {
    const int tok = b * PT + q0 + wave * 32 + qt * 16 + r;
    float inv[NMAP];
#pragma unroll
    for (int mp = 0; mp < NMAP; ++mp) {
      float ls = lsum[mp][qt];
      ls = rows_sum(ls);
      inv[mp] = 1.f / ls;
    }
    if constexpr (NMAP == 1) {
#pragma unroll
      for (int d = 0; d < 4; ++d)
        *(bf4*)(p.mix() + (size_t)tok * LDH + h * 64 + d * 16 + 4 * g) = pack4(o[0][qt][d] * inv[0]);
    } else {
      const float lam = p.lam()[l];
      const float li = 0.8f - 0.6f * expf(-0.3f * (float)l);
      f4 val[4];
      float ss = 0.f;
#pragma unroll
      for (int d = 0; d < 4; ++d) {
        val[d] = o[0][qt][d] * inv[0] - o[NMAP - 1][qt][d] * (lam * inv[NMAP - 1]);
        ss += val[d][0] * val[d][0] + val[d][1] * val[d][1] + val[d][2] * val[d][2] + val[d][3] * val[d][3];
      }
      ss = rows_sum(ss);
      const float rs = rsqrtf(ss * (1.f / 64.f) + EPSN) * (1.f - li);
      f4 gd[4];
#pragma unroll
      for (int d = 0; d < 4; ++d) gd[d] = *(const f4*)(p.g_diff_norm + l * 64 + d * 16 + 4 * g);
#pragma unroll
      for (int d = 0; d < 4; ++d) *(bf4*)(p.mix() + (size_t)tok * LDH + 256 + h * 64 + d * 16 + 4 * g) = pack4(val[d] * rs * gd[d]);
    }
  }
}

template <int DQK, int NMAP>
__device__ __forceinline__ void attn_dispatch(const Params& p, int l, int item, const __bf16* Q, const __bf16* K, const __bf16* Vt, char* smem) {
  int b, h, q0, nk;
  if (item < 512) { b = (item >> 2) & 1; h = item & 3; q0 = CTXL + (item >> 3) * 128; nk = PT; }
  else { int it = item - 512; b = it >> 3; h = (it >> 1) & 3; q0 = (it & 1) * 128; nk = CTXL; }
  attn_item<DQK, NMAP>(p, l, Q, K, Vt, b, h, q0, nk, smem);
}

__device__ __forceinline__ void hgrn1_item(const Params& p, int item, char* smem) {
  __bf16* kteT = (__bf16*)smem;
  __bf16* vT = kteT + 64 * 72;
  float* ptot = (float*)(vT + 64 * 72);
  const int tid = tid_(), lane = tid & 63, wave = tid >> 6, r = lane & 15, g = lane >> 4;
  const int c = item % NCH, bh = item / NCH;
  const int b = bh >> 3, h = bh & 7;
  const int tok0 = b * PT + c * 64;
  __syncthreads();
#pragma unroll
  for (int i = 0; i < 2; ++i) {
    int dv = (tid >> 3) + 32 * i;
    *(bf8*)(vT + dv * 72 + (tid & 7) * 8) = *(const bf8*)(p.hvt() + ((size_t)bh * 64 + dv) * PT + c * 64 + (tid & 7) * 8);
  }
  const int k = tid & 63, part = tid >> 6;
  float lfa[2][16];
#pragma unroll
  for (int dd = 0; dd < 2; ++dd) {
    const float* lfp = p.lf() + ((size_t)dd * NTOK + tok0 + part * 16) * 512 + h * 64 + k;
#pragma unroll
    for (int i = 0; i < 16; ++i) lfa[dd][i] = lfp[(size_t)i * 512];
  }
#pragma unroll
  for (int dir = 0; dir < 2; ++dir) {
    float lfv[16], cl[16];
#pragma unroll
    for (int i = 0; i < 16; ++i) lfv[i] = lfa[dir][i];
    float run = 0.f;
    if (dir == 0) {
#pragma unroll
      for (int i = 0; i < 16; ++i) { run += lfv[i]; cl[i] = run; }
    } else {
#pragma unroll
      for (int i = 15; i >= 0; --i) { run += lfv[i]; cl[i] = run; }
    }
    __syncthreads();
    ptot[part * 64 + k] = run;
    __syncthreads();
    float off = 0.f, total = 0.f;
#pragma unroll
    for (int q = 0; q < 4; ++q) {
      float t = ptot[q * 64 + k];
      total += t;
      if (dir == 0 ? (q < part) : (q > part)) off += t;
    }
#pragma unroll
    for (int i = 0; i < 16; ++i) {
      float cum = cl[i] + off;
      float kte = (1.f - __expf(lfv[i])) * __expf(total - cum);
      kteT[k * 72 + part * 16 + i] = (__bf16)kte;
    }
    const size_t sidx = ((size_t)bh * 2 + dir) * NCH + c;
    if (part == 0) p.dk()[sidx * 64 + k] = __expf(total);
    __syncthreads();
    f4 acc[4];
#pragma unroll
    for (int nt = 0; nt < 4; ++nt) acc[nt] = f4{0.f, 0.f, 0.f, 0.f};
#pragma unroll
    for (int ks = 0; ks < 2; ++ks) {
      bf8 af = *(const bf8*)(vT + (wave * 16 + r) * 72 + ks * 32 + g * 8);
#pragma unroll
      for (int nt = 0; nt < 4; ++nt) {
        bf8 bfr = *(const bf8*)(kteT + (nt * 16 + r) * 72 + ks * 32 + g * 8);
        acc[nt] = mfma16(af, bfr, acc[nt]);
      }
    }
    float* up = p.ut() + sidx * 4096;
#pragma unroll
    for (int nt = 0; nt < 4; ++nt)
#pragma unroll
      for (int q = 0; q < 4; ++q) up[(wave * 16 + 4 * g + q) * 64 + nt * 16 + r] = acc[nt][q];
  }
}

__device__ __forceinline__ void hgrn2_item(const Params& p, int item) {
  const int idx = item * 256 + tid_();
  const int e = idx & 4095, sd = idx >> 12;
  const int dir = sd & 1, kk = e & 63;
  const float* up = p.ut() + (size_t)sd * NCH * 4096 + e;
  const float* dp = p.dk() + (size_t)sd * NCH * 64 + kk;
  __bf16* sp = p.st() + (size_t)sd * NCH * 4096 + e;
  float S = 0.f;
  for (int jb = 0; jb < NCH; jb += 22) {
    float u[22], d[22];
    int cc[22];
#pragma unroll
    for (int q = 0; q < 22; ++q) {
      int j = jb + q;
      int c = dir == 0 ? j : (j < 4 ? 3 - j : 135 - j);
      cc[q] = c;
      u[q] = up[(size_t)c * 4096];
      d[q] = dp[c * 64];
    }
#pragma unroll
    for (int q = 0; q < 22; ++q) {
      sp[(size_t)cc[q] * 4096] = (__bf16)S;
      S = d[q] * S + u[q];
    }
  }
}

__device__ __forceinline__ void hgrn3_item(const Params& p, int l, int item, char* smem) {
  __bf16* qS = (__bf16*)smem;
  __bf16* kS = qS + 64 * 72;
  __bf16* vT = kS + 64 * 72;
  __bf16* stS = vT + 64 * 72;
  float* cumS = (float*)(stS + 64 * 72);
  float* ptot = cumS + 64 * 68;
  const int tid = tid_(), lane = tid & 63, wave = tid >> 6, r = lane & 15, g = lane >> 4;
  const int c = item % NCH, bh = item / NCH;
  const int b = bh >> 3, h = bh & 7;
  const int tok0 = b * PT + c * 64;
  __syncthreads();
#pragma unroll
  for (int i = 0; i < 2; ++i) {
    int row = (tid >> 3) + 32 * i;
    *(bf8*)(vT + row * 72 + (tid & 7) * 8) = *(const bf8*)(p.hvt() + ((size_t)bh * 64 + row) * PT + c * 64 + (tid & 7) * 8);
    *(bf8*)(qS + row * 72 + (tid & 7) * 8) = *(const bf8*)(p.hq() + (size_t)(tok0 + row) * 512 + h * 64 + (tid & 7) * 8);
  }
  f4 o[4];
#pragma unroll
  for (int d = 0; d < 4; ++d) o[d] = f4{0.f, 0.f, 0.f, 0.f};
  const int k = tid & 63, part = tid >> 6;
  const int t = 16 * wave + r;
  bf8 sta[2][2];
#pragma unroll
  for (int dd = 0; dd < 2; ++dd) {
    const __bf16* sp = p.st() + (((size_t)bh * 2 + dd) * NCH + c) * 4096;
#pragma unroll
    for (int i = 0; i < 2; ++i) sta[dd][i] = *(const bf8*)(sp + ((tid >> 3) + 32 * i) * 64 + (tid & 7) * 8);
  }
  float lfa[2][16];
#pragma unroll
  for (int dd = 0; dd < 2; ++dd) {
    const float* lfp = p.lf() + ((size_t)dd * NTOK + tok0 + part * 16) * 512 + h * 64 + k;
#pragma unroll
    for (int i = 0; i < 16; ++i) lfa[dd][i] = lfp[(size_t)i * 512];
  }
#pragma unroll
  for (int dir = 0; dir < 2; ++dir) {
    float lfv[16], cl[16];
#pragma unroll
    for (int i = 0; i < 16; ++i) lfv[i] = lfa[dir][i];
    float run = 0.f;
    if (dir == 0) {
#pragma unroll
      for (int i = 0; i < 16; ++i) { run += lfv[i]; cl[i] = run; }
    } else {
#pragma unroll
      for (int i = 15; i >= 0; --i) { run += lfv[i]; cl[i] = run; }
    }
    __syncthreads();
    ptot[part * 64 + k] = run;
#pragma unroll
    for (int i = 0; i < 16; ++i) kS[(part * 16 + i) * 72 + k] = (__bf16)((1.f - __expf(lfv[i])));
#pragma unroll
    for (int i = 0; i < 2; ++i) *(bf8*)(stS + ((tid >> 3) + 32 * i) * 72 + (tid & 7) * 8) = sta[dir][i];
    __syncthreads();
    float off = 0.f;
#pragma unroll
    for (int q = 0; q < 4; ++q) {
      float tt = ptot[q * 64 + k];
      if (dir == 0 ? (q < part) : (q > part)) off += tt;
    }
#pragma unroll
    for (int i = 0; i < 16; ++i) cumS[(part * 16 + i) * 68 + k] = cl[i] + off;
    __syncthreads();
    float cs[2][8];
    bf8 qtf[2], qhf[2];
#pragma unroll
    for (int ks = 0; ks < 2; ++ks) {
      const int dk0 = ks * 32 + 8 * g;
      bf8 qv = *(const bf8*)(qS + t * 72 + dk0);
#pragma unroll
      for (int j = 0; j < 8; ++j) {
        float cst;
        if (dir == 0) cst = wave > 0 ? cumS[(16 * wave - 1) * 68 + dk0 + j] : 0.f;
        else cst = wave < 3 ? cumS[(16 * wave + 16) * 68 + dk0 + j] : 0.f;
        cs[ks][j] = cst;
        float cv = cumS[t * 68 + dk0 + j];
        float qf_ = (float)qv[j];
        qtf[ks][j] = (__bf16)(qf_ * __expf(cv - cst));
        qhf[ks][j] = (__bf16)(qf_ * __expf(cv));
      }
    }
#pragma unroll
    for (int m = 0; m < 2; ++m) {
      const bool need = dir == 0 ? (m <= (wave >> 1)) : (m >= (wave >> 1));
      if (need) {
        bf8 pf;
#pragma unroll
        for (int tp = 0; tp < 2; ++tp) {
          const int srow = 32 * m + 8 * (r >> 2) + 4 * tp + (r & 3);
          f4 sc = f4{0.f, 0.f, 0.f, 0.f};
#pragma unroll
          for (int ks = 0; ks < 2; ++ks) {
            const int dk0 = ks * 32 + 8 * g;
            bf8 kv = *(const bf8*)(kS + srow * 72 + dk0);
            bf8 ktf;
#pragma unroll
            for (int j = 0; j < 8; ++j) {
              float ex = fminf(cs[ks][j] - cumS[srow * 68 + dk0 + j], 80.f);
              ktf[j] = (__bf16)((float)kv[j] * __expf(ex));
            }
            sc = mfma16(ktf, qtf[ks], sc);
          }
#pragma unroll
          for (int q = 0; q < 4; ++q) {
            const int s = 32 * m + 8 * g + 4 * tp + q;
            const bool keep = dir == 0 ? (s <= t) : (s >= t);
            pf[tp * 4 + q] = keep ? (__bf16)sc[q] : (__bf16)0.f;
          }
        }
#pragma unroll
        for (int d = 0; d < 4; ++d) {
          bf8 vf = *(const bf8*)(vT + (d * 16 + r) * 72 + 32 * m + 8 * g);
          o[d] = mfma16(vf, pf, o[d]);
        }
      }
    }
#pragma unroll
    for (int d = 0; d < 4; ++d)
#pragma unroll
      for (int ks = 0; ks < 2; ++ks) {
        bf8 sf = *(const bf8*)(stS + (d * 16 + r) * 72 + ks * 32 + 8 * g);
        o[d] = mfma16(sf, qhf[ks], o[d]);
      }
  }
  float ss = 0.f;
#pragma unroll
  for (int d = 0; d < 4; ++d) ss += o[d][0] * o[d][0] + o[d][1] * o[d][1] + o[d][2] * o[d][2] + o[d][3] * o[d][3];
  ss = rows_sum(ss);
  const float rs = rsqrtf(ss * (1.f / 64.f) + EPSN);
  f4 gn[4]; bf4 gate[4];
#pragma unroll
  for (int d = 0; d < 4; ++d) {
    gn[d] = *(const f4*)(p.g_hgrn_norm + l * 64 + d * 16 + 4 * g);
    gate[d] = *(const bf4*)(p.hg() + (size_t)(tok0 + t) * 512 + h * 64 + d * 16 + 4 * g);
  }
#pragma unroll
  for (int d = 0; d < 4; ++d) {
    f4 res;
#pragma unroll
    for (int q = 0; q < 4; ++q) res[q] = o[d][q] * rs * gn[d][q] * (float)gate[d][q];
    *(bf4*)(p.mix() + (size_t)(tok0 + t) * LDH + 512 + h * 64 + d * 16 + 4 * g) = pack4(res);
  }
}

#define NPHASE 38
#ifndef ONLY
#define ONLY -1
#endif
#define PHEN(x) (ONLY < 0 || ONLY == (x))
__device__ __forceinline__ void run_phase(const Params& p, int ph, char* smem) {
  const int bid = bid_(), G = gridDim.x;
  if (ph == 0) { if (PHEN(100)) phase0(p, smem); return; }
  if (ph == NPHASE - 1) {
    for (int it = bid; it < NB * SEQ / 16; it += G) final_norm_item(p, it);
    return;
  }
  const int l = (ph - 1) / 9, sp = (ph - 1) % 9;
  const int nmt = mtile_count(l);
  switch (sp) {
    case 0: if (PHEN(0)) {
      for (int i = bid * 256 + tid_(); i < (INWP - INW) * DM / 8; i += G * 256) {
        bf8 z;
#pragma unroll
        for (int j = 0; j < 8; ++j) z[j] = (__bf16)0.f;
        *(bf8*)(p.wt_in() + (size_t)(INW + (i >> 7)) * LDH + (size_t)(i & 127) * 8) = z;
      }
      for (int it = bid; it < 1056 + 6688; it += G) {
        if (it < 1056) norm_item(p, l, 0, it);
        else conv_item(p, l, it - 1056, smem);
      }
    } break;
    case 1: if (PHEN(1)) {
      {
        int mt, nt, mtn = 0, ntn = 0;
        bool have = gemm_pick(0, bid, G, 132, 30, 10, mt, nt), pre = false;
        for (int st = 0; have; ++st) {
          const bool hn = gemm_pick(st + 1, bid, G, 132, 30, 10, mtn, ntn);
          gemm_tile<EPI_IN, false>(p, l, p.hb(), LDH, p.wt_in(), LDH, DM, mt * 128, nt * 128, smem, pre, hn, mtn * 128, ntn * 128);
          pre = hn; have = hn; mt = mtn; nt = ntn;
        }
      }
    } break;
    case 2: if (PHEN(2)) {
      const int natt = l < 3 ? 528 : 512;
      const int total = natt + 396 + 528 + 2112, K = (total + G - 1) / G;
      const bool flip = (bid >> 3) & 1;
      for (int kk = 0; kk < K; ++kk) {
        const int k = flip ? (kk + 1 == K ? 0 : kk + 1) : kk;
        const int it0 = bid + k * G;
        if (it0 >= total) continue;
        if (it0 < natt) { attn_dispatch<32, 2>(p, l, it0, p.qd(), p.kd(), p.vdt(), smem); continue; }
        const int it = it0 - natt;
        if (it < 396) gemm_tile<EPI_UQ, true>(p, l, p.cq(), 256, p.wt_uq(), 256, 256, (it / 3) * 128, (it % 3) * 128, smem);
        else if (it < 924) { int j = it - 396; gemm_tile<EPI_UKV, true>(p, l, p.ckv(), 128, p.wt_ukv(), 128, 128, (j / 4) * 128, (j % 4) * 128, smem); }
        else hgrn1_item(p, it - 924, smem);
      }
    } break;
    case 3: if (PHEN(3)) {
      const int natt = l < 3 ? 528 : 512;
      const int total = 512 + natt, K = (total + G - 1) / G;
      const bool flip = (bid >> 3) & 1;
      for (int kk = 0; kk < K; ++kk) {
        const int k = flip ? (kk + 1 == K ? 0 : kk + 1) : kk;
        const int it = bid + k * G;
        if (it >= total) continue;
        if (it < 512) hgrn2_item(p, it);
        else attn_dispatch<96, 1>(p, l, it - 512, p.qm(), p.km(), p.vmt(), smem);
      }
    } break;
    case 4: if (PHEN(4)) {
      for (int j = bid; j < 2112; j += G) {
        if (l == 3 && (j % NCH) < 4) continue;
        hgrn3_item(p, l, j, smem);
      }
    } break;
    case 5: if (PHEN(5)) {
      {
        int mt, nt, mtn = 0, ntn = 0;
        bool have = gemm_pick(0, bid, G, 128, 8, 8, mt, nt), pre = false;
        for (int st = 0; have; ++st) {
          const bool hn = gemm_pick(st + 1, bid, G, 128, 8, 8, mtn, ntn);
          gemm_tile<EPI_OUT, false>(p, l, p.mix(), LDH, p.wt_out(), LDH, DM, mtile_index(3, mt) * 128, nt * 128, smem, pre, hn,
                                    mtile_index(3, mtn) * 128, ntn * 128);
          pre = hn; have = hn; mt = mtn; nt = ntn;
        }
      }
      if (l < 3) {
        for (int u = bid; u < 32 * 8; u += G) {
          const int tile = u >> 3, sp = u & 7;
          const int cm = tile >> 3, nt = tile & 7;
          const int mt = (cm >> 1) * 66 + (cm & 1);
          gemm_tile<EPI_OUT_AT, false>(p, l, p.mix() + sp * 128, LDH, p.wt_out() + sp * 128, LDH, 128, mt * 128, nt * 128, smem);
        }
      }
    } break;
    case 6: if (PHEN(6)) {
      for (int it = bid; it < 1056; it += G) norm_item(p, l, 1, it);
    } break;
    case 7: if (PHEN(7)) {
      {
        int mt, nt, mtn = 0, ntn = 0;
        bool have = gemm_pick(0, bid, G, nmt, 44, 11, mt, nt), pre = false;
        for (int st = 0; have; ++st) {
          const bool hn = gemm_pick(st + 1, bid, G, nmt, 44, 11, mtn, ntn);
          gemm_tile<EPI_UP, false>(p, l, p.hb(), LDH, p.wt_gu(), LDH, DM, mtile_index(l, mt) * 128, nt * 128, smem, pre, hn,
                                   mtile_index(l, mtn) * 128, ntn * 128);
          pre = hn; have = hn; mt = mtn; nt = ntn;
        }
      }
    } break;
    case 8: if (PHEN(8)) {
      {
        int mt, nt, mtn = 0, ntn = 0;
        bool have = gemm_pick(0, bid, G, 128, 8, 8, mt, nt), pre = false;
        for (int st = 0; have; ++st) {
          const bool hn = gemm_pick(st + 1, bid, G, 128, 8, 8, mtn, ntn);
          gemm_tile<EPI_DOWN, false>(p, l, p.act(), LDF, p.wt_down(), LDF, DFF, mtile_index(3, mt) * 128, nt * 128, smem, pre, hn,
                                     mtile_index(3, mtn) * 128, ntn * 128);
          pre = hn; have = hn; mt = mtn; nt = ntn;
        }
      }
      if (l < 3) {
        for (int u = bid; u < 32 * 11; u += G) {
          const int tile = u / 11, sp = u - tile * 11;
          const int cm = tile >> 3, nt = tile & 7;
          const int mt = (cm >> 1) * 66 + (cm & 1);
          gemm_tile<EPI_DOWN_AT, false>(p, l, p.act() + sp * 256, LDF, p.wt_down() + sp * 256, LDF, 256, mt * 128, nt * 128, smem);
        }
      }
    } break;
  }
}

#define XB_TMO      128
#define XB_XCNT(j)  (256  + 64 * (j))
#define XB_XSUB(j)  (1280 + 64 * (j))
#define XB_XGEN(j)  (2304 + 64 * (j))
#define XB_TOP      3328
#define XB_TOPGEN   3392
#define XCD_BAR_WORDS 3456
#define XB_SPIN_CAP (1u << 22)
#define LAS __attribute__((address_space(3)))

__device__ __forceinline__ unsigned xb_ld(unsigned* p)              { return __hip_atomic_load(p, __ATOMIC_RELAXED, __HIP_MEMORY_SCOPE_AGENT); }
__device__ __forceinline__ unsigned xb_add(unsigned* p, unsigned v) { return __hip_atomic_fetch_add(p, v, __ATOMIC_RELAXED, __HIP_MEMORY_SCOPE_AGENT); }
__device__ __forceinline__ unsigned xb_xcc_id() { return (unsigned)__builtin_amdgcn_s_getreg((3 << 11) | 20) & 0xFu; }
#define XB_SPIN(cond, bar) do { unsigned _sp = 0; while (cond) { __builtin_amdgcn_s_sleep(1); \
    if ((++_sp & 255u) == 0u) { if (xb_ld(&(bar)[XB_TMO])) break; if (_sp > XB_SPIN_CAP) { atomicAdd(&(bar)[XB_TMO], 1u); break; } } } } while (0)

struct XcdBarrier {
    unsigned* bar; unsigned x;
    volatile LAS unsigned* st;
};

__device__ __forceinline__ XcdBarrier xcd_barrier_post(unsigned* bar, volatile LAS unsigned* st) {
    XcdBarrier b; b.bar = bar; b.x = xb_xcc_id(); b.st = st;
    if (threadIdx.x == 0) (void)xb_add(&bar[XB_XCNT(b.x)], 1u);
    return b;
}
__device__ __forceinline__ void xcd_barrier_complete(unsigned* bar, unsigned x, unsigned& nloc, unsigned& nx) {
    const unsigned G = gridDim.x * gridDim.y * gridDim.z;
    unsigned sum, cnt, mine, sp = 0u;
    for (;;) {
        sum = 0u; cnt = 0u; mine = 0u;
#pragma unroll
        for (unsigned j = 0; j < 16; ++j) { const unsigned c = xb_ld(&bar[XB_XCNT(j)]); sum += c; cnt += (c > 0u) ? 1u : 0u; mine = (j == x) ? c : mine; }
        if (sum == G) break;
        __builtin_amdgcn_s_sleep(1);
        if ((++sp & 255u) == 0u) { if (xb_ld(&bar[XB_TMO])) break; if (sp > XB_SPIN_CAP) { atomicAdd(&bar[XB_TMO], 1u); break; } }
    }
    nloc = mine > 0u ? mine : 1u; nx = cnt > 0u ? cnt : 1u;
}

__device__ __forceinline__ void xcd_barrier(const XcdBarrier& b) {
    asm volatile("s_waitcnt vmcnt(0)" ::: "memory");
    __syncthreads();
    if (threadIdx.x == 0) {
        unsigned* bar = b.bar;
        __builtin_amdgcn_s_waitcnt(0);
        unsigned nloc = b.st[0], nx = b.st[1];
        if (nloc == 0u) { xcd_barrier_complete(bar, b.x, nloc, nx); b.st[0] = nloc; b.st[1] = nx; }
        const unsigned old = xb_add(&bar[XB_XSUB(b.x)], 1u);
        const unsigned gen = old / nloc;
        if (old + 1u == (gen + 1u) * nloc) {
            __builtin_amdgcn_fence(__ATOMIC_RELEASE, "agent");
            asm volatile("s_waitcnt vmcnt(0)" ::: "memory");
            const unsigned og = xb_add(&bar[XB_TOP], 1u);
            const unsigned tg = og / nx;
            if (og + 1u == (tg + 1u) * nx) xb_add(&bar[XB_TOPGEN], 1u);
            else XB_SPIN(xb_ld(&bar[XB_TOPGEN]) == tg, bar);
            __builtin_amdgcn_fence(__ATOMIC_ACQUIRE, "agent");
            xb_add(&bar[XB_XGEN(b.x)], 1u);
            asm volatile("s_waitcnt vmcnt(0)" ::: "memory");
        } else {
            XB_SPIN(xb_ld(&bar[XB_XGEN(b.x)]) == gen, bar);
            __builtin_amdgcn_fence(__ATOMIC_ACQUIRE, "agent");
            asm volatile("s_waitcnt vmcnt(0)" ::: "memory");
        }
    }
    __syncthreads();
}


__device__ __forceinline__ void grid_barrier(unsigned* cnt, unsigned target) {
  asm volatile("s_waitcnt vmcnt(0)" ::: "memory");
  __syncthreads();
  if (tid_() == 0) {
    __builtin_amdgcn_fence(__ATOMIC_RELEASE, "agent");
    asm volatile("s_waitcnt vmcnt(0)" ::: "memory");
    __hip_atomic_fetch_add(cnt, 1u, __ATOMIC_RELAXED, __HIP_MEMORY_SCOPE_AGENT);
    unsigned spins = 0;
    while (__hip_atomic_load(cnt, __ATOMIC_RELAXED, __HIP_MEMORY_SCOPE_AGENT) < target) {
      __builtin_amdgcn_s_sleep(2);
      if (++spins > (1u << 24)) break;
    }
    __builtin_amdgcn_fence(__ATOMIC_ACQUIRE, "agent");
    asm volatile("s_waitcnt vmcnt(0)" ::: "memory");
  }
  __syncthreads();
}

__global__ void __launch_bounds__(256, 2) hybrid_megakernel(Params p, int ph0, int ph1) {
  __shared__ __attribute__((aligned(16))) char smem[SMEM_BYTES];
  cg::grid_group grid = cg::this_grid();
  volatile LAS unsigned* xst = (volatile LAS unsigned*)(smem + 66048);
  if (__builtin_amdgcn_workitem_id_x() == 0) { xst[0] = 0u; xst[1] = 0u; }
  __syncthreads();
  XcdBarrier xb; xb.bar = nullptr; xb.x = 0; xb.st = xst;
  for (int ph = ph0; ph < ph1; ++ph) {
    Params q = p;
    size_t zoff = 0;
    asm volatile("" : "+s"(zoff));
    q.ws = p.ws + zoff; q.out = p.out + zoff;
    run_phase(q, ph, smem);
#ifdef REPMASK
    if (ph > 0 && ph < NPHASE - 1 && ((REPMASK >> ((ph - 1) % 9)) & 1)) { grid.sync(); run_phase(q, ph, smem); }
#endif
    if (ph + 1 < ph1) {
      if (ph == ph0) { grid.sync(); xb = xcd_barrier_post((unsigned*)(p.ws + OFF_xbar), xst); }
      else xcd_barrier(xb);
    }
  }
}

extern "C" void kernel_launch(void* const* d_in, const int* in_sizes, int n_in, void* d_out, int out_size, void* d_ws,
                              size_t ws_size, hipStream_t stream) {
  static int grid_blocks = 0;
  if (!grid_blocks) {
    int dev = 0, cus = 0, per_cu = 0;
    hipGetDevice(&dev);
    hipDeviceGetAttribute(&cus, hipDeviceAttributeMultiprocessorCount, dev);
    hipOccupancyMaxActiveBlocksPerMultiprocessor(&per_cu, hybrid_megakernel, 256, 0);
    if (per_cu > 2) per_cu = 2;
    if (per_cu < 1) per_cu = 1;
    grid_blocks = cus * per_cu;
  }
  Params p{};
  const float* const* in = (const float* const*)d_in;
  p.x = in[0]; p.c = in[1]; p.ctx = in[2]; p.c_ctx = in[3]; p.w_ada = in[4]; p.b_ada = in[5]; p.g_norm1 = in[6];
  p.g_norm2 = in[7]; p.w_in = in[8]; p.g_q_norm = in[9]; p.w_uq = in[10]; p.g_kv_norm = in[11]; p.w_ukv = in[12];
  p.diff_lambda = in[13]; p.g_diff_norm = in[14]; p.hgrn_lb = in[15]; p.g_hgrn_norm = in[16]; p.w_out = in[17];
  p.w_gate = in[18]; p.w_up = in[19]; p.w_down = in[20]; p.g_final = in[21];
  p.out = (float*)d_out;
  p.ws = (char*)d_ws;
  if (WS_TOTAL > ws_size) { fprintf(stderr, "workspace too small: need %zu have %zu\n", (size_t)WS_TOTAL, ws_size); return; }
  int ph0 = 0, ph1 = NPHASE;
  void* args[] = {&p, &ph0, &ph1};
  hipError_t e = hipLaunchCooperativeKernel((void*)hybrid_megakernel, dim3(grid_blocks), dim3(256), args, 0, stream);
  if (e != hipSuccess) fprintf(stderr, "cooperative launch failed: %s (grid %d)\n", hipGetErrorString(e), grid_blocks);
}
```

```cpp
#include <hip/hip_runtime.h>
#include <hip/hip_cooperative_groups.h>
#include <cstdio>
namespace cg = cooperative_groups;

typedef __attribute__((ext_vector_type(8))) __bf16 bf8;
typedef __attribute__((ext_vector_type(4))) __bf16 bf4;
typedef __attribute__((ext_vector_type(4))) float f4;

#define XCD_BAR_WORDS_C 3456
#define NB 2
#define SEQ 8192
#define CTXL 256
#define PT 8448
#define NTOK 16896
#define DM 1024
#define INW 3744
#define INWP 3840
#define DFF 2816
#define NCH 132
#define LDH 1088
#define LDF 2880
#define LOG2E 1.4426950408889634f
#define EPSN 1e-6f
#define SMEM_BYTES 66064

constexpr size_t al256(size_t x) { return (x + 255) & ~(size_t)255; }
constexpr size_t OFF_xc = 0;
constexpr size_t OFF_mod = OFF_xc + al256((size_t)NB*CTXL*DM*4);
constexpr size_t OFF_rope = OFF_mod + al256((size_t)4*3*6144*4);
constexpr size_t OFF_llb = OFF_rope + al256(128*8*2*4);
constexpr size_t OFF_l1mlb = OFF_llb + al256(4*1024*4);
constexpr size_t OFF_lam = OFF_l1mlb + al256(4*1024*4);
constexpr size_t OFF_wt_in = OFF_lam + al256(256);
constexpr size_t OFF_wt_uq = OFF_wt_in + al256((size_t)INWP*LDH*2);
constexpr size_t OFF_wt_ukv = OFF_wt_uq + al256((size_t)384*256*2);
constexpr size_t OFF_wt_out = OFF_wt_ukv + al256((size_t)512*128*2);
constexpr size_t OFF_wt_gu = OFF_wt_out + al256((size_t)DM*LDH*2);
constexpr size_t OFF_wt_down = OFF_wt_gu + al256((size_t)2*DFF*LDH*2);
constexpr size_t OFF_hb = OFF_wt_down + al256((size_t)DM*LDF*2);
constexpr size_t OFF_cq = OFF_hb + al256((size_t)NTOK*LDH*2);
constexpr size_t OFF_ckv = OFF_cq + al256((size_t)NTOK*256*2);
constexpr size_t OFF_qm = OFF_ckv + al256((size_t)NTOK*128*2);
constexpr size_t OFF_km = OFF_qm + al256((size_t)NB*4*PT*96*2);
constexpr size_t OFF_vmt = OFF_km + al256((size_t)NB*4*PT*96*2);
constexpr size_t OFF_qd = OFF_vmt + al256((size_t)NB*4*64*PT*2);
constexpr size_t OFF_kd = OFF_qd + al256((size_t)NB*4*2*PT*32*2);
constexpr size_t OFF_vdt = OFF_kd + al256((size_t)NB*4*2*PT*32*2);
constexpr size_t OFF_hq = OFF_vdt + al256((size_t)NB*4*64*PT*2);
constexpr size_t OFF_hvt = OFF_hq + al256((size_t)NTOK*512*2);
constexpr size_t OFF_hg = OFF_hvt + al256((size_t)NB*8*64*PT*2);
constexpr size_t OFF_dk = OFF_hg + al256((size_t)NTOK*512*2);
constexpr size_t OFF_st = OFF_dk + al256((size_t)NB*8*2*NCH*64*4);
constexpr size_t OFF_lf = OFF_st + al256((size_t)NB*8*2*NCH*4096*2);
constexpr size_t OFF_ut = OFF_lf + al256((size_t)2*NTOK*512*4);
constexpr size_t OFF_xbar = OFF_ut + al256((size_t)NB*8*2*NCH*4096*4);
constexpr size_t WS_TOTAL_OLD = OFF_ut + al256((size_t)NB*8*2*NCH*4096*4);
constexpr size_t WS_TOTAL = OFF_xbar + al256((size_t)XCD_BAR_WORDS_C*4);
struct Params {
  const float *x, *c, *ctx, *c_ctx, *w_ada, *b_ada, *g_norm1, *g_norm2, *w_in, *g_q_norm, *w_uq, *g_kv_norm, *w_ukv,
      *diff_lambda, *g_diff_norm, *hgrn_lb, *g_hgrn_norm, *w_out, *w_gate, *w_up, *w_down, *g_final;
  float* out;
  char* ws;
  __device__ __forceinline__ float* xc() const { return (float*)(ws + OFF_xc); }
  __device__ __forceinline__ float* mod() const { return (float*)(ws + OFF_mod); }
  __device__ __forceinline__ float* rope() const { return (float*)(ws + OFF_rope); }
  __device__ __forceinline__ float* llb() const { return (float*)(ws + OFF_llb); }
  __device__ __forceinline__ float* l1mlb() const { return (float*)(ws + OFF_l1mlb); }
  __device__ __forceinline__ float* lam() const { return (float*)(ws + OFF_lam); }
  __device__ __forceinline__ __bf16* wt_in() const { return (__bf16*)(ws + OFF_wt_in); }
  __device__ __forceinline__ __bf16* wt_uq() const { return (__bf16*)(ws + OFF_wt_uq); }
  __device__ __forceinline__ __bf16* wt_ukv() const { return (__bf16*)(ws + OFF_wt_ukv); }
  __device__ __forceinline__ __bf16* wt_out() const { return (__bf16*)(ws + OFF_wt_out); }
  __device__ __forceinline__ __bf16* wt_gu() const { return (__bf16*)(ws + OFF_wt_gu); }
  __device__ __forceinline__ __bf16* wt_down() const { return (__bf16*)(ws + OFF_wt_down); }
  __device__ __forceinline__ __bf16* hb() const { return (__bf16*)(ws + OFF_hb); }
  __device__ __forceinline__ __bf16* cq() const { return (__bf16*)(ws + OFF_cq); }
  __device__ __forceinline__ __bf16* ckv() const { return (__bf16*)(ws + OFF_ckv); }
  __device__ __forceinline__ __bf16* qm() const { return (__bf16*)(ws + OFF_qm); }
  __device__ __forceinline__ __bf16* km() const { return (__bf16*)(ws + OFF_km); }
  __device__ __forceinline__ __bf16* vmt() const { return (__bf16*)(ws + OFF_vmt); }
  __device__ __forceinline__ __bf16* qd() const { return (__bf16*)(ws + OFF_qd); }
  __device__ __forceinline__ __bf16* kd() const { return (__bf16*)(ws + OFF_kd); }
  __device__ __forceinline__ __bf16* vdt() const { return (__bf16*)(ws + OFF_vdt); }
  __device__ __forceinline__ __bf16* hq() const { return (__bf16*)(ws + OFF_hq); }
  __device__ __forceinline__ __bf16* hvt() const { return (__bf16*)(ws + OFF_hvt); }
  __device__ __forceinline__ __bf16* hg() const { return (__bf16*)(ws + OFF_hg); }
  __device__ __forceinline__ float* dk() const { return (float*)(ws + OFF_dk); }
  __device__ __forceinline__ __bf16* st() const { return (__bf16*)(ws + OFF_st); }
  __device__ __forceinline__ float* lf() const { return (float*)(ws + OFF_lf); }
  __device__ __forceinline__ float* ut() const { return (float*)(ws + OFF_ut); }
  __device__ __forceinline__ __bf16* mix() const { return hb(); }
  __device__ __forceinline__ __bf16* act() const { return (__bf16*)lf(); }
};

__device__ __forceinline__ int tid_() { int t = __builtin_amdgcn_workitem_id_x(); asm volatile("" : "+v"(t)); return t; }
__device__ __forceinline__ int bid_() { int t = __builtin_amdgcn_workgroup_id_x(); asm volatile("" : "+s"(t)); return t; }
__device__ __forceinline__ float silu_f(float x) { return x * __builtin_amdgcn_rcpf(1.f + __expf(-x)); }
__device__ __forceinline__ float wave_sum(float v) {
  v += __uint_as_float(__builtin_amdgcn_update_dpp(0u, __float_as_uint(v), 0x128, 0xf, 0xf, false));
  v += __uint_as_float(__builtin_amdgcn_update_dpp(0u, __float_as_uint(v), 0x124, 0xf, 0xf, false));
  v += __uint_as_float(__builtin_amdgcn_update_dpp(0u, __float_as_uint(v), 0x122, 0xf, 0xf, false));
  v += __uint_as_float(__builtin_amdgcn_update_dpp(0u, __float_as_uint(v), 0x121, 0xf, 0xf, false));
  unsigned u = __float_as_uint(v);
  auto a = __builtin_amdgcn_permlane16_swap(u, u, false, false);
  float m = __uint_as_float(a[0]) + __uint_as_float(a[1]);
  unsigned w = __float_as_uint(m);
  auto b = __builtin_amdgcn_permlane32_swap(w, w, false, false);
  return __uint_as_float(b[0]) + __uint_as_float(b[1]);
}
__device__ __forceinline__ float* xrow(const Params& p, int tok) {
  int b = tok / PT, pp = tok - b * PT;
  return pp < CTXL ? p.xc() + (size_t)(b * CTXL + pp) * DM : p.out + (size_t)(b * SEQ + pp - CTXL) * DM;
}
__device__ __forceinline__ float log_forget(float z, float lb, float oml) {
  const float sg = __builtin_amdgcn_rcpf(1.f + __expf(-fmaxf(z, -80.f)));
  return __logf(lb + oml * sg);
}
__device__ __forceinline__ float rows_max(float x) {
  unsigned u = __float_as_uint(x);
  auto a = __builtin_amdgcn_permlane16_swap(u, u, false, false);
  float m = fmaxf(__uint_as_float(a[0]), __uint_as_float(a[1]));
  unsigned v = __float_as_uint(m);
  auto b = __builtin_amdgcn_permlane32_swap(v, v, false, false);
  return fmaxf(__uint_as_float(b[0]), __uint_as_float(b[1]));
}
__device__ __forceinline__ float rows_sum(float x) {
  unsigned u = __float_as_uint(x);
  auto a = __builtin_amdgcn_permlane16_swap(u, u, false, false);
  float m = __uint_as_float(a[0]) + __uint_as_float(a[1]);
  unsigned v = __float_as_uint(m);
  auto b = __builtin_amdgcn_permlane32_swap(v, v, false, false);
  return __uint_as_float(b[0]) + __uint_as_float(b[1]);
}
__device__ __forceinline__ f4 mfma16(bf8 a, bf8 b, f4 c) { return __builtin_amdgcn_mfma_f32_16x16x32_bf16(a, b, c, 0, 0, 0); }

__device__ __forceinline__ void phase0(const Params& p, char* smem) {
  const int tid = tid_();
  const int gsz = gridDim.x * 256, gtid = bid_() * 256 + tid;
  {
    const float4* xs = (const float4*)p.x; float4* xo = (float4*)p.out;
    for (int i = gtid; i < NB * SEQ * DM / 4; i += gsz) xo[i] = xs[i];
    const float4* cs = (const float4*)p.ctx; float4* co = (float4*)p.xc();
    for (int i = gtid; i < NB * CTXL * DM / 4; i += gsz) co[i] = cs[i];
  }
  if (gtid < 1024) {
    int pos = gtid >> 3, f = gtid & 7;
    float freq = powf(10000.f, -(float)f / 8.f);
    float ang = (float)pos * freq, s, c;
    sincosf(ang, &s, &c);
    p.rope()[gtid * 2] = c; p.rope()[gtid * 2 + 1] = s;
  } else if (gtid < 2048) {
    int n = gtid - 1024;
    float r0 = p.hgrn_lb[n], r1 = p.hgrn_lb[1024 + n], r2 = p.hgrn_lb[2048 + n], r3 = p.hgrn_lb[3072 + n];
    float m = fmaxf(fmaxf(r0, r1), fmaxf(r2, r3));
    float e0 = expf(r0 - m), e1 = expf(r1 - m), e2 = expf(r2 - m), e3 = expf(r3 - m);
    float s = e0 + e1 + e2 + e3;
    float p0 = e0 / s, p1 = e1 / s, p2 = e2 / s, p3 = e3 / s;
    float c0 = p0, c1 = c0 + p1, c2 = c1 + p2, c3 = c2 + p3;
    p.llb()[n] = 0.f; p.l1mlb()[n] = 1.f;
    p.llb()[1024 + n] = c1 - c0; p.l1mlb()[1024 + n] = 1.f - (c1 - c0);
    p.llb()[2048 + n] = c2 - c0; p.l1mlb()[2048 + n] = 1.f - (c2 - c0);
    p.llb()[3072 + n] = c3 - c0; p.l1mlb()[3072 + n] = 1.f - (c3 - c0);
  } else if (gtid >= 4096 && gtid < 4096 + XCD_BAR_WORDS_C) {
    ((unsigned*)(p.ws + OFF_xbar))[gtid - 4096] = 0u;
  } else if (gtid == 2052) {
    *(unsigned*)(p.ws + OFF_lam + 128) = 0u;
  } else if (gtid < 2052) {
    int l = gtid - 2048;
    const float* d = p.diff_lambda + l * 128;
    float s1 = 0.f, s2 = 0.f;
    for (int i = 0; i < 32; ++i) { s1 += d[i] * d[32 + i]; s2 += d[64 + i] * d[96 + i]; }
    float li = 0.8f - 0.6f * expf(-0.3f * (float)l);
    p.lam()[l] = expf(s1) - expf(s2) + li;
  }
  float* sl = (float*)smem;
  float* red = sl + 3072;
  bool have = false;
  for (int item = bid_(); item < 768; item += gridDim.x) {
    if (!have) {
      for (int i = tid; i < 1024; i += 256) {
        sl[i] = silu_f(p.c[i]); sl[1024 + i] = silu_f(p.c[1024 + i]); sl[2048 + i] = silu_f(p.c_ctx[i]);
      }
      have = true;
      __syncthreads();
    }
    int l = item / 192, n0 = (item % 192) * 32;
    int col = tid & 31, kg = tid >> 5;
    const float* W = p.w_ada + (size_t)l * DM * 6144 + n0 + col;
    float a0 = 0.f, a1 = 0.f, a2 = 0.f;
#pragma unroll 8
    for (int k = kg * 128; k < kg * 128 + 128; ++k) {
      float w = W[(size_t)k * 6144];
      a0 += sl[k] * w; a1 += sl[1024 + k] * w; a2 += sl[2048 + k] * w;
    }
    red[(kg * 3 + 0) * 32 + col] = a0; red[(kg * 3 + 1) * 32 + col] = a1; red[(kg * 3 + 2) * 32 + col] = a2;
    __syncthreads();
    if (tid < 96) {
      int v = tid >> 5, cc = tid & 31;
      float s = p.b_ada[l * 6144 + n0 + cc];
#pragma unroll
      for (int q = 0; q < 8; ++q) s += red[(q * 3 + v) * 32 + cc];
      p.mod()[(size_t)(l * 3 + v) * 6144 + n0 + cc] = s;
    }
    __syncthreads();
  }
}

struct ConvD { const float* srcp; size_t sstride; __bf16* dstp; const float* ksp; };

__device__ __forceinline__ ConvD conv_decode(const Params& p, int l, int it, int tid) {
  const float* src; int N, ntn, mode = 0, dld; __bf16* dst; const float* ks = nullptr;
  if (it < 1872) { src = p.w_in + (size_t)l * DM * INW; N = INW; ntn = 117; dst = p.wt_in(); dld = LDH; }
  else if (it < 1920) { it -= 1872; src = p.w_uq + (size_t)l * 256 * 384; N = 384; ntn = 12; dst = p.wt_uq(); dld = 256; ks = p.g_q_norm + l * 256; }
  else if (it < 1952) { it -= 1920; src = p.w_ukv + (size_t)l * 128 * 512; N = 512; ntn = 16; dst = p.wt_ukv(); dld = 128; ks = p.g_kv_norm + l * 128; }
  else if (it < 2464) { it -= 1952; src = p.w_out + (size_t)l * DM * DM; N = DM; ntn = 32; dst = p.wt_out(); dld = LDH; }
  else if (it < 3872) { it -= 2464; src = p.w_gate + (size_t)l * DM * DFF; N = DFF; ntn = 88; dst = p.wt_gu(); mode = 1; dld = LDH; }
  else if (it < 5280) { it -= 3872; src = p.w_up + (size_t)l * DM * DFF; N = DFF; ntn = 88; dst = p.wt_gu(); mode = 2; dld = LDH; }
  else { it -= 5280; src = p.w_down + (size_t)l * DFF * DM; N = DM; ntn = 32; dst = p.wt_down(); dld = LDF; }
  const int kt = it / ntn, nt = it - kt * ntn;
  ConvD d;
  d.srcp = src + (size_t)(kt * 64 + (tid >> 3)) * N + nt * 32 + (tid & 7) * 4;
  d.sstride = (size_t)32 * N;
  const int n = nt * 32 + (tid >> 3);
  int row = n;
  if (mode == 1) row = (n >> 4) * 32 + (n & 15);
  else if (mode == 2) row = (n >> 4) * 32 + 16 + (n & 15);
  d.dstp = dst + (size_t)row * dld + kt * 64 + (tid & 7) * 8;
  d.ksp = ks ? ks + kt * 64 + (tid & 7) * 8 : nullptr;
  return d;
}

__device__ __forceinline__ void conv_items(const Params& p, int l, int first, int step, char* smem) {
  float* tile = (float*)smem;
  const int tid = tid_();
  if (first >= 6688) return;
  ConvD cur = conv_decode(p, l, first, tid);
  float4 v0 = *(const float4*)(cur.srcp), v1 = *(const float4*)(cur.srcp + cur.sstride);
  for (int it = first; it < 6688; it += step) {
    const int itn = it + step < 6688 ? it + step : it;
    const ConvD nxt = conv_decode(p, l, itn, tid);
    const float4 n0 = *(const float4*)(nxt.srcp), n1 = *(const float4*)(nxt.srcp + nxt.sstride);
    __syncthreads();
    {
      const int r = tid >> 3, c4 = tid & 7;
      float* t = tile + r * 33 + c4 * 4;
      t[0] = v0.x; t[1] = v0.y; t[2] = v0.z; t[3] = v0.w;
      t += 32 * 33;
      t[0] = v1.x; t[1] = v1.y; t[2] = v1.z; t[3] = v1.w;
    }
    __syncthreads();
    {
      const int nr = tid >> 3, kc = tid & 7;
      bf8 o;
#pragma unroll
      for (int j = 0; j < 8; ++j) {
        float v = tile[(kc * 8 + j) * 33 + nr];
        if (cur.ksp) v *= cur.ksp[j];
        o[j] = (__bf16)v;
      }
      *(bf8*)cur.dstp = o;
    }
    cur = nxt; v0 = n0; v1 = n1;
  }
}

__device__ __forceinline__ void norm_item(const Params& p, int l, int which, int item) {
  const int lane = tid_() & 63, wave = tid_() >> 6;
  const int tok0 = item * 16 + wave * 4;
  const int b = tok0 / PT, pp = tok0 - b * PT;
  const int v = pp < CTXL ? 2 : b;
  const float* g = (which ? p.g_norm2 : p.g_norm1) + l * DM;
  const float* md = p.mod() + (size_t)(l * 3 + v) * 6144 + (which ? 3072 : 0);
  f4 a[4], sh[4];
#pragma unroll
  for (int i = 0; i < 4; ++i) {
    int k = i * 256 + lane * 4;
    f4 gg = *(const f4*)(g + k), sc = *(const f4*)(md + 1024 + k);
    sh[i] = *(const f4*)(md + k);
    a[i] = gg * (1.f + sc);
  }
  f4 xv[4][4];
#pragma unroll
  for (int r = 0; r < 4; ++r) {
    const float* xr = xrow(p, tok0 + r);
#pragma unroll
    for (int i = 0; i < 4; ++i) xv[r][i] = *(const f4*)(xr + i * 256 + lane * 4);
  }
#pragma unroll
  for (int r = 0; r < 4; ++r) {
    float ss = 0.f;
#pragma unroll
    for (int i = 0; i < 4; ++i)
      ss += xv[r][i][0] * xv[r][i][0] + xv[r][i][1] * xv[r][i][1] + xv[r][i][2] * xv[r][i][2] + xv[r][i][3] * xv[r][i][3];
    ss = wave_sum(ss);
    float rstd = rsqrtf(ss * (1.f / DM) + EPSN);
#pragma unroll
    for (int i = 0; i < 4; ++i) {
      f4 h = xv[r][i] * rstd * a[i] + sh[i];
      bf4 o; o[0] = (__bf16)h[0]; o[1] = (__bf16)h[1]; o[2] = (__bf16)h[2]; o[3] = (__bf16)h[3];
      *(bf4*)(p.hb() + (size_t)(tok0 + r) * LDH + i * 256 + lane * 4) = o;
    }
  }
}

__device__ __forceinline__ void final_norm_item(const Params& p, int item) {
  const int lane = tid_() & 63, wave = tid_() >> 6;
  const int row0 = item * 16 + wave * 4;
  f4 g[4];
#pragma unroll
  for (int i = 0; i < 4; ++i) g[i] = *(const f4*)(p.g_final + i * 256 + lane * 4);
  f4 xv[4][4];
#pragma unroll
  for (int r = 0; r < 4; ++r)
#pragma unroll
    for (int i = 0; i < 4; ++i) xv[r][i] = *(const f4*)(p.out + (size_t)(row0 + r) * DM + i * 256 + lane * 4);
#pragma unroll
  for (int r = 0; r < 4; ++r) {
    float ss = 0.f;
#pragma unroll
    for (int i = 0; i < 4; ++i)
      ss += xv[r][i][0] * xv[r][i][0] + xv[r][i][1] * xv[r][i][1] + xv[r][i][2] * xv[r][i][2] + xv[r][i][3] * xv[r][i][3];
    ss = wave_sum(ss);
    float rstd = rsqrtf(ss * (1.f / DM) + EPSN);
#pragma unroll
    for (int i = 0; i < 4; ++i) *(f4*)(p.out + (size_t)(row0 + r) * DM + i * 256 + lane * 4) = xv[r][i] * rstd * g[i];
  }
}

#define GLD 72
enum { EPI_IN = 0, EPI_UQ, EPI_UKV, EPI_OUT, EPI_UP, EPI_DOWN, EPI_OUT_AT, EPI_DOWN_AT };

__device__ __forceinline__ f4 rope4(const Params& p, f4 a, int prow, int axis, int r) {
  f4 o;
#pragma unroll
  for (int reg = 0; reg < 4; ++reg) {
    float pv = __uint_as_float(__builtin_amdgcn_update_dpp(0u, __float_as_uint(a[reg]), 0x128, 0xf, 0xf, false));
    int t = prow + reg - CTXL;
    int pos = axis ? (t & 63) : (t >> 6);
    float2 cs = ((const float2*)p.rope())[pos * 8 + (r & 7)];
    o[reg] = (r & 8) ? a[reg] * cs.x + pv * cs.y : a[reg] * cs.x - pv * cs.y;
  }
  return o;
}
__device__ __forceinline__ bf4 pack4(f4 a) {
  bf4 o; o[0] = (__bf16)a[0]; o[1] = (__bf16)a[1]; o[2] = (__bf16)a[2]; o[3] = (__bf16)a[3];
  return o;
}

template <int EPI>
__device__ __forceinline__ void gemm_epilogue(const Params& p, int l, f4 (&acc)[4][4], int m0, int n0, int wm, int wn, int lane,
                                              const float* rowss) {
  const int r = lane & 15, g = lane >> 4;
  const int b = m0 / PT;
  const int pp0 = m0 - b * PT;
  const bool lat = pp0 >= CTXL;
  const int v = lat ? b : 2;
  const float* md = p.mod() + (size_t)(l * 3 + v) * 6144;
  const int prow0 = pp0 + wm * 64 + 4 * g;
  const int tok0 = b * PT + prow0;
  constexpr int STEP = (EPI == EPI_UP) ? 2 : 1;
  if constexpr (EPI == EPI_OUT || EPI == EPI_DOWN) {
    float* xb = (lat ? p.out + (size_t)(b * SEQ + prow0 - CTXL) * DM : p.xc() + (size_t)(b * CTXL + prow0) * DM) + n0 + wn * 64 + r;
    float gt[4];
    f4 xin[4][4];
#pragma unroll
    for (int ni = 0; ni < 4; ++ni) gt[ni] = md[(EPI == EPI_OUT ? 2048 : 5120) + n0 + wn * 64 + ni * 16 + r];
#pragma unroll
    for (int mi = 0; mi < 4; ++mi)
#pragma unroll
      for (int ni = 0; ni < 4; ++ni)
#pragma unroll
        for (int q = 0; q < 4; ++q) xin[mi][ni][q] = xb[(size_t)(mi * 16 + q) * DM + ni * 16];
#pragma unroll
    for (int mi = 0; mi < 4; ++mi)
#pragma unroll
      for (int ni = 0; ni < 4; ++ni)
#pragma unroll
        for (int q = 0; q < 4; ++q) xb[(size_t)(mi * 16 + q) * DM + ni * 16] = xin[mi][ni][q] + gt[ni] * acc[mi][ni][q];
    return;
  }
  float tla[4] = {0.f, 0.f, 0.f, 0.f}, tl1[4] = {0.f, 0.f, 0.f, 0.f};
  if constexpr (EPI == EPI_IN) {
#pragma unroll
    for (int ni = 0; ni < 4; ++ni) {
      const int c0 = n0 + wn * 64 + ni * 16;
      if (c0 >= 1696 && c0 < 2720) {
        const int dir = c0 >= 2208;
        const int n1 = c0 + r - (dir ? 2208 : 1696);
        tla[ni] = p.llb()[(l * 2 + dir) * 512 + n1];
        tl1[ni] = p.l1mlb()[(l * 2 + dir) * 512 + n1];
      }
    }
  }
#pragma unroll 1
  for (int ni = 0; ni < 4; ni += STEP) {
    const int col0 = n0 + wn * 64 + ni * 16;
    const int col = col0 + r;
    if constexpr (EPI == EPI_IN) {
      if (col0 < 384) {
        __bf16* dst = col0 < 256 ? p.cq() + col : p.ckv() + (col - 256);
        const int ld = col0 < 256 ? 256 : 128;
#pragma unroll
        for (int mi = 0; mi < 4; ++mi)
#pragma unroll
          for (int q = 0; q < 4; ++q) dst[(size_t)(tok0 + mi * 16 + q) * ld] = (__bf16)acc[mi][0][q];
      } else if (col0 < 416) {
        f4 v[4];
#pragma unroll
        for (int mi = 0; mi < 4; ++mi) {
          v[mi] = acc[mi][0];
          if (lat) v[mi] = rope4(p, v[mi], prow0 + mi * 16, (col0 - 384) >> 4, r);
        }
#pragma unroll
        for (int mi = 0; mi < 4; ++mi)
#pragma unroll
          for (int h = 0; h < 4; ++h)
#pragma unroll
            for (int q = 0; q < 4; ++q) p.km()[((size_t)(b * 4 + h) * PT + prow0 + mi * 16 + q) * 96 + 64 + col - 384] = (__bf16)v[mi][q];
      } else if (col0 < 928) {
        const bool isq = col0 < 672;
        const int n1 = col - (isq ? 416 : 672);
        const int head = n1 >> 6, map = (n1 >> 5) & 1, d = n1 & 31;
        __bf16* dst = (isq ? p.qd() : p.kd()) + ((size_t)((b * 4 + head) * 2 + map) * PT) * 32 + d;
        const float sc = isq ? 0.17677669529663687f * LOG2E : 1.f;
        f4 v[4];
#pragma unroll
        for (int mi = 0; mi < 4; ++mi) {
          v[mi] = acc[mi][0];
          if (lat) v[mi] = rope4(p, v[mi], prow0 + mi * 16, (n1 >> 4) & 1, r);
        }
#pragma unroll
        for (int mi = 0; mi < 4; ++mi)
#pragma unroll
          for (int q = 0; q < 4; ++q) dst[(size_t)(prow0 + mi * 16 + q) * 32] = (__bf16)(v[mi][q] * sc);
      } else if (col0 < 1184 || (col0 >= 2720 && col0 < 3232)) {
        const bool isd = col0 < 1184;
        const int n1 = col - (isd ? 928 : 2720);
        __bf16* dst = isd ? p.vdt() + ((size_t)(b * 4 + (n1 >> 6)) * 64 + (n1 & 63)) * PT
                          : p.hvt() + ((size_t)(b * 8 + (n1 >> 6)) * 64 + (n1 & 63)) * PT;
#pragma unroll
        for (int mi = 0; mi < 4; ++mi) *(bf4*)(dst + prow0 + mi * 16) = pack4(acc[mi][0]);
      } else if (col0 < 1696 || (col0 >= 3232 && col0 < INW)) {
        const bool ish = col0 < 1696;
        __bf16* dst = ish ? p.hq() + (col - 1184) : p.hg() + (col - 3232);
#pragma unroll
        for (int mi = 0; mi < 4; ++mi)
#pragma unroll
          for (int q = 0; q < 4; ++q) dst[(size_t)(tok0 + mi * 16 + q) * 512] = (__bf16)silu_f(acc[mi][0][q]);
      } else if (col0 < 2720) {
        const int dir = col0 >= 2208;
        const int n1 = col - (dir ? 2208 : 1696);
        const float la = tla[0], l1m = tl1[0];
        float* dst = p.lf() + (size_t)dir * NTOK * 512 + n1;
#pragma unroll
        for (int mi = 0; mi < 4; ++mi)
#pragma unroll
          for (int q = 0; q < 4; ++q) dst[(size_t)(tok0 + mi * 16 + q) * 512] = log_forget(acc[mi][0][q], la, l1m);
      }
    } else if constexpr (EPI == EPI_UQ) {
      const int head = col0 / 96, d0 = col0 - head * 96;
      const float sc = 0.10206207261596577f * LOG2E;
      __bf16* dst = p.qm() + ((size_t)(b * 4 + head) * PT) * 96 + d0 + r;
      f4 v[4];
#pragma unroll
      for (int mi = 0; mi < 4; ++mi) {
        f4 a = acc[mi][0];
#pragma unroll
        for (int q = 0; q < 4; ++q) a[q] *= rsqrtf(rowss[wm * 64 + mi * 16 + 4 * g + q] * (1.f / 256.f) + EPSN);
        if (d0 >= 64 && lat) a = rope4(p, a, prow0 + mi * 16, (d0 - 64) >> 4, r);
        v[mi] = a;
      }
#pragma unroll
      for (int mi = 0; mi < 4; ++mi)
#pragma unroll
        for (int q = 0; q < 4; ++q) dst[(size_t)(prow0 + mi * 16 + q) * 96] = (__bf16)(v[mi][q] * sc);
    } else if constexpr (EPI == EPI_UKV) {
      const int head = col >> 7, d = col & 127;
#pragma unroll
      for (int mi = 0; mi < 4; ++mi) {
        f4 a = acc[mi][0];
        const int prow = prow0 + mi * 16;
#pragma unroll
        for (int q = 0; q < 4; ++q) a[q] *= rsqrtf(rowss[wm * 64 + mi * 16 + 4 * g + q] * (1.f / 128.f) + EPSN);
        if ((col0 & 127) < 64) {
#pragma unroll
          for (int q = 0; q < 4; ++q) p.km()[((size_t)(b * 4 + head) * PT + prow + q) * 96 + d] = (__bf16)a[q];
        } else {
          *(bf4*)(p.vmt() + ((size_t)(b * 4 + head) * 64 + d - 64) * PT + prow) = pack4(a);
        }
      }
    } else if constexpr (EPI == EPI_OUT || EPI == EPI_DOWN) {
    } else if constexpr (EPI == EPI_OUT_AT || EPI == EPI_DOWN_AT) {
      const float gt = md[(EPI == EPI_OUT_AT ? 2048 : 5120) + col];
      float* xb = (lat ? p.out + (size_t)(b * SEQ + prow0 - CTXL) * DM : p.xc() + (size_t)(b * CTXL + prow0) * DM) + col;
#pragma unroll
      for (int mi = 0; mi < 4; ++mi)
#pragma unroll
        for (int q = 0; q < 4; ++q) atomicAdd(xb + (size_t)(mi * 16 + q) * DM, gt * acc[mi][0][q]);
    } else if constexpr (EPI == EPI_UP) {
      const int n = (col0 >> 5) * 16 + r;
#pragma unroll
      for (int mi = 0; mi < 4; ++mi)
#pragma unroll
        for (int q = 0; q < 4; ++q)
          p.act()[(size_t)(tok0 + mi * 16 + q) * LDF + n] = (__bf16)(silu_f(acc[mi][0][q]) * acc[mi][1][q]);
    }
#pragma unroll
    for (int mi = 0; mi < 4; ++mi) {
      if constexpr (STEP == 1) { acc[mi][0] = acc[mi][1]; acc[mi][1] = acc[mi][2]; acc[mi][2] = acc[mi][3]; }
      else { acc[mi][0] = acc[mi][2]; acc[mi][1] = acc[mi][3]; }
    }
    tla[0] = tla[1]; tla[1] = tla[2]; tla[2] = tla[3]; tl1[0] = tl1[1]; tl1[1] = tl1[2]; tl1[2] = tl1[3];
  }
}

#define RAW_BARRIER() do { asm volatile("s_waitcnt lgkmcnt(0)" ::: "memory"); __builtin_amdgcn_s_barrier(); } while (0)

template <int EPI, bool ROWSS>
__device__ __forceinline__ void gemm_tile(const Params& p, int l, const __bf16* __restrict__ A, int lda, const __bf16* __restrict__ Bt, int ldb, int K,
                          int m0, int n0, char* smem, bool pre = false, bool has_next = false, int m0n = 0, int n0n = 0) {
  __bf16* S0 = (__bf16*)smem;
  float* rowss = (float*)(smem + 65536);
  const int tid = tid_(), lane = tid & 63, wave = tid >> 6;
  const int wm = wave >> 1, wn = wave & 1, r = lane & 15, g = lane >> 4;
  f4 acc[4][4];
#pragma unroll
  for (int i = 0; i < 4; ++i)
#pragma unroll
    for (int j = 0; j < 4; ++j) acc[i][j] = f4{0.f, 0.f, 0.f, 0.f};
  if constexpr (ROWSS) {
    const int row = tid >> 1, half = tid & 1;
    const __bf16* rp = A + (size_t)(m0 + row) * lda + half * (K >> 1);
    float sq = 0.f;
    for (int c = 0; c < (K >> 4); ++c) {
      bf8 v = *(const bf8*)(rp + c * 8);
#pragma unroll
      for (int j = 0; j < 8; ++j) { float f = (float)v[j]; sq += f * f; }
    }
    sq += __shfl_xor(sq, 1);
    __syncthreads();
    if (!half) rowss[row] = sq;
  }
  const int lrow = lane >> 3;
  const int sz = (lane >> 4);
  const __bf16* gaw[4]; const __bf16* gbw[4];
#pragma unroll
  for (int i = 0; i < 4; ++i) {
    const int rg = wave + 4 * i;
    const int row = rg * 8 + lrow;
    const int cl = (lane & 7) ^ (((rg & 1) * 4 + sz) & 7);
    gaw[i] = A + (size_t)(m0 + row) * lda + cl * 8;
    gbw[i] = Bt + (size_t)(n0 + row) * ldb + cl * 8;
  }
  const int aoff = (wm * 64 + r) * 64, boff = 8192 + (wn * 64 + r) * 64;
  const int sw = r >> 1;
  const int KT = K / 64;
  if (!pre) {
    __syncthreads();
#pragma unroll
    for (int i = 0; i < 4; ++i) {
      __builtin_amdgcn_global_load_lds((const unsigned*)(gaw[i]), (unsigned*)(S0 + (wave + 4 * i) * 512), 16, 0, 0);
      __builtin_amdgcn_global_load_lds((const unsigned*)(gbw[i]), (unsigned*)(S0 + 8192 + (wave + 4 * i) * 512), 16, 0, 0);
    }
  }
  asm volatile("s_waitcnt vmcnt(0)" ::: "memory");
  RAW_BARRIER();
  for (int kt = 0; kt < KT; ++kt) {
    const __bf16* Sc = S0 + (kt & 1) * 16384;
    __bf16* Sn = S0 + ((kt + 1) & 1) * 16384;
    if (kt + 1 < KT) {
#pragma unroll
      for (int i = 0; i < 4; ++i) {
        __builtin_amdgcn_global_load_lds((const unsigned*)(gaw[i] + (kt + 1) * 64), (unsigned*)(Sn + (wave + 4 * i) * 512), 16, 0, 0);
        __builtin_amdgcn_global_load_lds((const unsigned*)(gbw[i] + (kt + 1) * 64), (unsigned*)(Sn + 8192 + (wave + 4 * i) * 512), 16, 0, 0);
      }
    }
#pragma unroll
    for (int ks = 0; ks < 2; ++ks) {
      bf8 af[4], bfr[4];
      const int ch = ((ks * 4 + g) ^ sw) * 8;
#pragma unroll
      for (int i = 0; i < 4; ++i) {
        af[i] = *(const bf8*)(Sc + aoff + i * 1024 + ch);
        bfr[i] = *(const bf8*)(Sc + boff + i * 1024 + ch);
      }
#pragma unroll
      for (int i = 0; i < 4; ++i)
#pragma unroll
        for (int j = 0; j < 4; ++j) acc[i][j] = mfma16(af[i], bfr[j], acc[i][j]);
    }
    asm volatile("s_waitcnt vmcnt(0)" ::: "memory");
    RAW_BARRIER();
  }
  if (has_next) {
#pragma unroll
    for (int i = 0; i < 4; ++i) {
      const int rg = wave + 4 * i;
      const int row = rg * 8 + lrow;
      const int cl = (lane & 7) ^ (((rg & 1) * 4 + sz) & 7);
      __builtin_amdgcn_global_load_lds((const unsigned*)(A + (size_t)(m0n + row) * lda + cl * 8), (unsigned*)(S0 + rg * 512), 16, 0, 0);
      __builtin_amdgcn_global_load_lds((const unsigned*)(Bt + (size_t)(n0n + row) * ldb + cl * 8), (unsigned*)(S0 + 8192 + rg * 512), 16, 0, 0);
    }
  }
  gemm_epilogue<EPI>(p, l, acc, m0, n0, wm, wn, lane, rowss);
}

__device__ __forceinline__ int mtile_count(int l) { return l < 3 ? 132 : 128; }
__device__ __forceinline__ int mtile_index(int l, int i) { return l < 3 ? i : (i >> 6) * 66 + 2 + (i & 63); }

__device__ __forceinline__ bool gemm_pick(int step, int bid, int G, int MT, int NT, int W, int& mt, int& nt) {
  const int C = G >> 3;
  const int L = (step * 8 + (bid & 7)) * C + (bid >> 3);
  if (L >= MT * NT) return false;
  const int s = L / (W * MT), rem = L - s * W * MT;
  mt = rem / W; nt = s * W + (rem - mt * W);
  return true;
}

template <int DQK, int NMAP>
__device__ __forceinline__ void attn_item(const Params& p, int l, const __bf16* __restrict__ Q, const __bf16* __restrict__ Kp,
                          const __bf16* __restrict__ Vt, int b, int h, int q0, int nkeys, char* smem) {
  constexpr int KLD = DQK + 8;
  constexpr int KCH = DQK / 8;
  constexpr int NKC = NMAP * 64 * KCH / 256;
  constexpr int NKS = DQK / 32;
  __bf16* Ks = (__bf16*)smem;
  __bf16* Vs = Ks + NMAP * 64 * KLD;
  const int tid = tid_(), lane = tid & 63, wave = tid >> 6, r = lane & 15, g = lane >> 4;
  const __bf16* Qb = Q + (size_t)((b * 4 + h) * NMAP) * PT * DQK;
  const __bf16* Kb = Kp + (size_t)((b * 4 + h) * NMAP) * PT * DQK;
  const __bf16* Vb = Vt + (size_t)((b * 4 + h) * 64) * PT;

  bf8 qf[NMAP][2][NKS];
#pragma unroll
  for (int mp = 0; mp < NMAP; ++mp)
#pragma unroll
    for (int qt = 0; qt < 2; ++qt)
#pragma unroll
      for (int ks = 0; ks < NKS; ++ks)
        qf[mp][qt][ks] = *(const bf8*)(Qb + ((size_t)mp * PT + q0 + wave * 32 + qt * 16 + r) * DQK + ks * 32 + g * 8);

  f4 o[NMAP][2][4];
  float mrun[NMAP][2], lsum[NMAP][2];
  f4 negm[NMAP][2];
#pragma unroll
  for (int mp = 0; mp < NMAP; ++mp)
#pragma unroll
    for (int qt = 0; qt < 2; ++qt) {
      mrun[mp][qt] = 0.f; lsum[mp][qt] = 0.f; negm[mp][qt] = f4{0.f, 0.f, 0.f, 0.f};
#pragma unroll
      for (int d = 0; d < 4; ++d) o[mp][qt][d] = f4{0.f, 0.f, 0.f, 0.f};
    }

  int koff_g[NKC], koff_s[NKC];
#pragma unroll
  for (int i = 0; i < NKC; ++i) {
    int c = tid + 256 * i;
    int mp = c / (64 * KCH), rem = c - mp * 64 * KCH;
    int row = rem / KCH, kc = rem - row * KCH;
    koff_g[i] = (mp * PT + row) * DQK + kc * 8;
    koff_s[i] = (mp * 64 + row) * KLD + kc * 8;
  }
  bf8 rk[NKC], rv[2];
  const int nkb = nkeys / 64;
#pragma unroll
  for (int i = 0; i < NKC; ++i) rk[i] = *(const bf8*)(Kb + koff_g[i]);
#pragma unroll
  for (int i = 0; i < 2; ++i) rv[i] = *(const bf8*)(Vb + (size_t)((tid >> 3) + 32 * i) * PT + (tid & 7) * 8);

  for (int kb = 0; kb < nkb; ++kb) {
    __syncthreads();
#pragma unroll
    for (int i = 0; i < NKC; ++i) *(bf8*)(Ks + koff_s[i]) = rk[i];
#pragma unroll
    for (int i = 0; i < 2; ++i) *(bf8*)(Vs + ((tid >> 3) + 32 * i) * 72 + (tid & 7) * 8) = rv[i];
    __syncthreads();
    if (kb + 1 < nkb) {
#pragma unroll
      for (int i = 0; i < NKC; ++i) rk[i] = *(const bf8*)(Kb + koff_g[i] + (size_t)(kb + 1) * 64 * DQK);
#pragma unroll
      for (int i = 0; i < 2; ++i) rv[i] = *(const bf8*)(Vb + (size_t)((tid >> 3) + 32 * i) * PT + (kb + 1) * 64 + (tid & 7) * 8);
    }
    f4 s[NMAP][2][2][2];
    __builtin_amdgcn_s_setprio(1);
#pragma unroll
    for (int mp = 0; mp < NMAP; ++mp)
#pragma unroll
      for (int m = 0; m < 2; ++m)
#pragma unroll
        for (int tp = 0; tp < 2; ++tp) {
          f4 s0 = negm[mp][0], s1 = negm[mp][1];
          const int krow = 32 * m + 8 * (r >> 2) + 4 * tp + (r & 3);
#pragma unroll
          for (int ks = 0; ks < NKS; ++ks) {
            bf8 kf = *(const bf8*)(Ks + (mp * 64 + krow) * KLD + ks * 32 + g * 8);
            s0 = mfma16(kf, qf[mp][0][ks], s0);
            s1 = mfma16(kf, qf[mp][1][ks], s1);
          }
          s[mp][0][m][tp] = s0; s[mp][1][m][tp] = s1;
        }
    __builtin_amdgcn_s_setprio(0);
    bf8 pf[NMAP][2][2];
#pragma unroll
    for (int mp = 0; mp < NMAP; ++mp)
#pragma unroll
      for (int qt = 0; qt < 2; ++qt) {
        float ps = 0.f;
#pragma unroll
        for (int m = 0; m < 2; ++m) {
          bf8 pk;
#pragma unroll
          for (int tp = 0; tp < 2; ++tp)
#pragma unroll
            for (int q = 0; q < 4; ++q) {
              float e = __builtin_amdgcn_exp2f(s[mp][qt][m][tp][q]);
              ps += e;
              pk[tp * 4 + q] = (__bf16)e;
            }
          pf[mp][qt][m] = pk;
        }
        const bool hi = __builtin_amdgcn_ballot_w64(!(ps < 65536.f)) != 0ull;
        const bool lo = __builtin_amdgcn_ballot_w64(ps > 0.f || lsum[mp][qt] > 0.f) == 0ull;
        if (hi || lo) {
          float bm = -INFINITY;
#pragma unroll
          for (int m = 0; m < 2; ++m)
#pragma unroll
            for (int tp = 0; tp < 2; ++tp)
#pragma unroll
              for (int q = 0; q < 4; ++q) bm = fmaxf(bm, s[mp][qt][m][tp][q]);
          bm = rows_max(bm);
          const float sh = lo ? bm : fmaxf(bm, 0.f);
          const float alpha = lo ? 1.f : __builtin_amdgcn_exp2f(-sh);
          mrun[mp][qt] += sh;
          const float nm = -mrun[mp][qt];
          negm[mp][qt] = f4{nm, nm, nm, nm};
          lsum[mp][qt] *= alpha;
#pragma unroll
          for (int d = 0; d < 4; ++d) o[mp][qt][d] *= alpha;
          ps = 0.f;
#pragma unroll
          for (int m = 0; m < 2; ++m) {
            bf8 pk;
#pragma unroll
            for (int tp = 0; tp < 2; ++tp)
#pragma unroll
              for (int q = 0; q < 4; ++q) {
                float e = __builtin_amdgcn_exp2f(s[mp][qt][m][tp][q] - sh);
                ps += e;
                pk[tp * 4 + q] = (__bf16)e;
              }
            pf[mp][qt][m] = pk;
          }
        }
        lsum[mp][qt] += ps;
      }
    __builtin_amdgcn_s_setprio(1);
#pragma unroll
    for (int d = 0; d < 4; ++d)
#pragma unroll
      for (int m = 0; m < 2; ++m) {
        bf8 vf = *(const bf8*)(Vs + (d * 16 + r) * 72 + 32 * m + 8 * g);
#pragma unroll
        for (int mp = 0; mp < NMAP; ++mp)
#pragma unroll
          for (int qt = 0; qt < 2; ++qt) o[mp][qt][d] = mfma16(vf, pf[mp][qt][m], o[mp][qt][d]);
      }
    __builtin_amdgcn_s_setprio(0);
  }
#pragma unroll
  for (int qt = 0; qt < 2; ++qt) {
    const int tok = b * PT + q0 + wave * 32 + qt * 16 + r;
    float inv[NMAP];
#pragma unroll
    for (int mp = 0; mp < NMAP; ++mp) {
      float ls = lsum[mp][qt];
      ls = rows_sum(ls);
      inv[mp] = 1.f / ls;
    }
    if constexpr (NMAP == 1) {
#pragma unroll
      for (int d = 0; d < 4; ++d)
        *(bf4*)(p.mix() + (size_t)tok * LDH + h * 64 + d * 16 + 4 * g) = pack4(o[0][qt][d] * inv[0]);
    } else {
      const float lam = p.lam()[l];
      const float li = 0.8f - 0.6f * expf(-0.3f * (float)l);
      f4 val[4];
      float ss = 0.f;
#pragma unroll
      for (int d = 0; d < 4; ++d) {
        val[d] = o[0][qt][d] * inv[0] - o[NMAP - 1][qt][d] * (lam * inv[NMAP - 1]);
        ss += val[d][0] * val[d][0] + val[d][1] * val[d][1] + val[d][2] * val[d][2] + val[d][3] * val[d][3];
      }
      ss = rows_sum(ss);
      const float rs = rsqrtf(ss * (1.f / 64.f) + EPSN) * (1.f - li);
      f4 gd[4];
#pragma unroll
      for (int d = 0; d < 4; ++d) gd[d] = *(const f4*)(p.g_diff_norm + l * 64 + d * 16 + 4 * g);
#pragma unroll
      for (int d = 0; d < 4; ++d) *(bf4*)(p.mix() + (size_t)tok * LDH + 256 + h * 64 + d * 16 + 4 * g) = pack4(val[d] * rs * gd[d]);
    }
  }
}

template <int DQK, int NMAP>
__device__ __forceinline__ void attn_dispatch(const Params& p, int l, int item, const __bf16* Q, const __bf16* K, const __bf16* Vt, char* smem) {
  int b, h, q0, nk;
  if (item < 512) { b = (item >> 2) & 1; h = item & 3; q0 = CTXL + (item >> 3) * 128; nk = PT; }
  else { int it = item - 512; b = it >> 3; h = (it >> 1) & 3; q0 = (it & 1) * 128; nk = CTXL; }
  attn_item<DQK, NMAP>(p, l, Q, K, Vt, b, h, q0, nk, smem);
}

__device__ __forceinline__ void hgrn1_item(const Params& p, int item, char* smem) {
  __bf16* kteT = (__bf16*)smem;
  __bf16* vT = kteT + 64 * 72;
  float* ptot = (float*)(vT + 64 * 72);
  const int tid = tid_(), lane = tid & 63, wave = tid >> 6, r = lane & 15, g = lane >> 4;
  const int c = item % NCH, bh = item / NCH;
  const int b = bh >> 3, h = bh & 7;
  const int tok0 = b * PT + c * 64;
  __syncthreads();
#pragma unroll
  for (int i = 0; i < 2; ++i) {
    int dv = (tid >> 3) + 32 * i;
    *(bf8*)(vT + dv * 72 + (tid & 7) * 8) = *(const bf8*)(p.hvt() + ((size_t)bh * 64 + dv) * PT + c * 64 + (tid & 7) * 8);
  }
  const int k = tid & 63, part = tid >> 6;
  float lfa[2][16];
#pragma unroll
  for (int dd = 0; dd < 2; ++dd) {
    const float* lfp = p.lf() + ((size_t)dd * NTOK + tok0 + part * 16) * 512 + h * 64 + k;
#pragma unroll
    for (int i = 0; i < 16; ++i) lfa[dd][i] = lfp[(size_t)i * 512];
  }
#pragma unroll
  for (int dir = 0; dir < 2; ++dir) {
    float lfv[16], cl[16];
#pragma unroll
    for (int i = 0; i < 16; ++i) lfv[i] = lfa[dir][i];
    float run = 0.f;
    if (dir == 0) {
#pragma unroll
      for (int i = 0; i < 16; ++i) { run += lfv[i]; cl[i] = run; }
    } else {
#pragma unroll
      for (int i = 15; i >= 0; --i) { run += lfv[i]; cl[i] = run; }
    }
    __syncthreads();
    ptot[part * 64 + k] = run;
    __syncthreads();
    float off = 0.f, total = 0.f;
#pragma unroll
    for (int q = 0; q < 4; ++q) {
      float t = ptot[q * 64 + k];
      total += t;
      if (dir == 0 ? (q < part) : (q > part)) off += t;
    }
#pragma unroll
    for (int i = 0; i < 16; ++i) {
      float cum = cl[i] + off;
      float kte = (1.f - __expf(lfv[i])) * __expf(total - cum);
      kteT[k * 72 + part * 16 + i] = (__bf16)kte;
    }
    const size_t sidx = ((size_t)bh * 2 + dir) * NCH + c;
    if (part == 0) p.dk()[sidx * 64 + k] = __expf(total);
    __syncthreads();
    f4 acc[4];
#pragma unroll
    for (int nt = 0; nt < 4; ++nt) acc[nt] = f4{0.f, 0.f, 0.f, 0.f};
#pragma unroll
    for (int ks = 0; ks < 2; ++ks) {
      bf8 af = *(const bf8*)(vT + (wave * 16 + r) * 72 + ks * 32 + g * 8);
#pragma unroll
      for (int nt = 0; nt < 4; ++nt) {
        bf8 bfr = *(const bf8*)(kteT + (nt * 16 + r) * 72 + ks * 32 + g * 8);
        acc[nt] = mfma16(af, bfr, acc[nt]);
      }
    }
    float* up = p.ut() + sidx * 4096;
#pragma unroll
    for (int nt = 0; nt < 4; ++nt)
#pragma unroll
      for (int q = 0; q < 4; ++q) up[(wave * 16 + 4 * g + q) * 64 + nt * 16 + r] = acc[nt][q];
  }
}

__device__ __forceinline__ void hgrn2_item(const Params& p, int item) {
  const int idx = item * 256 + tid_();
  const int e = idx & 4095, sd = idx >> 12;
  const int dir = sd & 1, kk = e & 63;
  const float* up = p.ut() + (size_t)sd * NCH * 4096 + e;
  const float* dp = p.dk() + (size_t)sd * NCH * 64 + kk;
  __bf16* sp = p.st() + (size_t)sd * NCH * 4096 + e;
  float S = 0.f;
  for (int jb = 0; jb < NCH; jb += 22) {
    float u[22], d[22];
    int cc[22];
#pragma unroll
    for (int q = 0; q < 22; ++q) {
      int j = jb + q;
      int c = dir == 0 ? j : (j < 4 ? 3 - j : 135 - j);
      cc[q] = c;
      u[q] = up[(size_t)c * 4096];
      d[q] = dp[c * 64];
    }
#pragma unroll
    for (int q = 0; q < 22; ++q) {
      sp[(size_t)cc[q] * 4096] = (__bf16)S;
      S = d[q] * S + u[q];
    }
  }
}

__device__ __forceinline__ void hgrn3_item(const Params& p, int l, int item, char* smem) {
  __bf16* qS = (__bf16*)smem;
  __bf16* kS = qS + 64 * 72;
  __bf16* vT = kS + 64 * 72;
  __bf16* stS = vT + 64 * 72;
  float* cumS = (float*)(stS + 64 * 72);
  float* ptot = cumS + 64 * 68;
  const int tid = tid_(), lane = tid & 63, wave = tid >> 6, r = lane & 15, g = lane >> 4;
  const int c = item % NCH, bh = item / NCH;
  const int b = bh >> 3, h = bh & 7;
  const int tok0 = b * PT + c * 64;
  __syncthreads();
#pragma unroll
  for (int i = 0; i < 2; ++i) {
    int row = (tid >> 3) + 32 * i;
    *(bf8*)(vT + row * 72 + (tid & 7) * 8) = *(const bf8*)(p.hvt() + ((size_t)bh * 64 + row) * PT + c * 64 + (tid & 7) * 8);
    *(bf8*)(qS + row * 72 + (tid & 7) * 8) = *(const bf8*)(p.hq() + (size_t)(tok0 + row) * 512 + h * 64 + (tid & 7) * 8);
  }
  f4 o[4];
#pragma unroll
  for (int d = 0; d < 4; ++d) o[d] = f4{0.f, 0.f, 0.f, 0.f};
  const int k = tid & 63, part = tid >> 6;
  const int t = 16 * wave + r;
  bf8 sta[2][2];
#pragma unroll
  for (int dd = 0; dd < 2; ++dd) {
    const __bf16* sp = p.st() + (((size_t)bh * 2 + dd) * NCH + c) * 4096;
#pragma unroll
    for (int i = 0; i < 2; ++i) sta[dd][i] = *(const bf8*)(sp + ((tid >> 3) + 32 * i) * 64 + (tid & 7) * 8);
  }
  float lfa[2][16];
#pragma unroll
  for (int dd = 0; dd < 2; ++dd) {
    const float* lfp = p.lf() + ((size_t)dd * NTOK + tok0 + part * 16) * 512 + h * 64 + k;
#pragma unroll
    for (int i = 0; i < 16; ++i) lfa[dd][i] = lfp[(size_t)i * 512];
  }
#pragma unroll
  for (int dir = 0; dir < 2; ++dir) {
    float lfv[16], cl[16];
#pragma unroll
    for (int i = 0; i < 16; ++i) lfv[i] = lfa[dir][i];
    float run = 0.f;
    if (dir == 0) {
#pragma unroll
      for (int i = 0; i < 16; ++i) { run += lfv[i]; cl[i] = run; }
    } else {
#pragma unroll
      for (int i = 15; i >= 0; --i) { run += lfv[i]; cl[i] = run; }
    }
    __syncthreads();
    ptot[part * 64 + k] = run;
#pragma unroll
    for (int i = 0; i < 16; ++i) kS[(part * 16 + i) * 72 + k] = (__bf16)((1.f - __expf(lfv[i])));
#pragma unroll
    for (int i = 0; i < 2; ++i) *(bf8*)(stS + ((tid >> 3) + 32 * i) * 72 + (tid & 7) * 8) = sta[dir][i];
    __syncthreads();
    float off = 0.f;
#pragma unroll
    for (int q = 0; q < 4; ++q) {
      float tt = ptot[q * 64 + k];
      if (dir == 0 ? (q < part) : (q > part)) off += tt;
    }
#pragma unroll
    for (int i = 0; i < 16; ++i) cumS[(part * 16 + i) * 68 + k] = cl[i] + off;
    __syncthreads();
    float cs[2][8];
    bf8 qtf[2], qhf[2];
#pragma unroll
    for (int ks = 0; ks < 2; ++ks) {
      const int dk0 = ks * 32 + 8 * g;
      bf8 qv = *(const bf8*)(qS + t * 72 + dk0);
#pragma unroll
      for (int j = 0; j < 8; ++j) {
        float cst;
        if (dir == 0) cst = wave > 0 ? cumS[(16 * wave - 1) * 68 + dk0 + j] : 0.f;
        else cst = wave < 3 ? cumS[(16 * wave + 16) * 68 + dk0 + j] : 0.f;
        cs[ks][j] = cst;
        float cv = cumS[t * 68 + dk0 + j];
        float qf_ = (float)qv[j];
        qtf[ks][j] = (__bf16)(qf_ * __expf(cv - cst));
        qhf[ks][j] = (__bf16)(qf_ * __expf(cv));
      }
    }
#pragma unroll
    for (int m = 0; m < 2; ++m) {
      const bool need = dir == 0 ? (m <= (wave >> 1)) : (m >= (wave >> 1));
      if (need) {
        bf8 pf;
#pragma unroll
        for (int tp = 0; tp < 2; ++tp) {
          const int srow = 32 * m + 8 * (r >> 2) + 4 * tp + (r & 3);
          f4 sc = f4{0.f, 0.f, 0.f, 0.f};
#pragma unroll
          for (int ks = 0; ks < 2; ++ks) {
            const int dk0 = ks * 32 + 8 * g;
            bf8 kv = *(const bf8*)(kS + srow * 72 + dk0);
            bf8 ktf;
#pragma unroll
            for (int j = 0; j < 8; ++j) {
              float ex = fminf(cs[ks][j] - cumS[srow * 68 + dk0 + j], 80.f);
              ktf[j] = (__bf16)((float)kv[j] * __expf(ex));
            }
            sc = mfma16(ktf, qtf[ks], sc);
          }
#pragma unroll
          for (int q = 0; q < 4; ++q) {
            const int s = 32 * m + 8 * g + 4 * tp + q;
            const bool keep = dir == 0 ? (s <= t) : (s >= t);
            pf[tp * 4 + q] = keep ? (__bf16)sc[q] : (__bf16)0.f;
          }
        }
#pragma unroll
        for (int d = 0; d < 4; ++d) {
          bf8 vf = *(const bf8*)(vT + (d * 16 + r) * 72 + 32 * m + 8 * g);
          o[d] = mfma16(vf, pf, o[d]);
        }
      }
    }
#pragma unroll
    for (int d = 0; d < 4; ++d)
#pragma unroll
      for (int ks = 0; ks < 2; ++ks) {
        bf8 sf = *(const bf8*)(stS + (d * 16 + r) * 72 + ks * 32 + 8 * g);
        o[d] = mfma16(sf, qhf[ks], o[d]);
      }
  }
  float ss = 0.f;
#pragma unroll
  for (int d = 0; d < 4; ++d) ss += o[d][0] * o[d][0] + o[d][1] * o[d][1] + o[d][2] * o[d][2] + o[d][3] * o[d][3];
  ss = rows_sum(ss);
  const float rs = rsqrtf(ss * (1.f / 64.f) + EPSN);
  f4 gn[4]; bf4 gate[4];
#pragma unroll
  for (int d = 0; d < 4; ++d) {
    gn[d] = *(const f4*)(p.g_hgrn_norm + l * 64 + d * 16 + 4 * g);
    gate[d] = *(const bf4*)(p.hg() + (size_t)(tok0 + t) * 512 + h * 64 + d * 16 + 4 * g);
  }
#pragma unroll
  for (int d = 0; d < 4; ++d) {
    f4 res;
#pragma unroll
    for (int q = 0; q < 4; ++q) res[q] = o[d][q] * rs * gn[d][q] * (float)gate[d][q];
    *(bf4*)(p.mix() + (size_t)(tok0 + t) * LDH + 512 + h * 64 + d * 16 + 4 * g) = pack4(res);
  }
}

#define NPHASE 38
#ifndef ONLY
#define ONLY -1
#endif
#define PHEN(x) (ONLY < 0 || ONLY == (x))
__device__ __forceinline__ void run_phase(const Params& p, int ph, char* smem) {
  const int bid = bid_(), G = gridDim.x;
  if (ph == 0) { if (PHEN(100)) phase0(p, smem); return; }
  if (ph == NPHASE - 1) {
    for (int it = bid; it < NB * SEQ / 16; it += G) final_norm_item(p, it);
    return;
  }
  const int l = (ph - 1) / 9, sp = (ph - 1) % 9;
  const int nmt = mtile_count(l);
  switch (sp) {
    case 0: if (PHEN(0)) {
      for (int i = bid * 256 + tid_(); i < (INWP - INW) * DM / 8; i += G * 256) {
        bf8 z;
#pragma unroll
        for (int j = 0; j < 8; ++j) z[j] = (__bf16)0.f;
        *(bf8*)(p.wt_in() + (size_t)(INW + (i >> 7)) * LDH + (size_t)(i & 127) * 8) = z;
      }
      for (int it = bid; it < 1056; it += G) norm_item(p, l, 0, it);
      conv_items(p, l, bid, G, smem);
    } break;
    case 1: if (PHEN(1)) {
      {
        int mt, nt, mtn = 0, ntn = 0;
        bool have = gemm_pick(0, bid, G, 132, 30, 10, mt, nt), pre = false;
        for (int st = 0; have; ++st) {
          const bool hn = gemm_pick(st + 1, bid, G, 132, 30, 10, mtn, ntn);
          gemm_tile<EPI_IN, false>(p, l, p.hb(), LDH, p.wt_in(), LDH, DM, mt * 128, nt * 128, smem, pre, hn, mtn * 128, ntn * 128);
          pre = hn; have = hn; mt = mtn; nt = ntn;
        }
      }
    } break;
    case 2: if (PHEN(2)) {
      const int natt = l < 3 ? 528 : 512;
      const int total = natt + 396 + 528 + 2112, K = (total + G - 1) / G;
      const bool flip = (bid >> 3) & 1;
      for (int kk = 0; kk < K; ++kk) {
        const int k = flip ? (kk + 1 == K ? 0 : kk + 1) : kk;
        const int it0 = bid + k * G;
        if (it0 >= total) continue;
        if (it0 < natt) { attn_dispatch<32, 2>(p, l, it0, p.qd(), p.kd(), p.vdt(), smem); continue; }
        const int it = it0 - natt;
        if (it < 396) gemm_tile<EPI_UQ, true>(p, l, p.cq(), 256, p.wt_uq(), 256, 256, (it / 3) * 128, (it % 3) * 128, smem);
        else if (it < 924) { int j = it - 396; gemm_tile<EPI_UKV, true>(p, l, p.ckv(), 128, p.wt_ukv(), 128, 128, (j / 4) * 128, (j % 4) * 128, smem); }
        else hgrn1_item(p, it - 924, smem);
      }
    } break;
    case 3: if (PHEN(3)) {
      const int natt = l < 3 ? 528 : 512;
      const int total = 512 + natt, K = (total + G - 1) / G;
      const bool flip = (bid >> 3) & 1;
      for (int kk = 0; kk < K; ++kk) {
        const int k = flip ? (kk + 1 == K ? 0 : kk + 1) : kk;
        const int it = bid + k * G;
        if (it >= total) continue;
        if (it < 512) hgrn2_item(p, it);
        else attn_dispatch<96, 1>(p, l, it - 512, p.qm(), p.km(), p.vmt(), smem);
      }
    } break;
    case 4: if (PHEN(4)) {
      for (int j = bid; j < 2112; j += G) {
        if (l == 3 && (j % NCH) < 4) continue;
        hgrn3_item(p, l, j, smem);
      }
    } break;
    case 5: if (PHEN(5)) {
      {
        int mt, nt, mtn = 0, ntn = 0;
        bool have = gemm_pick(0, bid, G, 128, 8, 8, mt, nt), pre = false;
        for (int st = 0; have; ++st) {
          const bool hn = gemm_pick(st + 1, bid, G, 128, 8, 8, mtn, ntn);
          gemm_tile<EPI_OUT, false>(p, l, p.mix(), LDH, p.wt_out(), LDH, DM, mtile_index(3, mt) * 128, nt * 128, smem, pre, hn,
                                    mtile_index(3, mtn) * 128, ntn * 128);
          pre = hn; have = hn; mt = mtn; nt = ntn;
        }
      }
      if (l < 3) {
        for (int u = bid; u < 32 * 8; u += G) {
          const int tile = u >> 3, sp = u & 7;
          const int cm = tile >> 3, nt = tile & 7;
          const int mt = (cm >> 1) * 66 + (cm & 1);
          gemm_tile<EPI_OUT_AT, false>(p, l, p.mix() + sp * 128, LDH, p.wt_out() + sp * 128, LDH, 128, mt * 128, nt * 128, smem);
        }
      }
    } break;
    case 6: if (PHEN(6)) {
      for (int it = bid; it < 1056; it += G) norm_item(p, l, 1, it);
    } break;
    case 7: if (PHEN(7)) {
      {
        int mt, nt, mtn = 0, ntn = 0;
        bool have = gemm_pick(0, bid, G, nmt, 44, 11, mt, nt), pre = false;
        for (int st = 0; have; ++st) {
          const bool hn = gemm_pick(st + 1, bid, G, nmt, 44, 11, mtn, ntn);
          gemm_tile<EPI_UP, false>(p, l, p.hb(), LDH, p.wt_gu(), LDH, DM, mtile_index(l, mt) * 128, nt * 128, smem, pre, hn,
                                   mtile_index(l, mtn) * 128, ntn * 128);
          pre = hn; have = hn; mt = mtn; nt = ntn;
        }
      }
    } break;
    case 8: if (PHEN(8)) {
      {
        int mt, nt, mtn = 0, ntn = 0;
        bool have = gemm_pick(0, bid, G, 128, 8, 8, mt, nt), pre = false;
        for (int st = 0; have; ++st) {
          const bool hn = gemm_pick(st + 1, bid, G, 128, 8, 8, mtn, ntn);
          gemm_tile<EPI_DOWN, false>(p, l, p.act(), LDF, p.wt_down(), LDF, DFF, mtile_index(3, mt) * 128, nt * 128, smem, pre, hn,
                                     mtile_index(3, mtn) * 128, ntn * 128);
          pre = hn; have = hn; mt = mtn; nt = ntn;
        }
      }
      if (l < 3) {
        for (int u = bid; u < 32 * 11; u += G) {
          const int tile = u / 11, sp = u - tile * 11;
          const int cm = tile >> 3, nt = tile & 7;
          const int mt = (cm >> 1) * 66 + (cm & 1);
          gemm_tile<EPI_DOWN_AT, false>(p, l, p.act() + sp * 256, LDF, p.wt_down() + sp * 256, LDF, 256, mt * 128, nt * 128, smem);
        }
      }
    } break;
  }
}

#define XB_TMO      128
#define XB_XCNT(j)  (256  + 64 * (j))
#define XB_XSUB(j)  (1280 + 64 * (j))
#define XB_XGEN(j)  (2304 + 64 * (j))
#define XB_TOP      3328
#define XB_TOPGEN   3392
#define XCD_BAR_WORDS 3456
#define XB_SPIN_CAP (1u << 22)
#define LAS __attribute__((address_space(3)))

__device__ __forceinline__ unsigned xb_ld(unsigned* p)              { return __hip_atomic_load(p, __ATOMIC_RELAXED, __HIP_MEMORY_SCOPE_AGENT); }
__device__ __forceinline__ unsigned xb_add(unsigned* p, unsigned v) { return __hip_atomic_fetch_add(p, v, __ATOMIC_RELAXED, __HIP_MEMORY_SCOPE_AGENT); }
__device__ __forceinline__ unsigned xb_xcc_id() { return (unsigned)__builtin_amdgcn_s_getreg((3 << 11) | 20) & 0xFu; }
#define XB_SPIN(cond, bar) do { unsigned _sp = 0; while (cond) { __builtin_amdgcn_s_sleep(1); \
    if ((++_sp & 255u) == 0u) { if (xb_ld(&(bar)[XB_TMO])) break; if (_sp > XB_SPIN_CAP) { atomicAdd(&(bar)[XB_TMO], 1u); break; } } } } while (0)

struct XcdBarrier {
    unsigned* bar; unsigned x;
    volatile LAS unsigned* st;
};

__device__ __forceinline__ XcdBarrier xcd_barrier_post(unsigned* bar, volatile LAS unsigned* st) {
    XcdBarrier b; b.bar = bar; b.x = xb_xcc_id(); b.st = st;
    if (threadIdx.x == 0) (void)xb_add(&bar[XB_XCNT(b.x)], 1u);
    return b;
}
__device__ __forceinline__ void xcd_barrier_complete(unsigned* bar, unsigned x, unsigned& nloc, unsigned& nx) {
    const unsigned G = gridDim.x * gridDim.y * gridDim.z;
    unsigned sum, cnt, mine, sp = 0u;
    for (;;) {
        sum = 0u; cnt = 0u; mine = 0u;
#pragma unroll
        for (unsigned j = 0; j < 16; ++j) { const unsigned c = xb_ld(&bar[XB_XCNT(j)]); sum += c; cnt += (c > 0u) ? 1u : 0u; mine = (j == x) ? c : mine; }
        if (sum == G) break;
        __builtin_amdgcn_s_sleep(1);
        if ((++sp & 255u) == 0u) { if (xb_ld(&bar[XB_TMO])) break; if (sp > XB_SPIN_CAP) { atomicAdd(&bar[XB_TMO], 1u); break; } }
    }
    nloc = mine > 0u ? mine : 1u; nx = cnt > 0u ? cnt : 1u;
}

__device__ __forceinline__ void xcd_barrier(const XcdBarrier& b) {
    asm volatile("s_waitcnt vmcnt(0)" ::: "memory");
    __syncthreads();
    if (threadIdx.x == 0) {
        unsigned* bar = b.bar;
        __builtin_amdgcn_s_waitcnt(0);
        unsigned nloc = b.st[0], nx = b.st[1];
        if (nloc == 0u) { xcd_barrier_complete(bar, b.x, nloc, nx); b.st[0] = nloc; b.st[1] = nx; }
        const unsigned old = xb_add(&bar[XB_XSUB(b.x)], 1u);
        const unsigned gen = old / nloc;
        if (old + 1u == (gen + 1u) * nloc) {
            __builtin_amdgcn_fence(__ATOMIC_RELEASE, "agent");
            asm volatile("s_waitcnt vmcnt(0)" ::: "memory");
            const unsigned og = xb_add(&bar[XB_TOP], 1u);
            const unsigned tg = og / nx;
            if (og + 1u == (tg + 1u) * nx) xb_add(&bar[XB_TOPGEN], 1u);
            else XB_SPIN(xb_ld(&bar[XB_TOPGEN]) == tg, bar);
            __builtin_amdgcn_fence(__ATOMIC_ACQUIRE, "agent");
            xb_add(&bar[XB_XGEN(b.x)], 1u);
            asm volatile("s_waitcnt vmcnt(0)" ::: "memory");
        } else {
            XB_SPIN(xb_ld(&bar[XB_XGEN(b.x)]) == gen, bar);
            __builtin_amdgcn_fence(__ATOMIC_ACQUIRE, "agent");
            asm volatile("s_waitcnt vmcnt(0)" ::: "memory");
        }
    }
    __syncthreads();
}


__device__ __forceinline__ void grid_barrier(unsigned* cnt, unsigned target) {
  asm volatile("s_waitcnt vmcnt(0)" ::: "memory");
  __syncthreads();
  if (tid_() == 0) {
    __builtin_amdgcn_fence(__ATOMIC_RELEASE, "agent");
    asm volatile("s_waitcnt vmcnt(0)" ::: "memory");
    __hip_atomic_fetch_add(cnt, 1u, __ATOMIC_RELAXED, __HIP_MEMORY_SCOPE_AGENT);
    unsigned spins = 0;
    while (__hip_atomic_load(cnt, __ATOMIC_RELAXED, __HIP_MEMORY_SCOPE_AGENT) < target) {
      __builtin_amdgcn_s_sleep(2);
      if (++spins > (1u << 24)) break;
    }
    __builtin_amdgcn_fence(__ATOMIC_ACQUIRE, "agent");
    asm volatile("s_waitcnt vmcnt(0)" ::: "memory");
  }
  __syncthreads();
}

__global__ void __launch_bounds__(256, 2) hybrid_megakernel(Params p, int ph0, int ph1) {
  __shared__ __attribute__((aligned(16))) char smem[SMEM_BYTES];
  cg::grid_group grid = cg::this_grid();
  volatile LAS unsigned* xst = (volatile LAS unsigned*)(smem + 66048);
  if (__builtin_amdgcn_workitem_id_x() == 0) { xst[0] = 0u; xst[1] = 0u; }
  __syncthreads();
  XcdBarrier xb; xb.bar = nullptr; xb.x = 0; xb.st = xst;
  for (int ph = ph0; ph < ph1; ++ph) {
    Params q = p;
    size_t zoff = 0;
    asm volatile("" : "+s"(zoff));
    q.ws = p.ws + zoff; q.out = p.out + zoff;
    run_phase(q, ph, smem);
#ifdef REPMASK
    if (ph > 0 && ph < NPHASE - 1 && ((REPMASK >> ((ph - 1) % 9)) & 1)) { grid.sync(); run_phase(q, ph, smem); }
#endif
    if (ph + 1 < ph1) {
      if (ph == ph0) { grid.sync(); xb = xcd_barrier_post((unsigned*)(p.ws + OFF_xbar), xst); }
      else xcd_barrier(xb);
    }
  }
}

extern "C" void kernel_launch(void* const* d_in, const int* in_sizes, int n_in, void* d_out, int out_size, void* d_ws,
                              size_t ws_size, hipStream_t stream) {
  static int grid_blocks = 0;
  if (!grid_blocks) {
    int dev = 0, cus = 0, per_cu = 0;
    hipGetDevice(&dev);
    hipDeviceGetAttribute(&cus, hipDeviceAttributeMultiprocessorCount, dev);
    hipOccupancyMaxActiveBlocksPerMultiprocessor(&per_cu, hybrid_megakernel, 256, 0);
    if (per_cu > 2) per_cu = 2;
    if (per_cu < 1) per_cu = 1;
    grid_blocks = cus * per_cu;
  }
  Params p{};
  const float* const* in = (const float* const*)d_in;
  p.x = in[0]; p.c = in[1]; p.ctx = in[2]; p.c_ctx = in[3]; p.w_ada = in[4]; p.b_ada = in[5]; p.g_norm1 = in[6];
  p.g_norm2 = in[7]; p.w_in = in[8]; p.g_q_norm = in[9]; p.w_uq = in[10]; p.g_kv_norm = in[11]; p.w_ukv = in[12];
  p.diff_lambda = in[13]; p.g_diff_norm = in[14]; p.hgrn_lb = in[15]; p.g_hgrn_norm = in[16]; p.w_out = in[17];
  p.w_gate = in[18]; p.w_up = in[19]; p.w_down = in[20]; p.g_final = in[21];
  p.out = (float*)d_out;
  p.ws = (char*)d_ws;
  if (WS_TOTAL > ws_size) { fprintf(stderr, "workspace too small: need %zu have %zu\n", (size_t)WS_TOTAL, ws_size); return; }
  int ph0 = 0, ph1 = NPHASE;
  void* args[] = {&p, &ph0, &ph1};
  hipError_t e = hipLaunchCooperativeKernel((void*)hybrid_megakernel, dim3(grid_blocks), dim3(256), args, 0, stream);
  if (e != hipSuccess) fprintf(stderr, "cooperative launch failed: %s (grid %d)\n", hipGetErrorString(e), grid_blocks);
}
```

```cpp
#include <hip/hip_runtime.h>
#include <hip/hip_cooperative_groups.h>
#include <cstdio>
namespace cg = cooperative_groups;

typedef __attribute__((ext_vector_type(8))) __bf16 bf8;
typedef __attribute__((ext_vector_type(4))) __bf16 bf4;
typedef __attribute__((ext_vector_type(4))) float f4;

#define XCD_BAR_WORDS_C 3456
#define NB 2
#define SEQ 8192
#define CTXL 256
#define PT 8448
#define NTOK 16896
#define DM 1024
#define INW 3744
#define INWP 3840
#define DFF 2816
#define NCH 132
#define LDH 1088
#define LDF 2880
#define LOG2E 1.4426950408889634f
#define EPSN 1e-6f
#define SMEM_BYTES 66064

constexpr size_t al256(size_t x) { return (x + 255) & ~(size_t)255; }
constexpr size_t OFF_xc = 0;
constexpr size_t OFF_mod = OFF_xc + al256((size_t)NB*CTXL*DM*4);
constexpr size_t OFF_rope = OFF_mod + al256((size_t)4*3*6144*4);
constexpr size_t OFF_llb = OFF_rope + al256(128*8*2*4);
constexpr size_t OFF_l1mlb = OFF_llb + al256(4*1024*4);
constexpr size_t OFF_lam = OFF_l1mlb + al256(4*1024*4);
constexpr size_t OFF_wt_in = OFF_lam + al256(256);
constexpr size_t OFF_wt_uq = OFF_wt_in + al256((size_t)INWP*LDH*2);
constexpr size_t OFF_wt_ukv = OFF_wt_uq + al256((size_t)384*256*2);
constexpr size_t OFF_wt_out = OFF_wt_ukv + al256((size_t)512*128*2);
constexpr size_t OFF_wt_gu = OFF_wt_out + al256((size_t)DM*LDH*2);
constexpr size_t OFF_wt_down = OFF_wt_gu + al256((size_t)2*DFF*LDH*2);
constexpr size_t OFF_hb = OFF_wt_down + al256((size_t)DM*LDF*2);
constexpr size_t OFF_cq = OFF_hb + al256((size_t)NTOK*LDH*2);
constexpr size_t OFF_ckv = OFF_cq + al256((size_t)NTOK*256*2);
constexpr size_t OFF_qm = OFF_ckv + al256((size_t)NTOK*128*2);
constexpr size_t OFF_km = OFF_qm + al256((size_t)NB*4*PT*96*2);
constexpr size_t OFF_vmt = OFF_km + al256((size_t)NB*4*PT*96*2);
constexpr size_t OFF_qd = OFF_vmt + al256((size_t)NB*4*64*PT*2);
constexpr size_t OFF_kd = OFF_qd + al256((size_t)NB*4*2*PT*32*2);
constexpr size_t OFF_vdt = OFF_kd + al256((size_t)NB*4*2*PT*32*2);
constexpr size_t OFF_hq = OFF_vdt + al256((size_t)NB*4*64*PT*2);
constexpr size_t OFF_hvt = OFF_hq + al256((size_t)NTOK*512*2);
constexpr size_t OFF_hg = OFF_hvt + al256((size_t)NB*8*64*PT*2);
constexpr size_t OFF_dk = OFF_hg + al256((size_t)NTOK*512*2);
constexpr size_t OFF_st = OFF_dk + al256((size_t)NB*8*2*NCH*64*4);
constexpr size_t OFF_lf = OFF_st + al256((size_t)NB*8*2*NCH*4096*2);
constexpr size_t OFF_ut = OFF_lf + al256((size_t)2*NTOK*512*4);
constexpr size_t OFF_xbar = OFF_ut + al256((size_t)NB*8*2*NCH*4096*4);
constexpr size_t WS_TOTAL_OLD = OFF_ut + al256((size_t)NB*8*2*NCH*4096*4);
constexpr size_t WS_TOTAL = OFF_xbar + al256((size_t)XCD_BAR_WORDS_C*4);
struct Params {
  const float *x, *c, *ctx, *c_ctx, *w_ada, *b_ada, *g_norm1, *g_norm2, *w_in, *g_q_norm, *w_uq, *g_kv_norm, *w_ukv,
      *diff_lambda, *g_diff_norm, *hgrn_lb, *g_hgrn_norm, *w_out, *w_gate, *w_up, *w_down, *g_final;
  float* out;
  char* ws;
  __device__ __forceinline__ float* xc() const { return (float*)(ws + OFF_xc); }
  __device__ __forceinline__ float* mod() const { return (float*)(ws + OFF_mod); }
  __device__ __forceinline__ float* rope() const { return (float*)(ws + OFF_rope); }
  __device__ __forceinline__ float* llb() const { return (float*)(ws + OFF_llb); }
  __device__ __forceinline__ float* l1mlb() const { return (float*)(ws + OFF_l1mlb); }
  __device__ __forceinline__ float* lam() const { return (float*)(ws + OFF_lam); }
  __device__ __forceinline__ __bf16* wt_in() const { return (__bf16*)(ws + OFF_wt_in); }
  __device__ __forceinline__ __bf16* wt_uq() const { return (__bf16*)(ws + OFF_wt_uq); }
  __device__ __forceinline__ __bf16* wt_ukv() const { return (__bf16*)(ws + OFF_wt_ukv); }
  __device__ __forceinline__ __bf16* wt_out() const { return (__bf16*)(ws + OFF_wt_out); }
  __device__ __forceinline__ __bf16* wt_gu() const { return (__bf16*)(ws + OFF_wt_gu); }
  __device__ __forceinline__ __bf16* wt_down() const { return (__bf16*)(ws + OFF_wt_down); }
  __device__ __forceinline__ __bf16* hb() const { return (__bf16*)(ws + OFF_hb); }
  __device__ __forceinline__ __bf16* cq() const { return (__bf16*)(ws + OFF_cq); }
  __device__ __forceinline__ __bf16* ckv() const { return (__bf16*)(ws + OFF_ckv); }
  __device__ __forceinline__ __bf16* qm() const { return (__bf16*)(ws + OFF_qm); }
  __device__ __forceinline__ __bf16* km() const { return (__bf16*)(ws + OFF_km); }
  __device__ __forceinline__ __bf16* vmt() const { return (__bf16*)(ws + OFF_vmt); }
  __device__ __forceinline__ __bf16* qd() const { return (__bf16*)(ws + OFF_qd); }
  __device__ __forceinline__ __bf16* kd() const { return (__bf16*)(ws + OFF_kd); }
  __device__ __forceinline__ __bf16* vdt() const { return (__bf16*)(ws + OFF_vdt); }
  __device__ __forceinline__ __bf16* hq() const { return (__bf16*)(ws + OFF_hq); }
  __device__ __forceinline__ __bf16* hvt() const { return (__bf16*)(ws + OFF_hvt); }
  __device__ __forceinline__ __bf16* hg() const { return (__bf16*)(ws + OFF_hg); }
  __device__ __forceinline__ float* dk() const { return (float*)(ws + OFF_dk); }
  __device__ __forceinline__ __bf16* st() const { return (__bf16*)(ws + OFF_st); }
  __device__ __forceinline__ float* lf() const { return (float*)(ws + OFF_lf); }
  __device__ __forceinline__ float* ut() const { return (float*)(ws + OFF_ut); }
  __device__ __forceinline__ __bf16* mix() const { return hb(); }
  __device__ __forceinline__ __bf16* act() const { return (__bf16*)lf(); }
};

__device__ __forceinline__ int tid_() { int t = __builtin_amdgcn_workitem_id_x(); asm volatile("" : "+v"(t)); return t; }
__device__ __forceinline__ int bid_() { int t = __builtin_amdgcn_workgroup_id_x(); asm volatile("" : "+s"(t)); return t; }
__device__ __forceinline__ float silu_f(float x) { return x * __builtin_amdgcn_rcpf(1.f + __expf(-x)); }
__device__ __forceinline__ float wave_sum(float v) {
  v += __uint_as_float(__builtin_amdgcn_update_dpp(0u, __float_as_uint(v), 0x128, 0xf, 0xf, false));
  v += __uint_as_float(__builtin_amdgcn_update_dpp(0u, __float_as_uint(v), 0x124, 0xf, 0xf, false));
  v += __uint_as_float(__builtin_amdgcn_update_dpp(0u, __float_as_uint(v), 0x122, 0xf, 0xf, false));
  v += __uint_as_float(__builtin_amdgcn_update_dpp(0u, __float_as_uint(v), 0x121, 0xf, 0xf, false));
  unsigned u = __float_as_uint(v);
  auto a = __builtin_amdgcn_permlane16_swap(u, u, false, false);
  float m = __uint_as_float(a[0]) + __uint_as_float(a[1]);
  unsigned w = __float_as_uint(m);
  auto b = __builtin_amdgcn_permlane32_swap(w, w, false, false);
  return __uint_as_float(b[0]) + __uint_as_float(b[1]);
}
__device__ __forceinline__ float* xrow(const Params& p, int tok) {
  int b = tok / PT, pp = tok - b * PT;
  return pp < CTXL ? p.xc() + (size_t)(b * CTXL + pp) * DM : p.out + (size_t)(b * SEQ + pp - CTXL) * DM;
}
__device__ __forceinline__ float log_forget(float z, float lb, float oml) {
  const float sg = __builtin_amdgcn_rcpf(1.f + __expf(-fmaxf(z, -80.f)));
  return __logf(lb + oml * sg);
}
__device__ __forceinline__ float rows_max(float x) {
  unsigned u = __float_as_uint(x);
  auto a = __builtin_amdgcn_permlane16_swap(u, u, false, false);
  float m = fmaxf(__uint_as_float(a[0]), __uint_as_float(a[1]));
  unsigned v = __float_as_uint(m);
  auto b = __builtin_amdgcn_permlane32_swap(v, v, false, false);
  return fmaxf(__uint_as_float(b[0]), __uint_as_float(b[1]));
}
__device__ __forceinline__ float rows_sum(float x) {
  unsigned u = __float_as_uint(x);
  auto a = __builtin_amdgcn_permlane16_swap(u, u, false, false);
  float m = __uint_as_float(a[0]) + __uint_as_float(a[1]);
  unsigned v = __float_as_uint(m);
  auto b = __builtin_amdgcn_permlane32_swap(v, v, false, false);
  return __uint_as_float(b[0]) + __uint_as_float(b[1]);
}
__device__ __forceinline__ f4 mfma16(bf8 a, bf8 b, f4 c) { return __builtin_amdgcn_mfma_f32_16x16x32_bf16(a, b, c, 0, 0, 0); }

__device__ __forceinline__ void phase0(const Params& p, char* smem) {
  const int tid = tid_();
  const int gsz = gridDim.x * 256, gtid = bid_() * 256 + tid;
  {
    const float4* xs = (const float4*)p.x; float4* xo = (float4*)p.out;
    for (int i = gtid; i < NB * SEQ * DM / 4; i += gsz) xo[i] = xs[i];
    const float4* cs = (const float4*)p.ctx; float4* co = (float4*)p.xc();
    for (int i = gtid; i < NB * CTXL * DM / 4; i += gsz) co[i] = cs[i];
  }
  if (gtid < 1024) {
    int pos = gtid >> 3, f = gtid & 7;
    float freq = powf(10000.f, -(float)f / 8.f);
    float ang = (float)pos * freq, s, c;
    sincosf(ang, &s, &c);
    p.rope()[gtid * 2] = c; p.rope()[gtid * 2 + 1] = s;
  } else if (gtid < 2048) {
    int n = gtid - 1024;
    float r0 = p.hgrn_lb[n], r1 = p.hgrn_lb[1024 + n], r2 = p.hgrn_lb[2048 + n], r3 = p.hgrn_lb[3072 + n];
    float m = fmaxf(fmaxf(r0, r1), fmaxf(r2, r3));
    float e0 = expf(r0 - m), e1 = expf(r1 - m), e2 = expf(r2 - m), e3 = expf(r3 - m);
    float s = e0 + e1 + e2 + e3;
    float p0 = e0 / s, p1 = e1 / s, p2 = e2 / s, p3 = e3 / s;
    float c0 = p0, c1 = c0 + p1, c2 = c1 + p2, c3 = c2 + p3;
    p.llb()[n] = 0.f; p.l1mlb()[n] = 1.f;
    p.llb()[1024 + n] = c1 - c0; p.l1mlb()[1024 + n] = 1.f - (c1 - c0);
    p.llb()[2048 + n] = c2 - c0; p.l1mlb()[2048 + n] = 1.f - (c2 - c0);
    p.llb()[3072 + n] = c3 - c0; p.l1mlb()[3072 + n] = 1.f - (c3 - c0);
  } else if (gtid >= 4096 && gtid < 4096 + XCD_BAR_WORDS_C) {
    ((unsigned*)(p.ws + OFF_xbar))[gtid - 4096] = 0u;
  } else if (gtid == 2052) {
    *(unsigned*)(p.ws + OFF_lam + 128) = 0u;
  } else if (gtid < 2052) {
    int l = gtid - 2048;
    const float* d = p.diff_lambda + l * 128;
    float s1 = 0.f, s2 = 0.f;
    for (int i = 0; i < 32; ++i) { s1 += d[i] * d[32 + i]; s2 += d[64 + i] * d[96 + i]; }
    float li = 0.8f - 0.6f * expf(-0.3f * (float)l);
    p.lam()[l] = expf(s1) - expf(s2) + li;
  }
  float* sl = (float*)smem;
  float* red = sl + 3072;
  bool have = false;
  for (int item = bid_(); item < 768; item += gridDim.x) {
    if (!have) {
      for (int i = tid; i < 1024; i += 256) {
        sl[i] = silu_f(p.c[i]); sl[1024 + i] = silu_f(p.c[1024 + i]); sl[2048 + i] = silu_f(p.c_ctx[i]);
      }
      have = true;
      __syncthreads();
    }
    int l = item / 192, n0 = (item % 192) * 32;
    int col = tid & 31, kg = tid >> 5;
    const float* W = p.w_ada + (size_t)l * DM * 6144 + n0 + col;
    float a0 = 0.f, a1 = 0.f, a2 = 0.f;
#pragma unroll 8
    for (int k = kg * 128; k < kg * 128 + 128; ++k) {
      float w = W[(size_t)k * 6144];
      a0 += sl[k] * w; a1 += sl[1024 + k] * w; a2 += sl[2048 + k] * w;
    }
    red[(kg * 3 + 0) * 32 + col] = a0; red[(kg * 3 + 1) * 32 + col] = a1; red[(kg * 3 + 2) * 32 + col] = a2;
    __syncthreads();
    if (tid < 96) {
      int v = tid >> 5, cc = tid & 31;
      float s = p.b_ada[l * 6144 + n0 + cc];
#pragma unroll
      for (int q = 0; q < 8; ++q) s += red[(q * 3 + v) * 32 + cc];
      p.mod()[(size_t)(l * 3 + v) * 6144 + n0 + cc] = s;
    }
    __syncthreads();
  }
}

struct ConvD { const float* srcp; size_t sstride; __bf16* dstp; const float* ksp; };

__device__ __forceinline__ ConvD conv_decode(const Params& p, int l, int it, int tid) {
  const float* src; int N, ntn, mode = 0, dld; __bf16* dst; const float* ks = nullptr;
  if (it < 1872) { src = p.w_in + (size_t)l * DM * INW; N = INW; ntn = 117; dst = p.wt_in(); dld = LDH; }
  else if (it < 1920) { it -= 1872; src = p.w_uq + (size_t)l * 256 * 384; N = 384; ntn = 12; dst = p.wt_uq(); dld = 256; ks = p.g_q_norm + l * 256; }
  else if (it < 1952) { it -= 1920; src = p.w_ukv + (size_t)l * 128 * 512; N = 512; ntn = 16; dst = p.wt_ukv(); dld = 128; ks = p.g_kv_norm + l * 128; }
  else if (it < 2464) { it -= 1952; src = p.w_out + (size_t)l * DM * DM; N = DM; ntn = 32; dst = p.wt_out(); dld = LDH; }
  else if (it < 3872) { it -= 2464; src = p.w_gate + (size_t)l * DM * DFF; N = DFF; ntn = 88; dst = p.wt_gu(); mode = 1; dld = LDH; }
  else if (it < 5280) { it -= 3872; src = p.w_up + (size_t)l * DM * DFF; N = DFF; ntn = 88; dst = p.wt_gu(); mode = 2; dld = LDH; }
  else { it -= 5280; src = p.w_down + (size_t)l * DFF * DM; N = DM; ntn = 32; dst = p.wt_down(); dld = LDF; }
  const int kt = it / ntn, nt = it - kt * ntn;
  ConvD d;
  d.srcp = src + (size_t)(kt * 64 + (tid >> 3)) * N + nt * 32 + (tid & 7) * 4;
  d.sstride = (size_t)32 * N;
  const int n = nt * 32 + (tid >> 3);
  int row = n;
  if (mode == 1) row = (n >> 4) * 32 + (n & 15);
  else if (mode == 2) row = (n >> 4) * 32 + 16 + (n & 15);
  d.dstp = dst + (size_t)row * dld + kt * 64 + (tid & 7) * 8;
  d.ksp = ks ? ks + kt * 64 + (tid & 7) * 8 : nullptr;
  return d;
}

__device__ __forceinline__ void conv_items(const Params& p, int l, int first, int step, char* smem) {
  float* tile = (float*)smem;
  const int tid = tid_();
  if (first >= 6688) return;
  ConvD cur = conv_decode(p, l, first, tid);
  float4 v0 = *(const float4*)(cur.srcp), v1 = *(const float4*)(cur.srcp + cur.sstride);
  for (int it = first; it < 6688; it += step) {
    const int itn = it + step < 6688 ? it + step : it;
    const ConvD nxt = conv_decode(p, l, itn, tid);
    const float4 n0 = *(const float4*)(nxt.srcp), n1 = *(const float4*)(nxt.srcp + nxt.sstride);
    __syncthreads();
    {
      const int r = tid >> 3, c4 = tid & 7;
      float* t = tile + r * 33 + c4 * 4;
      t[0] = v0.x; t[1] = v0.y; t[2] = v0.z; t[3] = v0.w;
      t += 32 * 33;
      t[0] = v1.x; t[1] = v1.y; t[2] = v1.z; t[3] = v1.w;
    }
    __syncthreads();
    {
      const int nr = tid >> 3, kc = tid & 7;
      bf8 o;
#pragma unroll
      for (int j = 0; j < 8; ++j) {
        float v = tile[(kc * 8 + j) * 33 + nr];
        if (cur.ksp) v *= cur.ksp[j];
        o[j] = (__bf16)v;
      }
      *(bf8*)cur.dstp = o;
    }
    cur = nxt; v0 = n0; v1 = n1;
  }
}

__device__ __forceinline__ void norm_item(const Params& p, int l, int which, int item) {
  const int lane = tid_() & 63, wave = tid_() >> 6;
  const int tok0 = item * 16 + wave * 4;
  const int b = tok0 / PT, pp = tok0 - b * PT;
  const int v = pp < CTXL ? 2 : b;
  const float* g = (which ? p.g_norm2 : p.g_norm1) + l * DM;
  const float* md = p.mod() + (size_t)(l * 3 + v) * 6144 + (which ? 3072 : 0);
  f4 a[4], sh[4];
#pragma unroll
  for (int i = 0; i < 4; ++i) {
    int k = i * 256 + lane * 4;
    f4 gg = *(const f4*)(g + k), sc = *(const f4*)(md + 1024 + k);
    sh[i] = *(const f4*)(md + k);
    a[i] = gg * (1.f + sc);
  }
  f4 xv[4][4];
#pragma unroll
  for (int r = 0; r < 4; ++r) {
    const float* xr = xrow(p, tok0 + r);
#pragma unroll
    for (int i = 0; i < 4; ++i) xv[r][i] = *(const f4*)(xr + i * 256 + lane * 4);
  }
#pragma unroll
  for (int r = 0; r < 4; ++r) {
    float ss = 0.f;
#pragma unroll
    for (int i = 0; i < 4; ++i)
      ss += xv[r][i][0] * xv[r][i][0] + xv[r][i][1] * xv[r][i][1] + xv[r][i][2] * xv[r][i][2] + xv[r][i][3] * xv[r][i][3];
    ss = wave_sum(ss);
    float rstd = rsqrtf(ss * (1.f / DM) + EPSN);
#pragma unroll
    for (int i = 0; i < 4; ++i) {
      f4 h = xv[r][i] * rstd * a[i] + sh[i];
      bf4 o; o[0] = (__bf16)h[0]; o[1] = (__bf16)h[1]; o[2] = (__bf16)h[2]; o[3] = (__bf16)h[3];
      *(bf4*)(p.hb() + (size_t)(tok0 + r) * LDH + i * 256 + lane * 4) = o;
    }
  }
}

__device__ __forceinline__ void final_norm_item(const Params& p, int item) {
  const int lane = tid_() & 63, wave = tid_() >> 6;
  const int row0 = item * 16 + wave * 4;
  f4 g[4];
#pragma unroll
  for (int i = 0; i < 4; ++i) g[i] = *(const f4*)(p.g_final + i * 256 + lane * 4);
  f4 xv[4][4];
#pragma unroll
  for (int r = 0; r < 4; ++r)
#pragma unroll
    for (int i = 0; i < 4; ++i) xv[r][i] = *(const f4*)(p.out + (size_t)(row0 + r) * DM + i * 256 + lane * 4);
#pragma unroll
  for (int r = 0; r < 4; ++r) {
    float ss = 0.f;
#pragma unroll
    for (int i = 0; i < 4; ++i)
      ss += xv[r][i][0] * xv[r][i][0] + xv[r][i][1] * xv[r][i][1] + xv[r][i][2] * xv[r][i][2] + xv[r][i][3] * xv[r][i][3];
    ss = wave_sum(ss);
    float rstd = rsqrtf(ss * (1.f / DM) + EPSN);
#pragma unroll
    for (int i = 0; i < 4; ++i) *(f4*)(p.out + (size_t)(row0 + r) * DM + i * 256 + lane * 4) = xv[r][i] * rstd * g[i];
  }
}

#define GLD 72
enum { EPI_IN = 0, EPI_UQ, EPI_UKV, EPI_OUT, EPI_UP, EPI_DOWN, EPI_OUT_AT, EPI_DOWN_AT };

__device__ __forceinline__ f4 rope4(const Params& p, f4 a, int prow, int axis, int r) {
  f4 o;
#pragma unroll
  for (int reg = 0; reg < 4; ++reg) {
    float pv = __uint_as_float(__builtin_amdgcn_update_dpp(0u, __float_as_uint(a[reg]), 0x128, 0xf, 0xf, false));
    int t = prow + reg - CTXL;
    int pos = axis ? (t & 63) : (t >> 6);
    float2 cs = ((const float2*)p.rope())[pos * 8 + (r & 7)];
    o[reg] = (r & 8) ? a[reg] * cs.x + pv * cs.y : a[reg] * cs.x - pv * cs.y;
  }
  return o;
}
__device__ __forceinline__ bf4 pack4(f4 a) {
  bf4 o; o[0] = (__bf16)a[0]; o[1] = (__bf16)a[1]; o[2] = (__bf16)a[2]; o[3] = (__bf16)a[3];
  return o;
}

template <int EPI>
__device__ __forceinline__ void gemm_epilogue(const Params& p, int l, f4 (&acc)[4][4], int m0, int n0, int wm, int wn, int lane,
                                              const float* rowss) {
  const int r = lane & 15, g = lane >> 4;
  const int b = m0 / PT;
  const int pp0 = m0 - b * PT;
  const bool lat = pp0 >= CTXL;
  const int v = lat ? b : 2;
  const float* md = p.mod() + (size_t)(l * 3 + v) * 6144;
  const int prow0 = pp0 + wm * 64 + 4 * g;
  const int tok0 = b * PT + prow0;
  constexpr int STEP = (EPI == EPI_UP) ? 2 : 1;
  if constexpr (EPI == EPI_OUT || EPI == EPI_DOWN) {
    float* xb = (lat ? p.out + (size_t)(b * SEQ + prow0 - CTXL) * DM : p.xc() + (size_t)(b * CTXL + prow0) * DM) + n0 + wn * 64 + r;
    float gt[4];
    f4 xin[4][4];
#pragma unroll
    for (int ni = 0; ni < 4; ++ni) gt[ni] = md[(EPI == EPI_OUT ? 2048 : 5120) + n0 + wn * 64 + ni * 16 + r];
#pragma unroll
    for (int mi = 0; mi < 4; ++mi)
#pragma unroll
      for (int ni = 0; ni < 4; ++ni)
#pragma unroll
        for (int q = 0; q < 4; ++q) xin[mi][ni][q] = xb[(size_t)(mi * 16 + q) * DM + ni * 16];
#pragma unroll
    for (int mi = 0; mi < 4; ++mi)
#pragma unroll
      for (int ni = 0; ni < 4; ++ni)
#pragma unroll
        for (int q = 0; q < 4; ++q) xb[(size_t)(mi * 16 + q) * DM + ni * 16] = xin[mi][ni][q] + gt[ni] * acc[mi][ni][q];
    return;
  }
  float tla[4] = {0.f, 0.f, 0.f, 0.f}, tl1[4] = {0.f, 0.f, 0.f, 0.f};
  if constexpr (EPI == EPI_IN) {
#pragma unroll
    for (int ni = 0; ni < 4; ++ni) {
      const int c0 = n0 + wn * 64 + ni * 16;
      if (c0 >= 1696 && c0 < 2720) {
        const int dir = c0 >= 2208;
        const int n1 = c0 + r - (dir ? 2208 : 1696);
        tla[ni] = p.llb()[(l * 2 + dir) * 512 + n1];
        tl1[ni] = p.l1mlb()[(l * 2 + dir) * 512 + n1];
      }
    }
  }
#pragma unroll 1
  for (int ni = 0; ni < 4; ni += STEP) {
    const int col0 = n0 + wn * 64 + ni * 16;
    const int col = col0 + r;
    if constexpr (EPI == EPI_IN) {
      if (col0 < 384) {
        __bf16* dst = col0 < 256 ? p.cq() + col : p.ckv() + (col - 256);
        const int ld = col0 < 256 ? 256 : 128;
#pragma unroll
        for (int mi = 0; mi < 4; ++mi)
#pragma unroll
          for (int q = 0; q < 4; ++q) dst[(size_t)(tok0 + mi * 16 + q) * ld] = (__bf16)acc[mi][0][q];
      } else if (col0 < 416) {
        f4 v[4];
#pragma unroll
        for (int mi = 0; mi < 4; ++mi) {
          v[mi] = acc[mi][0];
          if (lat) v[mi] = rope4(p, v[mi], prow0 + mi * 16, (col0 - 384) >> 4, r);
        }
#pragma unroll
        for (int mi = 0; mi < 4; ++mi)
#pragma unroll
          for (int h = 0; h < 4; ++h)
#pragma unroll
            for (int q = 0; q < 4; ++q) p.km()[((size_t)(b * 4 + h) * PT + prow0 + mi * 16 + q) * 96 + 64 + col - 384] = (__bf16)v[mi][q];
      } else if (col0 < 928) {
        const bool isq = col0 < 672;
        const int n1 = col - (isq ? 416 : 672);
        const int head = n1 >> 6, map = (n1 >> 5) & 1, d = n1 & 31;
        __bf16* dst = (isq ? p.qd() : p.kd()) + ((size_t)((b * 4 + head) * 2 + map) * PT) * 32 + d;
        const float sc = isq ? 0.17677669529663687f * LOG2E : 1.f;
        f4 v[4];
#pragma unroll
        for (int mi = 0; mi < 4; ++mi) {
          v[mi] = acc[mi][0];
          if (lat) v[mi] = rope4(p, v[mi], prow0 + mi * 16, (n1 >> 4) & 1, r);
        }
#pragma unroll
        for (int mi = 0; mi < 4; ++mi)
#pragma unroll
          for (int q = 0; q < 4; ++q) dst[(size_t)(prow0 + mi * 16 + q) * 32] = (__bf16)(v[mi][q] * sc);
      } else if (col0 < 1184 || (col0 >= 2720 && col0 < 3232)) {
        const bool isd = col0 < 1184;
        const int n1 = col - (isd ? 928 : 2720);
        __bf16* dst = isd ? p.vdt() + ((size_t)(b * 4 + (n1 >> 6)) * 64 + (n1 & 63)) * PT
                          : p.hvt() + ((size_t)(b * 8 + (n1 >> 6)) * 64 + (n1 & 63)) * PT;
#pragma unroll
        for (int mi = 0; mi < 4; ++mi) *(bf4*)(dst + prow0 + mi * 16) = pack4(acc[mi][0]);
      } else if (col0 < 1696 || (col0 >= 3232 && col0 < INW)) {
        const bool ish = col0 < 1696;
        __bf16* dst = ish ? p.hq() + (col - 1184) : p.hg() + (col - 3232);
#pragma unroll
        for (int mi = 0; mi < 4; ++mi)
#pragma unroll
          for (int q = 0; q < 4; ++q) dst[(size_t)(tok0 + mi * 16 + q) * 512] = (__bf16)silu_f(acc[mi][0][q]);
      } else if (col0 < 2720) {
        const int dir = col0 >= 2208;
        const int n1 = col - (dir ? 2208 : 1696);
        const float la = tla[0], l1m = tl1[0];
        float* dst = p.lf() + (size_t)dir * NTOK * 512 + n1;
#pragma unroll
        for (int mi = 0; mi < 4; ++mi)
#pragma unroll
          for (int q = 0; q < 4; ++q) dst[(size_t)(tok0 + mi * 16 + q) * 512] = log_forget(acc[mi][0][q], la, l1m);
      }
    } else if constexpr (EPI == EPI_UQ) {
      const int head = col0 / 96, d0 = col0 - head * 96;
      const float sc = 0.10206207261596577f * LOG2E;
      __bf16* dst = p.qm() + ((size_t)(b * 4 + head) * PT) * 96 + d0 + r;
      f4 v[4];
#pragma unroll
      for (int mi = 0; mi < 4; ++mi) {
        f4 a = acc[mi][0];
#pragma unroll
        for (int q = 0; q < 4; ++q) a[q] *= rsqrtf(rowss[wm * 64 + mi * 16 + 4 * g + q] * (1.f / 256.f) + EPSN);
        if (d0 >= 64 && lat) a = rope4(p, a, prow0 + mi * 16, (d0 - 64) >> 4, r);
        v[mi] = a;
      }
#pragma unroll
      for (int mi = 0; mi < 4; ++mi)
#pragma unroll
        for (int q = 0; q < 4; ++q) dst[(size_t)(prow0 + mi * 16 + q) * 96] = (__bf16)(v[mi][q] * sc);
    } else if constexpr (EPI == EPI_UKV) {
      const int head = col >> 7, d = col & 127;
#pragma unroll
      for (int mi = 0; mi < 4; ++mi) {
        f4 a = acc[mi][0];
        const int prow = prow0 + mi * 16;
#pragma unroll
        for (int q = 0; q < 4; ++q) a[q] *= rsqrtf(rowss[wm * 64 + mi * 16 + 4 * g + q] * (1.f / 128.f) + EPSN);
        if ((col0 & 127) < 64) {
#pragma unroll
          for (int q = 0; q < 4; ++q) p.km()[((size_t)(b * 4 + head) * PT + prow + q) * 96 + d] = (__bf16)a[q];
        } else {
          *(bf4*)(p.vmt() + ((size_t)(b * 4 + head) * 64 + d - 64) * PT + prow) = pack4(a);
        }
      }
    } else if constexpr (EPI == EPI_OUT || EPI == EPI_DOWN) {
    } else if constexpr (EPI == EPI_OUT_AT || EPI == EPI_DOWN_AT) {
      const float gt = md[(EPI == EPI_OUT_AT ? 2048 : 5120) + col];
      float* xb = (lat ? p.out + (size_t)(b * SEQ + prow0 - CTXL) * DM : p.xc() + (size_t)(b * CTXL + prow0) * DM) + col;
#pragma unroll
      for (int mi = 0; mi < 4; ++mi)
#pragma unroll
        for (int q = 0; q < 4; ++q) atomicAdd(xb + (size_t)(mi * 16 + q) * DM, gt * acc[mi][0][q]);
    } else if constexpr (EPI == EPI_UP) {
      const int n = (col0 >> 5) * 16 + r;
#pragma unroll
      for (int mi = 0; mi < 4; ++mi)
#pragma unroll
        for (int q = 0; q < 4; ++q)
          p.act()[(size_t)(tok0 + mi * 16 + q) * LDF + n] = (__bf16)(silu_f(acc[mi][0][q]) * acc[mi][1][q]);
    }
#pragma unroll
    for (int mi = 0; mi < 4; ++mi) {
      if constexpr (STEP == 1) { acc[mi][0] = acc[mi][1]; acc[mi][1] = acc[mi][2]; acc[mi][2] = acc[mi][3]; }
      else { acc[mi][0] = acc[mi][2]; acc[mi][1] = acc[mi][3]; }
    }
    tla[0] = tla[1]; tla[1] = tla[2]; tla[2] = tla[3]; tl1[0] = tl1[1]; tl1[1] = tl1[2]; tl1[2] = tl1[3];
  }
}

#define RAW_BARRIER() do { asm volatile("s_waitcnt lgkmcnt(0)" ::: "memory"); __builtin_amdgcn_s_barrier(); } while (0)

template <int EPI, bool ROWSS>
__device__ __forceinline__ void gemm_tile(const Params& p, int l, const __bf16* __restrict__ A, int lda, const __bf16* __restrict__ Bt, int ldb, int K,
                          int m0, int n0, char* smem, bool pre = false, bool has_next = false, int m0n = 0, int n0n = 0) {
  __bf16* S0 = (__bf16*)smem;
  float* rowss = (float*)(smem + 65536);
  const int tid = tid_(), lane = tid & 63, wave = tid >> 6;
  const int wm = wave >> 1, wn = wave & 1, r = lane & 15, g = lane >> 4;
  f4 acc[4][4];
#pragma unroll
  for (int i = 0; i < 4; ++i)
#pragma unroll
    for (int j = 0; j < 4; ++j) acc[i][j] = f4{0.f, 0.f, 0.f, 0.f};
  if constexpr (ROWSS) {
    const int row = tid >> 1, half = tid & 1;
    const __bf16* rp = A + (size_t)(m0 + row) * lda + half * (K >> 1);
    float sq = 0.f;
    for (int c = 0; c < (K >> 4); ++c) {
      bf8 v = *(const bf8*)(rp + c * 8);
#pragma unroll
      for (int j = 0; j < 8; ++j) { float f = (float)v[j]; sq += f * f; }
    }
    sq += __shfl_xor(sq, 1);
    __syncthreads();
    if (!half) rowss[row] = sq;
  }
  const int lrow = lane >> 3;
  const int sz = (lane >> 4);
  const __bf16* gaw[4]; const __bf16* gbw[4];
#pragma unroll
  for (int i = 0; i < 4; ++i) {
    const int rg = wave + 4 * i;
    const int row = rg * 8 + lrow;
    const int cl = (lane & 7) ^ (((rg & 1) * 4 + sz) & 7);
    gaw[i] = A + (size_t)(m0 + row) * lda + cl * 8;
    gbw[i] = Bt + (size_t)(n0 + row) * ldb + cl * 8;
  }
  const int aoff = (wm * 64 + r) * 64, boff = 8192 + (wn * 64 + r) * 64;
  const int sw = r >> 1;
  const int KT = K / 64;
  if (!pre) {
    __syncthreads();
#pragma unroll
    for (int i = 0; i < 4; ++i) {
      __builtin_amdgcn_global_load_lds((const unsigned*)(gaw[i]), (unsigned*)(S0 + (wave + 4 * i) * 512), 16, 0, 0);
      __builtin_amdgcn_global_load_lds((const unsigned*)(gbw[i]), (unsigned*)(S0 + 8192 + (wave + 4 * i) * 512), 16, 0, 0);
    }
  }
  asm volatile("s_waitcnt vmcnt(0)" ::: "memory");
  RAW_BARRIER();
  for (int kt = 0; kt < KT; ++kt) {
    const __bf16* Sc = S0 + (kt & 1) * 16384;
    __bf16* Sn = S0 + ((kt + 1) & 1) * 16384;
    if (kt + 1 < KT) {
#pragma unroll
      for (int i = 0; i < 4; ++i) {
        __builtin_amdgcn_global_load_lds((const unsigned*)(gaw[i] + (kt + 1) * 64), (unsigned*)(Sn + (wave + 4 * i) * 512), 16, 0, 0);
        __builtin_amdgcn_global_load_lds((const unsigned*)(gbw[i] + (kt + 1) * 64), (unsigned*)(Sn + 8192 + (wave + 4 * i) * 512), 16, 0, 0);
      }
    }
#pragma unroll
    for (int ks = 0; ks < 2; ++ks) {
      bf8 af[4], bfr[4];
      const int ch = ((ks * 4 + g) ^ sw) * 8;
#pragma unroll
      for (int i = 0; i < 4; ++i) {
        af[i] = *(const bf8*)(Sc + aoff + i * 1024 + ch);
        bfr[i] = *(const bf8*)(Sc + boff + i * 1024 + ch);
      }
      __builtin_amdgcn_s_setprio(1);
#pragma unroll
      for (int i = 0; i < 4; ++i)
#pragma unroll
        for (int j = 0; j < 4; ++j) acc[i][j] = mfma16(af[i], bfr[j], acc[i][j]);
      __builtin_amdgcn_s_setprio(0);
    }
    asm volatile("s_waitcnt vmcnt(0)" ::: "memory");
    RAW_BARRIER();
  }
  if (has_next) {
#pragma unroll
    for (int i = 0; i < 4; ++i) {
      const int rg = wave + 4 * i;
      const int row = rg * 8 + lrow;
      const int cl = (lane & 7) ^ (((rg & 1) * 4 + sz) & 7);
      __builtin_amdgcn_global_load_lds((const unsigned*)(A + (size_t)(m0n + row) * lda + cl * 8), (unsigned*)(S0 + rg * 512), 16, 0, 0);
      __builtin_amdgcn_global_load_lds((const unsigned*)(Bt + (size_t)(n0n + row) * ldb + cl * 8), (unsigned*)(S0 + 8192 + rg * 512), 16, 0, 0);
    }
  }
  gemm_epilogue<EPI>(p, l, acc, m0, n0, wm, wn, lane, rowss);
}

__device__ __forceinline__ int mtile_count(int l) { return l < 3 ? 132 : 128; }
__device__ __forceinline__ int mtile_index(int l, int i) { return l < 3 ? i : (i >> 6) * 66 + 2 + (i & 63); }

__device__ __forceinline__ bool gemm_pick(int step, int bid, int G, int MT, int NT, int W, int& mt, int& nt) {
  const int C = G >> 3;
  const int L = (step * 8 + (bid & 7)) * C + (bid >> 3);
  if (L >= MT * NT) return false;
  const int s = L / (W * MT), rem = L - s * W * MT;
  mt = rem / W; nt = s * W + (rem - mt * W);
  return true;
}

template <int DQK, int NMAP>
__device__ __forceinline__ void attn_item(const Params& p, int l, const __bf16* __restrict__ Q, const __bf16* __restrict__ Kp,
                          const __bf16* __restrict__ Vt, int b, int h, int q0, int nkeys, char* smem) {
  constexpr int KLD = DQK + 8;
  constexpr int KCH = DQK / 8;
  constexpr int NKC = NMAP * 64 * KCH / 256;
  constexpr int NKS = DQK / 32;
  __bf16* Ks = (__bf16*)smem;
  __bf16* Vs = Ks + NMAP * 64 * KLD;
  const int tid = tid_(), lane = tid & 63, wave = tid >> 6, r = lane & 15, g = lane >> 4;
  const __bf16* Qb = Q + (size_t)((b * 4 + h) * NMAP) * PT * DQK;
  const __bf16* Kb = Kp + (size_t)((b * 4 + h) * NMAP) * PT * DQK;
  const __bf16* Vb = Vt + (size_t)((b * 4 + h) * 64) * PT;

  bf8 qf[NMAP][2][NKS];
#pragma unroll
  for (int mp = 0; mp < NMAP; ++mp)
#pragma unroll
    for (int qt = 0; qt < 2; ++qt)
#pragma unroll
      for (int ks = 0; ks < NKS; ++ks)
        qf[mp][qt][ks] = *(const bf8*)(Qb + ((size_t)mp * PT + q0 + wave * 32 + qt * 16 + r) * DQK + ks * 32 + g * 8);

  f4 o[NMAP][2][4];
  float mrun[NMAP][2], lsum[NMAP][2];
  f4 negm[NMAP][2];
#pragma unroll
  for (int mp = 0; mp < NMAP; ++mp)
#pragma unroll
    for (int qt = 0; qt < 2; ++qt) {
      mrun[mp][qt] = 0.f; lsum[mp][qt] = 0.f; negm[mp][qt] = f4{0.f, 0.f, 0.f, 0.f};
#pragma unroll
      for (int d = 0; d < 4; ++d) o[mp][qt][d] = f4{0.f, 0.f, 0.f, 0.f};
    }

  int koff_g[NKC], koff_s[NKC];
#pragma unroll
  for (int i = 0; i < NKC; ++i) {
    int c = tid + 256 * i;
    int mp = c / (64 * KCH), rem = c - mp * 64 * KCH;
    int row = rem / KCH, kc = rem - row * KCH;
    koff_g[i] = (mp * PT + row) * DQK + kc * 8;
    koff_s[i] = (mp * 64 + row) * KLD + kc * 8;
  }
  bf8 rk[NKC], rv[2];
  const int nkb = nkeys / 64;
#pragma unroll
  for (int i = 0; i < NKC; ++i) rk[i] = *(const bf8*)(Kb + koff_g[i]);
#pragma unroll
  for (int i = 0; i < 2; ++i) rv[i] = *(const bf8*)(Vb + (size_t)((tid >> 3) + 32 * i) * PT + (tid & 7) * 8);

  for (int kb = 0; kb < nkb; ++kb) {
    __syncthreads();
#pragma unroll
    for (int i = 0; i < NKC; ++i) *(bf8*)(Ks + koff_s[i]) = rk[i];
#pragma unroll
    for (int i = 0; i < 2; ++i) *(bf8*)(Vs + ((tid >> 3) + 32 * i) * 72 + (tid & 7) * 8) = rv[i];
    __syncthreads();
    if (kb + 1 < nkb) {
#pragma unroll
      for (int i = 0; i < NKC; ++i) rk[i] = *(const bf8*)(Kb + koff_g[i] + (size_t)(kb + 1) * 64 * DQK);
#pragma unroll
      for (int i = 0; i < 2; ++i) rv[i] = *(const bf8*)(Vb + (size_t)((tid >> 3) + 32 * i) * PT + (kb + 1) * 64 + (tid & 7) * 8);
    }
    f4 s[NMAP][2][2][2];
    __builtin_amdgcn_s_setprio(1);
#pragma unroll
    for (int mp = 0; mp < NMAP; ++mp)
#pragma unroll
      for (int m = 0; m < 2; ++m)
#pragma unroll
        for (int tp = 0; tp < 2; ++tp) {
          f4 s0 = negm[mp][0], s1 = negm[mp][1];
          const int krow = 32 * m + 8 * (r >> 2) + 4 * tp + (r & 3);
#pragma unroll
          for (int ks = 0; ks < NKS; ++ks) {
            bf8 kf = *(const bf8*)(Ks + (mp * 64 + krow) * KLD + ks * 32 + g * 8);
            s0 = mfma16(kf, qf[mp][0][ks], s0);
            s1 = mfma16(kf, qf[mp][1][ks], s1);
          }
          s[mp][0][m][tp] = s0; s[mp][1][m][tp] = s1;
        }
    __builtin_amdgcn_s_setprio(0);
    bf8 pf[NMAP][2][2];
#pragma unroll
    for (int mp = 0; mp < NMAP; ++mp)
#pragma unroll
      for (int qt = 0; qt < 2; ++qt) {
        float ps = 0.f;
#pragma unroll
        for (int m = 0; m < 2; ++m) {
          bf8 pk;
#pragma unroll
          for (int tp = 0; tp < 2; ++tp)
#pragma unroll
            for (int q = 0; q < 4; ++q) {
              float e = __builtin_amdgcn_exp2f(s[mp][qt][m][tp][q]);
              ps += e;
              pk[tp * 4 + q] = (__bf16)e;
            }
          pf[mp][qt][m] = pk;
        }
        const bool hi = __builtin_amdgcn_ballot_w64(!(ps < 65536.f)) != 0ull;
        const bool lo = __builtin_amdgcn_ballot_w64(ps > 0.f || lsum[mp][qt] > 0.f) == 0ull;
        if (hi || lo) {
          float bm = -INFINITY;
#pragma unroll
          for (int m = 0; m < 2; ++m)
#pragma unroll
            for (int tp = 0; tp < 2; ++tp)
#pragma unroll
              for (int q = 0; q < 4; ++q) bm = fmaxf(bm, s[mp][qt][m][tp][q]);
          bm = rows_max(bm);
          const float sh = lo ? bm : fmaxf(bm, 0.f);
          const float alpha = lo ? 1.f : __builtin_amdgcn_exp2f(-sh);
          mrun[mp][qt] += sh;
          const float nm = -mrun[mp][qt];
          negm[mp][qt] = f4{nm, nm, nm, nm};
          lsum[mp][qt] *= alpha;
#pragma unroll
          for (int d = 0; d < 4; ++d) o[mp][qt][d] *= alpha;
          ps = 0.f;
#pragma unroll
          for (int m = 0; m < 2; ++m) {
            bf8 pk;
#pragma unroll
            for (int tp = 0; tp < 2; ++tp)
#pragma unroll
              for (int q = 0; q < 4; ++q) {
                float e = __builtin_amdgcn_exp2f(s[mp][qt][m][tp][q] - sh);
                ps += e;
                pk[tp * 4 + q] = (__bf16)e;
              }
            pf[mp][qt][m] = pk;
          }
        }
        lsum[mp][qt] += ps;
      }
    __builtin_amdgcn_s_setprio(1);
#pragma unroll
    for (int d = 0; d < 4; ++d)
#pragma unroll
      for (int m = 0; m < 2; ++m) {
        bf8 vf = *(const bf8*)(Vs + (d * 16 + r) * 72 + 32 * m + 8 * g);
#pragma unroll
        for (int mp = 0; mp < NMAP; ++mp)
#pragma unroll
          for (int qt = 0; qt < 2; ++qt) o[mp][qt][d] = mfma16(vf, pf[mp][qt][m], o[mp][qt][d]);
      }
    __builtin_amdgcn_s_setprio(0);
  }
#pragma unroll
  for (int qt = 0; qt < 2; ++qt) {
    const int tok = b * PT + q0 + wave * 32 + qt * 16 + r;
    float inv[NMAP];
#pragma unroll
    for (int mp = 0; mp < NMAP; ++mp) {
      float ls = lsum[mp][qt];
      ls = rows_sum(ls);
      inv[mp] = 1.f / ls;
    }
    if constexpr (NMAP == 1) {
#pragma unroll
      for (int d = 0; d < 4; ++d)
        *(bf4*)(p.mix() + (size_t)tok * LDH + h * 64 + d * 16 + 4 * g) = pack4(o[0][qt][d] * inv[0]);
    } else {
      const float lam = p.lam()[l];
      const float li = 0.8f - 0.6f * expf(-0.3f * (float)l);
      f4 val[4];
      float ss = 0.f;
#pragma unroll
      for (int d = 0; d < 4; ++d) {
        val[d] = o[0][qt][d] * inv[0] - o[NMAP - 1][qt][d] * (lam * inv[NMAP - 1]);
        ss += val[d][0] * val[d][0] + val[d][1] * val[d][1] + val[d][2] * val[d][2] + val[d][3] * val[d][3];
      }
      ss = rows_sum(ss);
      const float rs = rsqrtf(ss * (1.f / 64.f) + EPSN) * (1.f - li);
      f4 gd[4];
#pragma unroll
      for (int d = 0; d < 4; ++d) gd[d] = *(const f4*)(p.g_diff_norm + l * 64 + d * 16 + 4 * g);
#pragma unroll
      for (int d = 0; d < 4; ++d) *(bf4*)(p.mix() + (size_t)tok * LDH + 256 + h * 64 + d * 16 + 4 * g) = pack4(val[d] * rs * gd[d]);
    }
  }
}

template <int DQK, int NMAP>
__device__ __forceinline__ void attn_dispatch(const Params& p, int l, int item, const __bf16* Q, const __bf16* K, const __bf16* Vt, char* smem) {
  int b, h, q0, nk;
  if (item < 512) { b = (item >> 2) & 1; h = item & 3; q0 = CTXL + (item >> 3) * 128; nk = PT; }
  else { int it = item - 512; b = it >> 3; h = (it >> 1) & 3; q0 = (it & 1) * 128; nk = CTXL; }
  attn_item<DQK, NMAP>(p, l, Q, K, Vt, b, h, q0, nk, smem);
}

__device__ __forceinline__ void hgrn1_item(const Params& p, int item, char* smem) {
  __bf16* kteT = (__bf16*)smem;
  __bf16* vT = kteT + 64 * 72;
  float* ptot = (float*)(vT + 64 * 72);
  const int tid = tid_(), lane = tid & 63, wave = tid >> 6, r = lane & 15, g = lane >> 4;
  const int c = item % NCH, bh = item / NCH;
  const int b = bh >> 3, h = bh & 7;
  const int tok0 = b * PT + c * 64;
  __syncthreads();
#pragma unroll
  for (int i = 0; i < 2; ++i) {
    int dv = (tid >> 3) + 32 * i;
    *(bf8*)(vT + dv * 72 + (tid & 7) * 8) = *(const bf8*)(p.hvt() + ((size_t)bh * 64 + dv) * PT + c * 64 + (tid & 7) * 8);
  }
  const int k = tid & 63, part = tid >> 6;
  float lfa[2][16];
#pragma unroll
  for (int dd = 0; dd < 2; ++dd) {
    const float* lfp = p.lf() + ((size_t)dd * NTOK + tok0 + part * 16) * 512 + h * 64 + k;
#pragma unroll
    for (int i = 0; i < 16; ++i) lfa[dd][i] = lfp[(size_t)i * 512];
  }
#pragma unroll
  for (int dir = 0; dir < 2; ++dir) {
    float lfv[16], cl[16];
#pragma unroll
    for (int i = 0; i < 16; ++i) lfv[i] = lfa[dir][i];
    float run = 0.f;
    if (dir == 0) {
#pragma unroll
      for (int i = 0; i < 16; ++i) { run += lfv[i]; cl[i] = run; }
    } else {
#pragma unroll
      for (int i = 15; i >= 0; --i) { run += lfv[i]; cl[i] = run; }
    }
    __syncthreads();
    ptot[part * 64 + k] = run;
    __syncthreads();
    float off = 0.f, total = 0.f;
#pragma unroll
    for (int q = 0; q < 4; ++q) {
      float t = ptot[q * 64 + k];
      total += t;
      if (dir == 0 ? (q < part) : (q > part)) off += t;
    }
#pragma unroll
    for (int i = 0; i < 16; ++i) {
      float cum = cl[i] + off;
      float kte = (1.f - __expf(lfv[i])) * __expf(total - cum);
      kteT[k * 72 + part * 16 + i] = (__bf16)kte;
    }
    const size_t sidx = ((size_t)bh * 2 + dir) * NCH + c;
    if (part == 0) p.dk()[sidx * 64 + k] = __expf(total);
    __syncthreads();
    f4 acc[4];
#pragma unroll
    for (int nt = 0; nt < 4; ++nt) acc[nt] = f4{0.f, 0.f, 0.f, 0.f};
#pragma unroll
    for (int ks = 0; ks < 2; ++ks) {
      bf8 af = *(const bf8*)(vT + (wave * 16 + r) * 72 + ks * 32 + g * 8);
#pragma unroll
      for (int nt = 0; nt < 4; ++nt) {
        bf8 bfr = *(const bf8*)(kteT + (nt * 16 + r) * 72 + ks * 32 + g * 8);
        acc[nt] = mfma16(af, bfr, acc[nt]);
      }
    }
    float* up = p.ut() + sidx * 4096;
#pragma unroll
    for (int nt = 0; nt < 4; ++nt)
#pragma unroll
      for (int q = 0; q < 4; ++q) up[(wave * 16 + 4 * g + q) * 64 + nt * 16 + r] = acc[nt][q];
  }
}

__device__ __forceinline__ void hgrn2_item(const Params& p, int item) {
  const int idx = item * 256 + tid_();
  const int e = idx & 4095, sd = idx >> 12;
  const int dir = sd & 1, kk = e & 63;
  const float* up = p.ut() + (size_t)sd * NCH * 4096 + e;
  const float* dp = p.dk() + (size_t)sd * NCH * 64 + kk;
  __bf16* sp = p.st() + (size_t)sd * NCH * 4096 + e;
  float S = 0.f;
  for (int jb = 0; jb < NCH; jb += 22) {
    float u[22], d[22];
    int cc[22];
#pragma unroll
    for (int q = 0; q < 22; ++q) {
      int j = jb + q;
      int c = dir == 0 ? j : (j < 4 ? 3 - j : 135 - j);
      cc[q] = c;
      u[q] = up[(size_t)c * 4096];
      d[q] = dp[c * 64];
    }
#pragma unroll
    for (int q = 0; q < 22; ++q) {
      sp[(size_t)cc[q] * 4096] = (__bf16)S;
      S = d[q] * S + u[q];
    }
  }
}

__device__ __forceinline__ void hgrn3_item(const Params& p, int l, int item, char* smem) {
  __bf16* qS = (__bf16*)smem;
  __bf16* kS = qS + 64 * 72;
  __bf16* vT = kS + 64 * 72;
  __bf16* stS = vT + 64 * 72;
  float* cumS = (float*)(stS + 64 * 72);
  float* ptot = cumS + 64 * 68;
  const int tid = tid_(), lane = tid & 63, wave = tid >> 6, r = lane & 15, g = lane >> 4;
  const int c = item % NCH, bh = item / NCH;
  const int b = bh >> 3, h = bh & 7;
  const int tok0 = b * PT + c * 64;
  __syncthreads();
#pragma unroll
  for (int i = 0; i < 2; ++i) {
    int row = (tid >> 3) + 32 * i;
    *(bf8*)(vT + row * 72 + (tid & 7) * 8) = *(const bf8*)(p.hvt() + ((size_t)bh * 64 + row) * PT + c * 64 + (tid & 7) * 8);
    *(bf8*)(qS + row * 72 + (tid & 7) * 8) = *(const bf8*)(p.hq() + (size_t)(tok0 + row) * 512 + h * 64 + (tid & 7) * 8);
  }
  f4 o[4];
#pragma unroll
  for (int d = 0; d < 4; ++d) o[d] = f4{0.f, 0.f, 0.f, 0.f};
  const int k = tid & 63, part = tid >> 6;
  const int t = 16 * wave + r;
  bf8 sta[2][2];
#pragma unroll
  for (int dd = 0; dd < 2; ++dd) {
    const __bf16* sp = p.st() + (((size_t)bh * 2 + dd) * NCH + c) * 4096;
#pragma unroll
    for (int i = 0; i < 2; ++i) sta[dd][i] = *(const bf8*)(sp + ((tid >> 3) + 32 * i) * 64 + (tid & 7) * 8);
  }
  float lfa[2][16];
#pragma unroll
  for (int dd = 0; dd < 2; ++dd) {
    const float* lfp = p.lf() + ((size_t)dd * NTOK + tok0 + part * 16) * 512 + h * 64 + k;
#pragma unroll
    for (int i = 0; i < 16; ++i) lfa[dd][i] = lfp[(size_t)i * 512];
  }
#pragma unroll
  for (int dir = 0; dir < 2; ++dir) {
    float lfv[16], cl[16];
#pragma unroll
    for (int i = 0; i < 16; ++i) lfv[i] = lfa[dir][i];
    float run = 0.f;
    if (dir == 0) {
#pragma unroll
      for (int i = 0; i < 16; ++i) { run += lfv[i]; cl[i] = run; }
    } else {
#pragma unroll
      for (int i = 15; i >= 0; --i) { run += lfv[i]; cl[i] = run; }
    }
    __syncthreads();
    ptot[part * 64 + k] = run;
#pragma unroll
    for (int i = 0; i < 16; ++i) kS[(part * 16 + i) * 72 + k] = (__bf16)((1.f - __expf(lfv[i])));
#pragma unroll
    for (int i = 0; i < 2; ++i) *(bf8*)(stS + ((tid >> 3) + 32 * i) * 72 + (tid & 7) * 8) = sta[dir][i];
    __syncthreads();
    float off = 0.f;
#pragma unroll
    for (int q = 0; q < 4; ++q) {
      float tt = ptot[q * 64 + k];
      if (dir == 0 ? (q < part) : (q > part)) off += tt;
    }
#pragma unroll
    for (int i = 0; i < 16; ++i) cumS[(part * 16 + i) * 68 + k] = cl[i] + off;
    __syncthreads();
    float cs[2][8];
    bf8 qtf[2], qhf[2];
#pragma unroll
    for (int ks = 0; ks < 2; ++ks) {
      const int dk0 = ks * 32 + 8 * g;
      bf8 qv = *(const bf8*)(qS + t * 72 + dk0);
#pragma unroll
      for (int j = 0; j < 8; ++j) {
        float cst;
        if (dir == 0) cst = wave > 0 ? cumS[(16 * wave - 1) * 68 + dk0 + j] : 0.f;
        else cst = wave < 3 ? cumS[(16 * wave + 16) * 68 + dk0 + j] : 0.f;
        cs[ks][j] = cst;
        float cv = cumS[t * 68 + dk0 + j];
        float qf_ = (float)qv[j];
        qtf[ks][j] = (__bf16)(qf_ * __expf(cv - cst));
        qhf[ks][j] = (__bf16)(qf_ * __expf(cv));
      }
    }
#pragma unroll
    for (int m = 0; m < 2; ++m) {
      const bool need = dir == 0 ? (m <= (wave >> 1)) : (m >= (wave >> 1));
      if (need) {
        bf8 pf;
#pragma unroll
        for (int tp = 0; tp < 2; ++tp) {
          const int srow = 32 * m + 8 * (r >> 2) + 4 * tp + (r & 3);
          f4 sc = f4{0.f, 0.f, 0.f, 0.f};
#pragma unroll
          for (int ks = 0; ks < 2; ++ks) {
            const int dk0 = ks * 32 + 8 * g;
            bf8 kv = *(const bf8*)(kS + srow * 72 + dk0);
            bf8 ktf;
#pragma unroll
            for (int j = 0; j < 8; ++j) {
              float ex = fminf(cs[ks][j] - cumS[srow * 68 + dk0 + j], 80.f);
              ktf[j] = (__bf16)((float)kv[j] * __expf(ex));
            }
            sc = mfma16(ktf, qtf[ks], sc);
          }
#pragma unroll
          for (int q = 0; q < 4; ++q) {
            const int s = 32 * m + 8 * g + 4 * tp + q;
            const bool keep = dir == 0 ? (s <= t) : (s >= t);
            pf[tp * 4 + q] = keep ? (__bf16)sc[q] : (__bf16)0.f;
          }
        }
#pragma unroll
        for (int d = 0; d < 4; ++d) {
          bf8 vf = *(const bf8*)(vT + (d * 16 + r) * 72 + 32 * m + 8 * g);
          o[d] = mfma16(vf, pf, o[d]);
        }
      }
    }
#pragma unroll
    for (int d = 0; d < 4; ++d)
#pragma unroll
      for (int ks = 0; ks < 2; ++ks) {
        bf8 sf = *(const bf8*)(stS + (d * 16 + r) * 72 + ks * 32 + 8 * g);
        o[d] = mfma16(sf, qhf[ks], o[d]);
      }
  }
  float ss = 0.f;
#pragma unroll
  for (int d = 0; d < 4; ++d) ss += o[d][0] * o[d][0] + o[d][1] * o[d][1] + o[d][2] * o[d][2] + o[d][3] * o[d][3];
  ss = rows_sum(ss);
  const float rs = rsqrtf(ss * (1.f / 64.f) + EPSN);
  f4 gn[4]; bf4 gate[4];
#pragma unroll
  for (int d = 0; d < 4; ++d) {
    gn[d] = *(const f4*)(p.g_hgrn_norm + l * 64 + d * 16 + 4 * g);
    gate[d] = *(const bf4*)(p.hg() + (size_t)(tok0 + t) * 512 + h * 64 + d * 16 + 4 * g);
  }
#pragma unroll
  for (int d = 0; d < 4; ++d) {
    f4 res;
#pragma unroll
    for (int q = 0; q < 4; ++q) res[q] = o[d][q] * rs * gn[d][q] * (float)gate[d][q];
    *(bf4*)(p.mix() + (size_t)(tok0 + t) * LDH + 512 + h * 64 + d * 16 + 4 * g) = pack4(res);
  }
}

#define NPHASE 38
#ifndef ONLY
#define ONLY -1
#endif
#define PHEN(x) (ONLY < 0 || ONLY == (x))
__device__ __forceinline__ void run_phase(const Params& p, int ph, char* smem) {
  const int bid = bid_(), G = gridDim.x;
  if (ph == 0) { if (PHEN(100)) phase0(p, smem); return; }
  if (ph == NPHASE - 1) {
    for (int it = bid; it < NB * SEQ / 16; it += G) final_norm_item(p, it);
    return;
  }
  const int l = (ph - 1) / 9, sp = (ph - 1) % 9;
  const int nmt = mtile_count(l);
  switch (sp) {
    case 0: if (PHEN(0)) {
      for (int i = bid * 256 + tid_(); i < (INWP - INW) * DM / 8; i += G * 256) {
        bf8 z;
#pragma unroll
        for (int j = 0; j < 8; ++j) z[j] = (__bf16)0.f;
        *(bf8*)(p.wt_in() + (size_t)(INW + (i >> 7)) * LDH + (size_t)(i & 127) * 8) = z;
      }
      for (int it = bid; it < 1056; it += G) norm_item(p, l, 0, it);
      conv_items(p, l, bid, G, smem);
    } break;
    case 1: if (PHEN(1)) {
      {
        int mt, nt, mtn = 0, ntn = 0;
        bool have = gemm_pick(0, bid, G, 132, 30, 10, mt, nt), pre = false;
        for (int st = 0; have; ++st) {
          const bool hn = gemm_pick(st + 1, bid, G, 132, 30, 10, mtn, ntn);
          gemm_tile<EPI_IN, false>(p, l, p.hb(), LDH, p.wt_in(), LDH, DM, mt * 128, nt * 128, smem, pre, hn, mtn * 128, ntn * 128);
          pre = hn; have = hn; mt = mtn; nt = ntn;
        }
      }
    } break;
    case 2: if (PHEN(2)) {
      const int natt = l < 3 ? 528 : 512;
      const int total = natt + 396 + 528 + 2112, K = (total + G - 1) / G;
      const bool flip = (bid >> 3) & 1;
      for (int kk = 0; kk < K; ++kk) {
        const int k = flip ? (kk + 1 == K ? 0 : kk + 1) : kk;
        const int it0 = bid + k * G;
        if (it0 >= total) continue;
        if (it0 < natt) { attn_dispatch<32, 2>(p, l, it0, p.qd(), p.kd(), p.vdt(), smem); continue; }
        const int it = it0 - natt;
        if (it < 396) gemm_tile<EPI_UQ, true>(p, l, p.cq(), 256, p.wt_uq(), 256, 256, (it / 3) * 128, (it % 3) * 128, smem);
        else if (it < 924) { int j = it - 396; gemm_tile<EPI_UKV, true>(p, l, p.ckv(), 128, p.wt_ukv(), 128, 128, (j / 4) * 128, (j % 4) * 128, smem); }
        else hgrn1_item(p, it - 924, smem);
      }
    } break;
    case 3: if (PHEN(3)) {
      const int natt = l < 3 ? 528 : 512;
      const int total = 512 + natt, K = (total + G - 1) / G;
      const bool flip = (bid >> 3) & 1;
      for (int kk = 0; kk < K; ++kk) {
        const int k = flip ? (kk + 1 == K ? 0 : kk + 1) : kk;
        const int it = bid + k * G;
        if (it >= total) continue;
        if (it < 512) hgrn2_item(p, it);
        else attn_dispatch<96, 1>(p, l, it - 512, p.qm(), p.km(), p.vmt(), smem);
      }
    } break;
    case 4: if (PHEN(4)) {
      for (int j = bid; j < 2112; j += G) {
        if (l == 3 && (j % NCH) < 4) continue;
        hgrn3_item(p, l, j, smem);
      }
    } break;
    case 5: if (PHEN(5)) {
      {
        int mt, nt, mtn = 0, ntn = 0;
        bool have = gemm_pick(0, bid, G, 128, 8, 8, mt, nt), pre = false;
        for (int st = 0; have; ++st) {
          const bool hn = gemm_pick(st + 1, bid, G, 128, 8, 8, mtn, ntn);
          gemm_tile<EPI_OUT, false>(p, l, p.mix(), LDH, p.wt_out(), LDH, DM, mtile_index(3, mt) * 128, nt * 128, smem, pre, hn,
                                    mtile_index(3, mtn) * 128, ntn * 128);
          pre = hn; have = hn; mt = mtn; nt = ntn;
        }
      }
      if (l < 3) {
        for (int u = bid; u < 32 * 8; u += G) {
          const int tile = u >> 3, sp = u & 7;
          const int cm = tile >> 3, nt = tile & 7;
          const int mt = (cm >> 1) * 66 + (cm & 1);
          gemm_tile<EPI_OUT_AT, false>(p, l, p.mix() + sp * 128, LDH, p.wt_out() + sp * 128, LDH, 128, mt * 128, nt * 128, smem);
        }
      }
    } break;
    case 6: if (PHEN(6)) {
      for (int it = bid; it < 1056; it += G) norm_item(p, l, 1, it);
    } break;
    case 7: if (PHEN(7)) {
      {
        int mt, nt, mtn = 0, ntn = 0;
        bool have = gemm_pick(0, bid, G, nmt, 44, 11, mt, nt), pre = false;
        for (int st = 0; have; ++st) {
          const bool hn = gemm_pick(st + 1, bid, G, nmt, 44, 11, mtn, ntn);
          gemm_tile<EPI_UP, false>(p, l, p.hb(), LDH, p.wt_gu(), LDH, DM, mtile_index(l, mt) * 128, nt * 128, smem, pre, hn,
                                   mtile_index(l, mtn) * 128, ntn * 128);
          pre = hn; have = hn; mt = mtn; nt = ntn;
        }
      }
    } break;
    case 8: if (PHEN(8)) {
      {
        int mt, nt, mtn = 0, ntn = 0;
        bool have = gemm_pick(0, bid, G, 128, 8, 8, mt, nt), pre = false;
        for (int st = 0; have; ++st) {
          const bool hn = gemm_pick(st + 1, bid, G, 128, 8, 8, mtn, ntn);
          gemm_tile<EPI_DOWN, false>(p, l, p.act(), LDF, p.wt_down(), LDF, DFF, mtile_index(3, mt) * 128, nt * 128, smem, pre, hn,
                                     mtile_index(3, mtn) * 128, ntn * 128);
          pre = hn; have = hn; mt = mtn; nt = ntn;
        }
      }
      if (l < 3) {
        for (int u = bid; u < 32 * 11; u += G) {
          const int tile = u / 11, sp = u - tile * 11;
          const int cm = tile >> 3, nt = tile & 7;
          const int mt = (cm >> 1) * 66 + (cm & 1);
          gemm_tile<EPI_DOWN_AT, false>(p, l, p.act() + sp * 256, LDF, p.wt_down() + sp * 256, LDF, 256, mt * 128, nt * 128, smem);
        }
      }
    } break;
  }
}

#define XB_TMO      128
#define XB_XCNT(j)  (256  + 64 * (j))
#define XB_XSUB(j)  (1280 + 64 * (j))
#define XB_XGEN(j)  (2304 + 64 * (j))
#define XB_TOP      3328
#define XB_TOPGEN   3392
#define XCD_BAR_WORDS 3456
#define XB_SPIN_CAP (1u << 22)
#define LAS __attribute__((address_space(3)))

__device__ __forceinline__ unsigned xb_ld(unsigned* p)              { return __hip_atomic_load(p, __ATOMIC_RELAXED, __HIP_MEMORY_SCOPE_AGENT); }
__device__ __forceinline__ unsigned xb_add(unsigned* p, unsigned v) { return __hip_atomic_fetch_add(p, v, __ATOMIC_RELAXED, __HIP_MEMORY_SCOPE_AGENT); }
__device__ __forceinline__ unsigned xb_xcc_id() { return (unsigned)__builtin_amdgcn_s_getreg((3 << 11) | 20) & 0xFu; }
#define XB_SPIN(cond, bar) do { unsigned _sp = 0; while (cond) { __builtin_amdgcn_s_sleep(1); \
    if ((++_sp & 255u) == 0u) { if (xb_ld(&(bar)[XB_TMO])) break; if (_sp > XB_SPIN_CAP) { atomicAdd(&(bar)[XB_TMO], 1u); break; } } } } while (0)

struct XcdBarrier {
    unsigned* bar; unsigned x;
    volatile LAS unsigned* st;
};

__device__ __forceinline__ XcdBarrier xcd_barrier_post(unsigned* bar, volatile LAS unsigned* st) {
    XcdBarrier b; b.bar = bar; b.x = xb_xcc_id(); b.st = st;
    if (threadIdx.x == 0) (void)xb_add(&bar[XB_XCNT(b.x)], 1u);
    return b;
}
__device__ __forceinline__ void xcd_barrier_complete(unsigned* bar, unsigned x, unsigned& nloc, unsigned& nx) {
    const unsigned G = gridDim.x * gridDim.y * gridDim.z;
    unsigned sum, cnt, mine, sp = 0u;
    for (;;) {
        sum = 0u; cnt = 0u; mine = 0u;
#pragma unroll
        for (unsigned j = 0; j < 16; ++j) { const unsigned c = xb_ld(&bar[XB_XCNT(j)]); sum += c; cnt += (c > 0u) ? 1u : 0u; mine = (j == x) ? c : mine; }
        if (sum == G) break;
        __builtin_amdgcn_s_sleep(1);
        if ((++sp & 255u) == 0u) { if (xb_ld(&bar[XB_TMO])) break; if (sp > XB_SPIN_CAP) { atomicAdd(&bar[XB_TMO], 1u); break; } }
    }
    nloc = mine > 0u ? mine : 1u; nx = cnt > 0u ? cnt : 1u;
}

__device__ __forceinline__ void xcd_barrier(const XcdBarrier& b) {
    asm volatile("s_waitcnt vmcnt(0)" ::: "memory");
    __syncthreads();
    if (threadIdx.x == 0) {
        unsigned* bar = b.bar;
        __builtin_amdgcn_s_waitcnt(0);
        unsigned nloc = b.st[0], nx = b.st[1];
        if (nloc == 0u) { xcd_barrier_complete(bar, b.x, nloc, nx); b.st[0] = nloc; b.st[1] = nx; }
        const unsigned old = xb_add(&bar[XB_XSUB(b.x)], 1u);
        const unsigned gen = old / nloc;
        if (old + 1u == (gen + 1u) * nloc) {
            __builtin_amdgcn_fence(__ATOMIC_RELEASE, "agent");
            asm volatile("s_waitcnt vmcnt(0)" ::: "memory");
            const unsigned og = xb_add(&bar[XB_TOP], 1u);
            const unsigned tg = og / nx;
            if (og + 1u == (tg + 1u) * nx) xb_add(&bar[XB_TOPGEN], 1u);
            else XB_SPIN(xb_ld(&bar[XB_TOPGEN]) == tg, bar);
            __builtin_amdgcn_fence(__ATOMIC_ACQUIRE, "agent");
            xb_add(&bar[XB_XGEN(b.x)], 1u);
            asm volatile("s_waitcnt vmcnt(0)" ::: "memory");
        } else {
            XB_SPIN(xb_ld(&bar[XB_XGEN(b.x)]) == gen, bar);
            __builtin_amdgcn_fence(__ATOMIC_ACQUIRE, "agent");
            asm volatile("s_waitcnt vmcnt(0)" ::: "memory");
        }
    }
    __syncthreads();
}


__device__ __forceinline__ void grid_barrier(unsigned* cnt, unsigned target) {
  asm volatile("s_waitcnt vmcnt(0)" ::: "memory");
  __syncthreads();
  if (tid_() == 0) {
    __builtin_amdgcn_fence(__ATOMIC_RELEASE, "agent");
    asm volatile("s_waitcnt vmcnt(0)" ::: "memory");
    __hip_atomic_fetch_add(cnt, 1u, __ATOMIC_RELAXED, __HIP_MEMORY_SCOPE_AGENT);
    unsigned spins = 0;
    while (__hip_atomic_load(cnt, __ATOMIC_RELAXED, __HIP_MEMORY_SCOPE_AGENT) < target) {
      __builtin_amdgcn_s_sleep(2);
      if (++spins > (1u << 24)) break;
    }
    __builtin_amdgcn_fence(__ATOMIC_ACQUIRE, "agent");
    asm volatile("s_waitcnt vmcnt(0)" ::: "memory");
  }
  __syncthreads();
}

__global__ void __launch_bounds__(256, 2) hybrid_megakernel(Params p, int ph0, int ph1) {
  __shared__ __attribute__((aligned(16))) char smem[SMEM_BYTES];
  cg::grid_group grid = cg::this_grid();
  volatile LAS unsigned* xst = (volatile LAS unsigned*)(smem + 66048);
  if (__builtin_amdgcn_workitem_id_x() == 0) { xst[0] = 0u; xst[1] = 0u; }
  __syncthreads();
  XcdBarrier xb; xb.bar = nullptr; xb.x = 0; xb.st = xst;
  for (int ph = ph0; ph < ph1; ++ph) {
    Params q = p;
    size_t zoff = 0;
    asm volatile("" : "+s"(zoff));
    q.ws = p.ws + zoff; q.out = p.out + zoff;
    run_phase(q, ph, smem);
#ifdef REPMASK
    if (ph > 0 && ph < NPHASE - 1 && ((REPMASK >> ((ph - 1) % 9)) & 1)) { grid.sync(); run_phase(q, ph, smem); }
#endif
    if (ph + 1 < ph1) {
      if (ph == ph0) { grid.sync(); xb = xcd_barrier_post((unsigned*)(p.ws + OFF_xbar), xst); }
      else xcd_barrier(xb);
    }
  }
}

extern "C" void kernel_launch(void* const* d_in, const int* in_sizes, int n_in, void* d_out, int out_size, void* d_ws,
                              size_t ws_size, hipStream_t stream) {
  static int grid_blocks = 0;
  if (!grid_blocks) {
    int dev = 0, cus = 0, per_cu = 0;
    hipGetDevice(&dev);
    hipDeviceGetAttribute(&cus, hipDeviceAttributeMultiprocessorCount, dev);
    hipOccupancyMaxActiveBlocksPerMultiprocessor(&per_cu, hybrid_megakernel, 256, 0);
    if (per_cu > 2) per_cu = 2;
    if (per_cu < 1) per_cu = 1;
    grid_blocks = cus * per_cu;
  }
  Params p{};
  const float* const* in = (const float* const*)d_in;
  p.x = in[0]; p.c = in[1]; p.ctx = in[2]; p.c_ctx = in[3]; p.w_ada = in[4]; p.b_ada = in[5]; p.g_norm1 = in[6];
  p.g_norm2 = in[7]; p.w_in = in[8]; p.g_q_norm = in[9]; p.w_uq = in[10]; p.g_kv_norm = in[11]; p.w_ukv = in[12];
  p.diff_lambda = in[13]; p.g_diff_norm = in[14]; p.hgrn_lb = in[15]; p.g_hgrn_norm = in[16]; p.w_out = in[17];
  p.w_gate = in[18]; p.w_up = in[19]; p.w_down = in[20]; p.g_final = in[21];
  p.out = (float*)d_out;
  p.ws = (char*)d_ws;
  if (WS_TOTAL > ws_size) { fprintf(stderr, "workspace too small: need %zu have %zu\n", (size_t)WS_TOTAL, ws_size); return; }
  int ph0 = 0, ph1 = NPHASE;
  void* args[] = {&p, &ph0, &ph1};
  hipError_t e = hipLaunchCooperativeKernel((void*)hybrid_megakernel, dim3(grid_blocks), dim3(256), args, 0, stream);
  if (e != hipSuccess) fprintf(stderr, "cooperative launch failed: %s (grid %d)\n", hipGetErrorString(e), grid_blocks);
}
```

```cpp
#include <hip/hip_runtime.h>
#include <hip/hip_cooperative_groups.h>
#include <cstdio>
namespace cg = cooperative_groups;

typedef __attribute__((ext_vector_type(8))) __bf16 bf8;
typedef __attribute__((ext_vector_type(4))) __bf16 bf4;
typedef __attribute__((ext_vector_type(4))) float f4;

#define XCD_BAR_WORDS_C 3456
#define NB 2
#define SEQ 8192
#define CTXL 256
#define PT 8448
#define NTOK 16896
#define DM 1024
#define INW 3744
#define INWP 3840
#define DFF 2816
#define NCH 132
#define LDH 1088
#define LDF 2880
#define LOG2E 1.4426950408889634f
#define EPSN 1e-6f
#define SMEM_BYTES 66064

constexpr size_t al256(size_t x) { return (x + 255) & ~(size_t)255; }
constexpr size_t OFF_xc = 0;
constexpr size_t OFF_mod = OFF_xc + al256((size_t)NB*CTXL*DM*4);
constexpr size_t OFF_rope = OFF_mod + al256((size_t)4*3*6144*4);
constexpr size_t OFF_llb = OFF_rope + al256(128*8*2*4);
constexpr size_t OFF_l1mlb = OFF_llb + al256(4*1024*4);
constexpr size_t OFF_lam = OFF_l1mlb + al256(4*1024*4);
constexpr size_t OFF_wt_in = OFF_lam + al256(256);
constexpr size_t OFF_wt_uq = OFF_wt_in + al256((size_t)INWP*LDH*2);
constexpr size_t OFF_wt_ukv = OFF_wt_uq + al256((size_t)384*256*2);
constexpr size_t OFF_wt_out = OFF_wt_ukv + al256((size_t)512*128*2);
constexpr size_t OFF_wt_gu = OFF_wt_out + al256((size_t)DM*LDH*2);
constexpr size_t OFF_wt_down = OFF_wt_gu + al256((size_t)2*DFF*LDH*2);
constexpr size_t OFF_hb = OFF_wt_down + al256((size_t)DM*LDF*2);
constexpr size_t OFF_cq = OFF_hb + al256((size_t)NTOK*LDH*2);
constexpr size_t OFF_ckv = OFF_cq + al256((size_t)NTOK*256*2);
constexpr size_t OFF_qm = OFF_ckv + al256((size_t)NTOK*128*2);
constexpr size_t OFF_km = OFF_qm + al256((size_t)NB*4*PT*96*2);
constexpr size_t OFF_vmt = OFF_km + al256((size_t)NB*4*PT*96*2);
constexpr size_t OFF_qd = OFF_vmt + al256((size_t)NB*4*64*PT*2);
constexpr size_t OFF_kd = OFF_qd + al256((size_t)NB*4*2*PT*32*2);
constexpr size_t OFF_vdt = OFF_kd + al256((size_t)NB*4*2*PT*32*2);
constexpr size_t OFF_hq = OFF_vdt + al256((size_t)NB*4*64*PT*2);
constexpr size_t OFF_hvt = OFF_hq + al256((size_t)NTOK*512*2);
constexpr size_t OFF_hg = OFF_hvt + al256((size_t)NB*8*64*PT*2);
constexpr size_t OFF_dk = OFF_hg + al256((size_t)NTOK*512*2);
constexpr size_t OFF_st = OFF_dk + al256((size_t)NB*8*2*NCH*64*4);
constexpr size_t OFF_lf = OFF_st + al256((size_t)NB*8*2*NCH*4096*2);
constexpr size_t OFF_ut = OFF_lf + al256((size_t)2*NTOK*512*4);
constexpr size_t OFF_xbar = OFF_ut + al256((size_t)NB*8*2*NCH*4096*4);
constexpr size_t WS_TOTAL_OLD = OFF_ut + al256((size_t)NB*8*2*NCH*4096*4);
constexpr size_t WS_TOTAL = OFF_xbar + al256((size_t)XCD_BAR_WORDS_C*4);
struct Params {
  const float *x, *c, *ctx, *c_ctx, *w_ada, *b_ada, *g_norm1, *g_norm2, *w_in, *g_q_norm, *w_uq, *g_kv_norm, *w_ukv,
      *diff_lambda, *g_diff_norm, *hgrn_lb, *g_hgrn_norm, *w_out, *w_gate, *w_up, *w_down, *g_final;
  float* out;
  char* ws;
  __device__ __forceinline__ float* xc() const { return (float*)(ws + OFF_xc); }
  __device__ __forceinline__ float* mod() const { return (float*)(ws + OFF_mod); }
  __device__ __forceinline__ float* rope() const { return (float*)(ws + OFF_rope); }
  __device__ __forceinline__ float* llb() const { return (float*)(ws + OFF_llb); }
  __device__ __forceinline__ float* l1mlb() const { return (float*)(ws + OFF_l1mlb); }
  __device__ __forceinline__ float* lam() const { return (float*)(ws + OFF_lam); }
  __device__ __forceinline__ __bf16* wt_in() const { return (__bf16*)(ws + OFF_wt_in); }
  __device__ __forceinline__ __bf16* wt_uq() const { return (__bf16*)(ws + OFF_wt_uq); }
  __device__ __forceinline__ __bf16* wt_ukv() const { return (__bf16*)(ws + OFF_wt_ukv); }
  __device__ __forceinline__ __bf16* wt_out() const { return (__bf16*)(ws + OFF_wt_out); }
  __device__ __forceinline__ __bf16* wt_gu() const { return (__bf16*)(ws + OFF_wt_gu); }
  __device__ __forceinline__ __bf16* wt_down() const { return (__bf16*)(ws + OFF_wt_down); }
  __device__ __forceinline__ __bf16* hb() const { return (__bf16*)(ws + OFF_hb); }
  __device__ __forceinline__ __bf16* cq() const { return (__bf16*)(ws + OFF_cq); }
  __device__ __forceinline__ __bf16* ckv() const { return (__bf16*)(ws + OFF_ckv); }
  __device__ __forceinline__ __bf16* qm() const { return (__bf16*)(ws + OFF_qm); }
  __device__ __forceinline__ __bf16* km() const { return (__bf16*)(ws + OFF_km); }
  __device__ __forceinline__ __bf16* vmt() const { return (__bf16*)(ws + OFF_vmt); }
  __device__ __forceinline__ __bf16* qd() const { return (__bf16*)(ws + OFF_qd); }
  __device__ __forceinline__ __bf16* kd() const { return (__bf16*)(ws + OFF_kd); }
  __device__ __forceinline__ __bf16* vdt() const { return (__bf16*)(ws + OFF_vdt); }
  __device__ __forceinline__ __bf16* hq() const { return (__bf16*)(ws + OFF_hq); }
  __device__ __forceinline__ __bf16* hvt() const { return (__bf16*)(ws + OFF_hvt); }
  __device__ __forceinline__ __bf16* hg() const { return (__bf16*)(ws + OFF_hg); }
  __device__ __forceinline__ float* dk() const { return (float*)(ws + OFF_dk); }
  __device__ __forceinline__ __bf16* st() const { return (__bf16*)(ws + OFF_st); }
  __device__ __forceinline__ float* lf() const { return (float*)(ws + OFF_lf); }
  __device__ __forceinline__ float* ut() const { return (float*)(ws + OFF_ut); }
  __device__ __forceinline__ __bf16* mix() const { return hb(); }
  __device__ __forceinline__ __bf16* act() const { return (__bf16*)lf(); }
};

__device__ __forceinline__ int tid_() { int t = __builtin_amdgcn_workitem_id_x(); asm volatile("" : "+v"(t)); return t; }
__device__ __forceinline__ int bid_() { int t = __builtin_amdgcn_workgroup_id_x(); asm volatile("" : "+s"(t)); return t; }
__device__ __forceinline__ float silu_f(float x) { return x * __builtin_amdgcn_rcpf(1.f + __expf(-x)); }
__device__ __forceinline__ float wave_sum(float v) {
  v += __uint_as_float(__builtin_amdgcn_update_dpp(0u, __float_as_uint(v), 0x128, 0xf, 0xf, false));
  v += __uint_as_float(__builtin_amdgcn_update_dpp(0u, __float_as_uint(v), 0x124, 0xf, 0xf, false));
  v += __uint_as_float(__builtin_amdgcn_update_dpp(0u, __float_as_uint(v), 0x122, 0xf, 0xf, false));
  v += __uint_as_float(__builtin_amdgcn_update_dpp(0u, __float_as_uint(v), 0x121, 0xf, 0xf, false));
  unsigned u = __float_as_uint(v);
  auto a = __builtin_amdgcn_permlane16_swap(u, u, false, false);
  float m = __uint_as_float(a[0]) + __uint_as_float(a[1]);
  unsigned w = __float_as_uint(m);
  auto b = __builtin_amdgcn_permlane32_swap(w, w, false, false);
  return __uint_as_float(b[0]) + __uint_as_float(b[1]);
}
__device__ __forceinline__ float* xrow(const Params& p, int tok) {
  int b = tok / PT, pp = tok - b * PT;
  return pp < CTXL ? p.xc() + (size_t)(b * CTXL + pp) * DM : p.out + (size_t)(b * SEQ + pp - CTXL) * DM;
}
__device__ __forceinline__ float log_forget(float z, float lb, float oml) {
  const float sg = __builtin_amdgcn_rcpf(1.f + __expf(-fmaxf(z, -80.f)));
  return __logf(lb + oml * sg);
}
__device__ __forceinline__ float rows_max(float x) {
  unsigned u = __float_as_uint(x);
  auto a = __builtin_amdgcn_permlane16_swap(u, u, false, false);
  float m = fmaxf(__uint_as_float(a[0]), __uint_as_float(a[1]));
  unsigned v = __float_as_uint(m);
  auto b = __builtin_amdgcn_permlane32_swap(v, v, false, false);
  return fmaxf(__uint_as_float(b[0]), __uint_as_float(b[1]));
}
__device__ __forceinline__ float rows_sum(float x) {
  unsigned u = __float_as_uint(x);
  auto a = __builtin_amdgcn_permlane16_swap(u, u, false, false);
  float m = __uint_as_float(a[0]) + __uint_as_float(a[1]);
  unsigned v = __float_as_uint(m);
  auto b = __builtin_amdgcn_permlane32_swap(v, v, false, false);
  return __uint_as_float(b[0]) + __uint_as_float(b[1]);
}
__device__ __forceinline__ f4 mfma16(bf8 a, bf8 b, f4 c) { return __builtin_amdgcn_mfma_f32_16x16x32_bf16(a, b, c, 0, 0, 0); }

__device__ __forceinline__ void phase0(const Params& p, char* smem) {
  const int tid = tid_();
  const int gsz = gridDim.x * 256, gtid = bid_() * 256 + tid;
  {
    const float4* xs = (const float4*)p.x; float4* xo = (float4*)p.out;
    for (int i = gtid; i < NB * SEQ * DM / 4; i += gsz) xo[i] = xs[i];
    const float4* cs = (const float4*)p.ctx; float4* co = (float4*)p.xc();
    for (int i = gtid; i < NB * CTXL * DM / 4; i += gsz) co[i] = cs[i];
  }
  if (gtid < 1024) {
    int pos = gtid >> 3, f = gtid & 7;
    float freq = powf(10000.f, -(float)f / 8.f);
    float ang = (float)pos * freq, s, c;
    sincosf(ang, &s, &c);
    p.rope()[gtid * 2] = c; p.rope()[gtid * 2 + 1] = s;
  } else if (gtid < 2048) {
    int n = gtid - 1024;
    float r0 = p.hgrn_lb[n], r1 = p.hgrn_lb[1024 + n], r2 = p.hgrn_lb[2048 + n], r3 = p.hgrn_lb[3072 + n];
    float m = fmaxf(fmaxf(r0, r1), fmaxf(r2, r3));
    float e0 = expf(r0 - m), e1 = expf(r1 - m), e2 = expf(r2 - m), e3 = expf(r3 - m);
    float s = e0 + e1 + e2 + e3;
    float p0 = e0 / s, p1 = e1 / s, p2 = e2 / s, p3 = e3 / s;
    float c0 = p0, c1 = c0 + p1, c2 = c1 + p2, c3 = c2 + p3;
    p.llb()[n] = 0.f; p.l1mlb()[n] = 1.f;
    p.llb()[1024 + n] = c1 - c0; p.l1mlb()[1024 + n] = 1.f - (c1 - c0);
    p.llb()[2048 + n] = c2 - c0; p.l1mlb()[2048 + n] = 1.f - (c2 - c0);
    p.llb()[3072 + n] = c3 - c0; p.l1mlb()[3072 + n] = 1.f - (c3 - c0);
  } else if (gtid >= 4096 && gtid < 4096 + XCD_BAR_WORDS_C) {
    ((unsigned*)(p.ws + OFF_xbar))[gtid - 4096] = 0u;
  } else if (gtid == 2052) {
    *(unsigned*)(p.ws + OFF_lam + 128) = 0u;
  } else if (gtid < 2052) {
    int l = gtid - 2048;
    const float* d = p.diff_lambda + l * 128;
    float s1 = 0.f, s2 = 0.f;
    for (int i = 0; i < 32; ++i) { s1 += d[i] * d[32 + i]; s2 += d[64 + i] * d[96 + i]; }
    float li = 0.8f - 0.6f * expf(-0.3f * (float)l);
    p.lam()[l] = expf(s1) - expf(s2) + li;
  }
  float* sl = (float*)smem;
  float* red = sl + 3072;
  bool have = false;
  for (int item = bid_(); item < 768; item += gridDim.x) {
    if (!have) {
      for (int i = tid; i < 1024; i += 256) {
        sl[i] = silu_f(p.c[i]); sl[1024 + i] = silu_f(p.c[1024 + i]); sl[2048 + i] = silu_f(p.c_ctx[i]);
      }
      have = true;
      __syncthreads();
    }
    int l = item / 192, n0 = (item % 192) * 32;
    int col = tid & 31, kg = tid >> 5;
    const float* W = p.w_ada + (size_t)l * DM * 6144 + n0 + col;
    float a0 = 0.f, a1 = 0.f, a2 = 0.f;
#pragma unroll 8
    for (int k = kg * 128; k < kg * 128 + 128; ++k) {
      float w = W[(size_t)k * 6144];
      a0 += sl[k] * w; a1 += sl[1024 + k] * w; a2 += sl[2048 + k] * w;
    }
    red[(kg * 3 + 0) * 32 + col] = a0; red[(kg * 3 + 1) * 32 + col] = a1; red[(kg * 3 + 2) * 32 + col] = a2;
    __syncthreads();
    if (tid < 96) {
      int v = tid >> 5, cc = tid & 31;
      float s = p.b_ada[l * 6144 + n0 + cc];
#pragma unroll
      for (int q = 0; q < 8; ++q) s += red[(q * 3 + v) * 32 + cc];
      p.mod()[(size_t)(l * 3 + v) * 6144 + n0 + cc] = s;
    }
    __syncthreads();
  }
}

struct ConvD { const float* srcp; size_t sstride; __bf16* dstp; const float* ksp; };

__device__ __forceinline__ ConvD conv_decode(const Params& p, int l, int it, int tid) {
  const float* src; int N, ntn, mode = 0, dld; __bf16* dst; const float* ks = nullptr;
  if (it < 1872) { src = p.w_in + (size_t)l * DM * INW; N = INW; ntn = 117; dst = p.wt_in(); dld = LDH; }
  else if (it < 1920) { it -= 1872; src = p.w_uq + (size_t)l * 256 * 384; N = 384; ntn = 12; dst = p.wt_uq(); dld = 256; ks = p.g_q_norm + l * 256; }
  else if (it < 1952) { it -= 1920; src = p.w_ukv + (size_t)l * 128 * 512; N = 512; ntn = 16; dst = p.wt_ukv(); dld = 128; ks = p.g_kv_norm + l * 128; }
  else if (it < 2464) { it -= 1952; src = p.w_out + (size_t)l * DM * DM; N = DM; ntn = 32; dst = p.wt_out(); dld = LDH; }
  else if (it < 3872) { it -= 2464; src = p.w_gate + (size_t)l * DM * DFF; N = DFF; ntn = 88; dst = p.wt_gu(); mode = 1; dld = LDH; }
  else if (it < 5280) { it -= 3872; src = p.w_up + (size_t)l * DM * DFF; N = DFF; ntn = 88; dst = p.wt_gu(); mode = 2; dld = LDH; }
  else { it -= 5280; src = p.w_down + (size_t)l * DFF * DM; N = DM; ntn = 32; dst = p.wt_down(); dld = LDF; }
  const int kt = it / ntn, nt = it - kt * ntn;
  ConvD d;
  d.srcp = src + (size_t)(kt * 64 + (tid >> 3)) * N + nt * 32 + (tid & 7) * 4;
  d.sstride = (size_t)32 * N;
  const int n = nt * 32 + (tid >> 3);
  int row = n;
  if (mode == 1) row = (n >> 4) * 32 + (n & 15);
  else if (mode == 2) row = (n >> 4) * 32 + 16 + (n & 15);
  d.dstp = dst + (size_t)row * dld + kt * 64 + (tid & 7) * 8;
  d.ksp = ks ? ks + kt * 64 + (tid & 7) * 8 : nullptr;
  return d;
}

__device__ __forceinline__ void conv_items(const Params& p, int l, int first, int step, char* smem) {
  float* tile = (float*)smem;
  const int tid = tid_();
  if (first >= 6688) return;
  ConvD cur = conv_decode(p, l, first, tid);
  float4 v0 = *(const float4*)(cur.srcp), v1 = *(const float4*)(cur.srcp + cur.sstride);
  for (int it = first; it < 6688; it += step) {
    const int itn = it + step < 6688 ? it + step : it;
    const ConvD nxt = conv_decode(p, l, itn, tid);
    const float4 n0 = *(const float4*)(nxt.srcp), n1 = *(const float4*)(nxt.srcp + nxt.sstride);
    __syncthreads();
    {
      const int r = tid >> 3, c4 = tid & 7;
      float* t = tile + r * 33 + c4 * 4;
      t[0] = v0.x; t[1] = v0.y; t[2] = v0.z; t[3] = v0.w;
      t += 32 * 33;
      t[0] = v1.x; t[1] = v1.y; t[2] = v1.z; t[3] = v1.w;
    }
    __syncthreads();
    {
      const int nr = tid >> 3, kc = tid & 7;
      bf8 o;
#pragma unroll
      for (int j = 0; j < 8; ++j) {
        float v = tile[(kc * 8 + j) * 33 + nr];
        if (cur.ksp) v *= cur.ksp[j];
        o[j] = (__bf16)v;
      }
      *(bf8*)cur.dstp = o;
    }
    cur = nxt; v0 = n0; v1 = n1;
  }
}

__device__ __forceinline__ void norm_item(const Params& p, int l, int which, int item) {
  const int lane = tid_() & 63, wave = tid_() >> 6;
  const int tok0 = item * 16 + wave * 4;
  const int b = tok0 / PT, pp = tok0 - b * PT;
  const int v = pp < CTXL ? 2 : b;
  const float* g = (which ? p.g_norm2 : p.g_norm1) + l * DM;
  const float* md = p.mod() + (size_t)(l * 3 + v) * 6144 + (which ? 3072 : 0);
  f4 a[4], sh[4];
#pragma unroll
  for (int i = 0; i < 4; ++i) {
    int k = i * 256 + lane * 4;
    f4 gg = *(const f4*)(g + k), sc = *(const f4*)(md + 1024 + k);
    sh[i] = *(const f4*)(md + k);
    a[i] = gg * (1.f + sc);
  }
  f4 xv[4][4];
#pragma unroll
  for (int r = 0; r < 4; ++r) {
    const float* xr = xrow(p, tok0 + r);
#pragma unroll
    for (int i = 0; i < 4; ++i) xv[r][i] = *(const f4*)(xr + i * 256 + lane * 4);
  }
#pragma unroll
  for (int r = 0; r < 4; ++r) {
    float ss = 0.f;
#pragma unroll
    for (int i = 0; i < 4; ++i)
      ss += xv[r][i][0] * xv[r][i][0] + xv[r][i][1] * xv[r][i][1] + xv[r][i][2] * xv[r][i][2] + xv[r][i][3] * xv[r][i][3];
    ss = wave_sum(ss);
    float rstd = rsqrtf(ss * (1.f / DM) + EPSN);
#pragma unroll
    for (int i = 0; i < 4; ++i) {
      f4 h = xv[r][i] * rstd * a[i] + sh[i];
      bf4 o; o[0] = (__bf16)h[0]; o[1] = (__bf16)h[1]; o[2] = (__bf16)h[2]; o[3] = (__bf16)h[3];
      *(bf4*)(p.hb() + (size_t)(tok0 + r) * LDH + i * 256 + lane * 4) = o;
    }
  }
}

__device__ __forceinline__ void final_norm_item(const Params& p, int item) {
  const int lane = tid_() & 63, wave = tid_() >> 6;
  const int row0 = item * 16 + wave * 4;
  f4 g[4];
#pragma unroll
  for (int i = 0; i < 4; ++i) g[i] = *(const f4*)(p.g_final + i * 256 + lane * 4);
  f4 xv[4][4];
#pragma unroll
  for (int r = 0; r < 4; ++r)
#pragma unroll
    for (int i = 0; i < 4; ++i) xv[r][i] = *(const f4*)(p.out + (size_t)(row0 + r) * DM + i * 256 + lane * 4);
#pragma unroll
  for (int r = 0; r < 4; ++r) {
    float ss = 0.f;
#pragma unroll
    for (int i = 0; i < 4; ++i)
      ss += xv[r][i][0] * xv[r][i][0] + xv[r][i][1] * xv[r][i][1] + xv[r][i][2] * xv[r][i][2] + xv[r][i][3] * xv[r][i][3];
    ss = wave_sum(ss);
    float rstd = rsqrtf(ss * (1.f / DM) + EPSN);
#pragma unroll
    for (int i = 0; i < 4; ++i) *(f4*)(p.out + (size_t)(row0 + r) * DM + i * 256 + lane * 4) = xv[r][i] * rstd * g[i];
  }
}

#define GLD 72
enum { EPI_IN = 0, EPI_UQ, EPI_UKV, EPI_OUT, EPI_UP, EPI_DOWN, EPI_OUT_AT, EPI_DOWN_AT };

__device__ __forceinline__ f4 rope4(const Params& p, f4 a, int prow, int axis, int r) {
  f4 o;
#pragma unroll
  for (int reg = 0; reg < 4; ++reg) {
    float pv = __uint_as_float(__builtin_amdgcn_update_dpp(0u, __float_as_uint(a[reg]), 0x128, 0xf, 0xf, false));
    int t = prow + reg - CTXL;
    int pos = axis ? (t & 63) : (t >> 6);
    float2 cs = ((const float2*)p.rope())[pos * 8 + (r & 7)];
    o[reg] = (r & 8) ? a[reg] * cs.x + pv * cs.y : a[reg] * cs.x - pv * cs.y;
  }
  return o;
}
__device__ __forceinline__ bf4 pack4(f4 a) {
  bf4 o; o[0] = (__bf16)a[0]; o[1] = (__bf16)a[1]; o[2] = (__bf16)a[2]; o[3] = (__bf16)a[3];
  return o;
}

template <int EPI>
__device__ __forceinline__ void gemm_epilogue(const Params& p, int l, f4 (&acc)[4][4], int m0, int n0, int wm, int wn, int lane,
                                              const float* rowss) {
  const int r = lane & 15, g = lane >> 4;
  const int b = m0 / PT;
  const int pp0 = m0 - b * PT;
  const bool lat = pp0 >= CTXL;
  const int v = lat ? b : 2;
  const float* md = p.mod() + (size_t)(l * 3 + v) * 6144;
  const int prow0 = pp0 + wm * 64 + 4 * g;
  const int tok0 = b * PT + prow0;
  constexpr int STEP = (EPI == EPI_UP) ? 2 : 1;
  if constexpr (EPI == EPI_OUT || EPI == EPI_DOWN) {
    float* xb = (lat ? p.out + (size_t)(b * SEQ + prow0 - CTXL) * DM : p.xc() + (size_t)(b * CTXL + prow0) * DM) + n0 + wn * 64 + r;
    float gt[4];
    f4 xin[4][4];
#pragma unroll
    for (int ni = 0; ni < 4; ++ni) gt[ni] = md[(EPI == EPI_OUT ? 2048 : 5120) + n0 + wn * 64 + ni * 16 + r];
#pragma unroll
    for (int mi = 0; mi < 4; ++mi)
#pragma unroll
      for (int ni = 0; ni < 4; ++ni)
#pragma unroll
        for (int q = 0; q < 4; ++q) xin[mi][ni][q] = xb[(size_t)(mi * 16 + q) * DM + ni * 16];
#pragma unroll
    for (int mi = 0; mi < 4; ++mi)
#pragma unroll
      for (int ni = 0; ni < 4; ++ni)
#pragma unroll
        for (int q = 0; q < 4; ++q) xb[(size_t)(mi * 16 + q) * DM + ni * 16] = xin[mi][ni][q] + gt[ni] * acc[mi][ni][q];
    return;
  }
  float tla[4] = {0.f, 0.f, 0.f, 0.f}, tl1[4] = {0.f, 0.f, 0.f, 0.f};
  if constexpr (EPI == EPI_IN) {
#pragma unroll
    for (int ni = 0; ni < 4; ++ni) {
      const int c0 = n0 + wn * 64 + ni * 16;
      if (c0 >= 1696 && c0 < 2720) {
        const int dir = c0 >= 2208;
        const int n1 = c0 + r - (dir ? 2208 : 1696);
        tla[ni] = p.llb()[(l * 2 + dir) * 512 + n1];
        tl1[ni] = p.l1mlb()[(l * 2 + dir) * 512 + n1];
      }
    }
  }
#pragma unroll 1
  for (int ni = 0; ni < 4; ni += STEP) {
    const int col0 = n0 + wn * 64 + ni * 16;
    const int col = col0 + r;
    if constexpr (EPI == EPI_IN) {
      if (col0 < 384) {
        __bf16* dst = col0 < 256 ? p.cq() + col : p.ckv() + (col - 256);
        const int ld = col0 < 256 ? 256 : 128;
#pragma unroll
        for (int mi = 0; mi < 4; ++mi)
#pragma unroll
          for (int q = 0; q < 4; ++q) dst[(size_t)(tok0 + mi * 16 + q) * ld] = (__bf16)acc[mi][0][q];
      } else if (col0 < 416) {
        f4 v[4];
#pragma unroll
        for (int mi = 0; mi < 4; ++mi) {
          v[mi] = acc[mi][0];
          if (lat) v[mi] = rope4(p, v[mi], prow0 + mi * 16, (col0 - 384) >> 4, r);
        }
#pragma unroll
        for (int mi = 0; mi < 4; ++mi)
#pragma unroll
          for (int h = 0; h < 4; ++h)
#pragma unroll
            for (int q = 0; q < 4; ++q) p.km()[((size_t)(b * 4 + h) * PT + prow0 + mi * 16 + q) * 96 + 64 + col - 384] = (__bf16)v[mi][q];
      } else if (col0 < 928) {
        const bool isq = col0 < 672;
        const int n1 = col - (isq ? 416 : 672);
        const int head = n1 >> 6, map = (n1 >> 5) & 1, d = n1 & 31;
        __bf16* dst = (isq ? p.qd() : p.kd()) + ((size_t)((b * 4 + head) * 2 + map) * PT) * 32 + d;
        const float sc = isq ? 0.17677669529663687f * LOG2E : 1.f;
        f4 v[4];
#pragma unroll
        for (int mi = 0; mi < 4; ++mi) {
          v[mi] = acc[mi][0];
          if (lat) v[mi] = rope4(p, v[mi], prow0 + mi * 16, (n1 >> 4) & 1, r);
        }
#pragma unroll
        for (int mi = 0; mi < 4; ++mi)
#pragma unroll
          for (int q = 0; q < 4; ++q) dst[(size_t)(prow0 + mi * 16 + q) * 32] = (__bf16)(v[mi][q] * sc);
      } else if (col0 < 1184 || (col0 >= 2720 && col0 < 3232)) {
        const bool isd = col0 < 1184;
        const int n1 = col - (isd ? 928 : 2720);
        __bf16* dst = isd ? p.vdt() + ((size_t)(b * 4 + (n1 >> 6)) * 64 + (n1 & 63)) * PT
                          : p.hvt() + ((size_t)(b * 8 + (n1 >> 6)) * 64 + (n1 & 63)) * PT;
#pragma unroll
        for (int mi = 0; mi < 4; ++mi) *(bf4*)(dst + prow0 + mi * 16) = pack4(acc[mi][0]);
      } else if (col0 < 1696 || (col0 >= 3232 && col0 < INW)) {
        const bool ish = col0 < 1696;
        __bf16* dst = ish ? p.hq() + (col - 1184) : p.hg() + (col - 3232);
#pragma unroll
        for (int mi = 0; mi < 4; ++mi)
#pragma unroll
          for (int q = 0; q < 4; ++q) dst[(size_t)(tok0 + mi * 16 + q) * 512] = (__bf16)silu_f(acc[mi][0][q]);
      } else if (col0 < 2720) {
        const int dir = col0 >= 2208;
        const int n1 = col - (dir ? 2208 : 1696);
        const float la = tla[0], l1m = tl1[0];
        float* dst = p.lf() + (size_t)dir * NTOK * 512 + n1;
#pragma unroll
        for (int mi = 0; mi < 4; ++mi)
#pragma unroll
          for (int q = 0; q < 4; ++q) dst[(size_t)(tok0 + mi * 16 + q) * 512] = log_forget(acc[mi][0][q], la, l1m);
      }
    } else if constexpr (EPI == EPI_UQ) {
      const int head = col0 / 96, d0 = col0 - head * 96;
      const float sc = 0.10206207261596577f * LOG2E;
      __bf16* dst = p.qm() + ((size_t)(b * 4 + head) * PT) * 96 + d0 + r;
      f4 v[4];
#pragma unroll
      for (int mi = 0; mi < 4; ++mi) {
        f4 a = acc[mi][0];
#pragma unroll
        for (int q = 0; q < 4; ++q) a[q] *= rsqrtf(rowss[wm * 64 + mi * 16 + 4 * g + q] * (1.f / 256.f) + EPSN);
        if (d0 >= 64 && lat) a = rope4(p, a, prow0 + mi * 16, (d0 - 64) >> 4, r);
        v[mi] = a;
      }
#pragma unroll
      for (int mi = 0; mi < 4; ++mi)
#pragma unroll
        for (int q = 0; q < 4; ++q) dst[(size_t)(prow0 + mi * 16 + q) * 96] = (__bf16)(v[mi][q] * sc);
    } else if constexpr (EPI == EPI_UKV) {
      const int head = col >> 7, d = col & 127;
#pragma unroll
      for (int mi = 0; mi < 4; ++mi) {
        f4 a = acc[mi][0];
        const int prow = prow0 + mi * 16;
#pragma unroll
        for (int q = 0; q < 4; ++q) a[q] *= rsqrtf(rowss[wm * 64 + mi * 16 + 4 * g + q] * (1.f / 128.f) + EPSN);
        if ((col0 & 127) < 64) {
#pragma unroll
          for (int q = 0; q < 4; ++q) p.km()[((size_t)(b * 4 + head) * PT + prow + q) * 96 + d] = (__bf16)a[q];
        } else {
          *(bf4*)(p.vmt() + ((size_t)(b * 4 + head) * 64 + d - 64) * PT + prow) = pack4(a);
        }
      }
    } else if constexpr (EPI == EPI_OUT || EPI == EPI_DOWN) {
    } else if constexpr (EPI == EPI_OUT_AT || EPI == EPI_DOWN_AT) {
      const float gt = md[(EPI == EPI_OUT_AT ? 2048 : 5120) + col];
      float* xb = (lat ? p.out + (size_t)(b * SEQ + prow0 - CTXL) * DM : p.xc() + (size_t)(b * CTXL + prow0) * DM) + col;
#pragma unroll
      for (int mi = 0; mi < 4; ++mi)
#pragma unroll
        for (int q = 0; q < 4; ++q) atomicAdd(xb + (size_t)(mi * 16 + q) * DM, gt * acc[mi][0][q]);
    } else if constexpr (EPI == EPI_UP) {
      const int n = (col0 >> 5) * 16 + r;
#pragma unroll
      for (int mi = 0; mi < 4; ++mi)
#pragma unroll
        for (int q = 0; q < 4; ++q)
          p.act()[(size_t)(tok0 + mi * 16 + q) * LDF + n] = (__bf16)(silu_f(acc[mi][0][q]) * acc[mi][1][q]);
    }
#pragma unroll
    for (int mi = 0; mi < 4; ++mi) {
      if constexpr (STEP == 1) { acc[mi][0] = acc[mi][1]; acc[mi][1] = acc[mi][2]; acc[mi][2] = acc[mi][3]; }
      else { acc[mi][0] = acc[mi][2]; acc[mi][1] = acc[mi][3]; }
    }
    tla[0] = tla[1]; tla[1] = tla[2]; tla[2] = tla[3]; tl1[0] = tl1[1]; tl1[1] = tl1[2]; tl1[2] = tl1[3];
  }
}

#define RAW_BARRIER() do { asm volatile("s_waitcnt lgkmcnt(0)" ::: "memory"); __builtin_amdgcn_s_barrier(); } while (0)

template <int EPI, bool ROWSS>
__device__ __forceinline__ void gemm_tile(const Params& p, int l, const __bf16* __restrict__ A, int lda, const __bf16* __restrict__ Bt, int ldb, int K,
                          int m0, int n0, char* smem, bool pre = false, bool has_next = false, int m0n = 0, int n0n = 0) {
  __bf16* S0 = (__bf16*)smem;
  float* rowss = (float*)(smem + 65536);
  const int tid = tid_(), lane = tid & 63, wave = tid >> 6;
  const int wm = wave >> 1, wn = wave & 1, r = lane & 15, g = lane >> 4;
  f4 acc[4][4];
#pragma unroll
  for (int i = 0; i < 4; ++i)
#pragma unroll
    for (int j = 0; j < 4; ++j) acc[i][j] = f4{0.f, 0.f, 0.f, 0.f};
  if constexpr (ROWSS) {
    const int row = tid >> 1, half = tid & 1;
    const __bf16* rp = A + (size_t)(m0 + row) * lda + half * (K >> 1);
    float sq = 0.f;
    for (int c = 0; c < (K >> 4); ++c) {
      bf8 v = *(const bf8*)(rp + c * 8);
#pragma unroll
      for (int j = 0; j < 8; ++j) { float f = (float)v[j]; sq += f * f; }
    }
    sq += __shfl_xor(sq, 1);
    __syncthreads();
    if (!half) rowss[row] = sq;
  }
  const int lrow = lane >> 3;
  const int sz = (lane >> 4);
  const __bf16* gaw[4]; const __bf16* gbw[4];
#pragma unroll
  for (int i = 0; i < 4; ++i) {
    const int rg = wave + 4 * i;
    const int row = rg * 8 + lrow;
    const int cl = (lane & 7) ^ (((rg & 1) * 4 + sz) & 7);
    gaw[i] = A + (size_t)(m0 + row) * lda + cl * 8;
    gbw[i] = Bt + (size_t)(n0 + row) * ldb + cl * 8;
  }
  const int aoff = (wm * 64 + r) * 64, boff = 8192 + (wn * 64 + r) * 64;
  const int sw = r >> 1;
  const int KT = K / 64;
  if (!pre) {
    __syncthreads();
#pragma unroll
    for (int i = 0; i < 4; ++i) {
      __builtin_amdgcn_global_load_lds((const unsigned*)(gaw[i]), (unsigned*)(S0 + (wave + 4 * i) * 512), 16, 0, 0);
      __builtin_amdgcn_global_load_lds((const unsigned*)(gbw[i]), (unsigned*)(S0 + 8192 + (wave + 4 * i) * 512), 16, 0, 0);
    }
  }
  asm volatile("s_waitcnt vmcnt(0)" ::: "memory");
  RAW_BARRIER();
  for (int kt = 0; kt < KT; ++kt) {
    const __bf16* Sc = S0 + (kt & 1) * 16384;
    __bf16* Sn = S0 + ((kt + 1) & 1) * 16384;
    if (kt + 1 < KT) {
#pragma unroll
      for (int i = 0; i < 4; ++i) {
        __builtin_amdgcn_global_load_lds((const unsigned*)(gaw[i] + (kt + 1) * 64), (unsigned*)(Sn + (wave + 4 * i) * 512), 16, 0, 0);
        __builtin_amdgcn_global_load_lds((const unsigned*)(gbw[i] + (kt + 1) * 64), (unsigned*)(Sn + 8192 + (wave + 4 * i) * 512), 16, 0, 0);
      }
    }
    {
      bf8 af0[4], bf0[4], af1[4], bf1[4];
      const int ch0 = ((0 * 4 + g) ^ sw) * 8, ch1 = ((1 * 4 + g) ^ sw) * 8;
#pragma unroll
      for (int i = 0; i < 4; ++i) {
        af0[i] = *(const bf8*)(Sc + aoff + i * 1024 + ch0);
        bf0[i] = *(const bf8*)(Sc + boff + i * 1024 + ch0);
      }
#pragma unroll
      for (int i = 0; i < 4; ++i) {
        af1[i] = *(const bf8*)(Sc + aoff + i * 1024 + ch1);
        bf1[i] = *(const bf8*)(Sc + boff + i * 1024 + ch1);
      }
      __builtin_amdgcn_s_setprio(1);
#pragma unroll
      for (int i = 0; i < 4; ++i)
#pragma unroll
        for (int j = 0; j < 4; ++j) acc[i][j] = mfma16(af0[i], bf0[j], acc[i][j]);
#pragma unroll
      for (int i = 0; i < 4; ++i)
#pragma unroll
        for (int j = 0; j < 4; ++j) acc[i][j] = mfma16(af1[i], bf1[j], acc[i][j]);
      __builtin_amdgcn_s_setprio(0);
      __builtin_amdgcn_sched_group_barrier(0x100, 8, 0);
#pragma unroll
      for (int i = 0; i < 8; ++i) {
        __builtin_amdgcn_sched_group_barrier(0x008, 1, 0);
        __builtin_amdgcn_sched_group_barrier(0x100, 1, 0);
      }
      __builtin_amdgcn_sched_group_barrier(0x008, 24, 0);
    }
    asm volatile("s_waitcnt vmcnt(0)" ::: "memory");
    RAW_BARRIER();
  }
  if (has_next) {
#pragma unroll
    for (int i = 0; i < 4; ++i) {
      const int rg = wave + 4 * i;
      const int row = rg * 8 + lrow;
      const int cl = (lane & 7) ^ (((rg & 1) * 4 + sz) & 7);
      __builtin_amdgcn_global_load_lds((const unsigned*)(A + (size_t)(m0n + row) * lda + cl * 8), (unsigned*)(S0 + rg * 512), 16, 0, 0);
      __builtin_amdgcn_global_load_lds((const unsigned*)(Bt + (size_t)(n0n + row) * ldb + cl * 8), (unsigned*)(S0 + 8192 + rg * 512), 16, 0, 0);
    }
  }
  gemm_epilogue<EPI>(p, l, acc, m0, n0, wm, wn, lane, rowss);
}

__device__ __forceinline__ int mtile_count(int l) { return l < 3 ? 132 : 128; }
__device__ __forceinline__ int mtile_index(int l, int i) { return l < 3 ? i : (i >> 6) * 66 + 2 + (i & 63); }

__device__ __forceinline__ bool gemm_pick(int step, int bid, int G, int MT, int NT, int W, int& mt, int& nt) {
  const int C = G >> 3;
  const int L = (step * 8 + (bid & 7)) * C + (bid >> 3);
  if (L >= MT * NT) return false;
  const int s = L / (W * MT), rem = L - s * W * MT;
  mt = rem / W; nt = s * W + (rem - mt * W);
  return true;
}

template <int DQK, int NMAP>
__device__ __forceinline__ void attn_item(const Params& p, int l, const __bf16* __restrict__ Q, const __bf16* __restrict__ Kp,
                          const __bf16* __restrict__ Vt, int b, int h, int q0, int nkeys, char* smem) {
  constexpr int KLD = DQK + 8;
  constexpr int KCH = DQK / 8;
  constexpr int NKC = NMAP * 64 * KCH / 256;
  constexpr int NKS = DQK / 32;
  __bf16* Ks = (__bf16*)smem;
  __bf16* Vs = Ks + NMAP * 64 * KLD;
  const int tid = tid_(), lane = tid & 63, wave = tid >> 6, r = lane & 15, g = lane >> 4;
  const __bf16* Qb = Q + (size_t)((b * 4 + h) * NMAP) * PT * DQK;
  const __bf16* Kb = Kp + (size_t)((b * 4 + h) * NMAP) * PT * DQK;
  const __bf16* Vb = Vt + (size_t)((b * 4 + h) * 64) * PT;

  bf8 qf[NMAP][2][NKS];
#pragma unroll
  for (int mp = 0; mp < NMAP; ++mp)
#pragma unroll
    for (int qt = 0; qt < 2; ++qt)
#pragma unroll
      for (int ks = 0; ks < NKS; ++ks)
        qf[mp][qt][ks] = *(const bf8*)(Qb + ((size_t)mp * PT + q0 + wave * 32 + qt * 16 + r) * DQK + ks * 32 + g * 8);

  f4 o[NMAP][2][4];
  float mrun[NMAP][2], lsum[NMAP][2];
  f4 negm[NMAP][2];
#pragma unroll
  for (int mp = 0; mp < NMAP; ++mp)
#pragma unroll
    for (int qt = 0; qt < 2; ++qt) {
      mrun[mp][qt] = 0.f; lsum[mp][qt] = 0.f; negm[mp][qt] = f4{0.f, 0.f, 0.f, 0.f};
#pragma unroll
      for (int d = 0; d < 4; ++d) o[mp][qt][d] = f4{0.f, 0.f, 0.f, 0.f};
    }

  int koff_g[NKC], koff_s[NKC];
#pragma unroll
  for (int i = 0; i < NKC; ++i) {
    int c = tid + 256 * i;
    int mp = c / (64 * KCH), rem = c - mp * 64 * KCH;
    int row = rem / KCH, kc = rem - row * KCH;
    koff_g[i] = (mp * PT + row) * DQK + kc * 8;
    koff_s[i] = (mp * 64 + row) * KLD + kc * 8;
  }
  bf8 rk[NKC], rv[2];
  const int nkb = nkeys / 64;
#pragma unroll
  for (int i = 0; i < NKC; ++i) rk[i] = *(const bf8*)(Kb + koff_g[i]);
#pragma unroll
  for (int i = 0; i < 2; ++i) rv[i] = *(const bf8*)(Vb + (size_t)((tid >> 3) + 32 * i) * PT + (tid & 7) * 8);

  for (int kb = 0; kb < nkb; ++kb) {
    __syncthreads();
#pragma unroll
    for (int i = 0; i < NKC; ++i) *(bf8*)(Ks + koff_s[i]) = rk[i];
#pragma unroll
    for (int i = 0; i < 2; ++i) *(bf8*)(Vs + ((tid >> 3) + 32 * i) * 72 + (tid & 7) * 8) = rv[i];
    __syncthreads();
    if (kb + 1 < nkb) {
#pragma unroll
      for (int i = 0; i < NKC; ++i) rk[i] = *(const bf8*)(Kb + koff_g[i] + (size_t)(kb + 1) * 64 * DQK);
#pragma unroll
      for (int i = 0; i < 2; ++i) rv[i] = *(const bf8*)(Vb + (size_t)((tid >> 3) + 32 * i) * PT + (kb + 1) * 64 + (tid & 7) * 8);
    }
    f4 s[NMAP][2][2][2];
    __builtin_amdgcn_s_setprio(1);
#pragma unroll
    for (int mp = 0; mp < NMAP; ++mp)
#pragma unroll
      for (int m = 0; m < 2; ++m)
#pragma unroll
        for (int tp = 0; tp < 2; ++tp) {
          f4 s0 = negm[mp][0], s1 = negm[mp][1];
          const int krow = 32 * m + 8 * (r >> 2) + 4 * tp + (r & 3);
#pragma unroll
          for (int ks = 0; ks < NKS; ++ks) {
            bf8 kf = *(const bf8*)(Ks + (mp * 64 + krow) * KLD + ks * 32 + g * 8);
            s0 = mfma16(kf, qf[mp][0][ks], s0);
            s1 = mfma16(kf, qf[mp][1][ks], s1);
          }
          s[mp][0][m][tp] = s0; s[mp][1][m][tp] = s1;
        }
    __builtin_amdgcn_s_setprio(0);
    bf8 pf[NMAP][2][2];
#pragma unroll
    for (int mp = 0; mp < NMAP; ++mp)
#pragma unroll
      for (int qt = 0; qt < 2; ++qt) {
        float ps = 0.f;
#pragma unroll
        for (int m = 0; m < 2; ++m) {
          bf8 pk;
#pragma unroll
          for (int tp = 0; tp < 2; ++tp)
#pragma unroll
            for (int q = 0; q < 4; ++q) {
              float e = __builtin_amdgcn_exp2f(s[mp][qt][m][tp][q]);
              ps += e;
              pk[tp * 4 + q] = (__bf16)e;
            }
          pf[mp][qt][m] = pk;
        }
        const bool hi = __builtin_amdgcn_ballot_w64(!(ps < 65536.f)) != 0ull;
        const bool lo = __builtin_amdgcn_ballot_w64(ps > 0.f || lsum[mp][qt] > 0.f) == 0ull;
        if (hi || lo) {
          float bm = -INFINITY;
#pragma unroll
          for (int m = 0; m < 2; ++m)
#pragma unroll
            for (int tp = 0; tp < 2; ++tp)
#pragma unroll
              for (int q = 0; q < 4; ++q) bm = fmaxf(bm, s[mp][qt][m][tp][q]);
          bm = rows_max(bm);
          const float sh = lo ? bm : fmaxf(bm, 0.f);
          const float alpha = lo ? 1.f : __builtin_amdgcn_exp2f(-sh);
          mrun[mp][qt] += sh;
          const float nm = -mrun[mp][qt];
          negm[mp][qt] = f4{nm, nm, nm, nm};
          lsum[mp][qt] *= alpha;
#pragma unroll
          for (int d = 0; d < 4; ++d) o[mp][qt][d] *= alpha;
          ps = 0.f;
#pragma unroll
          for (int m = 0; m < 2; ++m) {
            bf8 pk;
#pragma unroll
            for (int tp = 0; tp < 2; ++tp)
#pragma unroll
              for (int q = 0; q < 4; ++q) {
                float e = __builtin_amdgcn_exp2f(s[mp][qt][m][tp][q] - sh);
                ps += e;
                pk[tp * 4 + q] = (__bf16)e;
              }
            pf[mp][qt][m] = pk;
          }
        }
        lsum[mp][qt] += ps;
      }
    __builtin_amdgcn_s_setprio(1);
#pragma unroll
    for (int d = 0; d < 4; ++d)
#pragma unroll
      for (int m = 0; m < 2; ++m) {
        bf8 vf = *(const bf8*)(Vs + (d * 16 + r) * 72 + 32 * m + 8 * g);
#pragma unroll
        for (int mp = 0; mp < NMAP; ++mp)
#pragma unroll
          for (int qt = 0; qt < 2; ++qt) o[mp][qt][d] = mfma16(vf, pf[mp][qt][m], o[mp][qt][d]);
      }
    __builtin_amdgcn_s_setprio(0);
  }
#pragma unroll
  for (int qt = 0; qt < 2; ++qt) {
    const int tok = b * PT + q0 + wave * 32 + qt * 16 + r;
    float inv[NMAP];
#pragma unroll
    for (int mp = 0; mp < NMAP; ++mp) {
      float ls = lsum[mp][qt];
      ls = rows_sum(ls);
      inv[mp] = 1.f / ls;
    }
    if constexpr (NMAP == 1) {
#pragma unroll
      for (int d = 0; d < 4; ++d)
        *(bf4*)(p.mix() + (size_t)tok * LDH + h * 64 + d * 16 + 4 * g) = pack4(o[0][qt][d] * inv[0]);
    } else {
      const float lam = p.lam()[l];
      const float li = 0.8f - 0.6f * expf(-0.3f * (float)l);
      f4 val[4];
      float ss = 0.f;
#pragma unroll
      for (int d = 0; d < 4; ++d) {
        val[d] = o[0][qt][d] * inv[0] - o[NMAP - 1][qt][d] * (lam * inv[NMAP - 1]);
        ss += val[d][0] * val[d][0] + val[d][1] * val[d][1] + val[d][2] * val[d][2] + val[d][3] * val[d][3];
      }
      ss = rows_sum(ss);
      const float rs = rsqrtf(ss * (1.f / 64.f) + EPSN) * (1.f - li);
      f4 gd[4];
#pragma unroll
      for (int d = 0; d < 4; ++d) gd[d] = *(const f4*)(p.g_diff_norm + l * 64 + d * 16 + 4 * g);
#pragma unroll
      for (int d = 0; d < 4; ++d) *(bf4*)(p.mix() + (size_t)tok * LDH + 256 + h * 64 + d * 16 + 4 * g) = pack4(val[d] * rs * gd[d]);
    }
  }
}

template <int DQK, int NMAP>
__device__ __forceinline__ void attn_dispatch(const Params& p, int l, int item, const __bf16* Q, const __bf16* K, const __bf16* Vt, char* smem) {
  int b, h, q0, nk;
  if (item < 512) { b = (item >> 2) & 1; h = item & 3; q0 = CTXL + (item >> 3) * 128; nk = PT; }
  else { int it = item - 512; b = it >> 3; h = (it >> 1) & 3; q0 = (it & 1) * 128; nk = CTXL; }
  attn_item<DQK, NMAP>(p, l, Q, K, Vt, b, h, q0, nk, smem);
}

__device__ __forceinline__ void hgrn1_item(const Params& p, int item, char* smem) {
  __bf16* kteT = (__bf16*)smem;
  __bf16* vT = kteT + 64 * 72;
  float* ptot = (float*)(vT + 64 * 72);
  const int tid = tid_(), lane = tid & 63, wave = tid >> 6, r = lane & 15, g = lane >> 4;
  const int c = item % NCH, bh = item / NCH;
  const int b = bh >> 3, h = bh & 7;
  const int tok0 = b * PT + c * 64;
  __syncthreads();
#pragma unroll
  for (int i = 0; i < 2; ++i) {
    int dv = (tid >> 3) + 32 * i;
    *(bf8*)(vT + dv * 72 + (tid & 7) * 8) = *(const bf8*)(p.hvt() + ((size_t)bh * 64 + dv) * PT + c * 64 + (tid & 7) * 8);
  }
  const int k = tid & 63, part = tid >> 6;
  float lfa[2][16];
#pragma unroll
  for (int dd = 0; dd < 2; ++dd) {
    const float* lfp = p.lf() + ((size_t)dd * NTOK + tok0 + part * 16) * 512 + h * 64 + k;
#pragma unroll
    for (int i = 0; i < 16; ++i) lfa[dd][i] = lfp[(size_t)i * 512];
  }
#pragma unroll
  for (int dir = 0; dir < 2; ++dir) {
    float lfv[16], cl[16];
#pragma unroll
    for (int i = 0; i < 16; ++i) lfv[i] = lfa[dir][i];
    float run = 0.f;
    if (dir == 0) {
#pragma unroll
      for (int i = 0; i < 16; ++i) { run += lfv[i]; cl[i] = run; }
    } else {
#pragma unroll
      for (int i = 15; i >= 0; --i) { run += lfv[i]; cl[i] = run; }
    }
    __syncthreads();
    ptot[part * 64 + k] = run;
    __syncthreads();
    float off = 0.f, total = 0.f;
#pragma unroll
    for (int q = 0; q < 4; ++q) {
      float t = ptot[q * 64 + k];
      total += t;
      if (dir == 0 ? (q < part) : (q > part)) off += t;
    }
#pragma unroll
    for (int i = 0; i < 16; ++i) {
      float cum = cl[i] + off;
      float kte = (1.f - __expf(lfv[i])) * __expf(total - cum);
      kteT[k * 72 + part * 16 + i] = (__bf16)kte;
    }
    const size_t sidx = ((size_t)bh * 2 + dir) * NCH + c;
    if (part == 0) p.dk()[sidx * 64 + k] = __expf(total);
    __syncthreads();
    f4 acc[4];
#pragma unroll
    for (int nt = 0; nt < 4; ++nt) acc[nt] = f4{0.f, 0.f, 0.f, 0.f};
#pragma unroll
    for (int ks = 0; ks < 2; ++ks) {
      bf8 af = *(const bf8*)(vT + (wave * 16 + r) * 72 + ks * 32 + g * 8);
#pragma unroll
      for (int nt = 0; nt < 4; ++nt) {
        bf8 bfr = *(const bf8*)(kteT + (nt * 16 + r) * 72 + ks * 32 + g * 8);
        acc[nt] = mfma16(af, bfr, acc[nt]);
      }
    }
    float* up = p.ut() + sidx * 4096;
#pragma unroll
    for (int nt = 0; nt < 4; ++nt)
#pragma unroll
      for (int q = 0; q < 4; ++q) up[(wave * 16 + 4 * g + q) * 64 + nt * 16 + r] = acc[nt][q];
  }
}

__device__ __forceinline__ void hgrn2_item(const Params& p, int item) {
  const int idx = item * 256 + tid_();
  const int e = idx & 4095, sd = idx >> 12;
  const int dir = sd & 1, kk = e & 63;
  const float* up = p.ut() + (size_t)sd * NCH * 4096 + e;
  const float* dp = p.dk() + (size_t)sd * NCH * 64 + kk;
  __bf16* sp = p.st() + (size_t)sd * NCH * 4096 + e;
  float S = 0.f;
  for (int jb = 0; jb < NCH; jb += 22) {
    float u[22], d[22];
    int cc[22];
#pragma unroll
    for (int q = 0; q < 22; ++q) {
      int j = jb + q;
      int c = dir == 0 ? j : (j < 4 ? 3 - j : 135 - j);
      cc[q] = c;
      u[q] = up[(size_t)c * 4096];
      d[q] = dp[c * 64];
    }
#pragma unroll
    for (int q = 0; q < 22; ++q) {
      sp[(size_t)cc[q] * 4096] = (__bf16)S;
      S = d[q] * S + u[q];
    }
  }
}

__device__ __forceinline__ void hgrn3_item(const Params& p, int l, int item, char* smem) {
  __bf16* qS = (__bf16*)smem;
  __bf16* kS = qS + 64 * 72;
  __bf16* vT = kS + 64 * 72;
  __bf16* stS = vT + 64 * 72;
  float* cumS = (float*)(stS + 64 * 72);
  float* ptot = cumS + 64 * 68;
  const int tid = tid_(), lane = tid & 63, wave = tid >> 6, r = lane & 15, g = lane >> 4;
  const int c = item % NCH, bh = item / NCH;
  const int b = bh >> 3, h = bh & 7;
  const int tok0 = b * PT + c * 64;
  __syncthreads();
#pragma unroll
  for (int i = 0; i < 2; ++i) {
    int row = (tid >> 3) + 32 * i;
    *(bf8*)(vT + row * 72 + (tid & 7) * 8) = *(const bf8*)(p.hvt() + ((size_t)bh * 64 + row) * PT + c * 64 + (tid & 7) * 8);
    *(bf8*)(qS + row * 72 + (tid & 7) * 8) = *(const bf8*)(p.hq() + (size_t)(tok0 + row) * 512 + h * 64 + (tid & 7) * 8);
  }
  f4 o[4];
#pragma unroll
  for (int d = 0; d < 4; ++d) o[d] = f4{0.f, 0.f, 0.f, 0.f};
  const int k = tid & 63, part = tid >> 6;
  const int t = 16 * wave + r;
  bf8 sta[2][2];
#pragma unroll
  for (int dd = 0; dd < 2; ++dd) {
    const __bf16* sp = p.st() + (((size_t)bh * 2 + dd) * NCH + c) * 4096;
#pragma unroll
    for (int i = 0; i < 2; ++i) sta[dd][i] = *(const bf8*)(sp + ((tid >> 3) + 32 * i) * 64 + (tid & 7) * 8);
  }
  float lfa[2][16];
#pragma unroll
  for (int dd = 0; dd < 2; ++dd) {
    const float* lfp = p.lf() + ((size_t)dd * NTOK + tok0 + part * 16) * 512 + h * 64 + k;
#pragma unroll
    for (int i = 0; i < 16; ++i) lfa[dd][i] = lfp[(size_t)i * 512];
  }
#pragma unroll
  for (int dir = 0; dir < 2; ++dir) {
    float lfv[16], cl[16];
#pragma unroll
    for (int i = 0; i < 16; ++i) lfv[i] = lfa[dir][i];
    float run = 0.f;
    if (dir == 0) {
#pragma unroll
      for (int i = 0; i < 16; ++i) { run += lfv[i]; cl[i] = run; }
    } else {
#pragma unroll
      for (int i = 15; i >= 0; --i) { run += lfv[i]; cl[i] = run; }
    }
    __syncthreads();
    ptot[part * 64 + k] = run;
#pragma unroll
    for (int i = 0; i < 16; ++i) kS[(part * 16 + i) * 72 + k] = (__bf16)((1.f - __expf(lfv[i])));
#pragma unroll
    for (int i = 0; i < 2; ++i) *(bf8*)(stS + ((tid >> 3) + 32 * i) * 72 + (tid & 7) * 8) = sta[dir][i];
    __syncthreads();
    float off = 0.f;
#pragma unroll
    for (int q = 0; q < 4; ++q) {
      float tt = ptot[q * 64 + k];
      if (dir == 0 ? (q < part) : (q > part)) off += tt;
    }
#pragma unroll
    for (int i = 0; i < 16; ++i) cumS[(part * 16 + i) * 68 + k] = cl[i] + off;
    __syncthreads();
    float cs[2][8];
    bf8 qtf[2], qhf[2];
#pragma unroll
    for (int ks = 0; ks < 2; ++ks) {
      const int dk0 = ks * 32 + 8 * g;
      bf8 qv = *(const bf8*)(qS + t * 72 + dk0);
#pragma unroll
      for (int j = 0; j < 8; ++j) {
        float cst;
        if (dir == 0) cst = wave > 0 ? cumS[(16 * wave - 1) * 68 + dk0 + j] : 0.f;
        else cst = wave < 3 ? cumS[(16 * wave + 16) * 68 + dk0 + j] : 0.f;
        cs[ks][j] = cst;
        float cv = cumS[t * 68 + dk0 + j];
        float qf_ = (float)qv[j];
        qtf[ks][j] = (__bf16)(qf_ * __expf(cv - cst));
        qhf[ks][j] = (__bf16)(qf_ * __expf(cv));
      }
    }
#pragma unroll
    for (int m = 0; m < 2; ++m) {
      const bool need = dir == 0 ? (m <= (wave >> 1)) : (m >= (wave >> 1));
      if (need) {
        bf8 pf;
#pragma unroll
        for (int tp = 0; tp < 2; ++tp) {
          const int srow = 32 * m + 8 * (r >> 2) + 4 * tp + (r & 3);
          f4 sc = f4{0.f, 0.f, 0.f, 0.f};
#pragma unroll
          for (int ks = 0; ks < 2; ++ks) {
            const int dk0 = ks * 32 + 8 * g;
            bf8 kv = *(const bf8*)(kS + srow * 72 + dk0);
            bf8 ktf;
#pragma unroll
            for (int j = 0; j < 8; ++j) {
              float ex = fminf(cs[ks][j] - cumS[srow * 68 + dk0 + j], 80.f);
              ktf[j] = (__bf16)((float)kv[j] * __expf(ex));
            }
            sc = mfma16(ktf, qtf[ks], sc);
          }
#pragma unroll
          for (int q = 0; q < 4; ++q) {
            const int s = 32 * m + 8 * g + 4 * tp + q;
            const bool keep = dir == 0 ? (s <= t) : (s >= t);
            pf[tp * 4 + q] = keep ? (__bf16)sc[q] : (__bf16)0.f;
          }
        }
#pragma unroll
        for (int d = 0; d < 4; ++d) {
          bf8 vf = *(const bf8*)(vT + (d * 16 + r) * 72 + 32 * m + 8 * g);
          o[d] = mfma16(vf, pf, o[d]);
        }
      }
    }
#pragma unroll
    for (int d = 0; d < 4; ++d)
#pragma unroll
      for (int ks = 0; ks < 2; ++ks) {
        bf8 sf = *(const bf8*)(stS + (d * 16 + r) * 72 + ks * 32 + 8 * g);
        o[d] = mfma16(sf, qhf[ks], o[d]);
      }
  }
  float ss = 0.f;
#pragma unroll
  for (int d = 0; d < 4; ++d) ss += o[d][0] * o[d][0] + o[d][1] * o[d][1] + o[d][2] * o[d][2] + o[d][3] * o[d][3];
  ss = rows_sum(ss);
  const float rs = rsqrtf(ss * (1.f / 64.f) + EPSN);
  f4 gn[4]; bf4 gate[4];
#pragma unroll
  for (int d = 0; d < 4; ++d) {
    gn[d] = *(const f4*)(p.g_hgrn_norm + l * 64 + d * 16 + 4 * g);
    gate[d] = *(const bf4*)(p.hg() + (size_t)(tok0 + t) * 512 + h * 64 + d * 16 + 4 * g);
  }
#pragma unroll
  for (int d = 0; d < 4; ++d) {
    f4 res;
#pragma unroll
    for (int q = 0; q < 4; ++q) res[q] = o[d][q] * rs * gn[d][q] * (float)gate[d][q];
    *(bf4*)(p.mix() + (size_t)(tok0 + t) * LDH + 512 + h * 64 + d * 16 + 4 * g) = pack4(res);
  }
}

#define NPHASE 38
#ifndef ONLY
#define ONLY -1
#endif
#define PHEN(x) (ONLY < 0 || ONLY == (x))
__device__ __forceinline__ void run_phase(const Params& p, int ph, char* smem) {
  const int bid = bid_(), G = gridDim.x;
  if (ph == 0) { if (PHEN(100)) phase0(p, smem); return; }
  if (ph == NPHASE - 1) {
    for (int it = bid; it < NB * SEQ / 16; it += G) final_norm_item(p, it);
    return;
  }
  const int l = (ph - 1) / 9, sp = (ph - 1) % 9;
  const int nmt = mtile_count(l);
  switch (sp) {
    case 0: if (PHEN(0)) {
      for (int i = bid * 256 + tid_(); i < (INWP - INW) * DM / 8; i += G * 256) {
        bf8 z;
#pragma unroll
        for (int j = 0; j < 8; ++j) z[j] = (__bf16)0.f;
        *(bf8*)(p.wt_in() + (size_t)(INW + (i >> 7)) * LDH + (size_t)(i & 127) * 8) = z;
      }
      for (int it = bid; it < 1056; it += G) norm_item(p, l, 0, it);
      conv_items(p, l, bid, G, smem);
    } break;
    case 1: if (PHEN(1)) {
      {
        int mt, nt, mtn = 0, ntn = 0;
        bool have = gemm_pick(0, bid, G, 132, 30, 10, mt, nt), pre = false;
        for (int st = 0; have; ++st) {
          const bool hn = gemm_pick(st + 1, bid, G, 132, 30, 10, mtn, ntn);
          gemm_tile<EPI_IN, false>(p, l, p.hb(), LDH, p.wt_in(), LDH, DM, mt * 128, nt * 128, smem, pre, hn, mtn * 128, ntn * 128);
          pre = hn; have = hn; mt = mtn; nt = ntn;
        }
      }
    } break;
    case 2: if (PHEN(2)) {
      const int natt = l < 3 ? 528 : 512;
      const int total = natt + 396 + 528 + 2112, K = (total + G - 1) / G;
      const bool flip = (bid >> 3) & 1;
      for (int kk = 0; kk < K; ++kk) {
        const int k = flip ? (kk + 1 == K ? 0 : kk + 1) : kk;
        const int it0 = bid + k * G;
        if (it0 >= total) continue;
        if (it0 < natt) { attn_dispatch<32, 2>(p, l, it0, p.qd(), p.kd(), p.vdt(), smem); continue; }
        const int it = it0 - natt;
        if (it < 396) gemm_tile<EPI_UQ, true>(p, l, p.cq(), 256, p.wt_uq(), 256, 256, (it / 3) * 128, (it % 3) * 128, smem);
        else if (it < 924) { int j = it - 396; gemm_tile<EPI_UKV, true>(p, l, p.ckv(), 128, p.wt_ukv(), 128, 128, (j / 4) * 128, (j % 4) * 128, smem); }
        else hgrn1_item(p, it - 924, smem);
      }
    } break;
    case 3: if (PHEN(3)) {
      const int natt = l < 3 ? 528 : 512;
      const int total = 512 + natt, K = (total + G - 1) / G;
      const bool flip = (bid >> 3) & 1;
      for (int kk = 0; kk < K; ++kk) {
        const int k = flip ? (kk + 1 == K ? 0 : kk + 1) : kk;
        const int it = bid + k * G;
        if (it >= total) continue;
        if (it < 512) hgrn2_item(p, it);
        else attn_dispatch<96, 1>(p, l, it - 512, p.qm(), p.km(), p.vmt(), smem);
      }
    } break;
    case 4: if (PHEN(4)) {
      for (int j = bid; j < 2112; j += G) {
        if (l == 3 && (j % NCH) < 4) continue;
        hgrn3_item(p, l, j, smem);
      }
    } break;
    case 5: if (PHEN(5)) {
      {
        int mt, nt, mtn = 0, ntn = 0;
        bool have = gemm_pick(0, bid, G, 128, 8, 8, mt, nt), pre = false;
        for (int st = 0; have; ++st) {
          const bool hn = gemm_pick(st + 1, bid, G, 128, 8, 8, mtn, ntn);
          gemm_tile<EPI_OUT, false>(p, l, p.mix(), LDH, p.wt_out(), LDH, DM, mtile_index(3, mt) * 128, nt * 128, smem, pre, hn,
                                    mtile_index(3, mtn) * 128, ntn * 128);
          pre = hn; have = hn; mt = mtn; nt = ntn;
        }
      }
      if (l < 3) {
        for (int u = bid; u < 32 * 8; u += G) {
          const int tile = u >> 3, sp = u & 7;
          const int cm = tile >> 3, nt = tile & 7;
          const int mt = (cm >> 1) * 66 + (cm & 1);
          gemm_tile<EPI_OUT_AT, false>(p, l, p.mix() + sp * 128, LDH, p.wt_out() + sp * 128, LDH, 128, mt * 128, nt * 128, smem);
        }
      }
    } break;
    case 6: if (PHEN(6)) {
      for (int it = bid; it < 1056; it += G) norm_item(p, l, 1, it);
    } break;
    case 7: if (PHEN(7)) {
      {
        int mt, nt, mtn = 0, ntn = 0;
        bool have = gemm_pick(0, bid, G, nmt, 44, 11, mt, nt), pre = false;
        for (int st = 0; have; ++st) {
          const bool hn = gemm_pick(st + 1, bid, G, nmt, 44, 11, mtn, ntn);
          gemm_tile<EPI_UP, false>(p, l, p.hb(), LDH, p.wt_gu(), LDH, DM, mtile_index(l, mt) * 128, nt * 128, smem, pre, hn,
                                   mtile_index(l, mtn) * 128, ntn * 128);
          pre = hn; have = hn; mt = mtn; nt = ntn;
        }
      }
    } break;
    case 8: if (PHEN(8)) {
      {
        int mt, nt, mtn = 0, ntn = 0;
        bool have = gemm_pick(0, bid, G, 128, 8, 8, mt, nt), pre = false;
        for (int st = 0; have; ++st) {
          const bool hn = gemm_pick(st + 1, bid, G, 128, 8, 8, mtn, ntn);
          gemm_tile<EPI_DOWN, false>(p, l, p.act(), LDF, p.wt_down(), LDF, DFF, mtile_index(3, mt) * 128, nt * 128, smem, pre, hn,
                                     mtile_index(3, mtn) * 128, ntn * 128);
          pre = hn; have = hn; mt = mtn; nt = ntn;
        }
      }
      if (l < 3) {
        for (int u = bid; u < 32 * 11; u += G) {
          const int tile = u / 11, sp = u - tile * 11;
          const int cm = tile >> 3, nt = tile & 7;
          const int mt = (cm >> 1) * 66 + (cm & 1);
          gemm_tile<EPI_DOWN_AT, false>(p, l, p.act() + sp * 256, LDF, p.wt_down() + sp * 256, LDF, 256, mt * 128, nt * 128, smem);
        }
      }
    } break;
  }
}

#define XB_TMO      128
#define XB_XCNT(j)  (256  + 64 * (j))
#define XB_XSUB(j)  (1280 + 64 * (j))
#define XB_XGEN(j)  (2304 + 64 * (j))
#define XB_TOP      3328
#define XB_TOPGEN   3392
#define XCD_BAR_WORDS 3456
#define XB_SPIN_CAP (1u << 22)
#define LAS __attribute__((address_space(3)))

__device__ __forceinline__ unsigned xb_ld(unsigned* p)              { return __hip_atomic_load(p, __ATOMIC_RELAXED, __HIP_MEMORY_SCOPE_AGENT); }
__device__ __forceinline__ unsigned xb_add(unsigned* p, unsigned v) { return __hip_atomic_fetch_add(p, v, __ATOMIC_RELAXED, __HIP_MEMORY_SCOPE_AGENT); }
__device__ __forceinline__ unsigned xb_xcc_id() { return (unsigned)__builtin_amdgcn_s_getreg((3 << 11) | 20) & 0xFu; }
#define XB_SPIN(cond, bar) do { unsigned _sp = 0; while (cond) { __builtin_amdgcn_s_sleep(1); \
    if ((++_sp & 255u) == 0u) { if (xb_ld(&(bar)[XB_TMO])) break; if (_sp > XB_SPIN_CAP) { atomicAdd(&(bar)[XB_TMO], 1u); break; } } } } while (0)

struct XcdBarrier {
    unsigned* bar; unsigned x;
    volatile LAS unsigned* st;
};

__device__ __forceinline__ XcdBarrier xcd_barrier_post(unsigned* bar, volatile LAS unsigned* st) {
    XcdBarrier b; b.bar = bar; b.x = xb_xcc_id(); b.st = st;
    if (threadIdx.x == 0) (void)xb_add(&bar[XB_XCNT(b.x)], 1u);
    return b;
}
__device__ __forceinline__ void xcd_barrier_complete(unsigned* bar, unsigned x, unsigned& nloc, unsigned& nx) {
    const unsigned G = gridDim.x * gridDim.y * gridDim.z;
    unsigned sum, cnt, mine, sp = 0u;
    for (;;) {
        sum = 0u; cnt = 0u; mine = 0u;
#pragma unroll
        for (unsigned j = 0; j < 16; ++j) { const unsigned c = xb_ld(&bar[XB_XCNT(j)]); sum += c; cnt += (c > 0u) ? 1u : 0u; mine = (j == x) ? c : mine; }
        if (sum == G) break;
        __builtin_amdgcn_s_sleep(1);
        if ((++sp & 255u) == 0u) { if (xb_ld(&bar[XB_TMO])) break; if (sp > XB_SPIN_CAP) { atomicAdd(&bar[XB_TMO], 1u); break; } }
    }
    nloc = mine > 0u ? mine : 1u; nx = cnt > 0u ? cnt : 1u;
}

__device__ __forceinline__ void xcd_barrier(const XcdBarrier& b) {
    asm volatile("s_waitcnt vmcnt(0)" ::: "memory");
    __syncthreads();
    if (threadIdx.x == 0) {
        unsigned* bar = b.bar;
        __builtin_amdgcn_s_waitcnt(0);
        unsigned nloc = b.st[0], nx = b.st[1];
        if (nloc == 0u) { xcd_barrier_complete(bar, b.x, nloc, nx); b.st[0] = nloc; b.st[1] = nx; }
        const unsigned old = xb_add(&bar[XB_XSUB(b.x)], 1u);
        const unsigned gen = old / nloc;
        if (old + 1u == (gen + 1u) * nloc) {
            __builtin_amdgcn_fence(__ATOMIC_RELEASE, "agent");
            asm volatile("s_waitcnt vmcnt(0)" ::: "memory");
            const unsigned og = xb_add(&bar[XB_TOP], 1u);
            const unsigned tg = og / nx;
            if (og + 1u == (tg + 1u) * nx) xb_add(&bar[XB_TOPGEN], 1u);
            else XB_SPIN(xb_ld(&bar[XB_TOPGEN]) == tg, bar);
            __builtin_amdgcn_fence(__ATOMIC_ACQUIRE, "agent");
            xb_add(&bar[XB_XGEN(b.x)], 1u);
            asm volatile("s_waitcnt vmcnt(0)" ::: "memory");
        } else {
            XB_SPIN(xb_ld(&bar[XB_XGEN(b.x)]) == gen, bar);
            __builtin_amdgcn_fence(__ATOMIC_ACQUIRE, "agent");
            asm volatile("s_waitcnt vmcnt(0)" ::: "memory");
        }
    }
    __syncthreads();
}


__device__ __forceinline__ void grid_barrier(unsigned* cnt, unsigned target) {
  asm volatile("s_waitcnt vmcnt(0)" ::: "memory");
  __syncthreads();
  if (tid_() == 0) {
    __builtin_amdgcn_fence(__ATOMIC_RELEASE, "agent");
    asm volatile("s_waitcnt vmcnt(0)" ::: "memory");
    __hip_atomic_fetch_add(cnt, 1u, __ATOMIC_RELAXED, __HIP_MEMORY_SCOPE_AGENT);
    unsigned spins = 0;
    while (__hip_atomic_load(cnt, __ATOMIC_RELAXED, __HIP_MEMORY_SCOPE_AGENT) < target) {
      __builtin_amdgcn_s_sleep(2);
      if (++spins > (1u << 24)) break;
    }
    __builtin_amdgcn_fence(__ATOMIC_ACQUIRE, "agent");
    asm volatile("s_waitcnt vmcnt(0)" ::: "memory");
  }
  __syncthreads();
}

__global__ void __launch_bounds__(256, 2) hybrid_megakernel(Params p, int ph0, int ph1) {
  __shared__ __attribute__((aligned(16))) char smem[SMEM_BYTES];
  cg::grid_group grid = cg::this_grid();
  volatile LAS unsigned* xst = (volatile LAS unsigned*)(smem + 66048);
  if (__builtin_amdgcn_workitem_id_x() == 0) { xst[0] = 0u; xst[1] = 0u; }
  __syncthreads();
  XcdBarrier xb; xb.bar = nullptr; xb.x = 0; xb.st = xst;
  for (int ph = ph0; ph < ph1; ++ph) {
    Params q = p;
    size_t zoff = 0;
    asm volatile("" : "+s"(zoff));
    q.ws = p.ws + zoff; q.out = p.out + zoff;
    run_phase(q, ph, smem);
#ifdef REPMASK
    if (ph > 0 && ph < NPHASE - 1 && ((REPMASK >> ((ph - 1) % 9)) & 1)) { grid.sync(); run_phase(q, ph, smem); }
#endif
    if (ph + 1 < ph1) {
      if (ph == ph0) { grid.sync(); xb = xcd_barrier_post((unsigned*)(p.ws + OFF_xbar), xst); }
      else xcd_barrier(xb);
    }
  }
}

extern "C" void kernel_launch(void* const* d_in, const int* in_sizes, int n_in, void* d_out, int out_size, void* d_ws,
                              size_t ws_size, hipStream_t stream) {
  static int grid_blocks = 0;
  if (!grid_blocks) {
    int dev = 0, cus = 0, per_cu = 0;
    hipGetDevice(&dev);
    hipDeviceGetAttribute(&cus, hipDeviceAttributeMultiprocessorCount, dev);
    hipOccupancyMaxActiveBlocksPerMultiprocessor(&per_cu, hybrid_megakernel, 256, 0);
    if (per_cu > 2) per_cu = 2;
    if (per_cu < 1) per_cu = 1;
    grid_blocks = cus * per_cu;
  }
  Params p{};
  const float* const* in = (const float* const*)d_in;
  p.x = in[0]; p.c = in[1]; p.ctx = in[2]; p.c_ctx = in[3]; p.w_ada = in[4]; p.b_ada = in[5]; p.g_norm1 = in[6];
  p.g_norm2 = in[7]; p.w_in = in[8]; p.g_q_norm = in[9]; p.w_uq = in[10]; p.g_kv_norm = in[11]; p.w_ukv = in[12];
  p.diff_lambda = in[13]; p.g_diff_norm = in[14]; p.hgrn_lb = in[15]; p.g_hgrn_norm = in[16]; p.w_out = in[17];
  p.w_gate = in[18]; p.w_up = in[19]; p.w_down = in[20]; p.g_final = in[21];
  p.out = (float*)d_out;
  p.ws = (char*)d_ws;
  if (WS_TOTAL > ws_size) { fprintf(stderr, "workspace too small: need %zu have %zu\n", (size_t)WS_TOTAL, ws_size); return; }
  int ph0 = 0, ph1 = NPHASE;
  void* args[] = {&p, &ph0, &ph1};
  hipError_t e = hipLaunchCooperativeKernel((void*)hybrid_megakernel, dim3(grid_blocks), dim3(256), args, 0, stream);
  if (e != hipSuccess) fprintf(stderr, "cooperative launch failed: %s (grid %d)\n", hipGetErrorString(e), grid_blocks);
}
```

```cpp
#include <hip/hip_runtime.h>
#include <hip/hip_cooperative_groups.h>
#include <cstdio>
namespace cg = cooperative_groups;

typedef __attribute__((ext_vector_type(8))) __bf16 bf8;
typedef __attribute__((ext_vector_type(4))) __bf16 bf4;
typedef __attribute__((ext_vector_type(4))) float f4;

#define XCD_BAR_WORDS_C 3456
#define NB 2
#define SEQ 8192
#define CTXL 256
#define PT 8448
#define NTOK 16896
#define DM 1024
#define INW 3744
#define INWP 3840
#define DFF 2816
#define NCH 132
#define LDH 1088
#define LDF 2880
#define LOG2E 1.4426950408889634f
#define EPSN 1e-6f
#define SMEM_BYTES 66064

constexpr size_t al256(size_t x) { return (x + 255) & ~(size_t)255; }
constexpr size_t OFF_xc = 0;
constexpr size_t OFF_mod = OFF_xc + al256((size_t)NB*CTXL*DM*4);
constexpr size_t OFF_rope = OFF_mod + al256((size_t)4*3*6144*4);
constexpr size_t OFF_llb = OFF_rope + al256(128*8*2*4);
constexpr size_t OFF_l1mlb = OFF_llb + al256(4*1024*4);
constexpr size_t OFF_lam = OFF_l1mlb + al256(4*1024*4);
constexpr size_t OFF_wt_in = OFF_lam + al256(256);
constexpr size_t OFF_wt_uq = OFF_wt_in + al256((size_t)INWP*LDH*2);
constexpr size_t OFF_wt_ukv = OFF_wt_uq + al256((size_t)384*256*2);
constexpr size_t OFF_wt_out = OFF_wt_ukv + al256((size_t)512*128*2);
constexpr size_t OFF_wt_gu = OFF_wt_out + al256((size_t)DM*LDH*2);
constexpr size_t OFF_wt_down = OFF_wt_gu + al256((size_t)2*DFF*LDH*2);
constexpr size_t OFF_hb = OFF_wt_down + al256((size_t)DM*LDF*2);
constexpr size_t OFF_cq = OFF_hb + al256((size_t)NTOK*LDH*2);
constexpr size_t OFF_ckv = OFF_cq + al256((size_t)NTOK*256*2);
constexpr size_t OFF_qm = OFF_ckv + al256((size_t)NTOK*128*2);
constexpr size_t OFF_km = OFF_qm + al256((size_t)NB*4*PT*96*2);
constexpr size_t OFF_vmt = OFF_km + al256((size_t)NB*4*PT*96*2);
constexpr size_t OFF_qd = OFF_vmt + al256((size_t)NB*4*64*PT*2);
constexpr size_t OFF_kd = OFF_qd + al256((size_t)NB*4*2*PT*32*2);
constexpr size_t OFF_vdt = OFF_kd + al256((size_t)NB*4*2*PT*32*2);
constexpr size_t OFF_hq = OFF_vdt + al256((size_t)NB*4*64*PT*2);
constexpr size_t OFF_hvt = OFF_hq + al256((size_t)NTOK*512*2);
constexpr size_t OFF_hg = OFF_hvt + al256((size_t)NB*8*64*PT*2);
constexpr size_t OFF_dk = OFF_hg + al256((size_t)NTOK*512*2);
constexpr size_t OFF_st = OFF_dk + al256((size_t)NB*8*2*NCH*64*4);
constexpr size_t OFF_lf = OFF_st + al256((size_t)NB*8*2*NCH*4096*2);
constexpr size_t OFF_ut = OFF_lf + al256((size_t)2*NTOK*512*4);
constexpr size_t OFF_xbar = OFF_ut + al256((size_t)NB*8*2*NCH*4096*4);
constexpr size_t WS_TOTAL_OLD = OFF_ut + al256((size_t)NB*8*2*NCH*4096*4);
constexpr size_t WS_TOTAL = OFF_xbar + al256((size_t)XCD_BAR_WORDS_C*4);
struct Params {
  const float *x, *c, *ctx, *c_ctx, *w_ada, *b_ada, *g_norm1, *g_norm2, *w_in, *g_q_norm, *w_uq, *g_kv_norm, *w_ukv,
      *diff_lambda, *g_diff_norm, *hgrn_lb, *g_hgrn_norm, *w_out, *w_gate, *w_up, *w_down, *g_final;
  float* out;
  char* ws;
  __device__ __forceinline__ float* xc() const { return (float*)(ws + OFF_xc); }
  __device__ __forceinline__ float* mod() const { return (float*)(ws + OFF_mod); }
  __device__ __forceinline__ float* rope() const { return (float*)(ws + OFF_rope); }
  __device__ __forceinline__ float* llb() const { return (float*)(ws + OFF_llb); }
  __device__ __forceinline__ float* l1mlb() const { return (float*)(ws + OFF_l1mlb); }
  __device__ __forceinline__ float* lam() const { return (float*)(ws + OFF_lam); }
  __device__ __forceinline__ __bf16* wt_in() const { return (__bf16*)(ws + OFF_wt_in); }
  __device__ __forceinline__ __bf16* wt_uq() const { return (__bf16*)(ws + OFF_wt_uq); }
  __device__ __forceinline__ __bf16* wt_ukv() const { return (__bf16*)(ws + OFF_wt_ukv); }
  __device__ __forceinline__ __bf16* wt_out() const { return (__bf16*)(ws + OFF_wt_out); }
  __device__ __forceinline__ __bf16* wt_gu() const { return (__bf16*)(ws + OFF_wt_gu); }
  __device__ __forceinline__ __bf16* wt_down() const { return (__bf16*)(ws + OFF_wt_down); }
  __device__ __forceinline__ __bf16* hb() const { return (__bf16*)(ws + OFF_hb); }
  __device__ __forceinline__ __bf16* cq() const { return (__bf16*)(ws + OFF_cq); }
  __device__ __forceinline__ __bf16* ckv() const { return (__bf16*)(ws + OFF_ckv); }
  __device__ __forceinline__ __bf16* qm() const { return (__bf16*)(ws + OFF_qm); }
  __device__ __forceinline__ __bf16* km() const { return (__bf16*)(ws + OFF_km); }
  __device__ __forceinline__ __bf16* vmt() const { return (__bf16*)(ws + OFF_vmt); }
  __device__ __forceinline__ __bf16* qd() const { return (__bf16*)(ws + OFF_qd); }
  __device__ __forceinline__ __bf16* kd() const { return (__bf16*)(ws + OFF_kd); }
  __device__ __forceinline__ __bf16* vdt() const { return (__bf16*)(ws + OFF_vdt); }
  __device__ __forceinline__ __bf16* hq() const { return (__bf16*)(ws + OFF_hq); }
  __device__ __forceinline__ __bf16* hvt() const { return (__bf16*)(ws + OFF_hvt); }
  __device__ __forceinline__ __bf16* hg() const { return (__bf16*)(ws + OFF_hg); }
  __device__ __forceinline__ float* dk() const { return (float*)(ws + OFF_dk); }
  __device__ __forceinline__ __bf16* st() const { return (__bf16*)(ws + OFF_st); }
  __device__ __forceinline__ float* lf() const { return (float*)(ws + OFF_lf); }
  __device__ __forceinline__ float* ut() const { return (float*)(ws + OFF_ut); }
  __device__ __forceinline__ __bf16* mix() const { return hb(); }
  __device__ __forceinline__ __bf16* act() const { return (__bf16*)lf(); }
};

__device__ __forceinline__ int tid_() { int t = __builtin_amdgcn_workitem_id_x(); asm volatile("" : "+v"(t)); return t; }
__device__ __forceinline__ int bid_() { int t = __builtin_amdgcn_workgroup_id_x(); asm volatile("" : "+s"(t)); return t; }
__device__ __forceinline__ float silu_f(float x) { return x * __builtin_amdgcn_rcpf(1.f + __expf(-x)); }
__device__ __forceinline__ float wave_sum(float v) {
  v += __uint_as_float(__builtin_amdgcn_update_dpp(0u, __float_as_uint(v), 0x128, 0xf, 0xf, false));
  v += __uint_as_float(__builtin_amdgcn_update_dpp(0u, __float_as_uint(v), 0x124, 0xf, 0xf, false));
  v += __uint_as_float(__builtin_amdgcn_update_dpp(0u, __float_as_uint(v), 0x122, 0xf, 0xf, false));
  v += __uint_as_float(__builtin_amdgcn_update_dpp(0u, __float_as_uint(v), 0x121, 0xf, 0xf, false));
  unsigned u = __float_as_uint(v);
  auto a = __builtin_amdgcn_permlane16_swap(u, u, false, false);
  float m = __uint_as_float(a[0]) + __uint_as_float(a[1]);
  unsigned w = __float_as_uint(m);
  auto b = __builtin_amdgcn_permlane32_swap(w, w, false, false);
  return __uint_as_float(b[0]) + __uint_as_float(b[1]);
}
__device__ __forceinline__ float* xrow(const Params& p, int tok) {
  int b = tok / PT, pp = tok - b * PT;
  return pp < CTXL ? p.xc() + (size_t)(b * CTXL + pp) * DM : p.out + (size_t)(b * SEQ + pp - CTXL) * DM;
}
__device__ __forceinline__ float log_forget(float z, float lb, float oml) {
  const float sg = __builtin_amdgcn_rcpf(1.f + __expf(-fmaxf(z, -80.f)));
  return __logf(lb + oml * sg);
}
__device__ __forceinline__ float rows_max(float x) {
  unsigned u = __float_as_uint(x);
  auto a = __builtin_amdgcn_permlane16_swap(u, u, false, false);
  float m = fmaxf(__uint_as_float(a[0]), __uint_as_float(a[1]));
  unsigned v = __float_as_uint(m);
  auto b = __builtin_amdgcn_permlane32_swap(v, v, false, false);
  return fmaxf(__uint_as_float(b[0]), __uint_as_float(b[1]));
}
__device__ __forceinline__ float rows_sum(float x) {
  unsigned u = __float_as_uint(x);
  auto a = __builtin_amdgcn_permlane16_swap(u, u, false, false);
  float m = __uint_as_float(a[0]) + __uint_as_float(a[1]);
  unsigned v = __float_as_uint(m);
  auto b = __builtin_amdgcn_permlane32_swap(v, v, false, false);
  return __uint_as_float(b[0]) + __uint_as_float(b[1]);
}
__device__ __forceinline__ f4 mfma16(bf8 a, bf8 b, f4 c) { return __builtin_amdgcn_mfma_f32_16x16x32_bf16(a, b, c, 0, 0, 0); }

__device__ __forceinline__ void phase0(const Params& p, char* smem) {
  const int tid = tid_();
  const int gsz = gridDim.x * 256, gtid = bid_() * 256 + tid;
  {
    const float4* xs = (const float4*)p.x; float4* xo = (float4*)p.out;
    for (int i = gtid; i < NB * SEQ * DM / 4; i += gsz) xo[i] = xs[i];
    const float4* cs = (const float4*)p.ctx; float4* co = (float4*)p.xc();
    for (int i = gtid; i < NB * CTXL * DM / 4; i += gsz) co[i] = cs[i];
  }
  if (gtid < 1024) {
    int pos = gtid >> 3, f = gtid & 7;
    float freq = powf(10000.f, -(float)f / 8.f);
    float ang = (float)pos * freq, s, c;
    sincosf(ang, &s, &c);
    p.rope()[gtid * 2] = c; p.rope()[gtid * 2 + 1] = s;
  } else if (gtid < 2048) {
    int n = gtid - 1024;
    float r0 = p.hgrn_lb[n], r1 = p.hgrn_lb[1024 + n], r2 = p.hgrn_lb[2048 + n], r3 = p.hgrn_lb[3072 + n];
    float m = fmaxf(fmaxf(r0, r1), fmaxf(r2, r3));
    float e0 = expf(r0 - m), e1 = expf(r1 - m), e2 = expf(r2 - m), e3 = expf(r3 - m);
    float s = e0 + e1 + e2 + e3;
    float p0 = e0 / s, p1 = e1 / s, p2 = e2 / s, p3 = e3 / s;
    float c0 = p0, c1 = c0 + p1, c2 = c1 + p2, c3 = c2 + p3;
    p.llb()[n] = 0.f; p.l1mlb()[n] = 1.f;
    p.llb()[1024 + n] = c1 - c0; p.l1mlb()[1024 + n] = 1.f - (c1 - c0);
    p.llb()[2048 + n] = c2 - c0; p.l1mlb()[2048 + n] = 1.f - (c2 - c0);
    p.llb()[3072 + n] = c3 - c0; p.l1mlb()[3072 + n] = 1.f - (c3 - c0);
  } else if (gtid >= 4096 && gtid < 4096 + XCD_BAR_WORDS_C) {
    ((unsigned*)(p.ws + OFF_xbar))[gtid - 4096] = 0u;
  } else if (gtid == 2052) {
    *(unsigned*)(p.ws + OFF_lam + 128) = 0u;
  } else if (gtid < 2052) {
    int l = gtid - 2048;
    const float* d = p.diff_lambda + l * 128;
    float s1 = 0.f, s2 = 0.f;
    for (int i = 0; i < 32; ++i) { s1 += d[i] * d[32 + i]; s2 += d[64 + i] * d[96 + i]; }
    float li = 0.8f - 0.6f * expf(-0.3f * (float)l);
    p.lam()[l] = expf(s1) - expf(s2) + li;
  }
  float* sl = (float*)smem;
  float* red = sl + 3072;
  bool have = false;
  for (int item = bid_(); item < 768; item += gridDim.x) {
    if (!have) {
      for (int i = tid; i < 1024; i += 256) {
        sl[i] = silu_f(p.c[i]); sl[1024 + i] = silu_f(p.c[1024 + i]); sl[2048 + i] = silu_f(p.c_ctx[i]);
      }
      have = true;
      __syncthreads();
    }
    int l = item / 192, n0 = (item % 192) * 32;
    int col = tid & 31, kg = tid >> 5;
    const float* W = p.w_ada + (size_t)l * DM * 6144 + n0 + col;
    float a0 = 0.f, a1 = 0.f, a2 = 0.f;
#pragma unroll 8
    for (int k = kg * 128; k < kg * 128 + 128; ++k) {
      float w = W[(size_t)k * 6144];
      a0 += sl[k] * w; a1 += sl[1024 + k] * w; a2 += sl[2048 + k] * w;
    }
    red[(kg * 3 + 0) * 32 + col] = a0; red[(kg * 3 + 1) * 32 + col] = a1; red[(kg * 3 + 2) * 32 + col] = a2;
    __syncthreads();
    if (tid < 96) {
      int v = tid >> 5, cc = tid & 31;
      float s = p.b_ada[l * 6144 + n0 + cc];
#pragma unroll
      for (int q = 0; q < 8; ++q) s += red[(q * 3 + v) * 32 + cc];
      p.mod()[(size_t)(l * 3 + v) * 6144 + n0 + cc] = s;
    }
    __syncthreads();
  }
}

struct ConvD { const float* srcp; size_t sstride; __bf16* dstp; const float* ksp; };

__device__ __forceinline__ ConvD conv_decode(const Params& p, int l, int it, int tid) {
  const float* src; int N, ntn, mode = 0, dld; __bf16* dst; const float* ks = nullptr;
  if (it < 1872) { src = p.w_in + (size_t)l * DM * INW; N = INW; ntn = 117; dst = p.wt_in(); dld = LDH; }
  else if (it < 1920) { it -= 1872; src = p.w_uq + (size_t)l * 256 * 384; N = 384; ntn = 12; dst = p.wt_uq(); dld = 256; ks = p.g_q_norm + l * 256; }
  else if (it < 1952) { it -= 1920; src = p.w_ukv + (size_t)l * 128 * 512; N = 512; ntn = 16; dst = p.wt_ukv(); dld = 128; ks = p.g_kv_norm + l * 128; }
  else if (it < 2464) { it -= 1952; src = p.w_out + (size_t)l * DM * DM; N = DM; ntn = 32; dst = p.wt_out(); dld = LDH; }
  else if (it < 3872) { it -= 2464; src = p.w_gate + (size_t)l * DM * DFF; N = DFF; ntn = 88; dst = p.wt_gu(); mode = 1; dld = LDH; }
  else if (it < 5280) { it -= 3872; src = p.w_up + (size_t)l * DM * DFF; N = DFF; ntn = 88; dst = p.wt_gu(); mode = 2; dld = LDH; }
  else { it -= 5280; src = p.w_down + (size_t)l * DFF * DM; N = DM; ntn = 32; dst = p.wt_down(); dld = LDF; }
  const int kt = it / ntn, nt = it - kt * ntn;
  ConvD d;
  d.srcp = src + (size_t)(kt * 64 + (tid >> 3)) * N + nt * 32 + (tid & 7) * 4;
  d.sstride = (size_t)32 * N;
  const int n = nt * 32 + (tid >> 3);
  int row = n;
  if (mode == 1) row = (n >> 4) * 32 + (n & 15);
  else if (mode == 2) row = (n >> 4) * 32 + 16 + (n & 15);
  d.dstp = dst + (size_t)row * dld + kt * 64 + (tid & 7) * 8;
  d.ksp = ks ? ks + kt * 64 + (tid & 7) * 8 : nullptr;
  return d;
}

__device__ __forceinline__ void conv_items(const Params& p, int l, int first, int step, char* smem) {
  float* tile = (float*)smem;
  const int tid = tid_();
  if (first >= 6688) return;
  ConvD cur = conv_decode(p, l, first, tid);
  float4 v0 = *(const float4*)(cur.srcp), v1 = *(const float4*)(cur.srcp + cur.sstride);
  for (int it = first; it < 6688; it += step) {
    const int itn = it + step < 6688 ? it + step : it;
    const ConvD nxt = conv_decode(p, l, itn, tid);
    const float4 n0 = *(const float4*)(nxt.srcp), n1 = *(const float4*)(nxt.srcp + nxt.sstride);
    __syncthreads();
    {
      const int r = tid >> 3, c4 = tid & 7;
      float* t = tile + r * 33 + c4 * 4;
      t[0] = v0.x; t[1] = v0.y; t[2] = v0.z; t[3] = v0.w;
      t += 32 * 33;
      t[0] = v1.x; t[1] = v1.y; t[2] = v1.z; t[3] = v1.w;
    }
    __syncthreads();
    {
      const int nr = tid >> 3, kc = tid & 7;
      bf8 o;
#pragma unroll
      for (int j = 0; j < 8; ++j) {
        float v = tile[(kc * 8 + j) * 33 + nr];
        if (cur.ksp) v *= cur.ksp[j];
        o[j] = (__bf16)v;
      }
      *(bf8*)cur.dstp = o;
    }
    cur = nxt; v0 = n0; v1 = n1;
  }
}

__device__ __forceinline__ void norm_item(const Params& p, int l, int which, int item) {
  const int lane = tid_() & 63, wave = tid_() >> 6;
  const int tok0 = item * 16 + wave * 4;
  const int b = tok0 / PT, pp = tok0 - b * PT;
  const int v = pp < CTXL ? 2 : b;
  const float* g = (which ? p.g_norm2 : p.g_norm1) + l * DM;
  const float* md = p.mod() + (size_t)(l * 3 + v) * 6144 + (which ? 3072 : 0);
  f4 a[4], sh[4];
#pragma unroll
  for (int i = 0; i < 4; ++i) {
    int k = i * 256 + lane * 4;
    f4 gg = *(const f4*)(g + k), sc = *(const f4*)(md + 1024 + k);
    sh[i] = *(const f4*)(md + k);
    a[i] = gg * (1.f + sc);
  }
  f4 xv[4][4];
#pragma unroll
  for (int r = 0; r < 4; ++r) {
    const float* xr = xrow(p, tok0 + r);
#pragma unroll
    for (int i = 0; i < 4; ++i) xv[r][i] = *(const f4*)(xr + i * 256 + lane * 4);
  }
#pragma unroll
  for (int r = 0; r < 4; ++r) {
    float ss = 0.f;
#pragma unroll
    for (int i = 0; i < 4; ++i)
      ss += xv[r][i][0] * xv[r][i][0] + xv[r][i][1] * xv[r][i][1] + xv[r][i][2] * xv[r][i][2] + xv[r][i][3] * xv[r][i][3];
    ss = wave_sum(ss);
    float rstd = rsqrtf(ss * (1.f / DM) + EPSN);
#pragma unroll
    for (int i = 0; i < 4; ++i) {
      f4 h = xv[r][i] * rstd * a[i] + sh[i];
      bf4 o; o[0] = (__bf16)h[0]; o[1] = (__bf16)h[1]; o[2] = (__bf16)h[2]; o[3] = (__bf16)h[3];
      *(bf4*)(p.hb() + (size_t)(tok0 + r) * LDH + i * 256 + lane * 4) = o;
    }
  }
}

__device__ __forceinline__ void final_norm_item(const Params& p, int item) {
  const int lane = tid_() & 63, wave = tid_() >> 6;
  const int row0 = item * 16 + wave * 4;
  f4 g[4];
#pragma unroll
  for (int i = 0; i < 4; ++i) g[i] = *(const f4*)(p.g_final + i * 256 + lane * 4);
  f4 xv[4][4];
#pragma unroll
  for (int r = 0; r < 4; ++r)
#pragma unroll
    for (int i = 0; i < 4; ++i) xv[r][i] = *(const f4*)(p.out + (size_t)(row0 + r) * DM + i * 256 + lane * 4);
#pragma unroll
  for (int r = 0; r < 4; ++r) {
    float ss = 0.f;
#pragma unroll
    for (int i = 0; i < 4; ++i)
      ss += xv[r][i][0] * xv[r][i][0] + xv[r][i][1] * xv[r][i][1] + xv[r][i][2] * xv[r][i][2] + xv[r][i][3] * xv[r][i][3];
    ss = wave_sum(ss);
    float rstd = rsqrtf(ss * (1.f / DM) + EPSN);
#pragma unroll
    for (int i = 0; i < 4; ++i) *(f4*)(p.out + (size_t)(row0 + r) * DM + i * 256 + lane * 4) = xv[r][i] * rstd * g[i];
  }
}

#define GLD 72
enum { EPI_IN = 0, EPI_UQ, EPI_UKV, EPI_OUT, EPI_UP, EPI_DOWN, EPI_OUT_AT, EPI_DOWN_AT };

__device__ __forceinline__ f4 rope4(const Params& p, f4 a, int prow, int axis, int r) {
  f4 o;
#pragma unroll
  for (int reg = 0; reg < 4; ++reg) {
    float pv = __uint_as_float(__builtin_amdgcn_update_dpp(0u, __float_as_uint(a[reg]), 0x128, 0xf, 0xf, false));
    int t = prow + reg - CTXL;
    int pos = axis ? (t & 63) : (t >> 6);
    float2 cs = ((const float2*)p.rope())[pos * 8 + (r & 7)];
    o[reg] = (r & 8) ? a[reg] * cs.x + pv * cs.y : a[reg] * cs.x - pv * cs.y;
  }
  return o;
}
__device__ __forceinline__ bf4 pack4(f4 a) {
  bf4 o; o[0] = (__bf16)a[0]; o[1] = (__bf16)a[1]; o[2] = (__bf16)a[2]; o[3] = (__bf16)a[3];
  return o;
}

template <int EPI>
__device__ __forceinline__ void gemm_epilogue(const Params& p, int l, f4 (&acc)[4][4], int m0, int n0, int wm, int wn, int lane,
                                              const float* rowss) {
  const int r = lane & 15, g = lane >> 4;
  const int b = m0 / PT;
  const int pp0 = m0 - b * PT;
  const bool lat = pp0 >= CTXL;
  const int v = lat ? b : 2;
  const float* md = p.mod() + (size_t)(l * 3 + v) * 6144;
  const int prow0 = pp0 + wm * 64 + 4 * g;
  const int tok0 = b * PT + prow0;
  constexpr int STEP = (EPI == EPI_UP) ? 2 : 1;
  if constexpr (EPI == EPI_OUT || EPI == EPI_DOWN) {
    float* xb = (lat ? p.out + (size_t)(b * SEQ + prow0 - CTXL) * DM : p.xc() + (size_t)(b * CTXL + prow0) * DM) + n0 + wn * 64 + r;
    float gt[4];
    f4 xin[4][4];
#pragma unroll
    for (int ni = 0; ni < 4; ++ni) gt[ni] = md[(EPI == EPI_OUT ? 2048 : 5120) + n0 + wn * 64 + ni * 16 + r];
#pragma unroll
    for (int mi = 0; mi < 4; ++mi)
#pragma unroll
      for (int ni = 0; ni < 4; ++ni)
#pragma unroll
        for (int q = 0; q < 4; ++q) xin[mi][ni][q] = xb[(size_t)(mi * 16 + q) * DM + ni * 16];
#pragma unroll
    for (int mi = 0; mi < 4; ++mi)
#pragma unroll
      for (int ni = 0; ni < 4; ++ni)
#pragma unroll
        for (int q = 0; q < 4; ++q) xb[(size_t)(mi * 16 + q) * DM + ni * 16] = xin[mi][ni][q] + gt[ni] * acc[mi][ni][q];
    return;
  }
  float tla[4] = {0.f, 0.f, 0.f, 0.f}, tl1[4] = {0.f, 0.f, 0.f, 0.f};
  if constexpr (EPI == EPI_IN) {
#pragma unroll
    for (int ni = 0; ni < 4; ++ni) {
      const int c0 = n0 + wn * 64 + ni * 16;
      if (c0 >= 1696 && c0 < 2720) {
        const int dir = c0 >= 2208;
        const int n1 = c0 + r - (dir ? 2208 : 1696);
        tla[ni] = p.llb()[(l * 2 + dir) * 512 + n1];
        tl1[ni] = p.l1mlb()[(l * 2 + dir) * 512 + n1];
      }
    }
  }
#pragma unroll 1
  for (int ni = 0; ni < 4; ni += STEP) {
    const int col0 = n0 + wn * 64 + ni * 16;
    const int col = col0 + r;
    if constexpr (EPI == EPI_IN) {
      if (col0 < 384) {
        __bf16* dst = col0 < 256 ? p.cq() + col : p.ckv() + (col - 256);
        const int ld = col0 < 256 ? 256 : 128;
#pragma unroll
        for (int mi = 0; mi < 4; ++mi)
#pragma unroll
          for (int q = 0; q < 4; ++q) dst[(size_t)(tok0 + mi * 16 + q) * ld] = (__bf16)acc[mi][0][q];
      } else if (col0 < 416) {
        f4 v[4];
#pragma unroll
        for (int mi = 0; mi < 4; ++mi) {
          v[mi] = acc[mi][0];
          if (lat) v[mi] = rope4(p, v[mi], prow0 + mi * 16, (col0 - 384) >> 4, r);
        }
#pragma unroll
        for (int mi = 0; mi < 4; ++mi)
#pragma unroll
          for (int h = 0; h < 4; ++h)
#pragma unroll
            for (int q = 0; q < 4; ++q) p.km()[((size_t)(b * 4 + h) * PT + prow0 + mi * 16 + q) * 96 + 64 + col - 384] = (__bf16)v[mi][q];
      } else if (col0 < 928) {
        const bool isq = col0 < 672;
        const int n1 = col - (isq ? 416 : 672);
        const int head = n1 >> 6, map = (n1 >> 5) & 1, d = n1 & 31;
        __bf16* dst = (isq ? p.qd() : p.kd()) + ((size_t)((b * 4 + head) * 2 + map) * PT) * 32 + d;
        const float sc = isq ? 0.17677669529663687f * LOG2E : 1.f;
        f4 v[4];
#pragma unroll
        for (int mi = 0; mi < 4; ++mi) {
          v[mi] = acc[mi][0];
          if (lat) v[mi] = rope4(p, v[mi], prow0 + mi * 16, (n1 >> 4) & 1, r);
        }
#pragma unroll
        for (int mi = 0; mi < 4; ++mi)
#pragma unroll
          for (int q = 0; q < 4; ++q) dst[(size_t)(prow0 + mi * 16 + q) * 32] = (__bf16)(v[mi][q] * sc);
      } else if (col0 < 1184 || (col0 >= 2720 && col0 < 3232)) {
        const bool isd = col0 < 1184;
        const int n1 = col - (isd ? 928 : 2720);
        __bf16* dst = isd ? p.vdt() + ((size_t)(b * 4 + (n1 >> 6)) * 64 + (n1 & 63)) * PT
                          : p.hvt() + ((size_t)(b * 8 + (n1 >> 6)) * 64 + (n1 & 63)) * PT;
#pragma unroll
        for (int mi = 0; mi < 4; ++mi) *(bf4*)(dst + prow0 + mi * 16) = pack4(acc[mi][0]);
      } else if (col0 < 1696 || (col0 >= 3232 && col0 < INW)) {
        const bool ish = col0 < 1696;
        __bf16* dst = ish ? p.hq() + (col - 1184) : p.hg() + (col - 3232);
#pragma unroll
        for (int mi = 0; mi < 4; ++mi)
#pragma unroll
          for (int q = 0; q < 4; ++q) dst[(size_t)(tok0 + mi * 16 + q) * 512] = (__bf16)silu_f(acc[mi][0][q]);
      } else if (col0 < 2720) {
        const int dir = col0 >= 2208;
        const int n1 = col - (dir ? 2208 : 1696);
        const float la = tla[0], l1m = tl1[0];
        float* dst = p.lf() + (size_t)dir * NTOK * 512 + n1;
#pragma unroll
        for (int mi = 0; mi < 4; ++mi)
#pragma unroll
          for (int q = 0; q < 4; ++q) dst[(size_t)(tok0 + mi * 16 + q) * 512] = log_forget(acc[mi][0][q], la, l1m);
      }
    } else if constexpr (EPI == EPI_UQ) {
      const int head = col0 / 96, d0 = col0 - head * 96;
      const float sc = 0.10206207261596577f * LOG2E;
      __bf16* dst = p.qm() + ((size_t)(b * 4 + head) * PT) * 96 + d0 + r;
      f4 v[4];
#pragma unroll
      for (int mi = 0; mi < 4; ++mi) {
        f4 a = acc[mi][0];
#pragma unroll
        for (int q = 0; q < 4; ++q) a[q] *= rsqrtf(rowss[wm * 64 + mi * 16 + 4 * g + q] * (1.f / 256.f) + EPSN);
        if (d0 >= 64 && lat) a = rope4(p, a, prow0 + mi * 16, (d0 - 64) >> 4, r);
        v[mi] = a;
      }
#pragma unroll
      for (int mi = 0; mi < 4; ++mi)
#pragma unroll
        for (int q = 0; q < 4; ++q) dst[(size_t)(prow0 + mi * 16 + q) * 96] = (__bf16)(v[mi][q] * sc);
    } else if constexpr (EPI == EPI_UKV) {
      const int head = col >> 7, d = col & 127;
#pragma unroll
      for (int mi = 0; mi < 4; ++mi) {
        f4 a = acc[mi][0];
        const int prow = prow0 + mi * 16;
#pragma unroll
        for (int q = 0; q < 4; ++q) a[q] *= rsqrtf(rowss[wm * 64 + mi * 16 + 4 * g + q] * (1.f / 128.f) + EPSN);
        if ((col0 & 127) < 64) {
#pragma unroll
          for (int q = 0; q < 4; ++q) p.km()[((size_t)(b * 4 + head) * PT + prow + q) * 96 + d] = (__bf16)a[q];
        } else {
          *(bf4*)(p.vmt() + ((size_t)(b * 4 + head) * 64 + d - 64) * PT + prow) = pack4(a);
        }
      }
    } else if constexpr (EPI == EPI_OUT || EPI == EPI_DOWN) {
    } else if constexpr (EPI == EPI_OUT_AT || EPI == EPI_DOWN_AT) {
      const float gt = md[(EPI == EPI_OUT_AT ? 2048 : 5120) + col];
      float* xb = (lat ? p.out + (size_t)(b * SEQ + prow0 - CTXL) * DM : p.xc() + (size_t)(b * CTXL + prow0) * DM) + col;
#pragma unroll
      for (int mi = 0; mi < 4; ++mi)
#pragma unroll
        for (int q = 0; q < 4; ++q) atomicAdd(xb + (size_t)(mi * 16 + q) * DM, gt * acc[mi][0][q]);
    } else if constexpr (EPI == EPI_UP) {
      const int n = (col0 >> 5) * 16 + r;
#pragma unroll
      for (int mi = 0; mi < 4; ++mi)
#pragma unroll
        for (int q = 0; q < 4; ++q)
          p.act()[(size_t)(tok0 + mi * 16 + q) * LDF + n] = (__bf16)(silu_f(acc[mi][0][q]) * acc[mi][1][q]);
    }
#pragma unroll
    for (int mi = 0; mi < 4; ++mi) {
      if constexpr (STEP == 1) { acc[mi][0] = acc[mi][1]; acc[mi][1] = acc[mi][2]; acc[mi][2] = acc[mi][3]; }
      else { acc[mi][0] = acc[mi][2]; acc[mi][1] = acc[mi][3]; }
    }
    tla[0] = tla[1]; tla[1] = tla[2]; tla[2] = tla[3]; tl1[0] = tl1[1]; tl1[1] = tl1[2]; tl1[2] = tl1[3];
  }
}

#define RAW_BARRIER() do { asm volatile("s_waitcnt lgkmcnt(0)" ::: "memory"); __builtin_amdgcn_s_barrier(); } while (0)

template <int EPI, bool ROWSS>
__device__ __forceinline__ void gemm_tile(const Params& p, int l, const __bf16* __restrict__ A, int lda, const __bf16* __restrict__ Bt, int ldb, int K,
                          int m0, int n0, char* smem, bool pre = false, bool has_next = false, int m0n = 0, int n0n = 0) {
  __bf16* S0 = (__bf16*)smem;
  float* rowss = (float*)(smem + 65536);
  const int tid = tid_(), lane = tid & 63, wave = tid >> 6;
  const int wm = wave >> 1, wn = wave & 1, r = lane & 15, g = lane >> 4;
  f4 acc[4][4];
#pragma unroll
  for (int i = 0; i < 4; ++i)
#pragma unroll
    for (int j = 0; j < 4; ++j) acc[i][j] = f4{0.f, 0.f, 0.f, 0.f};
  if constexpr (ROWSS) {
    const int row = tid >> 1, half = tid & 1;
    const __bf16* rp = A + (size_t)(m0 + row) * lda + half * (K >> 1);
    float sq = 0.f;
    for (int c = 0; c < (K >> 4); ++c) {
      bf8 v = *(const bf8*)(rp + c * 8);
#pragma unroll
      for (int j = 0; j < 8; ++j) { float f = (float)v[j]; sq += f * f; }
    }
    sq += __shfl_xor(sq, 1);
    __syncthreads();
    if (!half) rowss[row] = sq;
  }
  const int lrow = lane >> 3;
  const int sz = (lane >> 4);
  const __bf16* gaw[4]; const __bf16* gbw[4];
#pragma unroll
  for (int i = 0; i < 4; ++i) {
    const int rg = wave + 4 * i;
    const int row = rg * 8 + lrow;
    const int cl = (lane & 7) ^ (((rg & 1) * 4 + sz) & 7);
    gaw[i] = A + (size_t)(m0 + row) * lda + cl * 8;
    gbw[i] = Bt + (size_t)(n0 + row) * ldb + cl * 8;
  }
  const int aoff = (wm * 64 + r) * 64, boff = 8192 + (wn * 64 + r) * 64;
  const int sw = r >> 1;
  const int KT = K / 64;
  if (!pre) {
    __syncthreads();
#pragma unroll
    for (int i = 0; i < 4; ++i) {
      __builtin_amdgcn_global_load_lds((const unsigned*)(gaw[i]), (unsigned*)(S0 + (wave + 4 * i) * 512), 16, 0, 0);
      __builtin_amdgcn_global_load_lds((const unsigned*)(gbw[i]), (unsigned*)(S0 + 8192 + (wave + 4 * i) * 512), 16, 0, 0);
    }
  }
  asm volatile("s_waitcnt vmcnt(0)" ::: "memory");
  RAW_BARRIER();
  for (int kt = 0; kt < KT; ++kt) {
    const __bf16* Sc = S0 + (kt & 1) * 16384;
    __bf16* Sn = S0 + ((kt + 1) & 1) * 16384;
    if (kt + 1 < KT) {
#pragma unroll
      for (int i = 0; i < 4; ++i) {
        __builtin_amdgcn_global_load_lds((const unsigned*)(gaw[i] + (kt + 1) * 64), (unsigned*)(Sn + (wave + 4 * i) * 512), 16, 0, 0);
        __builtin_amdgcn_global_load_lds((const unsigned*)(gbw[i] + (kt + 1) * 64), (unsigned*)(Sn + 8192 + (wave + 4 * i) * 512), 16, 0, 0);
      }
    }
    {
      bf8 af0[4], bf0[4], af1[4], bf1[4];
      const int ch0 = ((0 * 4 + g) ^ sw) * 8, ch1 = ((1 * 4 + g) ^ sw) * 8;
#pragma unroll
      for (int i = 0; i < 4; ++i) {
        af0[i] = *(const bf8*)(Sc + aoff + i * 1024 + ch0);
        bf0[i] = *(const bf8*)(Sc + boff + i * 1024 + ch0);
      }
#pragma unroll
      for (int i = 0; i < 4; ++i) {
        af1[i] = *(const bf8*)(Sc + aoff + i * 1024 + ch1);
        bf1[i] = *(const bf8*)(Sc + boff + i * 1024 + ch1);
      }
      __builtin_amdgcn_s_setprio(1);
#pragma unroll
      for (int i = 0; i < 4; ++i)
#pragma unroll
        for (int j = 0; j < 4; ++j) acc[i][j] = mfma16(af0[i], bf0[j], acc[i][j]);
#pragma unroll
      for (int i = 0; i < 4; ++i)
#pragma unroll
        for (int j = 0; j < 4; ++j) acc[i][j] = mfma16(af1[i], bf1[j], acc[i][j]);
      __builtin_amdgcn_s_setprio(0);
      __builtin_amdgcn_sched_group_barrier(0x100, 8, 0);
#pragma unroll
      for (int i = 0; i < 8; ++i) {
        __builtin_amdgcn_sched_group_barrier(0x008, 1, 0);
        __builtin_amdgcn_sched_group_barrier(0x100, 1, 0);
      }
      __builtin_amdgcn_sched_group_barrier(0x008, 24, 0);
    }
    asm volatile("s_waitcnt vmcnt(0)" ::: "memory");
    RAW_BARRIER();
  }
  if (has_next) {
#pragma unroll
    for (int i = 0; i < 4; ++i) {
      const int rg = wave + 4 * i;
      const int row = rg * 8 + lrow;
      const int cl = (lane & 7) ^ (((rg & 1) * 4 + sz) & 7);
      __builtin_amdgcn_global_load_lds((const unsigned*)(A + (size_t)(m0n + row) * lda + cl * 8), (unsigned*)(S0 + rg * 512), 16, 0, 0);
      __builtin_amdgcn_global_load_lds((const unsigned*)(Bt + (size_t)(n0n + row) * ldb + cl * 8), (unsigned*)(S0 + 8192 + rg * 512), 16, 0, 0);
    }
  }
  gemm_epilogue<EPI>(p, l, acc, m0, n0, wm, wn, lane, rowss);
}

__device__ __forceinline__ int mtile_count(int l) { return l < 3 ? 132 : 128; }
__device__ __forceinline__ int mtile_index(int l, int i) { return l < 3 ? i : (i >> 6) * 66 + 2 + (i & 63); }

__device__ __forceinline__ bool gemm_pick(int step, int bid, int G, int MT, int NT, int W, int& mt, int& nt) {
  const int C = G >> 3;
  const int L = (step * 8 + (bid & 7)) * C + (bid >> 3);
  if (L >= MT * NT) return false;
  const int s = L / (W * MT), rem = L - s * W * MT;
  mt = rem / W; nt = s * W + (rem - mt * W);
  return true;
}

template <int DQK, int NMAP>
__device__ __forceinline__ void attn_item(const Params& p, int l, const __bf16* __restrict__ Q, const __bf16* __restrict__ Kp,
                          const __bf16* __restrict__ Vt, int b, int h, int q0, int nkeys, char* smem) {
  constexpr int KLD = DQK + 8;
  constexpr int KCH = DQK / 8;
  constexpr int NKC = NMAP * 64 * KCH / 256;
  constexpr int NKS = DQK / 32;
  __bf16* Ks = (__bf16*)smem;
  __bf16* Vs = Ks + NMAP * 64 * KLD;
  const int tid = tid_(), lane = tid & 63, wave = tid >> 6, r = lane & 15, g = lane >> 4;
  const __bf16* Qb = Q + (size_t)((b * 4 + h) * NMAP) * PT * DQK;
  const __bf16* Kb = Kp + (size_t)((b * 4 + h) * NMAP) * PT * DQK;
  const __bf16* Vb = Vt + (size_t)((b * 4 + h) * 64) * PT;

  bf8 qf[NMAP][2][NKS];
#pragma unroll
  for (int mp = 0; mp < NMAP; ++mp)
#pragma unroll
    for (int qt = 0; qt < 2; ++qt)
#pragma unroll
      for (int ks = 0; ks < NKS; ++ks)
        qf[mp][qt][ks] = *(const bf8*)(Qb + ((size_t)mp * PT + q0 + wave * 32 + qt * 16 + r) * DQK + ks * 32 + g * 8);

  f4 o[NMAP][2][4];
  float mrun[NMAP][2], lsum[NMAP][2];
  f4 negm[NMAP][2];
#pragma unroll
  for (int mp = 0; mp < NMAP; ++mp)
#pragma unroll
    for (int qt = 0; qt < 2; ++qt) {
      mrun[mp][qt] = 0.f; lsum[mp][qt] = 0.f; negm[mp][qt] = f4{0.f, 0.f, 0.f, 0.f};
#pragma unroll
      for (int d = 0; d < 4; ++d) o[mp][qt][d] = f4{0.f, 0.f, 0.f, 0.f};
    }

  int koff_g[NKC], koff_s[NKC];
#pragma unroll
  for (int i = 0; i < NKC; ++i) {
    int c = tid + 256 * i;
    int mp = c / (64 * KCH), rem = c - mp * 64 * KCH;
    int row = rem / KCH, kc = rem - row * KCH;
    koff_g[i] = (mp * PT + row) * DQK + kc * 8;
    koff_s[i] = (mp * 64 + row) * KLD + kc * 8;
  }
  bf8 rk[NKC], rv[2];
  const int nkb = nkeys / 64;
#pragma unroll
  for (int i = 0; i < NKC; ++i) rk[i] = *(const bf8*)(Kb + koff_g[i]);
#pragma unroll
  for (int i = 0; i < 2; ++i) rv[i] = *(const bf8*)(Vb + (size_t)((tid >> 3) + 32 * i) * PT + (tid & 7) * 8);

  for (int kb = 0; kb < nkb; ++kb) {
    __syncthreads();
#pragma unroll
    for (int i = 0; i < NKC; ++i) *(bf8*)(Ks + koff_s[i]) = rk[i];
#pragma unroll
    for (int i = 0; i < 2; ++i) *(bf8*)(Vs + ((tid >> 3) + 32 * i) * 72 + (tid & 7) * 8) = rv[i];
    __syncthreads();
    if (kb + 1 < nkb) {
#pragma unroll
      for (int i = 0; i < NKC; ++i) rk[i] = *(const bf8*)(Kb + koff_g[i] + (size_t)(kb + 1) * 64 * DQK);
#pragma unroll
      for (int i = 0; i < 2; ++i) rv[i] = *(const bf8*)(Vb + (size_t)((tid >> 3) + 32 * i) * PT + (kb + 1) * 64 + (tid & 7) * 8);
    }
    f4 s[NMAP][2][2][2];
    {
      bf8 kfr[NMAP][2][2][NKS];
#pragma unroll
      for (int mp = 0; mp < NMAP; ++mp)
#pragma unroll
        for (int m = 0; m < 2; ++m)
#pragma unroll
          for (int tp = 0; tp < 2; ++tp) {
            const int krow = 32 * m + 8 * (r >> 2) + 4 * tp + (r & 3);
#pragma unroll
            for (int ks = 0; ks < NKS; ++ks) kfr[mp][m][tp][ks] = *(const bf8*)(Ks + (mp * 64 + krow) * KLD + ks * 32 + g * 8);
          }
      __builtin_amdgcn_s_setprio(1);
#pragma unroll
      for (int mp = 0; mp < NMAP; ++mp)
#pragma unroll
        for (int m = 0; m < 2; ++m)
#pragma unroll
          for (int tp = 0; tp < 2; ++tp) {
            f4 s0 = negm[mp][0], s1 = negm[mp][1];
#pragma unroll
            for (int ks = 0; ks < NKS; ++ks) {
              s0 = mfma16(kfr[mp][m][tp][ks], qf[mp][0][ks], s0);
              s1 = mfma16(kfr[mp][m][tp][ks], qf[mp][1][ks], s1);
            }
            s[mp][0][m][tp] = s0; s[mp][1][m][tp] = s1;
          }
      __builtin_amdgcn_s_setprio(0);
    }
    bf8 pf[NMAP][2][2];
#pragma unroll
    for (int mp = 0; mp < NMAP; ++mp)
#pragma unroll
      for (int qt = 0; qt < 2; ++qt) {
        float ps = 0.f;
#pragma unroll
        for (int m = 0; m < 2; ++m) {
          bf8 pk;
#pragma unroll
          for (int tp = 0; tp < 2; ++tp)
#pragma unroll
            for (int q = 0; q < 4; ++q) {
              float e = __builtin_amdgcn_exp2f(s[mp][qt][m][tp][q]);
              ps += e;
              pk[tp * 4 + q] = (__bf16)e;
            }
          pf[mp][qt][m] = pk;
        }
        const bool hi = __builtin_amdgcn_ballot_w64(!(ps < 65536.f)) != 0ull;
        const bool lo = __builtin_amdgcn_ballot_w64(ps > 0.f || lsum[mp][qt] > 0.f) == 0ull;
        if (hi || lo) {
          float bm = -INFINITY;
#pragma unroll
          for (int m = 0; m < 2; ++m)
#pragma unroll
            for (int tp = 0; tp < 2; ++tp)
#pragma unroll
              for (int q = 0; q < 4; ++q) bm = fmaxf(bm, s[mp][qt][m][tp][q]);
          bm = rows_max(bm);
          const float sh = lo ? bm : fmaxf(bm, 0.f);
          const float alpha = lo ? 1.f : __builtin_amdgcn_exp2f(-sh);
          mrun[mp][qt] += sh;
          const float nm = -mrun[mp][qt];
          negm[mp][qt] = f4{nm, nm, nm, nm};
          lsum[mp][qt] *= alpha;
#pragma unroll
          for (int d = 0; d < 4; ++d) o[mp][qt][d] *= alpha;
          ps = 0.f;
#pragma unroll
          for (int m = 0; m < 2; ++m) {
            bf8 pk;
#pragma unroll
            for (int tp = 0; tp < 2; ++tp)
#pragma unroll
              for (int q = 0; q < 4; ++q) {
                float e = __builtin_amdgcn_exp2f(s[mp][qt][m][tp][q] - sh);
                ps += e;
                pk[tp * 4 + q] = (__bf16)e;
              }
            pf[mp][qt][m] = pk;
          }
        }
        lsum[mp][qt] += ps;
      }
    {
      bf8 vfr[4][2];
#pragma unroll
      for (int d = 0; d < 4; ++d)
#pragma unroll
        for (int m = 0; m < 2; ++m) vfr[d][m] = *(const bf8*)(Vs + (d * 16 + r) * 72 + 32 * m + 8 * g);
      __builtin_amdgcn_s_setprio(1);
#pragma unroll
      for (int d = 0; d < 4; ++d)
#pragma unroll
        for (int m = 0; m < 2; ++m)
#pragma unroll
          for (int mp = 0; mp < NMAP; ++mp)
#pragma unroll
            for (int qt = 0; qt < 2; ++qt) o[mp][qt][d] = mfma16(vfr[d][m], pf[mp][qt][m], o[mp][qt][d]);
    }
    __builtin_amdgcn_s_setprio(0);
  }
#pragma unroll
  for (int qt = 0; qt < 2; ++qt) {
    const int tok = b * PT + q0 + wave * 32 + qt * 16 + r;
    float inv[NMAP];
#pragma unroll
    for (int mp = 0; mp < NMAP; ++mp) {
      float ls = lsum[mp][qt];
      ls = rows_sum(ls);
      inv[mp] = 1.f / ls;
    }
    if constexpr (NMAP == 1) {
#pragma unroll
      for (int d = 0; d < 4; ++d)
        *(bf4*)(p.mix() + (size_t)tok * LDH + h * 64 + d * 16 + 4 * g) = pack4(o[0][qt][d] * inv[0]);
    } else {
      const float lam = p.lam()[l];
      const float li = 0.8f - 0.6f * expf(-0.3f * (float)l);
      f4 val[4];
      float ss = 0.f;
#pragma unroll
      for (int d = 0; d < 4; ++d) {
        val[d] = o[0][qt][d] * inv[0] - o[NMAP - 1][qt][d] * (lam * inv[NMAP - 1]);
        ss += val[d][0] * val[d][0] + val[d][1] * val[d][1] + val[d][2] * val[d][2] + val[d][3] * val[d][3];
      }
      ss = rows_sum(ss);
      const float rs = rsqrtf(ss * (1.f / 64.f) + EPSN) * (1.f - li);
      f4 gd[4];
#pragma unroll
      for (int d = 0; d < 4; ++d) gd[d] = *(const f4*)(p.g_diff_norm + l * 64 + d * 16 + 4 * g);
#pragma unroll
      for (int d = 0; d < 4; ++d) *(bf4*)(p.mix() + (size_t)tok * LDH + 256 + h * 64 + d * 16 + 4 * g) = pack4(val[d] * rs * gd[d]);
    }
  }
}

template <int DQK, int NMAP>
__device__ __forceinline__ void attn_dispatch(const Params& p, int l, int item, const __bf16* Q, const __bf16* K, const __bf16* Vt, char* smem) {
  int b, h, q0, nk;
  if (item < 512) { b = (item >> 2) & 1; h = item & 3; q0 = CTXL + (item >> 3) * 128; nk = PT; }
  else { int it = item - 512; b = it >> 3; h = (it >> 1) & 3; q0 = (it & 1) * 128; nk = CTXL; }
  attn_item<DQK, NMAP>(p, l, Q, K, Vt, b, h, q0, nk, smem);
}

__device__ __forceinline__ void hgrn1_item(const Params& p, int item, char* smem) {
  __bf16* kteT = (__bf16*)smem;
  __bf16* vT = kteT + 64 * 72;
  float* ptot = (float*)(vT + 64 * 72);
  const int tid = tid_(), lane = tid & 63, wave = tid >> 6, r = lane & 15, g = lane >> 4;
  const int c = item % NCH, bh = item / NCH;
  const int b = bh >> 3, h = bh & 7;
  const int tok0 = b * PT + c * 64;
  __syncthreads();
#pragma unroll
  for (int i = 0; i < 2; ++i) {
    int dv = (tid >> 3) + 32 * i;
    *(bf8*)(vT + dv * 72 + (tid & 7) * 8) = *(const bf8*)(p.hvt() + ((size_t)bh * 64 + dv) * PT + c * 64 + (tid & 7) * 8);
  }
  const int k = tid & 63, part = tid >> 6;
  float lfa[2][16];
#pragma unroll
  for (int dd = 0; dd < 2; ++dd) {
    const float* lfp = p.lf() + ((size_t)dd * NTOK + tok0 + part * 16) * 512 + h * 64 + k;
#pragma unroll
    for (int i = 0; i < 16; ++i) lfa[dd][i] = lfp[(size_t)i * 512];
  }
#pragma unroll
  for (int dir = 0; dir < 2; ++dir) {
    float lfv[16], cl[16];
#pragma unroll
    for (int i = 0; i < 16; ++i) lfv[i] = lfa[dir][i];
    float run = 0.f;
    if (dir == 0) {
#pragma unroll
      for (int i = 0; i < 16; ++i) { run += lfv[i]; cl[i] = run; }
    } else {
#pragma unroll
      for (int i = 15; i >= 0; --i) { run += lfv[i]; cl[i] = run; }
    }
    __syncthreads();
    ptot[part * 64 + k] = run;
    __syncthreads();
    float off = 0.f, total = 0.f;
#pragma unroll
    for (int q = 0; q < 4; ++q) {
      float t = ptot[q * 64 + k];
      total += t;
      if (dir == 0 ? (q < part) : (q > part)) off += t;
    }
#pragma unroll
    for (int i = 0; i < 16; ++i) {
      float cum = cl[i] + off;
      float kte = (1.f - __expf(lfv[i])) * __expf(total - cum);
      kteT[k * 72 + part * 16 + i] = (__bf16)kte;
    }
    const size_t sidx = ((size_t)bh * 2 + dir) * NCH + c;
    if (part == 0) p.dk()[sidx * 64 + k] = __expf(total);
    __syncthreads();
    f4 acc[4];
#pragma unroll
    for (int nt = 0; nt < 4; ++nt) acc[nt] = f4{0.f, 0.f, 0.f, 0.f};
#pragma unroll
    for (int ks = 0; ks < 2; ++ks) {
      bf8 af = *(const bf8*)(vT + (wave * 16 + r) * 72 + ks * 32 + g * 8);
#pragma unroll
      for (int nt = 0; nt < 4; ++nt) {
        bf8 bfr = *(const bf8*)(kteT + (nt * 16 + r) * 72 + ks * 32 + g * 8);
        acc[nt] = mfma16(af, bfr, acc[nt]);
      }
    }
    float* up = p.ut() + sidx * 4096;
#pragma unroll
    for (int nt = 0; nt < 4; ++nt)
#pragma unroll
      for (int q = 0; q < 4; ++q) up[(wave * 16 + 4 * g + q) * 64 + nt * 16 + r] = acc[nt][q];
  }
}

__device__ __forceinline__ void hgrn2_item(const Params& p, int item) {
  const int idx = item * 256 + tid_();
  const int e = idx & 4095, sd = idx >> 12;
  const int dir = sd & 1, kk = e & 63;
  const float* up = p.ut() + (size_t)sd * NCH * 4096 + e;
  const float* dp = p.dk() + (size_t)sd * NCH * 64 + kk;
  __bf16* sp = p.st() + (size_t)sd * NCH * 4096 + e;
  float S = 0.f;
  for (int jb = 0; jb < NCH; jb += 22) {
    float u[22], d[22];
    int cc[22];
#pragma unroll
    for (int q = 0; q < 22; ++q) {
      int j = jb + q;
      int c = dir == 0 ? j : (j < 4 ? 3 - j : 135 - j);
      cc[q] = c;
      u[q] = up[(size_t)c * 4096];
      d[q] = dp[c * 64];
    }
#pragma unroll
    for (int q = 0; q < 22; ++q) {
      sp[(size_t)cc[q] * 4096] = (__bf16)S;
      S = d[q] * S + u[q];
    }
  }
}

__device__ __forceinline__ void hgrn3_item(const Params& p, int l, int item, char* smem) {
  __bf16* qS = (__bf16*)smem;
  __bf16* kS = qS + 64 * 72;
  __bf16* vT = kS + 64 * 72;
  __bf16* stS = vT + 64 * 72;
  float* cumS = (float*)(stS + 64 * 72);
  float* ptot = cumS + 64 * 68;
  const int tid = tid_(), lane = tid & 63, wave = tid >> 6, r = lane & 15, g = lane >> 4;
  const int c = item % NCH, bh = item / NCH;
  const int b = bh >> 3, h = bh & 7;
  const int tok0 = b * PT + c * 64;
  __syncthreads();
#pragma unroll
  for (int i = 0; i < 2; ++i) {
    int row = (tid >> 3) + 32 * i;
    *(bf8*)(vT + row * 72 + (tid & 7) * 8) = *(const bf8*)(p.hvt() + ((size_t)bh * 64 + row) * PT + c * 64 + (tid & 7) * 8);
    *(bf8*)(qS + row * 72 + (tid & 7) * 8) = *(const bf8*)(p.hq() + (size_t)(tok0 + row) * 512 + h * 64 + (tid & 7) * 8);
  }
  f4 o[4];
#pragma unroll
  for (int d = 0; d < 4; ++d) o[d] = f4{0.f, 0.f, 0.f, 0.f};
  const int k = tid & 63, part = tid >> 6;
  const int t = 16 * wave + r;
  bf8 sta[2][2];
#pragma unroll
  for (int dd = 0; dd < 2; ++dd) {
    const __bf16* sp = p.st() + (((size_t)bh * 2 + dd) * NCH + c) * 4096;
#pragma unroll
    for (int i = 0; i < 2; ++i) sta[dd][i] = *(const bf8*)(sp + ((tid >> 3) + 32 * i) * 64 + (tid & 7) * 8);
  }
  float lfa[2][16];
#pragma unroll
  for (int dd = 0; dd < 2; ++dd) {
    const float* lfp = p.lf() + ((size_t)dd * NTOK + tok0 + part * 16) * 512 + h * 64 + k;
#pragma unroll
    for (int i = 0; i < 16; ++i) lfa[dd][i] = lfp[(size_t)i * 512];
  }
#pragma unroll
  for (int dir = 0; dir < 2; ++dir) {
    float lfv[16], cl[16];
#pragma unroll
    for (int i = 0; i < 16; ++i) lfv[i] = lfa[dir][i];
    float run = 0.f;
    if (dir == 0) {
#pragma unroll
      for (int i = 0; i < 16; ++i) { run += lfv[i]; cl[i] = run; }
    } else {
#pragma unroll
      for (int i = 15; i >= 0; --i) { run += lfv[i]; cl[i] = run; }
    }
    __syncthreads();
    ptot[part * 64 + k] = run;
#pragma unroll
    for (int i = 0; i < 16; ++i) kS[(part * 16 + i) * 72 + k] = (__bf16)((1.f - __expf(lfv[i])));
#pragma unroll
    for (int i = 0; i < 2; ++i) *(bf8*)(stS + ((tid >> 3) + 32 * i) * 72 + (tid & 7) * 8) = sta[dir][i];
    __syncthreads();
    float off = 0.f;
#pragma unroll
    for (int q = 0; q < 4; ++q) {
      float tt = ptot[q * 64 + k];
      if (dir == 0 ? (q < part) : (q > part)) off += tt;
    }
#pragma unroll
    for (int i = 0; i < 16; ++i) cumS[(part * 16 + i) * 68 + k] = cl[i] + off;
    __syncthreads();
    float cs[2][8];
    bf8 qtf[2], qhf[2];
#pragma unroll
    for (int ks = 0; ks < 2; ++ks) {
      const int dk0 = ks * 32 + 8 * g;
      bf8 qv = *(const bf8*)(qS + t * 72 + dk0);
#pragma unroll
      for (int j = 0; j < 8; ++j) {
        float cst;
        if (dir == 0) cst = wave > 0 ? cumS[(16 * wave - 1) * 68 + dk0 + j] : 0.f;
        else cst = wave < 3 ? cumS[(16 * wave + 16) * 68 + dk0 + j] : 0.f;
        cs[ks][j] = cst;
        float cv = cumS[t * 68 + dk0 + j];
        float qf_ = (float)qv[j];
        qtf[ks][j] = (__bf16)(qf_ * __expf(cv - cst));
        qhf[ks][j] = (__bf16)(qf_ * __expf(cv));
      }
    }
#pragma unroll
    for (int m = 0; m < 2; ++m) {
      const bool need = dir == 0 ? (m <= (wave >> 1)) : (m >= (wave >> 1));
      if (need) {
        bf8 pf;
#pragma unroll
        for (int tp = 0; tp < 2; ++tp) {
          const int srow = 32 * m + 8 * (r >> 2) + 4 * tp + (r & 3);
          f4 sc = f4{0.f, 0.f, 0.f, 0.f};
#pragma unroll
          for (int ks = 0; ks < 2; ++ks) {
            const int dk0 = ks * 32 + 8 * g;
            bf8 kv = *(const bf8*)(kS + srow * 72 + dk0);
            bf8 ktf;
#pragma unroll
            for (int j = 0; j < 8; ++j) {
              float ex = fminf(cs[ks][j] - cumS[srow * 68 + dk0 + j], 80.f);
              ktf[j] = (__bf16)((float)kv[j] * __expf(ex));
            }
            sc = mfma16(ktf, qtf[ks], sc);
          }
#pragma unroll
          for (int q = 0; q < 4; ++q) {
            const int s = 32 * m + 8 * g + 4 * tp + q;
            const bool keep = dir == 0 ? (s <= t) : (s >= t);
            pf[tp * 4 + q] = keep ? (__bf16)sc[q] : (__bf16)0.f;
          }
        }
#pragma unroll
        for (int d = 0; d < 4; ++d) {
          bf8 vf = *(const bf8*)(vT + (d * 16 + r) * 72 + 32 * m + 8 * g);
          o[d] = mfma16(vf, pf, o[d]);
        }
      }
    }
#pragma unroll
    for (int d = 0; d < 4; ++d)
#pragma unroll
      for (int ks = 0; ks < 2; ++ks) {
        bf8 sf = *(const bf8*)(stS + (d * 16 + r) * 72 + ks * 32 + 8 * g);
        o[d] = mfma16(sf, qhf[ks], o[d]);
      }
  }
  float ss = 0.f;
#pragma unroll
  for (int d = 0; d < 4; ++d) ss += o[d][0] * o[d][0] + o[d][1] * o[d][1] + o[d][2] * o[d][2] + o[d][3] * o[d][3];
  ss = rows_sum(ss);
  const float rs = rsqrtf(ss * (1.f / 64.f) + EPSN);
  f4 gn[4]; bf4 gate[4];
#pragma unroll
  for (int d = 0; d < 4; ++d) {
    gn[d] = *(const f4*)(p.g_hgrn_norm + l * 64 + d * 16 + 4 * g);
    gate[d] = *(const bf4*)(p.hg() + (size_t)(tok0 + t) * 512 + h * 64 + d * 16 + 4 * g);
  }
#pragma unroll
  for (int d = 0; d < 4; ++d) {
    f4 res;
#pragma unroll
    for (int q = 0; q < 4; ++q) res[q] = o[d][q] * rs * gn[d][q] * (float)gate[d][q];
    *(bf4*)(p.mix() + (size_t)(tok0 + t) * LDH + 512 + h * 64 + d * 16 + 4 * g) = pack4(res);
  }
}

#define NPHASE 38
#ifndef ONLY
#define ONLY -1
#endif
#define PHEN(x) (ONLY < 0 || ONLY == (x))
__device__ __forceinline__ void run_phase(const Params& p, int ph, char* smem) {
  const int bid = bid_(), G = gridDim.x;
  if (ph == 0) { if (PHEN(100)) phase0(p, smem); return; }
  if (ph == NPHASE - 1) {
    for (int it = bid; it < NB * SEQ / 16; it += G) final_norm_item(p, it);
    return;
  }
  const int l = (ph - 1) / 9, sp = (ph - 1) % 9;
  const int nmt = mtile_count(l);
  switch (sp) {
    case 0: if (PHEN(0)) {
      for (int i = bid * 256 + tid_(); i < (INWP - INW) * DM / 8; i += G * 256) {
        bf8 z;
#pragma unroll
        for (int j = 0; j < 8; ++j) z[j] = (__bf16)0.f;
        *(bf8*)(p.wt_in() + (size_t)(INW + (i >> 7)) * LDH + (size_t)(i & 127) * 8) = z;
      }
      for (int it = bid; it < 1056; it += G) norm_item(p, l, 0, it);
      conv_items(p, l, bid, G, smem);
    } break;
    case 1: if (PHEN(1)) {
      {
        int mt, nt, mtn = 0, ntn = 0;
        bool have = gemm_pick(0, bid, G, 132, 30, 10, mt, nt), pre = false;
        for (int st = 0; have; ++st) {
          const bool hn = gemm_pick(st + 1, bid, G, 132, 30, 10, mtn, ntn);
          gemm_tile<EPI_IN, false>(p, l, p.hb(), LDH, p.wt_in(), LDH, DM, mt * 128, nt * 128, smem, pre, hn, mtn * 128, ntn * 128);
          pre = hn; have = hn; mt = mtn; nt = ntn;
        }
      }
    } break;
    case 2: if (PHEN(2)) {
      const int natt = l < 3 ? 528 : 512;
      const int total = natt + 396 + 528 + 2112, K = (total + G - 1) / G;
      const bool flip = (bid >> 3) & 1;
      for (int kk = 0; kk < K; ++kk) {
        const int k = flip ? (kk + 1 == K ? 0 : kk + 1) : kk;
        const int it0 = bid + k * G;
        if (it0 >= total) continue;
        if (it0 < natt) { attn_dispatch<32, 2>(p, l, it0, p.qd(), p.kd(), p.vdt(), smem); continue; }
        const int it = it0 - natt;
        if (it < 396) gemm_tile<EPI_UQ, true>(p, l, p.cq(), 256, p.wt_uq(), 256, 256, (it / 3) * 128, (it % 3) * 128, smem);
        else if (it < 924) { int j = it - 396; gemm_tile<EPI_UKV, true>(p, l, p.ckv(), 128, p.wt_ukv(), 128, 128, (j / 4) * 128, (j % 4) * 128, smem); }
        else hgrn1_item(p, it - 924, smem);
      }
    } break;
    case 3: if (PHEN(3)) {
      const int natt = l < 3 ? 528 : 512;
      const int total = 512 + natt, K = (total + G - 1) / G;
      const bool flip = (bid >> 3) & 1;
      for (int kk = 0; kk < K; ++kk) {
        const int k = flip ? (kk + 1 == K ? 0 : kk + 1) : kk;
        const int it = bid + k * G;
        if (it >= total) continue;
        if (it < 512) hgrn2_item(p, it);
        else attn_dispatch<96, 1>(p, l, it - 512, p.qm(), p.km(), p.vmt(), smem);
      }
    } break;
    case 4: if (PHEN(4)) {
      for (int j = bid; j < 2112; j += G) {
        if (l == 3 && (j % NCH) < 4) continue;
        hgrn3_item(p, l, j, smem);
      }
    } break;
    case 5: if (PHEN(5)) {
      {
        int mt, nt, mtn = 0, ntn = 0;
        bool have = gemm_pick(0, bid, G, 128, 8, 8, mt, nt), pre = false;
        for (int st = 0; have; ++st) {
          const bool hn = gemm_pick(st + 1, bid, G, 128, 8, 8, mtn, ntn);
          gemm_tile<EPI_OUT, false>(p, l, p.mix(), LDH, p.wt_out(), LDH, DM, mtile_index(3, mt) * 128, nt * 128, smem, pre, hn,
                                    mtile_index(3, mtn) * 128, ntn * 128);
          pre = hn; have = hn; mt = mtn; nt = ntn;
        }
      }
      if (l < 3) {
        for (int u = bid; u < 32 * 8; u += G) {
          const int tile = u >> 3, sp = u & 7;
          const int cm = tile >> 3, nt = tile & 7;
          const int mt = (cm >> 1) * 66 + (cm & 1);
          gemm_tile<EPI_OUT_AT, false>(p, l, p.mix() + sp * 128, LDH, p.wt_out() + sp * 128, LDH, 128, mt * 128, nt * 128, smem);
        }
      }
    } break;
    case 6: if (PHEN(6)) {
      for (int it = bid; it < 1056; it += G) norm_item(p, l, 1, it);
    } break;
    case 7: if (PHEN(7)) {
      {
        int mt, nt, mtn = 0, ntn = 0;
        bool have = gemm_pick(0, bid, G, nmt, 44, 11, mt, nt), pre = false;
        for (int st = 0; have; ++st) {
          const bool hn = gemm_pick(st + 1, bid, G, nmt, 44, 11, mtn, ntn);
          gemm_tile<EPI_UP, false>(p, l, p.hb(), LDH, p.wt_gu(), LDH, DM, mtile_index(l, mt) * 128, nt * 128, smem, pre, hn,
                                   mtile_index(l, mtn) * 128, ntn * 128);
          pre = hn; have = hn; mt = mtn; nt = ntn;
        }
      }
    } break;
    case 8: if (PHEN(8)) {
      {
        int mt, nt, mtn = 0, ntn = 0;
        bool have = gemm_pick(0, bid, G, 128, 8, 8, mt, nt), pre = false;
        for (int st = 0; have; ++st) {
          const bool hn = gemm_pick(st + 1, bid, G, 128, 8, 8, mtn, ntn);
          gemm_tile<EPI_DOWN, false>(p, l, p.act(), LDF, p.wt_down(), LDF, DFF, mtile_index(3, mt) * 128, nt * 128, smem, pre, hn,
                                     mtile_index(3, mtn) * 128, ntn * 128);
          pre = hn; have = hn; mt = mtn; nt = ntn;
        }
      }
      if (l < 3) {
        for (int u = bid; u < 32 * 11; u += G) {
          const int tile = u / 11, sp = u - tile * 11;
          const int cm = tile >> 3, nt = tile & 7;
          const int mt = (cm >> 1) * 66 + (cm & 1);
          gemm_tile<EPI_DOWN_AT, false>(p, l, p.act() + sp * 256, LDF, p.wt_down() + sp * 256, LDF, 256, mt * 128, nt * 128, smem);
        }
      }
    } break;
  }
}

#define XB_TMO      128
#define XB_XCNT(j)  (256  + 64 * (j))
#define XB_XSUB(j)  (1280 + 64 * (j))
#define XB_XGEN(j)  (2304 + 64 * (j))
#define XB_TOP      3328
#define XB_TOPGEN   3392
#define XCD_BAR_WORDS 3456
#define XB_SPIN_CAP (1u << 22)
#define LAS __attribute__((address_space(3)))

__device__ __forceinline__ unsigned xb_ld(unsigned* p)              { return __hip_atomic_load(p, __ATOMIC_RELAXED, __HIP_MEMORY_SCOPE_AGENT); }
__device__ __forceinline__ unsigned xb_add(unsigned* p, unsigned v) { return __hip_atomic_fetch_add(p, v, __ATOMIC_RELAXED, __HIP_MEMORY_SCOPE_AGENT); }
__device__ __forceinline__ unsigned xb_xcc_id() { return (unsigned)__builtin_amdgcn_s_getreg((3 << 11) | 20) & 0xFu; }
#define XB_SPIN(cond, bar) do { unsigned _sp = 0; while (cond) { __builtin_amdgcn_s_sleep(1); \
    if ((++_sp & 255u) == 0u) { if (xb_ld(&(bar)[XB_TMO])) break; if (_sp > XB_SPIN_CAP) { atomicAdd(&(bar)[XB_TMO], 1u); break; } } } } while (0)

struct XcdBarrier {
    unsigned* bar; unsigned x;
    volatile LAS unsigned* st;
};

__device__ __forceinline__ XcdBarrier xcd_barrier_post(unsigned* bar, volatile LAS unsigned* st) {
    XcdBarrier b; b.bar = bar; b.x = xb_xcc_id(); b.st = st;
    if (threadIdx.x == 0) (void)xb_add(&bar[XB_XCNT(b.x)], 1u);
    return b;
}
__device__ __forceinline__ void xcd_barrier_complete(unsigned* bar, unsigned x, unsigned& nloc, unsigned& nx) {
    const unsigned G = gridDim.x * gridDim.y * gridDim.z;
    unsigned sum, cnt, mine, sp = 0u;
    for (;;) {
        sum = 0u; cnt = 0u; mine = 0u;
#pragma unroll
        for (unsigned j = 0; j < 16; ++j) { const unsigned c = xb_ld(&bar[XB_XCNT(j)]); sum += c; cnt += (c > 0u) ? 1u : 0u; mine = (j == x) ? c : mine; }
        if (sum == G) break;
        __builtin_amdgcn_s_sleep(1);
        if ((++sp & 255u) == 0u) { if (xb_ld(&bar[XB_TMO])) break; if (sp > XB_SPIN_CAP) { atomicAdd(&bar[XB_TMO], 1u); break; } }
    }
    nloc = mine > 0u ? mine : 1u; nx = cnt > 0u ? cnt : 1u;
}

__device__ __forceinline__ void xcd_barrier(const XcdBarrier& b) {
    asm volatile("s_waitcnt vmcnt(0)" ::: "memory");
    __syncthreads();
    if (threadIdx.x == 0) {
        unsigned* bar = b.bar;
        __builtin_amdgcn_s_waitcnt(0);
        unsigned nloc = b.st[0], nx = b.st[1];
        if (nloc == 0u) { xcd_barrier_complete(bar, b.x, nloc, nx); b.st[0] = nloc; b.st[1] = nx; }
        const unsigned old = xb_add(&bar[XB_XSUB(b.x)], 1u);
        const unsigned gen = old / nloc;
        if (old + 1u == (gen + 1u) * nloc) {
            __builtin_amdgcn_fence(__ATOMIC_RELEASE, "agent");
            asm volatile("s_waitcnt vmcnt(0)" ::: "memory");
            const unsigned og = xb_add(&bar[XB_TOP], 1u);
            const unsigned tg = og / nx;
            if (og + 1u == (tg + 1u) * nx) xb_add(&bar[XB_TOPGEN], 1u);
            else XB_SPIN(xb_ld(&bar[XB_TOPGEN]) == tg, bar);
            __builtin_amdgcn_fence(__ATOMIC_ACQUIRE, "agent");
            xb_add(&bar[XB_XGEN(b.x)], 1u);
            asm volatile("s_waitcnt vmcnt(0)" ::: "memory");
        } else {
            XB_SPIN(xb_ld(&bar[XB_XGEN(b.x)]) == gen, bar);
            __builtin_amdgcn_fence(__ATOMIC_ACQUIRE, "agent");
            asm volatile("s_waitcnt vmcnt(0)" ::: "memory");
        }
    }
    __syncthreads();
}


__device__ __forceinline__ void grid_barrier(unsigned* cnt, unsigned target) {
  asm volatile("s_waitcnt vmcnt(0)" ::: "memory");
  __syncthreads();
  if (tid_() == 0) {
    __builtin_amdgcn_fence(__ATOMIC_RELEASE, "agent");
    asm volatile("s_waitcnt vmcnt(0)" ::: "memory");
    __hip_atomic_fetch_add(cnt, 1u, __ATOMIC_RELAXED, __HIP_MEMORY_SCOPE_AGENT);
    unsigned spins = 0;
    while (__hip_atomic_load(cnt, __ATOMIC_RELAXED, __HIP_MEMORY_SCOPE_AGENT) < target) {
      __builtin_amdgcn_s_sleep(2);
      if (++spins > (1u << 24)) break;
    }
    __builtin_amdgcn_fence(__ATOMIC_ACQUIRE, "agent");
    asm volatile("s_waitcnt vmcnt(0)" ::: "memory");
  }
  __syncthreads();
}

__global__ void __launch_bounds__(256, 2) hybrid_megakernel(Params p, int ph0, int ph1) {
  __shared__ __attribute__((aligned(16))) char smem[SMEM_BYTES];
  cg::grid_group grid = cg::this_grid();
  volatile LAS unsigned* xst = (volatile LAS unsigned*)(smem + 66048);
  if (__builtin_amdgcn_workitem_id_x() == 0) { xst[0] = 0u; xst[1] = 0u; }
  __syncthreads();
  XcdBarrier xb; xb.bar = nullptr; xb.x = 0; xb.st = xst;
  for (int ph = ph0; ph < ph1; ++ph) {
    Params q = p;
    size_t zoff = 0;
    asm volatile("" : "+s"(zoff));
    q.ws = p.ws + zoff; q.out = p.out + zoff;
    run_phase(q, ph, smem);
#ifdef REPMASK
    if (ph > 0 && ph < NPHASE - 1 && ((REPMASK >> ((ph - 1) % 9)) & 1)) { grid.sync(); run_phase(q, ph, smem); }
#endif
    if (ph + 1 < ph1) {
      if (ph == ph0) { grid.sync(); xb = xcd_barrier_post((unsigned*)(p.ws + OFF_xbar), xst); }
      else xcd_barrier(xb);
    }
  }
}

extern "C" void kernel_launch(void* const* d_in, const int* in_sizes, int n_in, void* d_out, int out_size, void* d_ws,
                              size_t ws_size, hipStream_t stream) {
  static int grid_blocks = 0;
  if (!grid_blocks) {
    int dev = 0, cus = 0, per_cu = 0;
    hipGetDevice(&dev);
    hipDeviceGetAttribute(&cus, hipDeviceAttributeMultiprocessorCount, dev);
    hipOccupancyMaxActiveBlocksPerMultiprocessor(&per_cu, hybrid_megakernel, 256, 0);
    if (per_cu > 2) per_cu = 2;
    if (per_cu < 1) per_cu = 1;
    grid_blocks = cus * per_cu;
  }
  Params p{};
  const float* const* in = (const float* const*)d_in;
  p.x = in[0]; p.c = in[1]; p.ctx = in[2]; p.c_ctx = in[3]; p.w_ada = in[4]; p.b_ada = in[5]; p.g_norm1 = in[6];
  p.g_norm2 = in[7]; p.w_in = in[8]; p.g_q_norm = in[9]; p.w_uq = in[10]; p.g_kv_norm = in[11]; p.w_ukv = in[12];
  p.diff_lambda = in[13]; p.g_diff_norm = in[14]; p.hgrn_lb = in[15]; p.g_hgrn_norm = in[16]; p.w_out = in[17];
  p.w_gate = in[18]; p.w_up = in[19]; p.w_down = in[20]; p.g_final = in[21];
  p.out = (float*)d_out;
  p.ws = (char*)d_ws;
  if (WS_TOTAL > ws_size) { fprintf(stderr, "workspace too small: need %zu have %zu\n", (size_t)WS_TOTAL, ws_size); return; }
  int ph0 = 0, ph1 = NPHASE;
  void* args[] = {&p, &ph0, &ph1};
  hipError_t e = hipLaunchCooperativeKernel((void*)hybrid_megakernel, dim3(grid_blocks), dim3(256), args, 0, stream);
  if (e != hipSuccess) fprintf(stderr, "cooperative launch failed: %s (grid %d)\n", hipGetErrorString(e), grid_blocks);
}
```

```cpp
#include <hip/hip_runtime.h>
#include <hip/hip_cooperative_groups.h>
#include <cstdio>
namespace cg = cooperative_groups;

typedef __attribute__((ext_vector_type(8))) __bf16 bf8;
typedef __attribute__((ext_vector_type(4))) __bf16 bf4;
typedef __attribute__((ext_vector_type(4))) float f4;

#define XCD_BAR_WORDS_C 3456
#define NB 2
#define SEQ 8192
#define CTXL 256
#define PT 8448
#define NTOK 16896
#define DM 1024
#define INW 3744
#define INWP 3840
#define DFF 2816
#define NCH 132
#define LDH 1088
#define LDF 2880
#define LOG2E 1.4426950408889634f
#define EPSN 1e-6f
#define SMEM_BYTES 66064

constexpr size_t al256(size_t x) { return (x + 255) & ~(size_t)255; }
constexpr size_t OFF_xc = 0;
constexpr size_t OFF_mod = OFF_xc + al256((size_t)NB*CTXL*DM*4);
constexpr size_t OFF_rope = OFF_mod + al256((size_t)4*3*6144*4);
constexpr size_t OFF_llb = OFF_rope + al256(128*8*2*4);
constexpr size_t OFF_l1mlb = OFF_llb + al256(4*1024*4);
constexpr size_t OFF_lam = OFF_l1mlb + al256(4*1024*4);
constexpr size_t OFF_wt_in = OFF_lam + al256(256);
constexpr size_t OFF_wt_uq = OFF_wt_in + al256((size_t)INWP*LDH*2);
constexpr size_t OFF_wt_ukv = OFF_wt_uq + al256((size_t)384*256*2);
constexpr size_t OFF_wt_out = OFF_wt_ukv + al256((size_t)512*128*2);
constexpr size_t OFF_wt_gu = OFF_wt_out + al256((size_t)DM*LDH*2);
constexpr size_t OFF_wt_down = OFF_wt_gu + al256((size_t)2*DFF*LDH*2);
constexpr size_t OFF_hb = OFF_wt_down + al256((size_t)DM*LDF*2);
constexpr size_t OFF_cq = OFF_hb + al256((size_t)NTOK*LDH*2);
constexpr size_t OFF_ckv = OFF_cq + al256((size_t)NTOK*256*2);
constexpr size_t OFF_qm = OFF_ckv + al256((size_t)NTOK*128*2);
constexpr size_t OFF_km = OFF_qm + al256((size_t)NB*4*PT*96*2);
constexpr size_t OFF_vmt = OFF_km + al256((size_t)NB*4*PT*96*2);
constexpr size_t OFF_qd = OFF_vmt + al256((size_t)NB*4*64*PT*2);
constexpr size_t OFF_kd = OFF_qd + al256((size_t)NB*4*2*PT*32*2);
constexpr size_t OFF_vdt = OFF_kd + al256((size_t)NB*4*2*PT*32*2);
constexpr size_t OFF_hq = OFF_vdt + al256((size_t)NB*4*64*PT*2);
constexpr size_t OFF_hvt = OFF_hq + al256((size_t)NTOK*512*2);
constexpr size_t OFF_hg = OFF_hvt + al256((size_t)NB*8*64*PT*2);
constexpr size_t OFF_dk = OFF_hg + al256((size_t)NTOK*512*2);
constexpr size_t OFF_st = OFF_dk + al256((size_t)NB*8*2*NCH*64*4);
constexpr size_t OFF_lf = OFF_st + al256((size_t)NB*8*2*NCH*4096*2);
constexpr size_t OFF_ut = OFF_lf + al256((size_t)2*NTOK*512*4);
constexpr size_t OFF_xbar = OFF_ut + al256((size_t)NB*8*2*NCH*4096*4);
constexpr size_t WS_TOTAL_OLD = OFF_ut + al256((size_t)NB*8*2*NCH*4096*4);
constexpr size_t WS_TOTAL = OFF_xbar + al256((size_t)XCD_BAR_WORDS_C*4);
struct Params {
  const float *x, *c, *ctx, *c_ctx, *w_ada, *b_ada, *g_norm1, *g_norm2, *w_in, *g_q_norm, *w_uq, *g_kv_norm, *w_ukv,
      *diff_lambda, *g_diff_norm, *hgrn_lb, *g_hgrn_norm, *w_out, *w_gate, *w_up, *w_down, *g_final;
  float* out;
  char* ws;
  __device__ __forceinline__ float* xc() const { return (float*)(ws + OFF_xc); }
  __device__ __forceinline__ float* mod() const { return (float*)(ws + OFF_mod); }
  __device__ __forceinline__ float* rope() const { return (float*)(ws + OFF_rope); }
  __device__ __forceinline__ float* llb() const { return (float*)(ws + OFF_llb); }
  __device__ __forceinline__ float* l1mlb() const { return (float*)(ws + OFF_l1mlb); }
  __device__ __forceinline__ float* lam() const { return (float*)(ws + OFF_lam); }
  __device__ __forceinline__ __bf16* wt_in() const { return (__bf16*)(ws + OFF_wt_in); }
  __device__ __forceinline__ __bf16* wt_uq() const { return (__bf16*)(ws + OFF_wt_uq); }
  __device__ __forceinline__ __bf16* wt_ukv() const { return (__bf16*)(ws + OFF_wt_ukv); }
  __device__ __forceinline__ __bf16* wt_out() const { return (__bf16*)(ws + OFF_wt_out); }
  __device__ __forceinline__ __bf16* wt_gu() const { return (__bf16*)(ws + OFF_wt_gu); }
  __device__ __forceinline__ __bf16* wt_down() const { return (__bf16*)(ws + OFF_wt_down); }
  __device__ __forceinline__ __bf16* hb() const { return (__bf16*)(ws + OFF_hb); }
  __device__ __forceinline__ __bf16* cq() const { return (__bf16*)(ws + OFF_cq); }
  __device__ __forceinline__ __bf16* ckv() const { return (__bf16*)(ws + OFF_ckv); }
  __device__ __forceinline__ __bf16* qm() const { return (__bf16*)(ws + OFF_qm); }
  __device__ __forceinline__ __bf16* km() const { return (__bf16*)(ws + OFF_km); }
  __device__ __forceinline__ __bf16* vmt() const { return (__bf16*)(ws + OFF_vmt); }
  __device__ __forceinline__ __bf16* qd() const { return (__bf16*)(ws + OFF_qd); }
  __device__ __forceinline__ __bf16* kd() const { return (__bf16*)(ws + OFF_kd); }
  __device__ __forceinline__ __bf16* vdt() const { return (__bf16*)(ws + OFF_vdt); }
  __device__ __forceinline__ __bf16* hq() const { return (__bf16*)(ws + OFF_hq); }
  __device__ __forceinline__ __bf16* hvt() const { return (__bf16*)(ws + OFF_hvt); }
  __device__ __forceinline__ __bf16* hg() const { return (__bf16*)(ws + OFF_hg); }
  __device__ __forceinline__ float* dk() const { return (float*)(ws + OFF_dk); }
  __device__ __forceinline__ __bf16* st() const { return (__bf16*)(ws + OFF_st); }
  __device__ __forceinline__ float* lf() const { return (float*)(ws + OFF_lf); }
  __device__ __forceinline__ float* ut() const { return (float*)(ws + OFF_ut); }
  __device__ __forceinline__ __bf16* mix() const { return hb(); }
  __device__ __forceinline__ __bf16* act() const { return (__bf16*)lf(); }
};

__device__ __forceinline__ int tid_() { int t = __builtin_amdgcn_workitem_id_x(); asm volatile("" : "+v"(t)); return t; }
__device__ __forceinline__ int bid_() { int t = __builtin_amdgcn_workgroup_id_x(); asm volatile("" : "+s"(t)); return t; }
__device__ __forceinline__ float silu_f(float x) { return x * __builtin_amdgcn_rcpf(1.f + __expf(-x)); }
__device__ __forceinline__ float wave_sum(float v) {
  v += __uint_as_float(__builtin_amdgcn_update_dpp(0u, __float_as_uint(v), 0x128, 0xf, 0xf, false));
  v += __uint_as_float(__builtin_amdgcn_update_dpp(0u, __float_as_uint(v), 0x124, 0xf, 0xf, false));
  v += __uint_as_float(__builtin_amdgcn_update_dpp(0u, __float_as_uint(v), 0x122, 0xf, 0xf, false));
  v += __uint_as_float(__builtin_amdgcn_update_dpp(0u, __float_as_uint(v), 0x121, 0xf, 0xf, false));
  unsigned u = __float_as_uint(v);
  auto a = __builtin_amdgcn_permlane16_swap(u, u, false, false);
  float m = __uint_as_float(a[0]) + __uint_as_float(a[1]);
  unsigned w = __float_as_uint(m);
  auto b = __builtin_amdgcn_permlane32_swap(w, w, false, false);
  return __uint_as_float(b[0]) + __uint_as_float(b[1]);
}
__device__ __forceinline__ float* xrow(const Params& p, int tok) {
  int b = tok / PT, pp = tok - b * PT;
  return pp < CTXL ? p.xc() + (size_t)(b * CTXL + pp) * DM : p.out + (size_t)(b * SEQ + pp - CTXL) * DM;
}
__device__ __forceinline__ float log_forget(float z, float lb, float oml) {
  const float sg = __builtin_amdgcn_rcpf(1.f + __expf(-fmaxf(z, -80.f)));
  return __logf(lb + oml * sg);
}
__device__ __forceinline__ float rows_max(float x) {
  unsigned u = __float_as_uint(x);
  auto a = __builtin_amdgcn_permlane16_swap(u, u, false, false);
  float m = fmaxf(__uint_as_float(a[0]), __uint_as_float(a[1]));
  unsigned v = __float_as_uint(m);
  auto b = __builtin_amdgcn_permlane32_swap(v, v, false, false);
  return fmaxf(__uint_as_float(b[0]), __uint_as_float(b[1]));
}
__device__ __forceinline__ float rows_sum(float x) {
  unsigned u = __float_as_uint(x);
  auto a = __builtin_amdgcn_permlane16_swap(u, u, false, false);
  float m = __uint_as_float(a[0]) + __uint_as_float(a[1]);
  unsigned v = __float_as_uint(m);
  auto b = __builtin_amdgcn_permlane32_swap(v, v, false, false);
  return __uint_as_float(b[0]) + __uint_as_float(b[1]);
}
__device__ __forceinline__ f4 mfma16(bf8 a, bf8 b, f4 c) { return __builtin_amdgcn_mfma_f32_16x16x32_bf16(a, b, c, 0, 0, 0); }

__device__ __forceinline__ void phase0(const Params& p, char* smem) {
  const int tid = tid_();
  const int gsz = gridDim.x * 256, gtid = bid_() * 256 + tid;
  {
    const float4* xs = (const float4*)p.x; float4* xo = (float4*)p.out;
    for (int i = gtid; i < NB * SEQ * DM / 4; i += gsz) xo[i] = xs[i];
    const float4* cs = (const float4*)p.ctx; float4* co = (float4*)p.xc();
    for (int i = gtid; i < NB * CTXL * DM / 4; i += gsz) co[i] = cs[i];
  }
  if (gtid < 1024) {
    int pos = gtid >> 3, f = gtid & 7;
    float freq = powf(10000.f, -(float)f / 8.f);
    float ang = (float)pos * freq, s, c;
    sincosf(ang, &s, &c);
    p.rope()[gtid * 2] = c; p.rope()[gtid * 2 + 1] = s;
  } else if (gtid < 2048) {
    int n = gtid - 1024;
    float r0 = p.hgrn_lb[n], r1 = p.hgrn_lb[1024 + n], r2 = p.hgrn_lb[2048 + n], r3 = p.hgrn_lb[3072 + n];
    float m = fmaxf(fmaxf(r0, r1), fmaxf(r2, r3));
    float e0 = expf(r0 - m), e1 = expf(r1 - m), e2 = expf(r2 - m), e3 = expf(r3 - m);
    float s = e0 + e1 + e2 + e3;
    float p0 = e0 / s, p1 = e1 / s, p2 = e2 / s, p3 = e3 / s;
    float c0 = p0, c1 = c0 + p1, c2 = c1 + p2, c3 = c2 + p3;
    p.llb()[n] = 0.f; p.l1mlb()[n] = 1.f;
    p.llb()[1024 + n] = c1 - c0; p.l1mlb()[1024 + n] = 1.f - (c1 - c0);
    p.llb()[2048 + n] = c2 - c0; p.l1mlb()[2048 + n] = 1.f - (c2 - c0);
    p.llb()[3072 + n] = c3 - c0; p.l1mlb()[3072 + n] = 1.f - (c3 - c0);
  } else if (gtid >= 4096 && gtid < 4096 + XCD_BAR_WORDS_C) {
    ((unsigned*)(p.ws + OFF_xbar))[gtid - 4096] = 0u;
  } else if (gtid == 2052) {
    *(unsigned*)(p.ws + OFF_lam + 128) = 0u;
  } else if (gtid < 2052) {
    int l = gtid - 2048;
    const float* d = p.diff_lambda + l * 128;
    float s1 = 0.f, s2 = 0.f;
    for (int i = 0; i < 32; ++i) { s1 += d[i] * d[32 + i]; s2 += d[64 + i] * d[96 + i]; }
    float li = 0.8f - 0.6f * expf(-0.3f * (float)l);
    p.lam()[l] = expf(s1) - expf(s2) + li;
  }
  float* sl = (float*)smem;
  float* red = sl + 3072;
  bool have = false;
  for (int item = bid_(); item < 768; item += gridDim.x) {
    if (!have) {
      for (int i = tid; i < 1024; i += 256) {
        sl[i] = silu_f(p.c[i]); sl[1024 + i] = silu_f(p.c[1024 + i]); sl[2048 + i] = silu_f(p.c_ctx[i]);
      }
      have = true;
      __syncthreads();
    }
    int l = item / 192, n0 = (item % 192) * 32;
    int col = tid & 31, kg = tid >> 5;
    const float* W = p.w_ada + (size_t)l * DM * 6144 + n0 + col;
    float a0 = 0.f, a1 = 0.f, a2 = 0.f;
#pragma unroll 8
    for (int k = kg * 128; k < kg * 128 + 128; ++k) {
      float w = W[(size_t)k * 6144];
      a0 += sl[k] * w; a1 += sl[1024 + k] * w; a2 += sl[2048 + k] * w;
    }
    red[(kg * 3 + 0) * 32 + col] = a0; red[(kg * 3 + 1) * 32 + col] = a1; red[(kg * 3 + 2) * 32 + col] = a2;
    __syncthreads();
    if (tid < 96) {
      int v = tid >> 5, cc = tid & 31;
      float s = p.b_ada[l * 6144 + n0 + cc];
#pragma unroll
      for (int q = 0; q < 8; ++q) s += red[(q * 3 + v) * 32 + cc];
      p.mod()[(size_t)(l * 3 + v) * 6144 + n0 + cc] = s;
    }
    __syncthreads();
  }
}

struct ConvD { const float* srcp; size_t sstride; __bf16* dstp; const float* ksp; };

__device__ __forceinline__ ConvD conv_decode(const Params& p, int l, int it, int tid) {
  const float* src; int N, ntn, mode = 0, dld; __bf16* dst; const float* ks = nullptr;
  if (it < 1872) { src = p.w_in + (size_t)l * DM * INW; N = INW; ntn = 117; dst = p.wt_in(); dld = LDH; }
  else if (it < 1920) { it -= 1872; src = p.w_uq + (size_t)l * 256 * 384; N = 384; ntn = 12; dst = p.wt_uq(); dld = 256; ks = p.g_q_norm + l * 256; }
  else if (it < 1952) { it -= 1920; src = p.w_ukv + (size_t)l * 128 * 512; N = 512; ntn = 16; dst = p.wt_ukv(); dld = 128; ks = p.g_kv_norm + l * 128; }
  else if (it < 2464) { it -= 1952; src = p.w_out + (size_t)l * DM * DM; N = DM; ntn = 32; dst = p.wt_out(); dld = LDH; }
  else if (it < 3872) { it -= 2464; src = p.w_gate + (size_t)l * DM * DFF; N = DFF; ntn = 88; dst = p.wt_gu(); mode = 1; dld = LDH; }
  else if (it < 5280) { it -= 3872; src = p.w_up + (size_t)l * DM * DFF; N = DFF; ntn = 88; dst = p.wt_gu(); mode = 2; dld = LDH; }
  else { it -= 5280; src = p.w_down + (size_t)l * DFF * DM; N = DM; ntn = 32; dst = p.wt_down(); dld = LDF; }
  const int kt = it / ntn, nt = it - kt * ntn;
  ConvD d;
  d.srcp = src + (size_t)(kt * 64 + (tid >> 3)) * N + nt * 32 + (tid & 7) * 4;
  d.sstride = (size_t)32 * N;
  const int n = nt * 32 + (tid >> 3);
  int row = n;
  if (mode == 1) row = (n >> 4) * 32 + (n & 15);
  else if (mode == 2) row = (n >> 4) * 32 + 16 + (n & 15);
  d.dstp = dst + (size_t)row * dld + kt * 64 + (tid & 7) * 8;
  d.ksp = ks ? ks + kt * 64 + (tid & 7) * 8 : nullptr;
  return d;
}

__device__ __forceinline__ void conv_items(const Params& p, int l, int first, int step, char* smem) {
  float* tile = (float*)smem;
  const int tid = tid_();
  if (first >= 6688) return;
  ConvD cur = conv_decode(p, l, first, tid);
  float4 v0 = *(const float4*)(cur.srcp), v1 = *(const float4*)(cur.srcp + cur.sstride);
  for (int it = first; it < 6688; it += step) {
    const int itn = it + step < 6688 ? it + step : it;
    const ConvD nxt = conv_decode(p, l, itn, tid);
    const float4 n0 = *(const float4*)(nxt.srcp), n1 = *(const float4*)(nxt.srcp + nxt.sstride);
    __syncthreads();
    {
      const int r = tid >> 3, c4 = tid & 7;
      float* t = tile + r * 33 + c4 * 4;
      t[0] = v0.x; t[1] = v0.y; t[2] = v0.z; t[3] = v0.w;
      t += 32 * 33;
      t[0] = v1.x; t[1] = v1.y; t[2] = v1.z; t[3] = v1.w;
    }
    __syncthreads();
    {
      const int nr = tid >> 3, kc = tid & 7;
      bf8 o;
#pragma unroll
      for (int j = 0; j < 8; ++j) {
        float v = tile[(kc * 8 + j) * 33 + nr];
        if (cur.ksp) v *= cur.ksp[j];
        o[j] = (__bf16)v;
      }
      *(bf8*)cur.dstp = o;
    }
    cur = nxt; v0 = n0; v1 = n1;
  }
}

__device__ __forceinline__ void norm_item(const Params& p, int l, int which, int item) {
  const int lane = tid_() & 63, wave = tid_() >> 6;
  const int tok0 = item * 16 + wave * 4;
  const int b = tok0 / PT, pp = tok0 - b * PT;
  const int v = pp < CTXL ? 2 : b;
  const float* g = (which ? p.g_norm2 : p.g_norm1) + l * DM;
  const float* md = p.mod() + (size_t)(l * 3 + v) * 6144 + (which ? 3072 : 0);
  f4 a[4], sh[4];
#pragma unroll
  for (int i = 0; i < 4; ++i) {
    int k = i * 256 + lane * 4;
    f4 gg = *(const f4*)(g + k), sc = *(const f4*)(md + 1024 + k);
    sh[i] = *(const f4*)(md + k);
    a[i] = gg * (1.f + sc);
  }
  f4 xv[4][4];
#pragma unroll
  for (int r = 0; r < 4; ++r) {
    const float* xr = xrow(p, tok0 + r);
#pragma unroll
    for (int i = 0; i < 4; ++i) xv[r][i] = *(const f4*)(xr + i * 256 + lane * 4);
  }
#pragma unroll
  for (int r = 0; r < 4; ++r) {
    float ss = 0.f;
#pragma unroll
    for (int i = 0; i < 4; ++i)
      ss += xv[r][i][0] * xv[r][i][0] + xv[r][i][1] * xv[r][i][1] + xv[r][i][2] * xv[r][i][2] + xv[r][i][3] * xv[r][i][3];
    ss = wave_sum(ss);
    float rstd = rsqrtf(ss * (1.f / DM) + EPSN);
#pragma unroll
    for (int i = 0; i < 4; ++i) {
      f4 h = xv[r][i] * rstd * a[i] + sh[i];
      bf4 o; o[0] = (__bf16)h[0]; o[1] = (__bf16)h[1]; o[2] = (__bf16)h[2]; o[3] = (__bf16)h[3];
      *(bf4*)(p.hb() + (size_t)(tok0 + r) * LDH + i * 256 + lane * 4) = o;
    }
  }
}

__device__ __forceinline__ void final_norm_item(const Params& p, int item) {
  const int lane = tid_() & 63, wave = tid_() >> 6;
  const int row0 = item * 16 + wave * 4;
  f4 g[4];
#pragma unroll
  for (int i = 0; i < 4; ++i) g[i] = *(const f4*)(p.g_final + i * 256 + lane * 4);
  f4 xv[4][4];
#pragma unroll
  for (int r = 0; r < 4; ++r)
#pragma unroll
    for (int i = 0; i < 4; ++i) xv[r][i] = *(const f4*)(p.out + (size_t)(row0 + r) * DM + i * 256 + lane * 4);
#pragma unroll
  for (int r = 0; r < 4; ++r) {
    float ss = 0.f;
#pragma unroll
    for (int i = 0; i < 4; ++i)
      ss += xv[r][i][0] * xv[r][i][0] + xv[r][i][1] * xv[r][i][1] + xv[r][i][2] * xv[r][i][2] + xv[r][i][3] * xv[r][i][3];
    ss = wave_sum(ss);
    float rstd = rsqrtf(ss * (1.f / DM) + EPSN);
#pragma unroll
    for (int i = 0; i < 4; ++i) *(f4*)(p.out + (size_t)(row0 + r) * DM + i * 256 + lane * 4) = xv[r][i] * rstd * g[i];
  }
}

#define GLD 72
enum { EPI_IN = 0, EPI_UQ, EPI_UKV, EPI_OUT, EPI_UP, EPI_DOWN, EPI_OUT_AT, EPI_DOWN_AT };

__device__ __forceinline__ f4 rope4(const Params& p, f4 a, int prow, int axis, int r) {
  f4 o;
#pragma unroll
  for (int reg = 0; reg < 4; ++reg) {
    float pv = __uint_as_float(__builtin_amdgcn_update_dpp(0u, __float_as_uint(a[reg]), 0x128, 0xf, 0xf, false));
    int t = prow + reg - CTXL;
    int pos = axis ? (t & 63) : (t >> 6);
    float2 cs = ((const float2*)p.rope())[pos * 8 + (r & 7)];
    o[reg] = (r & 8) ? a[reg] * cs.x + pv * cs.y : a[reg] * cs.x - pv * cs.y;
  }
  return o;
}
__device__ __forceinline__ bf4 pack4(f4 a) {
  bf4 o; o[0] = (__bf16)a[0]; o[1] = (__bf16)a[1]; o[2] = (__bf16)a[2]; o[3] = (__bf16)a[3];
  return o;
}

template <int EPI>
__device__ __forceinline__ void gemm_epilogue(const Params& p, int l, f4 (&acc)[4][4], int m0, int n0, int wm, int wn, int lane,
                                              const float* rowss) {
  const int r = lane & 15, g = lane >> 4;
  const int b = m0 / PT;
  const int pp0 = m0 - b * PT;
  const bool lat = pp0 >= CTXL;
  const int v = lat ? b : 2;
  const float* md = p.mod() + (size_t)(l * 3 + v) * 6144;
  const int prow0 = pp0 + wm * 64 + 4 * g;
  const int tok0 = b * PT + prow0;
  constexpr int STEP = (EPI == EPI_UP) ? 2 : 1;
  if constexpr (EPI == EPI_OUT || EPI == EPI_DOWN) {
    float* xb = (lat ? p.out + (size_t)(b * SEQ + prow0 - CTXL) * DM : p.xc() + (size_t)(b * CTXL + prow0) * DM) + n0 + wn * 64 + r;
    float gt[4];
    f4 xin[4][4];
#pragma unroll
    for (int ni = 0; ni < 4; ++ni) gt[ni] = md[(EPI == EPI_OUT ? 2048 : 5120) + n0 + wn * 64 + ni * 16 + r];
#pragma unroll
    for (int mi = 0; mi < 4; ++mi)
#pragma unroll
      for (int ni = 0; ni < 4; ++ni)
#pragma unroll
        for (int q = 0; q < 4; ++q) xin[mi][ni][q] = xb[(size_t)(mi * 16 + q) * DM + ni * 16];
#pragma unroll
    for (int mi = 0; mi < 4; ++mi)
#pragma unroll
      for (int ni = 0; ni < 4; ++ni)
#pragma unroll
        for (int q = 0; q < 4; ++q) xb[(size_t)(mi * 16 + q) * DM + ni * 16] = xin[mi][ni][q] + gt[ni] * acc[mi][ni][q];
    return;
  }
  float tla[4] = {0.f, 0.f, 0.f, 0.f}, tl1[4] = {0.f, 0.f, 0.f, 0.f};
  if constexpr (EPI == EPI_IN) {
#pragma unroll
    for (int ni = 0; ni < 4; ++ni) {
      const int c0 = n0 + wn * 64 + ni * 16;
      if (c0 >= 1696 && c0 < 2720) {
        const int dir = c0 >= 2208;
        const int n1 = c0 + r - (dir ? 2208 : 1696);
        tla[ni] = p.llb()[(l * 2 + dir) * 512 + n1];
        tl1[ni] = p.l1mlb()[(l * 2 + dir) * 512 + n1];
      }
    }
  }
#pragma unroll 1
  for (int ni = 0; ni < 4; ni += STEP) {
    const int col0 = n0 + wn * 64 + ni * 16;
    const int col = col0 + r;
    if constexpr (EPI == EPI_IN) {
      if (col0 < 384) {
        __bf16* dst = col0 < 256 ? p.cq() + col : p.ckv() + (col - 256);
        const int ld = col0 < 256 ? 256 : 128;
#pragma unroll
        for (int mi = 0; mi < 4; ++mi)
#pragma unroll
          for (int q = 0; q < 4; ++q) dst[(size_t)(tok0 + mi * 16 + q) * ld] = (__bf16)acc[mi][0][q];
      } else if (col0 < 416) {
        f4 v[4];
#pragma unroll
        for (int mi = 0; mi < 4; ++mi) {
          v[mi] = acc[mi][0];
          if (lat) v[mi] = rope4(p, v[mi], prow0 + mi * 16, (col0 - 384) >> 4, r);
        }
#pragma unroll
        for (int mi = 0; mi < 4; ++mi)
#pragma unroll
          for (int h = 0; h < 4; ++h)
#pragma unroll
            for (int q = 0; q < 4; ++q) p.km()[((size_t)(b * 4 + h) * PT + prow0 + mi * 16 + q) * 96 + 64 + col - 384] = (__bf16)v[mi][q];
      } else if (col0 < 928) {
        const bool isq = col0 < 672;
        const int n1 = col - (isq ? 416 : 672);
        const int head = n1 >> 6, map = (n1 >> 5) & 1, d = n1 & 31;
        __bf16* dst = (isq ? p.qd() : p.kd()) + ((size_t)((b * 4 + head) * 2 + map) * PT) * 32 + d;
        const float sc = isq ? 0.17677669529663687f * LOG2E : 1.f;
        f4 v[4];
#pragma unroll
        for (int mi = 0; mi < 4; ++mi) {
          v[mi] = acc[mi][0];
          if (lat) v[mi] = rope4(p, v[mi], prow0 + mi * 16, (n1 >> 4) & 1, r);
        }
#pragma unroll
        for (int mi = 0; mi < 4; ++mi)
#pragma unroll
          for (int q = 0; q < 4; ++q) dst[(size_t)(prow0 + mi * 16 + q) * 32] = (__bf16)(v[mi][q] * sc);
      } else if (col0 < 1184 || (col0 >= 2720 && col0 < 3232)) {
        const bool isd = col0 < 1184;
        const int n1 = col - (isd ? 928 : 2720);
        __bf16* dst = isd ? p.vdt() + ((size_t)(b * 4 + (n1 >> 6)) * 64 + (n1 & 63)) * PT
                          : p.hvt() + ((size_t)(b * 8 + (n1 >> 6)) * 64 + (n1 & 63)) * PT;
#pragma unroll
        for (int mi = 0; mi < 4; ++mi) *(bf4*)(dst + prow0 + mi * 16) = pack4(acc[mi][0]);
      } else if (col0 < 1696 || (col0 >= 3232 && col0 < INW)) {
        const bool ish = col0 < 1696;
        __bf16* dst = ish ? p.hq() + (col - 1184) : p.hg() + (col - 3232);
#pragma unroll
        for (int mi = 0; mi < 4; ++mi)
#pragma unroll
          for (int q = 0; q < 4; ++q) dst[(size_t)(tok0 + mi * 16 + q) * 512] = (__bf16)silu_f(acc[mi][0][q]);
      } else if (col0 < 2720) {
        const int dir = col0 >= 2208;
        const int n1 = col - (dir ? 2208 : 1696);
        const float la = tla[0], l1m = tl1[0];
        float* dst = p.lf() + (size_t)dir * NTOK * 512 + n1;
#pragma unroll
        for (int mi = 0; mi < 4; ++mi)
#pragma unroll
          for (int q = 0; q < 4; ++q) dst[(size_t)(tok0 + mi * 16 + q) * 512] = log_forget(acc[mi][0][q], la, l1m);
      }
    } else if constexpr (EPI == EPI_UQ) {
      const int head = col0 / 96, d0 = col0 - head * 96;
      const float sc = 0.10206207261596577f * LOG2E;
      __bf16* dst = p.qm() + ((size_t)(b * 4 + head) * PT) * 96 + d0 + r;
      f4 v[4];
#pragma unroll
      for (int mi = 0; mi < 4; ++mi) {
        f4 a = acc[mi][0];
#pragma unroll
        for (int q = 0; q < 4; ++q) a[q] *= rsqrtf(rowss[wm * 64 + mi * 16 + 4 * g + q] * (1.f / 256.f) + EPSN);
        if (d0 >= 64 && lat) a = rope4(p, a, prow0 + mi * 16, (d0 - 64) >> 4, r);
        v[mi] = a;
      }
#pragma unroll
      for (int mi = 0; mi < 4; ++mi)
#pragma unroll
        for (int q = 0; q < 4; ++q) dst[(size_t)(prow0 + mi * 16 + q) * 96] = (__bf16)(v[mi][q] * sc);
    } else if constexpr (EPI == EPI_UKV) {
      const int head = col >> 7, d = col & 127;
#pragma unroll
      for (int mi = 0; mi < 4; ++mi) {
        f4 a = acc[mi][0];
        const int prow = prow0 + mi * 16;
#pragma unroll
        for (int q = 0; q < 4; ++q) a[q] *= rsqrtf(rowss[wm * 64 + mi * 16 + 4 * g + q] * (1.f / 128.f) + EPSN);
        if ((col0 & 127) < 64) {
#pragma unroll
          for (int q = 0; q < 4; ++q) p.km()[((size_t)(b * 4 + head) * PT + prow + q) * 96 + d] = (__bf16)a[q];
        } else {
          *(bf4*)(p.vmt() + ((size_t)(b * 4 + head) * 64 + d - 64) * PT + prow) = pack4(a);
        }
      }
    } else if constexpr (EPI == EPI_OUT || EPI == EPI_DOWN) {
    } else if constexpr (EPI == EPI_OUT_AT || EPI == EPI_DOWN_AT) {
      const float gt = md[(EPI == EPI_OUT_AT ? 2048 : 5120) + col];
      float* xb = (lat ? p.out + (size_t)(b * SEQ + prow0 - CTXL) * DM : p.xc() + (size_t)(b * CTXL + prow0) * DM) + col;
#pragma unroll
      for (int mi = 0; mi < 4; ++mi)
#pragma unroll
        for (int q = 0; q < 4; ++q) atomicAdd(xb + (size_t)(mi * 16 + q) * DM, gt * acc[mi][0][q]);
    } else if constexpr (EPI == EPI_UP) {
      const int n = (col0 >> 5) * 16 + r;
#pragma unroll
      for (int mi = 0; mi < 4; ++mi)
#pragma unroll
        for (int q = 0; q < 4; ++q)
          p.act()[(size_t)(tok0 + mi * 16 + q) * LDF + n] = (__bf16)(silu_f(acc[mi][0][q]) * acc[mi][1][q]);
    }
#pragma unroll
    for (int mi = 0; mi < 4; ++mi) {
      if constexpr (STEP == 1) { acc[mi][0] = acc[mi][1]; acc[mi][1] = acc[mi][2]; acc[mi][2] = acc[mi][3]; }
      else { acc[mi][0] = acc[mi][2]; acc[mi][1] = acc[mi][3]; }
    }
    tla[0] = tla[1]; tla[1] = tla[2]; tla[2] = tla[3]; tl1[0] = tl1[1]; tl1[1] = tl1[2]; tl1[2] = tl1[3];
  }
}

#define RAW_BARRIER() do { asm volatile("s_waitcnt lgkmcnt(0)" ::: "memory"); __builtin_amdgcn_s_barrier(); } while (0)

template <int EPI, bool ROWSS>
__device__ __forceinline__ void gemm_tile(const Params& p, int l, const __bf16* __restrict__ A, int lda, const __bf16* __restrict__ Bt, int ldb, int K,
                          int m0, int n0, char* smem, bool pre = false, bool has_next = false, int m0n = 0, int n0n = 0) {
  __bf16* S0 = (__bf16*)smem;
  float* rowss = (float*)(smem + 65536);
  const int tid = tid_(), lane = tid & 63, wave = tid >> 6;
  const int wm = wave >> 1, wn = wave & 1, r = lane & 15, g = lane >> 4;
  f4 acc[4][4];
#pragma unroll
  for (int i = 0; i < 4; ++i)
#pragma unroll
    for (int j = 0; j < 4; ++j) acc[i][j] = f4{0.f, 0.f, 0.f, 0.f};
  if constexpr (ROWSS) {
    const int row = tid >> 1, half = tid & 1;
    const __bf16* rp = A + (size_t)(m0 + row) * lda + half * (K >> 1);
    float sq = 0.f;
    for (int c = 0; c < (K >> 4); ++c) {
      bf8 v = *(const bf8*)(rp + c * 8);
#pragma unroll
      for (int j = 0; j < 8; ++j) { float f = (float)v[j]; sq += f * f; }
    }
    sq += __shfl_xor(sq, 1);
    __syncthreads();
    if (!half) rowss[row] = sq;
  }
  const int lrow = lane >> 3;
  const int sz = (lane >> 4);
  const __bf16* gaw[4]; const __bf16* gbw[4];
#pragma unroll
  for (int i = 0; i < 4; ++i) {
    const int rg = wave + 4 * i;
    const int row = rg * 8 + lrow;
    const int cl = (lane & 7) ^ (((rg & 1) * 4 + sz) & 7);
    gaw[i] = A + (size_t)(m0 + row) * lda + cl * 8;
    gbw[i] = Bt + (size_t)(n0 + row) * ldb + cl * 8;
  }
  const int aoff = (wm * 64 + r) * 64, boff = 8192 + (wn * 64 + r) * 64;
  const int sw = r >> 1;
  const int KT = K / 64;
  if (!pre) {
    __syncthreads();
#pragma unroll
    for (int i = 0; i < 4; ++i) {
      __builtin_amdgcn_global_load_lds((const unsigned*)(gaw[i]), (unsigned*)(S0 + (wave + 4 * i) * 512), 16, 0, 0);
      __builtin_amdgcn_global_load_lds((const unsigned*)(gbw[i]), (unsigned*)(S0 + 8192 + (wave + 4 * i) * 512), 16, 0, 0);
    }
  }
  asm volatile("s_waitcnt vmcnt(0)" ::: "memory");
  RAW_BARRIER();
  for (int kt = 0; kt < KT; ++kt) {
    const __bf16* Sc = S0 + (kt & 1) * 16384;
    __bf16* Sn = S0 + ((kt + 1) & 1) * 16384;
    if (kt + 1 < KT) {
#pragma unroll
      for (int i = 0; i < 4; ++i) {
        __builtin_amdgcn_global_load_lds((const unsigned*)(gaw[i] + (kt + 1) * 64), (unsigned*)(Sn + (wave + 4 * i) * 512), 16, 0, 0);
        __builtin_amdgcn_global_load_lds((const unsigned*)(gbw[i] + (kt + 1) * 64), (unsigned*)(Sn + 8192 + (wave + 4 * i) * 512), 16, 0, 0);
      }
    }
    {
      bf8 af0[4], bf0[4], af1[4], bf1[4];
      const int ch0 = ((0 * 4 + g) ^ sw) * 8, ch1 = ((1 * 4 + g) ^ sw) * 8;
#pragma unroll
      for (int i = 0; i < 4; ++i) {
        af0[i] = *(const bf8*)(Sc + aoff + i * 1024 + ch0);
        bf0[i] = *(const bf8*)(Sc + boff + i * 1024 + ch0);
      }
#pragma unroll
      for (int i = 0; i < 4; ++i) {
        af1[i] = *(const bf8*)(Sc + aoff + i * 1024 + ch1);
        bf1[i] = *(const bf8*)(Sc + boff + i * 1024 + ch1);
      }
      __builtin_amdgcn_s_setprio(1);
#pragma unroll
      for (int i = 0; i < 4; ++i)
#pragma unroll
        for (int j = 0; j < 4; ++j) acc[i][j] = mfma16(af0[i], bf0[j], acc[i][j]);
#pragma unroll
      for (int i = 0; i < 4; ++i)
#pragma unroll
        for (int j = 0; j < 4; ++j) acc[i][j] = mfma16(af1[i], bf1[j], acc[i][j]);
      __builtin_amdgcn_s_setprio(0);
      __builtin_amdgcn_sched_group_barrier(0x100, 8, 0);
#pragma unroll
      for (int i = 0; i < 8; ++i) {
        __builtin_amdgcn_sched_group_barrier(0x008, 1, 0);
        __builtin_amdgcn_sched_group_barrier(0x100, 1, 0);
      }
      __builtin_amdgcn_sched_group_barrier(0x008, 24, 0);
    }
    asm volatile("s_waitcnt vmcnt(0)" ::: "memory");
    RAW_BARRIER();
  }
  if (has_next) {
#pragma unroll
    for (int i = 0; i < 4; ++i) {
      const int rg = wave + 4 * i;
      const int row = rg * 8 + lrow;
      const int cl = (lane & 7) ^ (((rg & 1) * 4 + sz) & 7);
      __builtin_amdgcn_global_load_lds((const unsigned*)(A + (size_t)(m0n + row) * lda + cl * 8), (unsigned*)(S0 + rg * 512), 16, 0, 0);
      __builtin_amdgcn_global_load_lds((const unsigned*)(Bt + (size_t)(n0n + row) * ldb + cl * 8), (unsigned*)(S0 + 8192 + rg * 512), 16, 0, 0);
    }
  }
  gemm_epilogue<EPI>(p, l, acc, m0, n0, wm, wn, lane, rowss);
}

__device__ __forceinline__ int mtile_count(int l) { return l < 3 ? 132 : 128; }
__device__ __forceinline__ int mtile_index(int l, int i) { return l < 3 ? i : (i >> 6) * 66 + 2 + (i & 63); }

__device__ __forceinline__ bool gemm_pick(int step, int bid, int G, int MT, int NT, int W, int& mt, int& nt) {
  const int C = G >> 3;
  const int L = (step * 8 + (bid & 7)) * C + (bid >> 3);
  if (L >= MT * NT) return false;
  const int s = L / (W * MT), rem = L - s * W * MT;
  mt = rem / W; nt = s * W + (rem - mt * W);
  return true;
}

template <int DQK, int NMAP>
__device__ __forceinline__ void attn_item(const Params& p, int l, const __bf16* __restrict__ Q, const __bf16* __restrict__ Kp,
                          const __bf16* __restrict__ Vt, int b, int h, int q0, int nkeys, char* smem) {
  constexpr int KLD = DQK;
  constexpr int KCH = DQK / 8;
  constexpr int NKC = NMAP * 64 * KCH / 256;
  constexpr int NKS = DQK / 32;
  __bf16* Ks = (__bf16*)smem;
  __bf16* Vs = Ks + NMAP * 64 * KLD;
  const int tid = tid_(), lane = tid & 63, wave = tid >> 6, r = lane & 15, g = lane >> 4;
  const __bf16* Qb = Q + (size_t)((b * 4 + h) * NMAP) * PT * DQK;
  const __bf16* Kb = Kp + (size_t)((b * 4 + h) * NMAP) * PT * DQK;
  const __bf16* Vb = Vt + (size_t)((b * 4 + h) * 64) * PT;

  bf8 qf[NMAP][2][NKS];
#pragma unroll
  for (int mp = 0; mp < NMAP; ++mp)
#pragma unroll
    for (int qt = 0; qt < 2; ++qt)
#pragma unroll
      for (int ks = 0; ks < NKS; ++ks)
        qf[mp][qt][ks] = *(const bf8*)(Qb + ((size_t)mp * PT + q0 + wave * 32 + qt * 16 + r) * DQK + ks * 32 + g * 8);

  f4 o[NMAP][2][4];
  float mrun[NMAP][2], lsum[NMAP][2];
  f4 negm[NMAP][2];
#pragma unroll
  for (int mp = 0; mp < NMAP; ++mp)
#pragma unroll
    for (int qt = 0; qt < 2; ++qt) {
      mrun[mp][qt] = 0.f; lsum[mp][qt] = 0.f; negm[mp][qt] = f4{0.f, 0.f, 0.f, 0.f};
#pragma unroll
      for (int d = 0; d < 4; ++d) o[mp][qt][d] = f4{0.f, 0.f, 0.f, 0.f};
    }

  int koff_g[NKC], koff_s[NKC];
#pragma unroll
  for (int i = 0; i < NKC; ++i) {
    int c = tid + 256 * i;
    int mp = c / (64 * KCH), rem = c - mp * 64 * KCH;
    int row = rem / KCH, kc = rem - row * KCH;
    koff_g[i] = (mp * PT + row) * DQK + kc * 8;
    koff_s[i] = (mp * 64 + row) * KLD + (((kc & ~3) | ((kc & 3) ^ ((-(row >> 3)) & 3))) * 8);
  }
  bf8 rk[NKC], rv[2];
  const int nkb = nkeys / 64;
#pragma unroll
  for (int i = 0; i < NKC; ++i) rk[i] = *(const bf8*)(Kb + koff_g[i]);
#pragma unroll
  for (int i = 0; i < 2; ++i) rv[i] = *(const bf8*)(Vb + (size_t)((tid >> 3) + 32 * i) * PT + (tid & 7) * 8);

  for (int kb = 0; kb < nkb; ++kb) {
    __syncthreads();
#pragma unroll
    for (int i = 0; i < NKC; ++i) *(bf8*)(Ks + koff_s[i]) = rk[i];
#pragma unroll
    for (int i = 0; i < 2; ++i) *(bf8*)(Vs + ((tid >> 3) + 32 * i) * 64 + (((tid & 7) ^ ((tid >> 4) & 7)) * 8)) = rv[i];
    __syncthreads();
    if (kb + 1 < nkb) {
#pragma unroll
      for (int i = 0; i < NKC; ++i) rk[i] = *(const bf8*)(Kb + koff_g[i] + (size_t)(kb + 1) * 64 * DQK);
#pragma unroll
      for (int i = 0; i < 2; ++i) rv[i] = *(const bf8*)(Vb + (size_t)((tid >> 3) + 32 * i) * PT + (kb + 1) * 64 + (tid & 7) * 8);
    }
    f4 s[NMAP][2][2][2];
    {
      bf8 kfr[NMAP][2][2][NKS];
#pragma unroll
      for (int mp = 0; mp < NMAP; ++mp)
#pragma unroll
        for (int m = 0; m < 2; ++m)
#pragma unroll
          for (int tp = 0; tp < 2; ++tp) {
            const int krow = 32 * m + 8 * (r >> 2) + 4 * tp + (r & 3);
#pragma unroll
            for (int ks = 0; ks < NKS; ++ks) kfr[mp][m][tp][ks] = *(const bf8*)(Ks + (mp * 64 + krow) * KLD + ks * 32 + ((g ^ ((-(r >> 2)) & 3)) * 8));
          }
      __builtin_amdgcn_s_setprio(1);
#pragma unroll
      for (int mp = 0; mp < NMAP; ++mp)
#pragma unroll
        for (int m = 0; m < 2; ++m)
#pragma unroll
          for (int tp = 0; tp < 2; ++tp) {
            f4 s0 = negm[mp][0], s1 = negm[mp][1];
#pragma unroll
            for (int ks = 0; ks < NKS; ++ks) {
              s0 = mfma16(kfr[mp][m][tp][ks], qf[mp][0][ks], s0);
              s1 = mfma16(kfr[mp][m][tp][ks], qf[mp][1][ks], s1);
            }
            s[mp][0][m][tp] = s0; s[mp][1][m][tp] = s1;
          }
      __builtin_amdgcn_s_setprio(0);
    }
    bf8 pf[NMAP][2][2];
#pragma unroll
    for (int mp = 0; mp < NMAP; ++mp)
#pragma unroll
      for (int qt = 0; qt < 2; ++qt) {
        float ps = 0.f;
#pragma unroll
        for (int m = 0; m < 2; ++m) {
          bf8 pk;
#pragma unroll
          for (int tp = 0; tp < 2; ++tp)
#pragma unroll
            for (int q = 0; q < 4; ++q) {
              float e = __builtin_amdgcn_exp2f(s[mp][qt][m][tp][q]);
              ps += e;
              pk[tp * 4 + q] = (__bf16)e;
            }
          pf[mp][qt][m] = pk;
        }
        const bool hi = __builtin_amdgcn_ballot_w64(!(ps < 65536.f)) != 0ull;
        const bool lo = __builtin_amdgcn_ballot_w64(ps > 0.f || lsum[mp][qt] > 0.f) == 0ull;
        if (hi || lo) {
          float bm = -INFINITY;
#pragma unroll
          for (int m = 0; m < 2; ++m)
#pragma unroll
            for (int tp = 0; tp < 2; ++tp)
#pragma unroll
              for (int q = 0; q < 4; ++q) bm = fmaxf(bm, s[mp][qt][m][tp][q]);
          bm = rows_max(bm);
          const float sh = lo ? bm : fmaxf(bm, 0.f);
          const float alpha = lo ? 1.f : __builtin_amdgcn_exp2f(-sh);
          mrun[mp][qt] += sh;
          const float nm = -mrun[mp][qt];
          negm[mp][qt] = f4{nm, nm, nm, nm};
          lsum[mp][qt] *= alpha;
#pragma unroll
          for (int d = 0; d < 4; ++d) o[mp][qt][d] *= alpha;
          ps = 0.f;
#pragma unroll
          for (int m = 0; m < 2; ++m) {
            bf8 pk;
#pragma unroll
            for (int tp = 0; tp < 2; ++tp)
#pragma unroll
              for (int q = 0; q < 4; ++q) {
                float e = __builtin_amdgcn_exp2f(s[mp][qt][m][tp][q] - sh);
                ps += e;
                pk[tp * 4 + q] = (__bf16)e;
              }
            pf[mp][qt][m] = pk;
          }
        }
        lsum[mp][qt] += ps;
      }
    {
      bf8 vfr[4][2];
#pragma unroll
      for (int d = 0; d < 4; ++d)
#pragma unroll
        for (int m = 0; m < 2; ++m) vfr[d][m] = *(const bf8*)(Vs + (d * 16 + r) * 64 + (((4 * m + g) ^ (r >> 1)) * 8));
      __builtin_amdgcn_s_setprio(1);
#pragma unroll
      for (int d = 0; d < 4; ++d)
#pragma unroll
        for (int m = 0; m < 2; ++m)
#pragma unroll
          for (int mp = 0; mp < NMAP; ++mp)
#pragma unroll
            for (int qt = 0; qt < 2; ++qt) o[mp][qt][d] = mfma16(vfr[d][m], pf[mp][qt][m], o[mp][qt][d]);
    }
    __builtin_amdgcn_s_setprio(0);
  }
#pragma unroll
  for (int qt = 0; qt < 2; ++qt) {
    const int tok = b * PT + q0 + wave * 32 + qt * 16 + r;
    float inv[NMAP];
#pragma unroll
    for (int mp = 0; mp < NMAP; ++mp) {
      float ls = lsum[mp][qt];
      ls = rows_sum(ls);
      inv[mp] = 1.f / ls;
    }
    if constexpr (NMAP == 1) {
#pragma unroll
      for (int d = 0; d < 4; ++d)
        *(bf4*)(p.mix() + (size_t)tok * LDH + h * 64 + d * 16 + 4 * g) = pack4(o[0][qt][d] * inv[0]);
    } else {
      const float lam = p.lam()[l];
      const float li = 0.8f - 0.6f * expf(-0.3f * (float)l);
      f4 val[4];
      float ss = 0.f;
#pragma unroll
      for (int d = 0; d < 4; ++d) {
        val[d] = o[0][qt][d] * inv[0] - o[NMAP - 1][qt][d] * (lam * inv[NMAP - 1]);
        ss += val[d][0] * val[d][0] + val[d][1] * val[d][1] + val[d][2] * val[d][2] + val[d][3] * val[d][3];
      }
      ss = rows_sum(ss);
      const float rs = rsqrtf(ss * (1.f / 64.f) + EPSN) * (1.f - li);
      f4 gd[4];
#pragma unroll
      for (int d = 0; d < 4; ++d) gd[d] = *(const f4*)(p.g_diff_norm + l * 64 + d * 16 + 4 * g);
#pragma unroll
      for (int d = 0; d < 4; ++d) *(bf4*)(p.mix() + (size_t)tok * LDH + 256 + h * 64 + d * 16 + 4 * g) = pack4(val[d] * rs * gd[d]);
    }
  }
}

template <int DQK, int NMAP>
__device__ __forceinline__ void attn_dispatch(const Params& p, int l, int item, const __bf16* Q, const __bf16* K, const __bf16* Vt, char* smem) {
  int b, h, q0, nk;
  if (item < 512) { b = (item >> 2) & 1; h = item & 3; q0 = CTXL + (item >> 3) * 128; nk = PT; }
  else { int it = item - 512; b = it >> 3; h = (it >> 1) & 3; q0 = (it & 1) * 128; nk = CTXL; }
  attn_item<DQK, NMAP>(p, l, Q, K, Vt, b, h, q0, nk, smem);
}

__device__ __forceinline__ void hgrn1_item(const Params& p, int item, char* smem) {
  __bf16* kteT = (__bf16*)smem;
  __bf16* vT = kteT + 64 * 72;
  float* ptot = (float*)(vT + 64 * 72);
  const int tid = tid_(), lane = tid & 63, wave = tid >> 6, r = lane & 15, g = lane >> 4;
  const int c = item % NCH, bh = item / NCH;
  const int b = bh >> 3, h = bh & 7;
  const int tok0 = b * PT + c * 64;
  __syncthreads();
#pragma unroll
  for (int i = 0; i < 2; ++i) {
    int dv = (tid >> 3) + 32 * i;
    *(bf8*)(vT + dv * 72 + (tid & 7) * 8) = *(const bf8*)(p.hvt() + ((size_t)bh * 64 + dv) * PT + c * 64 + (tid & 7) * 8);
  }
  const int k = tid & 63, part = tid >> 6;
  float lfa[2][16];
#pragma unroll
  for (int dd = 0; dd < 2; ++dd) {
    const float* lfp = p.lf() + ((size_t)dd * NTOK + tok0 + part * 16) * 512 + h * 64 + k;
#pragma unroll
    for (int i = 0; i < 16; ++i) lfa[dd][i] = lfp[(size_t)i * 512];
  }
#pragma unroll
  for (int dir = 0; dir < 2; ++dir) {
    float lfv[16], cl[16];
#pragma unroll
    for (int i = 0; i < 16; ++i) lfv[i] = lfa[dir][i];
    float run = 0.f;
    if (dir == 0) {
#pragma unroll
      for (int i = 0; i < 16; ++i) { run += lfv[i]; cl[i] = run; }
    } else {
#pragma unroll
      for (int i = 15; i >= 0; --i) { run += lfv[i]; cl[i] = run; }
    }
    __syncthreads();
    ptot[part * 64 + k] = run;
    __syncthreads();
    float off = 0.f, total = 0.f;
#pragma unroll
    for (int q = 0; q < 4; ++q) {
      float t = ptot[q * 64 + k];
      total += t;
      if (dir == 0 ? (q < part) : (q > part)) off += t;
    }
#pragma unroll
    for (int i = 0; i < 16; ++i) {
      float cum = cl[i] + off;
      float kte = (1.f - __expf(lfv[i])) * __expf(total - cum);
      kteT[k * 72 + part * 16 + i] = (__bf16)kte;
    }
    const size_t sidx = ((size_t)bh * 2 + dir) * NCH + c;
    if (part == 0) p.dk()[sidx * 64 + k] = __expf(total);
    __syncthreads();
    f4 acc[4];
#pragma unroll
    for (int nt = 0; nt < 4; ++nt) acc[nt] = f4{0.f, 0.f, 0.f, 0.f};
#pragma unroll
    for (int ks = 0; ks < 2; ++ks) {
      bf8 af = *(const bf8*)(vT + (wave * 16 + r) * 72 + ks * 32 + g * 8);
#pragma unroll
      for (int nt = 0; nt < 4; ++nt) {
        bf8 bfr = *(const bf8*)(kteT + (nt * 16 + r) * 72 + ks * 32 + g * 8);
        acc[nt] = mfma16(af, bfr, acc[nt]);
      }
    }
    float* up = p.ut() + sidx * 4096;
#pragma unroll
    for (int nt = 0; nt < 4; ++nt)
#pragma unroll
      for (int q = 0; q < 4; ++q) up[(wave * 16 + 4 * g + q) * 64 + nt * 16 + r] = acc[nt][q];
  }
}

__device__ __forceinline__ void hgrn2_item(const Params& p, int item) {
  const int idx = item * 256 + tid_();
  const int e = idx & 4095, sd = idx >> 12;
  const int dir = sd & 1, kk = e & 63;
  const float* up = p.ut() + (size_t)sd * NCH * 4096 + e;
  const float* dp = p.dk() + (size_t)sd * NCH * 64 + kk;
  __bf16* sp = p.st() + (size_t)sd * NCH * 4096 + e;
  float S = 0.f;
  for (int jb = 0; jb < NCH; jb += 22) {
    float u[22], d[22];
    int cc[22];
#pragma unroll
    for (int q = 0; q < 22; ++q) {
      int j = jb + q;
      int c = dir == 0 ? j : (j < 4 ? 3 - j : 135 - j);
      cc[q] = c;
      u[q] = up[(size_t)c * 4096];
      d[q] = dp[c * 64];
    }
#pragma unroll
    for (int q = 0; q < 22; ++q) {
      sp[(size_t)cc[q] * 4096] = (__bf16)S;
      S = d[q] * S + u[q];
    }
  }
}

__device__ __forceinline__ void hgrn3_item(const Params& p, int l, int item, char* smem) {
  __bf16* qS = (__bf16*)smem;
  __bf16* kS = qS + 64 * 72;
  __bf16* vT = kS + 64 * 72;
  __bf16* stS = vT + 64 * 72;
  float* cumS = (float*)(stS + 64 * 72);
  float* ptot = cumS + 64 * 68;
  const int tid = tid_(), lane = tid & 63, wave = tid >> 6, r = lane & 15, g = lane >> 4;
  const int c = item % NCH, bh = item / NCH;
  const int b = bh >> 3, h = bh & 7;
  const int tok0 = b * PT + c * 64;
  __syncthreads();
#pragma unroll
  for (int i = 0; i < 2; ++i) {
    int row = (tid >> 3) + 32 * i;
    *(bf8*)(vT + row * 72 + (tid & 7) * 8) = *(const bf8*)(p.hvt() + ((size_t)bh * 64 + row) * PT + c * 64 + (tid & 7) * 8);
    *(bf8*)(qS + row * 72 + (tid & 7) * 8) = *(const bf8*)(p.hq() + (size_t)(tok0 + row) * 512 + h * 64 + (tid & 7) * 8);
  }
  f4 o[4];
#pragma unroll
  for (int d = 0; d < 4; ++d) o[d] = f4{0.f, 0.f, 0.f, 0.f};
  const int k = tid & 63, part = tid >> 6;
  const int t = 16 * wave + r;
  bf8 sta[2][2];
#pragma unroll
  for (int dd = 0; dd < 2; ++dd) {
    const __bf16* sp = p.st() + (((size_t)bh * 2 + dd) * NCH + c) * 4096;
#pragma unroll
    for (int i = 0; i < 2; ++i) sta[dd][i] = *(const bf8*)(sp + ((tid >> 3) + 32 * i) * 64 + (tid & 7) * 8);
  }
  float lfa[2][16];
#pragma unroll
  for (int dd = 0; dd < 2; ++dd) {
    const float* lfp = p.lf() + ((size_t)dd * NTOK + tok0 + part * 16) * 512 + h * 64 + k;
#pragma unroll
    for (int i = 0; i < 16; ++i) lfa[dd][i] = lfp[(size_t)i * 512];
  }
#pragma unroll
  for (int dir = 0; dir < 2; ++dir) {
    float lfv[16], cl[16];
#pragma unroll
    for (int i = 0; i < 16; ++i) lfv[i] = lfa[dir][i];
    float run = 0.f;
    if (dir == 0) {
#pragma unroll
      for (int i = 0; i < 16; ++i) { run += lfv[i]; cl[i] = run; }
    } else {
#pragma unroll
      for (int i = 15; i >= 0; --i) { run += lfv[i]; cl[i] = run; }
    }
    __syncthreads();
    ptot[part * 64 + k] = run;
#pragma unroll
    for (int i = 0; i < 16; ++i) kS[(part * 16 + i) * 72 + k] = (__bf16)((1.f - __expf(lfv[i])));
#pragma unroll
    for (int i = 0; i < 2; ++i) *(bf8*)(stS + ((tid >> 3) + 32 * i) * 72 + (tid & 7) * 8) = sta[dir][i];
    __syncthreads();
    float off = 0.f;
#pragma unroll
    for (int q = 0; q < 4; ++q) {
      float tt = ptot[q * 64 + k];
      if (dir == 0 ? (q < part) : (q > part)) off += tt;
    }
#pragma unroll
    for (int i = 0; i < 16; ++i) cumS[(part * 16 + i) * 68 + k] = cl[i] + off;
    __syncthreads();
    float cs[2][8];
    bf8 qtf[2], qhf[2];
#pragma unroll
    for (int ks = 0; ks < 2; ++ks) {
      const int dk0 = ks * 32 + 8 * g;
      bf8 qv = *(const bf8*)(qS + t * 72 + dk0);
#pragma unroll
      for (int j = 0; j < 8; ++j) {
        float cst;
        if (dir == 0) cst = wave > 0 ? cumS[(16 * wave - 1) * 68 + dk0 + j] : 0.f;
        else cst = wave < 3 ? cumS[(16 * wave + 16) * 68 + dk0 + j] : 0.f;
        cs[ks][j] = cst;
        float cv = cumS[t * 68 + dk0 + j];
        float qf_ = (float)qv[j];
        qtf[ks][j] = (__bf16)(qf_ * __expf(cv - cst));
        qhf[ks][j] = (__bf16)(qf_ * __expf(cv));
      }
    }
#pragma unroll
    for (int m = 0; m < 2; ++m) {
      const bool need = dir == 0 ? (m <= (wave >> 1)) : (m >= (wave >> 1));
      if (need) {
        bf8 pf;
#pragma unroll
        for (int tp = 0; tp < 2; ++tp) {
          const int srow = 32 * m + 8 * (r >> 2) + 4 * tp + (r & 3);
          f4 sc = f4{0.f, 0.f, 0.f, 0.f};
#pragma unroll
          for (int ks = 0; ks < 2; ++ks) {
            const int dk0 = ks * 32 + 8 * g;
            bf8 kv = *(const bf8*)(kS + srow * 72 + dk0);
            bf8 ktf;
#pragma unroll
            for (int j = 0; j < 8; ++j) {
              float ex = fminf(cs[ks][j] - cumS[srow * 68 + dk0 + j], 80.f);
              ktf[j] = (__bf16)((float)kv[j] * __expf(ex));
            }
            sc = mfma16(ktf, qtf[ks], sc);
          }
#pragma unroll
          for (int q = 0; q < 4; ++q) {
            const int s = 32 * m + 8 * g + 4 * tp + q;
            const bool keep = dir == 0 ? (s <= t) : (s >= t);
            pf[tp * 4 + q] = keep ? (__bf16)sc[q] : (__bf16)0.f;
          }
        }
#pragma unroll
        for (int d = 0; d < 4; ++d) {
          bf8 vf = *(const bf8*)(vT + (d * 16 + r) * 72 + 32 * m + 8 * g);
          o[d] = mfma16(vf, pf, o[d]);
        }
      }
    }
#pragma unroll
    for (int d = 0; d < 4; ++d)
#pragma unroll
      for (int ks = 0; ks < 2; ++ks) {
        bf8 sf = *(const bf8*)(stS + (d * 16 + r) * 72 + ks * 32 + 8 * g);
        o[d] = mfma16(sf, qhf[ks], o[d]);
      }
  }
  float ss = 0.f;
#pragma unroll
  for (int d = 0; d < 4; ++d) ss += o[d][0] * o[d][0] + o[d][1] * o[d][1] + o[d][2] * o[d][2] + o[d][3] * o[d][3];
  ss = rows_sum(ss);
  const float rs = rsqrtf(ss * (1.f / 64.f) + EPSN);
  f4 gn[4]; bf4 gate[4];
#pragma unroll
  for (int d = 0; d < 4; ++d) {
    gn[d] = *(const f4*)(p.g_hgrn_norm + l * 64 + d * 16 + 4 * g);
    gate[d] = *(const bf4*)(p.hg() + (size_t)(tok0 + t) * 512 + h * 64 + d * 16 + 4 * g);
  }
#pragma unroll
  for (int d = 0; d < 4; ++d) {
    f4 res;
#pragma unroll
    for (int q = 0; q < 4; ++q) res[q] = o[d][q] * rs * gn[d][q] * (float)gate[d][q];
    *(bf4*)(p.mix() + (size_t)(tok0 + t) * LDH + 512 + h * 64 + d * 16 + 4 * g) = pack4(res);
  }
}

#define NPHASE 38
#ifndef ONLY
#define ONLY -1
#endif
#define PHEN(x) (ONLY < 0 || ONLY == (x))
__device__ __forceinline__ void run_phase(const Params& p, int ph, char* smem) {
  const int bid = bid_(), G = gridDim.x;
  if (ph == 0) { if (PHEN(100)) phase0(p, smem); return; }
  if (ph == NPHASE - 1) {
    for (int it = bid; it < NB * SEQ / 16; it += G) final_norm_item(p, it);
    return;
  }
  const int l = (ph - 1) / 9, sp = (ph - 1) % 9;
  const int nmt = mtile_count(l);
  switch (sp) {
    case 0: if (PHEN(0)) {
      for (int i = bid * 256 + tid_(); i < (INWP - INW) * DM / 8; i += G * 256) {
        bf8 z;
#pragma unroll
        for (int j = 0; j < 8; ++j) z[j] = (__bf16)0.f;
        *(bf8*)(p.wt_in() + (size_t)(INW + (i >> 7)) * LDH + (size_t)(i & 127) * 8) = z;
      }
      for (int it = bid; it < 1056; it += G) norm_item(p, l, 0, it);
      conv_items(p, l, bid, G, smem);
    } break;
    case 1: if (PHEN(1)) {
      {
        int mt, nt, mtn = 0, ntn = 0;
        bool have = gemm_pick(0, bid, G, 132, 30, 10, mt, nt), pre = false;
        for (int st = 0; have; ++st) {
          const bool hn = gemm_pick(st + 1, bid, G, 132, 30, 10, mtn, ntn);
          gemm_tile<EPI_IN, false>(p, l, p.hb(), LDH, p.wt_in(), LDH, DM, mt * 128, nt * 128, smem, pre, hn, mtn * 128, ntn * 128);
          pre = hn; have = hn; mt = mtn; nt = ntn;
        }
      }
    } break;
    case 2: if (PHEN(2)) {
      const int natt = l < 3 ? 528 : 512;
      const int total = natt + 396 + 528 + 2112, K = (total + G - 1) / G;
      const bool flip = (bid >> 3) & 1;
      for (int kk = 0; kk < K; ++kk) {
        const int k = flip ? (kk + 1 == K ? 0 : kk + 1) : kk;
        const int it0 = bid + k * G;
        if (it0 >= total) continue;
        if (it0 < natt) { attn_dispatch<32, 2>(p, l, it0, p.qd(), p.kd(), p.vdt(), smem); continue; }
        const int it = it0 - natt;
        if (it < 396) gemm_tile<EPI_UQ, true>(p, l, p.cq(), 256, p.wt_uq(), 256, 256, (it / 3) * 128, (it % 3) * 128, smem);
        else if (it < 924) { int j = it - 396; gemm_tile<EPI_UKV, true>(p, l, p.ckv(), 128, p.wt_ukv(), 128, 128, (j / 4) * 128, (j % 4) * 128, smem); }
        else hgrn1_item(p, it - 924, smem);
      }
    } break;
    case 3: if (PHEN(3)) {
      const int natt = l < 3 ? 528 : 512;
      const int total = 512 + natt, K = (total + G - 1) / G;
      const bool flip = (bid >> 3) & 1;
      for (int kk = 0; kk < K; ++kk) {
        const int k = flip ? (kk + 1 == K ? 0 : kk + 1) : kk;
        const int it = bid + k * G;
        if (it >= total) continue;
        if (it < 512) hgrn2_item(p, it);
        else attn_dispatch<96, 1>(p, l, it - 512, p.qm(), p.km(), p.vmt(), smem);
      }
    } break;
    case 4: if (PHEN(4)) {
      for (int j = bid; j < 2112; j += G) {
        if (l == 3 && (j % NCH) < 4) continue;
        hgrn3_item(p, l, j, smem);
      }
    } break;
    case 5: if (PHEN(5)) {
      {
        int mt, nt, mtn = 0, ntn = 0;
        bool have = gemm_pick(0, bid, G, 128, 8, 8, mt, nt), pre = false;
        for (int st = 0; have; ++st) {
          const bool hn = gemm_pick(st + 1, bid, G, 128, 8, 8, mtn, ntn);
          gemm_tile<EPI_OUT, false>(p, l, p.mix(), LDH, p.wt_out(), LDH, DM, mtile_index(3, mt) * 128, nt * 128, smem, pre, hn,
                                    mtile_index(3, mtn) * 128, ntn * 128);
          pre = hn; have = hn; mt = mtn; nt = ntn;
        }
      }
      if (l < 3) {
        for (int u = bid; u < 32 * 8; u += G) {
          const int tile = u >> 3, sp = u & 7;
          const int cm = tile >> 3, nt = tile & 7;
          const int mt = (cm >> 1) * 66 + (cm & 1);
          gemm_tile<EPI_OUT_AT, false>(p, l, p.mix() + sp * 128, LDH, p.wt_out() + sp * 128, LDH, 128, mt * 128, nt * 128, smem);
        }
      }
    } break;
    case 6: if (PHEN(6)) {
      for (int it = bid; it < 1056; it += G) norm_item(p, l, 1, it);
    } break;
    case 7: if (PHEN(7)) {
      {
        int mt, nt, mtn = 0, ntn = 0;
        bool have = gemm_pick(0, bid, G, nmt, 44, 11, mt, nt), pre = false;
        for (int st = 0; have; ++st) {
          const bool hn = gemm_pick(st + 1, bid, G, nmt, 44, 11, mtn, ntn);
          gemm_tile<EPI_UP, false>(p, l, p.hb(), LDH, p.wt_gu(), LDH, DM, mtile_index(l, mt) * 128, nt * 128, smem, pre, hn,
                                   mtile_index(l, mtn) * 128, ntn * 128);
          pre = hn; have = hn; mt = mtn; nt = ntn;
        }
      }
    } break;
    case 8: if (PHEN(8)) {
      {
        int mt, nt, mtn = 0, ntn = 0;
        bool have = gemm_pick(0, bid, G, 128, 8, 8, mt, nt), pre = false;
        for (int st = 0; have; ++st) {
          const bool hn = gemm_pick(st + 1, bid, G, 128, 8, 8, mtn, ntn);
          gemm_tile<EPI_DOWN, false>(p, l, p.act(), LDF, p.wt_down(), LDF, DFF, mtile_index(3, mt) * 128, nt * 128, smem, pre, hn,
                                     mtile_index(3, mtn) * 128, ntn * 128);
          pre = hn; have = hn; mt = mtn; nt = ntn;
        }
      }
      if (l < 3) {
        for (int u = bid; u < 32 * 11; u += G) {
          const int tile = u / 11, sp = u - tile * 11;
          const int cm = tile >> 3, nt = tile & 7;
          const int mt = (cm >> 1) * 66 + (cm & 1);
          gemm_tile<EPI_DOWN_AT, false>(p, l, p.act() + sp * 256, LDF, p.wt_down() + sp * 256, LDF, 256, mt * 128, nt * 128, smem);
        }
      }
    } break;
  }
}

#define XB_TMO      128
#define XB_XCNT(j)  (256  + 64 * (j))
#define XB_XSUB(j)  (1280 + 64 * (j))
#define XB_XGEN(j)  (2304 + 64 * (j))
#define XB_TOP      3328
#define XB_TOPGEN   3392
#define XCD_BAR_WORDS 3456
#define XB_SPIN_CAP (1u << 22)
#define LAS __attribute__((address_space(3)))

__device__ __forceinline__ unsigned xb_ld(unsigned* p)              { return __hip_atomic_load(p, __ATOMIC_RELAXED, __HIP_MEMORY_SCOPE_AGENT); }
__device__ __forceinline__ unsigned xb_add(unsigned* p, unsigned v) { return __hip_atomic_fetch_add(p, v, __ATOMIC_RELAXED, __HIP_MEMORY_SCOPE_AGENT); }
__device__ __forceinline__ unsigned xb_xcc_id() { return (unsigned)__builtin_amdgcn_s_getreg((3 << 11) | 20) & 0xFu; }
#define XB_SPIN(cond, bar) do { unsigned _sp = 0; while (cond) { __builtin_amdgcn_s_sleep(1); \
    if ((++_sp & 255u) == 0u) { if (xb_ld(&(bar)[XB_TMO])) break; if (_sp > XB_SPIN_CAP) { atomicAdd(&(bar)[XB_TMO], 1u); break; } } } } while (0)

struct XcdBarrier {
    unsigned* bar; unsigned x;
    volatile LAS unsigned* st;
};

__device__ __forceinline__ XcdBarrier xcd_barrier_post(unsigned* bar, volatile LAS unsigned* st) {
    XcdBarrier b; b.bar = bar; b.x = xb_xcc_id(); b.st = st;
    if (threadIdx.x == 0) (void)xb_add(&bar[XB_XCNT(b.x)], 1u);
    return b;
}
__device__ __forceinline__ void xcd_barrier_complete(unsigned* bar, unsigned x, unsigned& nloc, unsigned& nx) {
    const unsigned G = gridDim.x * gridDim.y * gridDim.z;
    unsigned sum, cnt, mine, sp = 0u;
    for (;;) {
        sum = 0u; cnt = 0u; mine = 0u;
#pragma unroll
        for (unsigned j = 0; j < 16; ++j) { const unsigned c = xb_ld(&bar[XB_XCNT(j)]); sum += c; cnt += (c > 0u) ? 1u : 0u; mine = (j == x) ? c : mine; }
        if (sum == G) break;
        __builtin_amdgcn_s_sleep(1);
        if ((++sp & 255u) == 0u) { if (xb_ld(&bar[XB_TMO])) break; if (sp > XB_SPIN_CAP) { atomicAdd(&bar[XB_TMO], 1u); break; } }
    }
    nloc = mine > 0u ? mine : 1u; nx = cnt > 0u ? cnt : 1u;
}

__device__ __forceinline__ void xcd_barrier(const XcdBarrier& b) {
    asm volatile("s_waitcnt vmcnt(0)" ::: "memory");
    __syncthreads();
    if (threadIdx.x == 0) {
        unsigned* bar = b.bar;
        __builtin_amdgcn_s_waitcnt(0);
        unsigned nloc = b.st[0], nx = b.st[1];
        if (nloc == 0u) { xcd_barrier_complete(bar, b.x, nloc, nx); b.st[0] = nloc; b.st[1] = nx; }
        const unsigned old = xb_add(&bar[XB_XSUB(b.x)], 1u);
        const unsigned gen = old / nloc;
        if (old + 1u == (gen + 1u) * nloc) {
            __builtin_amdgcn_fence(__ATOMIC_RELEASE, "agent");
            asm volatile("s_waitcnt vmcnt(0)" ::: "memory");
            const unsigned og = xb_add(&bar[XB_TOP], 1u);
            const unsigned tg = og / nx;
            if (og + 1u == (tg + 1u) * nx) xb_add(&bar[XB_TOPGEN], 1u);
            else XB_SPIN(xb_ld(&bar[XB_TOPGEN]) == tg, bar);
            __builtin_amdgcn_fence(__ATOMIC_ACQUIRE, "agent");
            xb_add(&bar[XB_XGEN(b.x)], 1u);
            asm volatile("s_waitcnt vmcnt(0)" ::: "memory");
        } else {
            XB_SPIN(xb_ld(&bar[XB_XGEN(b.x)]) == gen, bar);
            __builtin_amdgcn_fence(__ATOMIC_ACQUIRE, "agent");
            asm volatile("s_waitcnt vmcnt(0)" ::: "memory");
        }
    }
    __syncthreads();
}


__device__ __forceinline__ void grid_barrier(unsigned* cnt, unsigned target) {
  asm volatile("s_waitcnt vmcnt(0)" ::: "memory");
  __syncthreads();
  if (tid_() == 0) {
    __builtin_amdgcn_fence(__ATOMIC_RELEASE, "agent");
    asm volatile("s_waitcnt vmcnt(0)" ::: "memory");
    __hip_atomic_fetch_add(cnt, 1u, __ATOMIC_RELAXED, __HIP_MEMORY_SCOPE_AGENT);
    unsigned spins = 0;
    while (__hip_atomic_load(cnt, __ATOMIC_RELAXED, __HIP_MEMORY_SCOPE_AGENT) < target) {
      __builtin_amdgcn_s_sleep(2);
      if (++spins > (1u << 24)) break;
    }
    __builtin_amdgcn_fence(__ATOMIC_ACQUIRE, "agent");
    asm volatile("s_waitcnt vmcnt(0)" ::: "memory");
  }
  __syncthreads();
}

__global__ void __launch_bounds__(256, 2) hybrid_megakernel(Params p, int ph0, int ph1) {
  __shared__ __attribute__((aligned(16))) char smem[SMEM_BYTES];
  cg::grid_group grid = cg::this_grid();
  volatile LAS unsigned* xst = (volatile LAS unsigned*)(smem + 66048);
  if (__builtin_amdgcn_workitem_id_x() == 0) { xst[0] = 0u; xst[1] = 0u; }
  __syncthreads();
  XcdBarrier xb; xb.bar = nullptr; xb.x = 0; xb.st = xst;
  for (int ph = ph0; ph < ph1; ++ph) {
    Params q = p;
    size_t zoff = 0;
    asm volatile("" : "+s"(zoff));
    q.ws = p.ws + zoff; q.out = p.out + zoff;
    run_phase(q, ph, smem);
#ifdef REPMASK
    if (ph > 0 && ph < NPHASE - 1 && ((REPMASK >> ((ph - 1) % 9)) & 1)) { grid.sync(); run_phase(q, ph, smem); }
#endif
    if (ph + 1 < ph1) {
      if (ph == ph0) { grid.sync(); xb = xcd_barrier_post((unsigned*)(p.ws + OFF_xbar), xst); }
      else xcd_barrier(xb);
    }
  }
}

extern "C" void kernel_launch(void* const* d_in, const int* in_sizes, int n_in, void* d_out, int out_size, void* d_ws,
                              size_t ws_size, hipStream_t stream) {
  static int grid_blocks = 0;
  if (!grid_blocks) {
    int dev = 0, cus = 0, per_cu = 0;
    hipGetDevice(&dev);
    hipDeviceGetAttribute(&cus, hipDeviceAttributeMultiprocessorCount, dev);
    hipOccupancyMaxActiveBlocksPerMultiprocessor(&per_cu, hybrid_megakernel, 256, 0);
    if (per_cu > 2) per_cu = 2;
    if (per_cu < 1) per_cu = 1;
    grid_blocks = cus * per_cu;
  }
  Params p{};
  const float* const* in = (const float* const*)d_in;
  p.x = in[0]; p.c = in[1]; p.ctx = in[2]; p.c_ctx = in[3]; p.w_ada = in[4]; p.b_ada = in[5]; p.g_norm1 = in[6];
  p.g_norm2 = in[7]; p.w_in = in[8]; p.g_q_norm = in[9]; p.w_uq = in[10]; p.g_kv_norm = in[11]; p.w_ukv = in[12];
  p.diff_lambda = in[13]; p.g_diff_norm = in[14]; p.hgrn_lb = in[15]; p.g_hgrn_norm = in[16]; p.w_out = in[17];
  p.w_gate = in[18]; p.w_up = in[19]; p.w_down = in[20]; p.g_final = in[21];
  p.out = (float*)d_out;
  p.ws = (char*)d_ws;
  if (WS_TOTAL > ws_size) { fprintf(stderr, "workspace too small: need %zu have %zu\n", (size_t)WS_TOTAL, ws_size); return; }
  int ph0 = 0, ph1 = NPHASE;
  void* args[] = {&p, &ph0, &ph1};
  hipError_t e = hipLaunchCooperativeKernel((void*)hybrid_megakernel, dim3(grid_blocks), dim3(256), args, 0, stream);
  if (e != hipSuccess) fprintf(stderr, "cooperative launch failed: %s (grid %d)\n", hipGetErrorString(e), grid_blocks);
}
```

```cpp
#include <hip/hip_runtime.h>
#include <hip/hip_cooperative_groups.h>
#include <cstdio>
namespace cg = cooperative_groups;

typedef __attribute__((ext_vector_type(8))) __bf16 bf8;
typedef __attribute__((ext_vector_type(4))) __bf16 bf4;
typedef __attribute__((ext_vector_type(4))) float f4;

#define XCD_BAR_WORDS_C 3456
#define NB 2
#define SEQ 8192
#define CTXL 256
#define PT 8448
#define NTOK 16896
#define DM 1024
#define INW 3744
#define INWP 3840
#define DFF 2816
#define NCH 132
#define LDH 1088
#define LDF 2880
#define LOG2E 1.4426950408889634f
#define EPSN 1e-6f
#define SMEM_BYTES 66064

constexpr size_t al256(size_t x) { return (x + 255) & ~(size_t)255; }
constexpr size_t OFF_xc = 0;
constexpr size_t OFF_mod = OFF_xc + al256((size_t)NB*CTXL*DM*4);
constexpr size_t OFF_rope = OFF_mod + al256((size_t)4*3*6144*4);
constexpr size_t OFF_llb = OFF_rope + al256(128*8*2*4);
constexpr size_t OFF_l1mlb = OFF_llb + al256(4*1024*4);
constexpr size_t OFF_lam = OFF_l1mlb + al256(4*1024*4);
constexpr size_t OFF_wt_in = OFF_lam + al256(256);
constexpr size_t OFF_wt_uq = OFF_wt_in + al256((size_t)INWP*LDH*2);
constexpr size_t OFF_wt_ukv = OFF_wt_uq + al256((size_t)384*256*2);
constexpr size_t OFF_wt_out = OFF_wt_ukv + al256((size_t)512*128*2);
constexpr size_t OFF_wt_gu = OFF_wt_out + al256((size_t)DM*LDH*2);
constexpr size_t OFF_wt_down = OFF_wt_gu + al256((size_t)2*DFF*LDH*2);
constexpr size_t OFF_hb = OFF_wt_down + al256((size_t)DM*LDF*2);
constexpr size_t OFF_cq = OFF_hb + al256((size_t)NTOK*LDH*2);
constexpr size_t OFF_ckv = OFF_cq + al256((size_t)NTOK*256*2);
constexpr size_t OFF_qm = OFF_ckv + al256((size_t)NTOK*128*2);
constexpr size_t OFF_km = OFF_qm + al256((size_t)NB*4*PT*96*2);
constexpr size_t OFF_vmt = OFF_km + al256((size_t)NB*4*PT*96*2);
constexpr size_t OFF_qd = OFF_vmt + al256((size_t)NB*4*64*PT*2);
constexpr size_t OFF_kd = OFF_qd + al256((size_t)NB*4*2*PT*32*2);
constexpr size_t OFF_vdt = OFF_kd + al256((size_t)NB*4*2*PT*32*2);
constexpr size_t OFF_hq = OFF_vdt + al256((size_t)NB*4*64*PT*2);
constexpr size_t OFF_hvt = OFF_hq + al256((size_t)NTOK*512*2);
constexpr size_t OFF_hg = OFF_hvt + al256((size_t)NB*8*64*PT*2);
constexpr size_t OFF_dk = OFF_hg + al256((size_t)NTOK*512*2);
constexpr size_t OFF_st = OFF_dk + al256((size_t)NB*8*2*NCH*64*4);
constexpr size_t OFF_lf = OFF_st + al256((size_t)NB*8*2*NCH*4096*2);
constexpr size_t OFF_ut = OFF_lf + al256((size_t)2*NTOK*512*4);
constexpr size_t OFF_xbar = OFF_ut + al256((size_t)NB*8*2*NCH*4096*4);
constexpr size_t WS_TOTAL_OLD = OFF_ut + al256((size_t)NB*8*2*NCH*4096*4);
constexpr size_t WS_TOTAL = OFF_xbar + al256((size_t)XCD_BAR_WORDS_C*4);
struct Params {
  const float *x, *c, *ctx, *c_ctx, *w_ada, *b_ada, *g_norm1, *g_norm2, *w_in, *g_q_norm, *w_uq, *g_kv_norm, *w_ukv,
      *diff_lambda, *g_diff_norm, *hgrn_lb, *g_hgrn_norm, *w_out, *w_gate, *w_up, *w_down, *g_final;
  float* out;
  char* ws;
  __device__ __forceinline__ float* xc() const { return (float*)(ws + OFF_xc); }
  __device__ __forceinline__ float* mod() const { return (float*)(ws + OFF_mod); }
  __device__ __forceinline__ float* rope() const { return (float*)(ws + OFF_rope); }
  __device__ __forceinline__ float* llb() const { return (float*)(ws + OFF_llb); }
  __device__ __forceinline__ float* l1mlb() const { return (float*)(ws + OFF_l1mlb); }
  __device__ __forceinline__ float* lam() const { return (float*)(ws + OFF_lam); }
  __device__ __forceinline__ __bf16* wt_in() const { return (__bf16*)(ws + OFF_wt_in); }
  __device__ __forceinline__ __bf16* wt_uq() const { return (__bf16*)(ws + OFF_wt_uq); }
  __device__ __forceinline__ __bf16* wt_ukv() const { return (__bf16*)(ws + OFF_wt_ukv); }
  __device__ __forceinline__ __bf16* wt_out() const { return (__bf16*)(ws + OFF_wt_out); }
  __device__ __forceinline__ __bf16* wt_gu() const { return (__bf16*)(ws + OFF_wt_gu); }
  __device__ __forceinline__ __bf16* wt_down() const { return (__bf16*)(ws + OFF_wt_down); }
  __device__ __forceinline__ __bf16* hb() const { return (__bf16*)(ws + OFF_hb); }
  __device__ __forceinline__ __bf16* cq() const { return (__bf16*)(ws + OFF_cq); }
  __device__ __forceinline__ __bf16* ckv() const { return (__bf16*)(ws + OFF_ckv); }
  __device__ __forceinline__ __bf16* qm() const { return (__bf16*)(ws + OFF_qm); }
  __device__ __forceinline__ __bf16* km() const { return (__bf16*)(ws + OFF_km); }
  __device__ __forceinline__ __bf16* vmt() const { return (__bf16*)(ws + OFF_vmt); }
  __device__ __forceinline__ __bf16* qd() const { return (__bf16*)(ws + OFF_qd); }
  __device__ __forceinline__ __bf16* kd() const { return (__bf16*)(ws + OFF_kd); }
  __device__ __forceinline__ __bf16* vdt() const { return (__bf16*)(ws + OFF_vdt); }
  __device__ __forceinline__ __bf16* hq() const { return (__bf16*)(ws + OFF_hq); }
  __device__ __forceinline__ __bf16* hvt() const { return (__bf16*)(ws + OFF_hvt); }
  __device__ __forceinline__ __bf16* hg() const { return (__bf16*)(ws + OFF_hg); }
  __device__ __forceinline__ float* dk() const { return (float*)(ws + OFF_dk); }
  __device__ __forceinline__ __bf16* st() const { return (__bf16*)(ws + OFF_st); }
  __device__ __forceinline__ float* lf() const { return (float*)(ws + OFF_lf); }
  __device__ __forceinline__ float* ut() const { return (float*)(ws + OFF_ut); }
  __device__ __forceinline__ __bf16* mix() const { return hb(); }
  __device__ __forceinline__ __bf16* act() const { return (__bf16*)lf(); }
};

__device__ __forceinline__ int tid_() { int t = __builtin_amdgcn_workitem_id_x(); asm volatile("" : "+v"(t)); return t; }
__device__ __forceinline__ int bid_() { int t = __builtin_amdgcn_workgroup_id_x(); asm volatile("" : "+s"(t)); return t; }
__device__ __forceinline__ float silu_f(float x) { return x * __builtin_amdgcn_rcpf(1.f + __expf(-x)); }
__device__ __forceinline__ float wave_sum(float v) {
  v += __uint_as_float(__builtin_amdgcn_update_dpp(0u, __float_as_uint(v), 0x128, 0xf, 0xf, false));
  v += __uint_as_float(__builtin_amdgcn_update_dpp(0u, __float_as_uint(v), 0x124, 0xf, 0xf, false));
  v += __uint_as_float(__builtin_amdgcn_update_dpp(0u, __float_as_uint(v), 0x122, 0xf, 0xf, false));
  v += __uint_as_float(__builtin_amdgcn_update_dpp(0u, __float_as_uint(v), 0x121, 0xf, 0xf, false));
  unsigned u = __float_as_uint(v);
  auto a = __builtin_amdgcn_permlane16_swap(u, u, false, false);
  float m = __uint_as_float(a[0]) + __uint_as_float(a[1]);
  unsigned w = __float_as_uint(m);
  auto b = __builtin_amdgcn_permlane32_swap(w, w, false, false);
  return __uint_as_float(b[0]) + __uint_as_float(b[1]);
}
__device__ __forceinline__ float* xrow(const Params& p, int tok) {
  int b = tok / PT, pp = tok - b * PT;
  return pp < CTXL ? p.xc() + (size_t)(b * CTXL + pp) * DM : p.out + (size_t)(b * SEQ + pp - CTXL) * DM;
}
__device__ __forceinline__ float log_forget(float z, float lb, float oml) {
  const float sg = __builtin_amdgcn_rcpf(1.f + __expf(-fmaxf(z, -80.f)));
  return __logf(lb + oml * sg);
}
__device__ __forceinline__ float rows_max(float x) {
  unsigned u = __float_as_uint(x);
  auto a = __builtin_amdgcn_permlane16_swap(u, u, false, false);
  float m = fmaxf(__uint_as_float(a[0]), __uint_as_float(a[1]));
  unsigned v = __float_as_uint(m);
  auto b = __builtin_amdgcn_permlane32_swap(v, v, false, false);
  return fmaxf(__uint_as_float(b[0]), __uint_as_float(b[1]));
}
__device__ __forceinline__ float rows_sum(float x) {
  unsigned u = __float_as_uint(x);
  auto a = __builtin_amdgcn_permlane16_swap(u, u, false, false);
  float m = __uint_as_float(a[0]) + __uint_as_float(a[1]);
  unsigned v = __float_as_uint(m);
  auto b = __builtin_amdgcn_permlane32_swap(v, v, false, false);
  return __uint_as_float(b[0]) + __uint_as_float(b[1]);
}
__device__ __forceinline__ f4 mfma16(bf8 a, bf8 b, f4 c) { return __builtin_amdgcn_mfma_f32_16x16x32_bf16(a, b, c, 0, 0, 0); }

__device__ __forceinline__ void phase0(const Params& p, char* smem) {
  const int tid = tid_();
  const int gsz = gridDim.x * 256, gtid = bid_() * 256 + tid;
  {
    const float4* xs = (const float4*)p.x; float4* xo = (float4*)p.out;
    for (int i = gtid; i < NB * SEQ * DM / 4; i += gsz) xo[i] = xs[i];
    const float4* cs = (const float4*)p.ctx; float4* co = (float4*)p.xc();
    for (int i = gtid; i < NB * CTXL * DM / 4; i += gsz) co[i] = cs[i];
  }
  if (gtid < 1024) {
    int pos = gtid >> 3, f = gtid & 7;
    float freq = powf(10000.f, -(float)f / 8.f);
    float ang = (float)pos * freq, s, c;
    sincosf(ang, &s, &c);
    p.rope()[gtid * 2] = c; p.rope()[gtid * 2 + 1] = s;
  } else if (gtid < 2048) {
    int n = gtid - 1024;
    float r0 = p.hgrn_lb[n], r1 = p.hgrn_lb[1024 + n], r2 = p.hgrn_lb[2048 + n], r3 = p.hgrn_lb[3072 + n];
    float m = fmaxf(fmaxf(r0, r1), fmaxf(r2, r3));
    float e0 = expf(r0 - m), e1 = expf(r1 - m), e2 = expf(r2 - m), e3 = expf(r3 - m);
    float s = e0 + e1 + e2 + e3;
    float p0 = e0 / s, p1 = e1 / s, p2 = e2 / s, p3 = e3 / s;
    float c0 = p0, c1 = c0 + p1, c2 = c1 + p2, c3 = c2 + p3;
    p.llb()[n] = 0.f; p.l1mlb()[n] = 1.f;
    p.llb()[1024 + n] = c1 - c0; p.l1mlb()[1024 + n] = 1.f - (c1 - c0);
    p.llb()[2048 + n] = c2 - c0; p.l1mlb()[2048 + n] = 1.f - (c2 - c0);
    p.llb()[3072 + n] = c3 - c0; p.l1mlb()[3072 + n] = 1.f - (c3 - c0);
  } else if (gtid >= 4096 && gtid < 4096 + XCD_BAR_WORDS_C) {
    ((unsigned*)(p.ws + OFF_xbar))[gtid - 4096] = 0u;
  } else if (gtid == 2052) {
    *(unsigned*)(p.ws + OFF_lam + 128) = 0u;
  } else if (gtid < 2052) {
    int l = gtid - 2048;
    const float* d = p.diff_lambda + l * 128;
    float s1 = 0.f, s2 = 0.f;
    for (int i = 0; i < 32; ++i) { s1 += d[i] * d[32 + i]; s2 += d[64 + i] * d[96 + i]; }
    float li = 0.8f - 0.6f * expf(-0.3f * (float)l);
    p.lam()[l] = expf(s1) - expf(s2) + li;
  }
  float* sl = (float*)smem;
  float* red = sl + 3072;
  bool have = false;
  for (int item = bid_(); item < 768; item += gridDim.x) {
    if (!have) {
      for (int i = tid; i < 1024; i += 256) {
        sl[i] = silu_f(p.c[i]); sl[1024 + i] = silu_f(p.c[1024 + i]); sl[2048 + i] = silu_f(p.c_ctx[i]);
      }
      have = true;
      __syncthreads();
    }
    int l = item / 192, n0 = (item % 192) * 32;
    int col = tid & 31, kg = tid >> 5;
    const float* W = p.w_ada + (size_t)l * DM * 6144 + n0 + col;
    float a0 = 0.f, a1 = 0.f, a2 = 0.f;
#pragma unroll 8
    for (int k = kg * 128; k < kg * 128 + 128; ++k) {
      float w = W[(size_t)k * 6144];
      a0 += sl[k] * w; a1 += sl[1024 + k] * w; a2 += sl[2048 + k] * w;
    }
    red[(kg * 3 + 0) * 32 + col] = a0; red[(kg * 3 + 1) * 32 + col] = a1; red[(kg * 3 + 2) * 32 + col] = a2;
    __syncthreads();
    if (tid < 96) {
      int v = tid >> 5, cc = tid & 31;
      float s = p.b_ada[l * 6144 + n0 + cc];
#pragma unroll
      for (int q = 0; q < 8; ++q) s += red[(q * 3 + v) * 32 + cc];
      p.mod()[(size_t)(l * 3 + v) * 6144 + n0 + cc] = s;
    }
    __syncthreads();
  }
}

struct ConvD { const float* srcp; size_t sstride; __bf16* dstp; const float* ksp; };

__device__ __forceinline__ ConvD conv_decode(const Params& p, int l, int it, int tid) {
  const float* src; int N, ntn, mode = 0, dld; __bf16* dst; const float* ks = nullptr;
  if (it < 1872) { src = p.w_in + (size_t)l * DM * INW; N = INW; ntn = 117; dst = p.wt_in(); dld = LDH; }
  else if (it < 1920) { it -= 1872; src = p.w_uq + (size_t)l * 256 * 384; N = 384; ntn = 12; dst = p.wt_uq(); dld = 256; ks = p.g_q_norm + l * 256; }
  else if (it < 1952) { it -= 1920; src = p.w_ukv + (size_t)l * 128 * 512; N = 512; ntn = 16; dst = p.wt_ukv(); dld = 128; ks = p.g_kv_norm + l * 128; }
  else if (it < 2464) { it -= 1952; src = p.w_out + (size_t)l * DM * DM; N = DM; ntn = 32; dst = p.wt_out(); dld = LDH; }
  else if (it < 3872) { it -= 2464; src = p.w_gate + (size_t)l * DM * DFF; N = DFF; ntn = 88; dst = p.wt_gu(); mode = 1; dld = LDH; }
  else if (it < 5280) { it -= 3872; src = p.w_up + (size_t)l * DM * DFF; N = DFF; ntn = 88; dst = p.wt_gu(); mode = 2; dld = LDH; }
  else { it -= 5280; src = p.w_down + (size_t)l * DFF * DM; N = DM; ntn = 32; dst = p.wt_down(); dld = LDF; }
  const int kt = it / ntn, nt = it - kt * ntn;
  ConvD d;
  d.srcp = src + (size_t)(kt * 64 + (tid >> 3)) * N + nt * 32 + (tid & 7) * 4;
  d.sstride = (size_t)32 * N;
  const int n = nt * 32 + (tid >> 3);
  int row = n;
  if (mode == 1) row = (n >> 4) * 32 + (n & 15);
  else if (mode == 2) row = (n >> 4) * 32 + 16 + (n & 15);
  d.dstp = dst + (size_t)row * dld + kt * 64 + (tid & 7) * 8;
  d.ksp = ks ? ks + kt * 64 + (tid & 7) * 8 : nullptr;
  return d;
}

__device__ __forceinline__ void conv_items(const Params& p, int l, int first, int step, char* smem) {
  float* tile = (float*)smem;
  const int tid = tid_();
  if (first >= 6688) return;
  ConvD cur = conv_decode(p, l, first, tid);
  float4 v0 = *(const float4*)(cur.srcp), v1 = *(const float4*)(cur.srcp + cur.sstride);
  for (int it = first; it < 6688; it += step) {
    const int itn = it + step < 6688 ? it + step : it;
    const ConvD nxt = conv_decode(p, l, itn, tid);
    const float4 n0 = *(const float4*)(nxt.srcp), n1 = *(const float4*)(nxt.srcp + nxt.sstride);
    __syncthreads();
    {
      const int r = tid >> 3, c4 = tid & 7;
      float* t = tile + r * 33 + c4 * 4;
      t[0] = v0.x; t[1] = v0.y; t[2] = v0.z; t[3] = v0.w;
      t += 32 * 33;
      t[0] = v1.x; t[1] = v1.y; t[2] = v1.z; t[3] = v1.w;
    }
    __syncthreads();
    {
      const int nr = tid >> 3, kc = tid & 7;
      bf8 o;
#pragma unroll
      for (int j = 0; j < 8; ++j) {
        float v = tile[(kc * 8 + j) * 33 + nr];
        if (cur.ksp) v *= cur.ksp[j];
        o[j] = (__bf16)v;
      }
      *(bf8*)cur.dstp = o;
    }
    cur = nxt; v0 = n0; v1 = n1;
  }
}

__device__ __forceinline__ void norm_item(const Params& p, int l, int which, int item) {
  const int lane = tid_() & 63, wave = tid_() >> 6;
  const int tok0 = item * 16 + wave * 4;
  const int b = tok0 / PT, pp = tok0 - b * PT;
  const int v = pp < CTXL ? 2 : b;
  const float* g = (which ? p.g_norm2 : p.g_norm1) + l * DM;
  const float* md = p.mod() + (size_t)(l * 3 + v) * 6144 + (which ? 3072 : 0);
  f4 a[4], sh[4];
#pragma unroll
  for (int i = 0; i < 4; ++i) {
    int k = i * 256 + lane * 4;
    f4 gg = *(const f4*)(g + k), sc = *(const f4*)(md + 1024 + k);
    sh[i] = *(const f4*)(md + k);
    a[i] = gg * (1.f + sc);
  }
  f4 xv[4][4];
#pragma unroll
  for (int r = 0; r < 4; ++r) {
    const float* xr = xrow(p, tok0 + r);
#pragma unroll
    for (int i = 0; i < 4; ++i) xv[r][i] = *(const f4*)(xr + i * 256 + lane * 4);
  }
#pragma unroll
  for (int r = 0; r < 4; ++r) {
    float ss = 0.f;
#pragma unroll
    for (int i = 0; i < 4; ++i)
      ss += xv[r][i][0] * xv[r][i][0] + xv[r][i][1] * xv[r][i][1] + xv[r][i][2] * xv[r][i][2] + xv[r][i][3] * xv[r][i][3];
    ss = wave_sum(ss);
    float rstd = rsqrtf(ss * (1.f / DM) + EPSN);
#pragma unroll
    for (int i = 0; i < 4; ++i) {
      f4 h = xv[r][i] * rstd * a[i] + sh[i];
      bf4 o; o[0] = (__bf16)h[0]; o[1] = (__bf16)h[1]; o[2] = (__bf16)h[2]; o[3] = (__bf16)h[3];
      *(bf4*)(p.hb() + (size_t)(tok0 + r) * LDH + i * 256 + lane * 4) = o;
    }
  }
}

__device__ __forceinline__ void final_norm_item(const Params& p, int item) {
  const int lane = tid_() & 63, wave = tid_() >> 6;
  const int row0 = item * 16 + wave * 4;
  f4 g[4];
#pragma unroll
  for (int i = 0; i < 4; ++i) g[i] = *(const f4*)(p.g_final + i * 256 + lane * 4);
  f4 xv[4][4];
#pragma unroll
  for (int r = 0; r < 4; ++r)
#pragma unroll
    for (int i = 0; i < 4; ++i) xv[r][i] = *(const f4*)(p.out + (size_t)(row0 + r) * DM + i * 256 + lane * 4);
#pragma unroll
  for (int r = 0; r < 4; ++r) {
    float ss = 0.f;
#pragma unroll
    for (int i = 0; i < 4; ++i)
      ss += xv[r][i][0] * xv[r][i][0] + xv[r][i][1] * xv[r][i][1] + xv[r][i][2] * xv[r][i][2] + xv[r][i][3] * xv[r][i][3];
    ss = wave_sum(ss);
    float rstd = rsqrtf(ss * (1.f / DM) + EPSN);
#pragma unroll
    for (int i = 0; i < 4; ++i) *(f4*)(p.out + (size_t)(row0 + r) * DM + i * 256 + lane * 4) = xv[r][i] * rstd * g[i];
  }
}

#define GLD 72
enum { EPI_IN = 0, EPI_UQ, EPI_UKV, EPI_OUT, EPI_UP, EPI_DOWN, EPI_OUT_AT, EPI_DOWN_AT };

__device__ __forceinline__ f4 rope4(const Params& p, f4 a, int prow, int axis, int r) {
  f4 o;
#pragma unroll
  for (int reg = 0; reg < 4; ++reg) {
    float pv = __uint_as_float(__builtin_amdgcn_update_dpp(0u, __float_as_uint(a[reg]), 0x128, 0xf, 0xf, false));
    int t = prow + reg - CTXL;
    int pos = axis ? (t & 63) : (t >> 6);
    float2 cs = ((const float2*)p.rope())[pos * 8 + (r & 7)];
    o[reg] = (r & 8) ? a[reg] * cs.x + pv * cs.y : a[reg] * cs.x - pv * cs.y;
  }
  return o;
}
__device__ __forceinline__ bf4 pack4(f4 a) {
  bf4 o; o[0] = (__bf16)a[0]; o[1] = (__bf16)a[1]; o[2] = (__bf16)a[2]; o[3] = (__bf16)a[3];
  return o;
}

template <int EPI>
__device__ __forceinline__ void gemm_epilogue(const Params& p, int l, f4 (&acc)[4][4], int m0, int n0, int wm, int wn, int lane,
                                              const float* rowss) {
  const int r = lane & 15, g = lane >> 4;
  const int b = m0 / PT;
  const int pp0 = m0 - b * PT;
  const bool lat = pp0 >= CTXL;
  const int v = lat ? b : 2;
  const float* md = p.mod() + (size_t)(l * 3 + v) * 6144;
  const int prow0 = pp0 + wm * 64 + 4 * g;
  const int tok0 = b * PT + prow0;
  constexpr int STEP = (EPI == EPI_UP) ? 2 : 1;
  if constexpr (EPI == EPI_OUT || EPI == EPI_DOWN) {
    float* xb = (lat ? p.out + (size_t)(b * SEQ + prow0 - CTXL) * DM : p.xc() + (size_t)(b * CTXL + prow0) * DM) + n0 + wn * 64 + r;
    float gt[4];
    f4 xin[4][4];
#pragma unroll
    for (int ni = 0; ni < 4; ++ni) gt[ni] = md[(EPI == EPI_OUT ? 2048 : 5120) + n0 + wn * 64 + ni * 16 + r];
#pragma unroll
    for (int mi = 0; mi < 4; ++mi)
#pragma unroll
      for (int ni = 0; ni < 4; ++ni)
#pragma unroll
        for (int q = 0; q < 4; ++q) xin[mi][ni][q] = xb[(size_t)(mi * 16 + q) * DM + ni * 16];
#pragma unroll
    for (int mi = 0; mi < 4; ++mi)
#pragma unroll
      for (int ni = 0; ni < 4; ++ni)
#pragma unroll
        for (int q = 0; q < 4; ++q) xb[(size_t)(mi * 16 + q) * DM + ni * 16] = xin[mi][ni][q] + gt[ni] * acc[mi][ni][q];
    return;
  }
  float tla[4] = {0.f, 0.f, 0.f, 0.f}, tl1[4] = {0.f, 0.f, 0.f, 0.f};
  if constexpr (EPI == EPI_IN) {
#pragma unroll
    for (int ni = 0; ni < 4; ++ni) {
      const int c0 = n0 + wn * 64 + ni * 16;
      if (c0 >= 1696 && c0 < 2720) {
        const int dir = c0 >= 2208;
        const int n1 = c0 + r - (dir ? 2208 : 1696);
        tla[ni] = p.llb()[(l * 2 + dir) * 512 + n1];
        tl1[ni] = p.l1mlb()[(l * 2 + dir) * 512 + n1];
      }
    }
  }
#pragma unroll 1
  for (int ni = 0; ni < 4; ni += STEP) {
    const int col0 = n0 + wn * 64 + ni * 16;
    const int col = col0 + r;
    if constexpr (EPI == EPI_IN) {
      if (col0 < 384) {
        __bf16* dst = col0 < 256 ? p.cq() + col : p.ckv() + (col - 256);
        const int ld = col0 < 256 ? 256 : 128;
#pragma unroll
        for (int mi = 0; mi < 4; ++mi)
#pragma unroll
          for (int q = 0; q < 4; ++q) dst[(size_t)(tok0 + mi * 16 + q) * ld] = (__bf16)acc[mi][0][q];
      } else if (col0 < 416) {
        f4 v[4];
#pragma unroll
        for (int mi = 0; mi < 4; ++mi) {
          v[mi] = acc[mi][0];
          if (lat) v[mi] = rope4(p, v[mi], prow0 + mi * 16, (col0 - 384) >> 4, r);
        }
#pragma unroll
        for (int mi = 0; mi < 4; ++mi)
#pragma unroll
          for (int h = 0; h < 4; ++h)
#pragma unroll
            for (int q = 0; q < 4; ++q) p.km()[((size_t)(b * 4 + h) * PT + prow0 + mi * 16 + q) * 96 + 64 + col - 384] = (__bf16)v[mi][q];
      } else if (col0 < 928) {
        const bool isq = col0 < 672;
        const int n1 = col - (isq ? 416 : 672);
        const int head = n1 >> 6, map = (n1 >> 5) & 1, d = n1 & 31;
        __bf16* dst = (isq ? p.qd() : p.kd()) + ((size_t)((b * 4 + head) * 2 + map) * PT) * 32 + d;
        const float sc = isq ? 0.17677669529663687f * LOG2E : 1.f;
        f4 v[4];
#pragma unroll
        for (int mi = 0; mi < 4; ++mi) {
          v[mi] = acc[mi][0];
          if (lat) v[mi] = rope4(p, v[mi], prow0 + mi * 16, (n1 >> 4) & 1, r);
        }
#pragma unroll
        for (int mi = 0; mi < 4; ++mi)
#pragma unroll
          for (int q = 0; q < 4; ++q) dst[(size_t)(prow0 + mi * 16 + q) * 32] = (__bf16)(v[mi][q] * sc);
      } else if (col0 < 1184 || (col0 >= 2720 && col0 < 3232)) {
        const bool isd = col0 < 1184;
        const int n1 = col - (isd ? 928 : 2720);
        __bf16* dst = isd ? p.vdt() + ((size_t)(b * 4 + (n1 >> 6)) * 64 + (n1 & 63)) * PT
                          : p.hvt() + ((size_t)(b * 8 + (n1 >> 6)) * 64 + (n1 & 63)) * PT;
#pragma unroll
        for (int mi = 0; mi < 4; ++mi) *(bf4*)(dst + prow0 + mi * 16) = pack4(acc[mi][0]);
      } else if (col0 < 1696 || (col0 >= 3232 && col0 < INW)) {
        const bool ish = col0 < 1696;
        __bf16* dst = ish ? p.hq() + (col - 1184) : p.hg() + (col - 3232);
#pragma unroll
        for (int mi = 0; mi < 4; ++mi)
#pragma unroll
          for (int q = 0; q < 4; ++q) dst[(size_t)(tok0 + mi * 16 + q) * 512] = (__bf16)silu_f(acc[mi][0][q]);
      } else if (col0 < 2720) {
        const int dir = col0 >= 2208;
        const int n1 = col - (dir ? 2208 : 1696);
        const float la = tla[0], l1m = tl1[0];
        float* dst = p.lf() + (size_t)dir * NTOK * 512 + n1;
#pragma unroll
        for (int mi = 0; mi < 4; ++mi)
#pragma unroll
          for (int q = 0; q < 4; ++q) dst[(size_t)(tok0 + mi * 16 + q) * 512] = log_forget(acc[mi][0][q], la, l1m);
      }
    } else if constexpr (EPI == EPI_UQ) {
      const int head = col0 / 96, d0 = col0 - head * 96;
      const float sc = 0.10206207261596577f * LOG2E;
      __bf16* dst = p.qm() + ((size_t)(b * 4 + head) * PT) * 96 + d0 + r;
      f4 v[4];
#pragma unroll
      for (int mi = 0; mi < 4; ++mi) {
        f4 a = acc[mi][0];
#pragma unroll
        for (int q = 0; q < 4; ++q) a[q] *= rsqrtf(rowss[wm * 64 + mi * 16 + 4 * g + q] * (1.f / 256.f) + EPSN);
        if (d0 >= 64 && lat) a = rope4(p, a, prow0 + mi * 16, (d0 - 64) >> 4, r);
        v[mi] = a;
      }
#pragma unroll
      for (int mi = 0; mi < 4; ++mi)
#pragma unroll
        for (int q = 0; q < 4; ++q) dst[(size_t)(prow0 + mi * 16 + q) * 96] = (__bf16)(v[mi][q] * sc);
    } else if constexpr (EPI == EPI_UKV) {
      const int head = col >> 7, d = col & 127;
#pragma unroll
      for (int mi = 0; mi < 4; ++mi) {
        f4 a = acc[mi][0];
        const int prow = prow0 + mi * 16;
#pragma unroll
        for (int q = 0; q < 4; ++q) a[q] *= rsqrtf(rowss[wm * 64 + mi * 16 + 4 * g + q] * (1.f / 128.f) + EPSN);
        if ((col0 & 127) < 64) {
#pragma unroll
          for (int q = 0; q < 4; ++q) p.km()[((size_t)(b * 4 + head) * PT + prow + q) * 96 + d] = (__bf16)a[q];
        } else {
          *(bf4*)(p.vmt() + ((size_t)(b * 4 + head) * 64 + d - 64) * PT + prow) = pack4(a);
        }
      }
    } else if constexpr (EPI == EPI_OUT || EPI == EPI_DOWN) {
    } else if constexpr (EPI == EPI_OUT_AT || EPI == EPI_DOWN_AT) {
      const float gt = md[(EPI == EPI_OUT_AT ? 2048 : 5120) + col];
      float* xb = (lat ? p.out + (size_t)(b * SEQ + prow0 - CTXL) * DM : p.xc() + (size_t)(b * CTXL + prow0) * DM) + col;
#pragma unroll
      for (int mi = 0; mi < 4; ++mi)
#pragma unroll
        for (int q = 0; q < 4; ++q) atomicAdd(xb + (size_t)(mi * 16 + q) * DM, gt * acc[mi][0][q]);
    } else if constexpr (EPI == EPI_UP) {
      const int n = (col0 >> 5) * 16 + r;
#pragma unroll
      for (int mi = 0; mi < 4; ++mi)
#pragma unroll
        for (int q = 0; q < 4; ++q)
          p.act()[(size_t)(tok0 + mi * 16 + q) * LDF + n] = (__bf16)(silu_f(acc[mi][0][q]) * acc[mi][1][q]);
    }
#pragma unroll
    for (int mi = 0; mi < 4; ++mi) {
      if constexpr (STEP == 1) { acc[mi][0] = acc[mi][1]; acc[mi][1] = acc[mi][2]; acc[mi][2] = acc[mi][3]; }
      else { acc[mi][0] = acc[mi][2]; acc[mi][1] = acc[mi][3]; }
    }
    tla[0] = tla[1]; tla[1] = tla[2]; tla[2] = tla[3]; tl1[0] = tl1[1]; tl1[1] = tl1[2]; tl1[2] = tl1[3];
  }
}

#define RAW_BARRIER() do { asm volatile("s_waitcnt lgkmcnt(0)" ::: "memory"); __builtin_amdgcn_s_barrier(); } while (0)

template <int EPI, bool ROWSS>
__device__ __forceinline__ void gemm_tile(const Params& p, int l, const __bf16* __restrict__ A, int lda, const __bf16* __restrict__ Bt, int ldb, int K,
                          int m0, int n0, char* smem, bool pre = false, bool has_next = false, int m0n = 0, int n0n = 0) {
  __bf16* S0 = (__bf16*)smem;
  float* rowss = (float*)(smem + 65536);
  const int tid = tid_(), lane = tid & 63, wave = tid >> 6;
  const int wm = wave >> 1, wn = wave & 1, r = lane & 15, g = lane >> 4;
  f4 acc[4][4];
#pragma unroll
  for (int i = 0; i < 4; ++i)
#pragma unroll
    for (int j = 0; j < 4; ++j) acc[i][j] = f4{0.f, 0.f, 0.f, 0.f};
  if constexpr (ROWSS) {
    const int row = tid >> 1, half = tid & 1;
    const __bf16* rp = A + (size_t)(m0 + row) * lda + half * (K >> 1);
    float sq = 0.f;
    for (int c = 0; c < (K >> 4); ++c) {
      bf8 v = *(const bf8*)(rp + c * 8);
#pragma unroll
      for (int j = 0; j < 8; ++j) { float f = (float)v[j]; sq += f * f; }
    }
    sq += __shfl_xor(sq, 1);
    __syncthreads();
    if (!half) rowss[row] = sq;
  }
  const int lrow = lane >> 3;
  const int sz = (lane >> 4);
  const __bf16* gaw[4]; const __bf16* gbw[4];
#pragma unroll
  for (int i = 0; i < 4; ++i) {
    const int rg = wave + 4 * i;
    const int row = rg * 8 + lrow;
    const int cl = (lane & 7) ^ (((rg & 1) * 4 + sz) & 7);
    gaw[i] = A + (size_t)(m0 + row) * lda + cl * 8;
    gbw[i] = Bt + (size_t)(n0 + row) * ldb + cl * 8;
  }
  const int aoff = (wm * 64 + r) * 64, boff = 8192 + (wn * 64 + r) * 64;
  const int sw = r >> 1;
  const int KT = K / 64;
  if (!pre) {
    __syncthreads();
#pragma unroll
    for (int i = 0; i < 4; ++i) {
      __builtin_amdgcn_global_load_lds((const unsigned*)(gaw[i]), (unsigned*)(S0 + (wave + 4 * i) * 512), 16, 0, 0);
      __builtin_amdgcn_global_load_lds((const unsigned*)(gbw[i]), (unsigned*)(S0 + 8192 + (wave + 4 * i) * 512), 16, 0, 0);
    }
  }
  asm volatile("s_waitcnt vmcnt(0)" ::: "memory");
  RAW_BARRIER();
  for (int kt = 0; kt < KT; ++kt) {
    const __bf16* Sc = S0 + (kt & 1) * 16384;
    __bf16* Sn = S0 + ((kt + 1) & 1) * 16384;
    if (kt + 1 < KT) {
#pragma unroll
      for (int i = 0; i < 4; ++i) {
        __builtin_amdgcn_global_load_lds((const unsigned*)(gaw[i] + (kt + 1) * 64), (unsigned*)(Sn + (wave + 4 * i) * 512), 16, 0, 0);
        __builtin_amdgcn_global_load_lds((const unsigned*)(gbw[i] + (kt + 1) * 64), (unsigned*)(Sn + 8192 + (wave + 4 * i) * 512), 16, 0, 0);
      }
    }
    {
      bf8 af0[4], bf0[4], af1[4], bf1[4];
      const int ch0 = ((0 * 4 + g) ^ sw) * 8, ch1 = ((1 * 4 + g) ^ sw) * 8;
#pragma unroll
      for (int i = 0; i < 4; ++i) {
        af0[i] = *(const bf8*)(Sc + aoff + i * 1024 + ch0);
        bf0[i] = *(const bf8*)(Sc + boff + i * 1024 + ch0);
      }
#pragma unroll
      for (int i = 0; i < 4; ++i) {
        af1[i] = *(const bf8*)(Sc + aoff + i * 1024 + ch1);
        bf1[i] = *(const bf8*)(Sc + boff + i * 1024 + ch1);
      }
      __builtin_amdgcn_s_setprio(1);
#pragma unroll
      for (int i = 0; i < 4; ++i)
#pragma unroll
        for (int j = 0; j < 4; ++j) acc[i][j] = mfma16(af0[i], bf0[j], acc[i][j]);
#pragma unroll
      for (int i = 0; i < 4; ++i)
#pragma unroll
        for (int j = 0; j < 4; ++j) acc[i][j] = mfma16(af1[i], bf1[j], acc[i][j]);
      __builtin_amdgcn_s_setprio(0);
      __builtin_amdgcn_sched_group_barrier(0x100, 8, 0);
#pragma unroll
      for (int i = 0; i < 8; ++i) {
        __builtin_amdgcn_sched_group_barrier(0x008, 1, 0);
        __builtin_amdgcn_sched_group_barrier(0x100, 1, 0);
      }
      __builtin_amdgcn_sched_group_barrier(0x008, 24, 0);
    }
    asm volatile("s_waitcnt vmcnt(0)" ::: "memory");
    RAW_BARRIER();
  }
  if (has_next) {
#pragma unroll
    for (int i = 0; i < 4; ++i) {
      const int rg = wave + 4 * i;
      const int row = rg * 8 + lrow;
      const int cl = (lane & 7) ^ (((rg & 1) * 4 + sz) & 7);
      __builtin_amdgcn_global_load_lds((const unsigned*)(A + (size_t)(m0n + row) * lda + cl * 8), (unsigned*)(S0 + rg * 512), 16, 0, 0);
      __builtin_amdgcn_global_load_lds((const unsigned*)(Bt + (size_t)(n0n + row) * ldb + cl * 8), (unsigned*)(S0 + 8192 + rg * 512), 16, 0, 0);
    }
  }
  gemm_epilogue<EPI>(p, l, acc, m0, n0, wm, wn, lane, rowss);
}

__device__ __forceinline__ int mtile_count(int l) { return l < 3 ? 132 : 128; }
__device__ __forceinline__ int mtile_index(int l, int i) { return l < 3 ? i : (i >> 6) * 66 + 2 + (i & 63); }

__device__ __forceinline__ bool gemm_pick(int step, int bid, int G, int MT, int NT, int W, int& mt, int& nt) {
  const int C = G >> 3;
  const int L = (step * 8 + (bid & 7)) * C + (bid >> 3);
  if (L >= MT * NT) return false;
  const int s = L / (W * MT), rem = L - s * W * MT;
  mt = rem / W; nt = s * W + (rem - mt * W);
  return true;
}

template <int DQK, int NMAP>
__device__ __forceinline__ void attn_item(const Params& p, int l, const __bf16* __restrict__ Q, const __bf16* __restrict__ Kp,
                          const __bf16* __restrict__ Vt, int b, int h, int q0, int nkeys, char* smem) {
  constexpr int KLD = DQK;
  constexpr int KCH = DQK / 8;
  constexpr int NKC = NMAP * 64 * KCH / 256;
  constexpr int NKS = DQK / 32;
  __bf16* Ks = (__bf16*)smem;
  __bf16* Vs = Ks + NMAP * 64 * KLD;
  const int tid = tid_(), lane = tid & 63, wave = tid >> 6, r = lane & 15, g = lane >> 4;
  const __bf16* Qb = Q + (size_t)((b * 4 + h) * NMAP) * PT * DQK;
  const __bf16* Kb = Kp + (size_t)((b * 4 + h) * NMAP) * PT * DQK;
  const __bf16* Vb = Vt + (size_t)((b * 4 + h) * 64) * PT;

  bf8 qf[NMAP][2][NKS];
#pragma unroll
  for (int mp = 0; mp < NMAP; ++mp)
#pragma unroll
    for (int qt = 0; qt < 2; ++qt)
#pragma unroll
      for (int ks = 0; ks < NKS; ++ks)
        qf[mp][qt][ks] = *(const bf8*)(Qb + ((size_t)mp * PT + q0 + wave * 32 + qt * 16 + r) * DQK + ks * 32 + g * 8);

  f4 o[NMAP][2][4];
  float mrun[NMAP][2], lsum[NMAP][2];
  f4 negm[NMAP][2];
#pragma unroll
  for (int mp = 0; mp < NMAP; ++mp)
#pragma unroll
    for (int qt = 0; qt < 2; ++qt) {
      mrun[mp][qt] = 0.f; lsum[mp][qt] = 0.f; negm[mp][qt] = f4{0.f, 0.f, 0.f, 0.f};
#pragma unroll
      for (int d = 0; d < 4; ++d) o[mp][qt][d] = f4{0.f, 0.f, 0.f, 0.f};
    }

  int koff_g[NKC], koff_s[NKC];
#pragma unroll
  for (int i = 0; i < NKC; ++i) {
    int c = tid + 256 * i;
    int mp = c / (64 * KCH), rem = c - mp * 64 * KCH;
    int row = rem / KCH, kc = rem - row * KCH;
    koff_g[i] = (mp * PT + row) * DQK + kc * 8;
    koff_s[i] = (mp * 64 + row) * KLD + (((kc & ~3) | ((kc & 3) ^ ((-(row >> 3)) & 3))) * 8);
  }
  bf8 rk[NKC], rv[2];
  const int nkb = nkeys / 64;
#pragma unroll
  for (int i = 0; i < NKC; ++i) rk[i] = *(const bf8*)(Kb + koff_g[i]);
#pragma unroll
  for (int i = 0; i < 2; ++i) rv[i] = *(const bf8*)(Vb + (size_t)((tid >> 3) + 32 * i) * PT + (tid & 7) * 8);

  for (int kb = 0; kb < nkb; ++kb) {
    __syncthreads();
    __builtin_amdgcn_s_setprio(2);
#pragma unroll
    for (int i = 0; i < NKC; ++i) *(bf8*)(Ks + koff_s[i]) = rk[i];
#pragma unroll
    for (int i = 0; i < 2; ++i) *(bf8*)(Vs + ((tid >> 3) + 32 * i) * 64 + (((tid & 7) ^ ((tid >> 4) & 7)) * 8)) = rv[i];
    __syncthreads();
    if (kb + 1 < nkb) {
#pragma unroll
      for (int i = 0; i < NKC; ++i) rk[i] = *(const bf8*)(Kb + koff_g[i] + (size_t)(kb + 1) * 64 * DQK);
#pragma unroll
      for (int i = 0; i < 2; ++i) rv[i] = *(const bf8*)(Vb + (size_t)((tid >> 3) + 32 * i) * PT + (kb + 1) * 64 + (tid & 7) * 8);
    }
    __builtin_amdgcn_s_setprio(0);
    f4 s[NMAP][2][2][2];
    {
      bf8 kfr[NMAP][2][2][NKS];
#pragma unroll
      for (int mp = 0; mp < NMAP; ++mp)
#pragma unroll
        for (int m = 0; m < 2; ++m)
#pragma unroll
          for (int tp = 0; tp < 2; ++tp) {
            const int krow = 32 * m + 8 * (r >> 2) + 4 * tp + (r & 3);
#pragma unroll
            for (int ks = 0; ks < NKS; ++ks) kfr[mp][m][tp][ks] = *(const bf8*)(Ks + (mp * 64 + krow) * KLD + ks * 32 + ((g ^ ((-(r >> 2)) & 3)) * 8));
          }
      __builtin_amdgcn_s_setprio(1);
#pragma unroll
      for (int mp = 0; mp < NMAP; ++mp)
#pragma unroll
        for (int m = 0; m < 2; ++m)
#pragma unroll
          for (int tp = 0; tp < 2; ++tp) {
            f4 s0 = negm[mp][0], s1 = negm[mp][1];
#pragma unroll
            for (int ks = 0; ks < NKS; ++ks) {
              s0 = mfma16(kfr[mp][m][tp][ks], qf[mp][0][ks], s0);
              s1 = mfma16(kfr[mp][m][tp][ks], qf[mp][1][ks], s1);
            }
            s[mp][0][m][tp] = s0; s[mp][1][m][tp] = s1;
          }
      __builtin_amdgcn_s_setprio(0);
    }
    bf8 pf[NMAP][2][2];
#pragma unroll
    for (int mp = 0; mp < NMAP; ++mp)
#pragma unroll
      for (int qt = 0; qt < 2; ++qt) {
        float ps = 0.f;
#pragma unroll
        for (int m = 0; m < 2; ++m) {
          bf8 pk;
#pragma unroll
          for (int tp = 0; tp < 2; ++tp)
#pragma unroll
            for (int q = 0; q < 4; ++q) {
              float e = __builtin_amdgcn_exp2f(s[mp][qt][m][tp][q]);
              ps += e;
              pk[tp * 4 + q] = (__bf16)e;
            }
          pf[mp][qt][m] = pk;
        }
        const bool hi = __builtin_amdgcn_ballot_w64(!(ps < 65536.f)) != 0ull;
        const bool lo = __builtin_amdgcn_ballot_w64(ps > 0.f || lsum[mp][qt] > 0.f) == 0ull;
        if (hi || lo) {
          float bm = -INFINITY;
#pragma unroll
          for (int m = 0; m < 2; ++m)
#pragma unroll
            for (int tp = 0; tp < 2; ++tp)
#pragma unroll
              for (int q = 0; q < 4; ++q) bm = fmaxf(bm, s[mp][qt][m][tp][q]);
          bm = rows_max(bm);
          const float sh = lo ? bm : fmaxf(bm, 0.f);
          const float alpha = lo ? 1.f : __builtin_amdgcn_exp2f(-sh);
          mrun[mp][qt] += sh;
          const float nm = -mrun[mp][qt];
          negm[mp][qt] = f4{nm, nm, nm, nm};
          lsum[mp][qt] *= alpha;
#pragma unroll
          for (int d = 0; d < 4; ++d) o[mp][qt][d] *= alpha;
          ps = 0.f;
#pragma unroll
          for (int m = 0; m < 2; ++m) {
            bf8 pk;
#pragma unroll
            for (int tp = 0; tp < 2; ++tp)
#pragma unroll
              for (int q = 0; q < 4; ++q) {
                float e = __builtin_amdgcn_exp2f(s[mp][qt][m][tp][q] - sh);
                ps += e;
                pk[tp * 4 + q] = (__bf16)e;
              }
            pf[mp][qt][m] = pk;
          }
        }
        lsum[mp][qt] += ps;
      }
    {
      bf8 vfr[4][2];
#pragma unroll
      for (int d = 0; d < 4; ++d)
#pragma unroll
        for (int m = 0; m < 2; ++m) vfr[d][m] = *(const bf8*)(Vs + (d * 16 + r) * 64 + (((4 * m + g) ^ (r >> 1)) * 8));
      __builtin_amdgcn_s_setprio(1);
#pragma unroll
      for (int d = 0; d < 4; ++d)
#pragma unroll
        for (int m = 0; m < 2; ++m)
#pragma unroll
          for (int mp = 0; mp < NMAP; ++mp)
#pragma unroll
            for (int qt = 0; qt < 2; ++qt) o[mp][qt][d] = mfma16(vfr[d][m], pf[mp][qt][m], o[mp][qt][d]);
    }
    __builtin_amdgcn_s_setprio(0);
  }
#pragma unroll
  for (int qt = 0; qt < 2; ++qt) {
    const int tok = b * PT + q0 + wave * 32 + qt * 16 + r;
    float inv[NMAP];
#pragma unroll
    for (int mp = 0; mp < NMAP; ++mp) {
      float ls = lsum[mp][qt];
      ls = rows_sum(ls);
      inv[mp] = 1.f / ls;
    }
    if constexpr (NMAP == 1) {
#pragma unroll
      for (int d = 0; d < 4; ++d)
        *(bf4*)(p.mix() + (size_t)tok * LDH + h * 64 + d * 16 + 4 * g) = pack4(o[0][qt][d] * inv[0]);
    } else {
      const float lam = p.lam()[l];
      const float li = 0.8f - 0.6f * expf(-0.3f * (float)l);
      f4 val[4];
      float ss = 0.f;
#pragma unroll
      for (int d = 0; d < 4; ++d) {
        val[d] = o[0][qt][d] * inv[0] - o[NMAP - 1][qt][d] * (lam * inv[NMAP - 1]);
        ss += val[d][0] * val[d][0] + val[d][1] * val[d][1] + val[d][2] * val[d][2] + val[d][3] * val[d][3];
      }
      ss = rows_sum(ss);
      const float rs = rsqrtf(ss * (1.f / 64.f) + EPSN) * (1.f - li);
      f4 gd[4];
#pragma unroll
      for (int d = 0; d < 4; ++d) gd[d] = *(const f4*)(p.g_diff_norm + l * 64 + d * 16 + 4 * g);
#pragma unroll
      for (int d = 0; d < 4; ++d) *(bf4*)(p.mix() + (size_t)tok * LDH + 256 + h * 64 + d * 16 + 4 * g) = pack4(val[d] * rs * gd[d]);
    }
  }
}

template <int DQK, int NMAP>
__device__ __forceinline__ void attn_dispatch(const Params& p, int l, int item, const __bf16* Q, const __bf16* K, const __bf16* Vt, char* smem) {
  int b, h, q0, nk;
  if (item < 512) { b = (item >> 2) & 1; h = item & 3; q0 = CTXL + (item >> 3) * 128; nk = PT; }
  else { int it = item - 512; b = it >> 3; h = (it >> 1) & 3; q0 = (it & 1) * 128; nk = CTXL; }
  attn_item<DQK, NMAP>(p, l, Q, K, Vt, b, h, q0, nk, smem);
}

__device__ __forceinline__ void hgrn1_item(const Params& p, int item, char* smem) {
  __bf16* kteT = (__bf16*)smem;
  __bf16* vT = kteT + 64 * 72;
  float* ptot = (float*)(vT + 64 * 72);
  const int tid = tid_(), lane = tid & 63, wave = tid >> 6, r = lane & 15, g = lane >> 4;
  const int c = item % NCH, bh = item / NCH;
  const int b = bh >> 3, h = bh & 7;
  const int tok0 = b * PT + c * 64;
  __syncthreads();
#pragma unroll
  for (int i = 0; i < 2; ++i) {
    int dv = (tid >> 3) + 32 * i;
    *(bf8*)(vT + dv * 72 + (tid & 7) * 8) = *(const bf8*)(p.hvt() + ((size_t)bh * 64 + dv) * PT + c * 64 + (tid & 7) * 8);
  }
  const int k = tid & 63, part = tid >> 6;
  float lfa[2][16];
#pragma unroll
  for (int dd = 0; dd < 2; ++dd) {
    const float* lfp = p.lf() + ((size_t)dd * NTOK + tok0 + part * 16) * 512 + h * 64 + k;
#pragma unroll
    for (int i = 0; i < 16; ++i) lfa[dd][i] = lfp[(size_t)i * 512];
  }
#pragma unroll
  for (int dir = 0; dir < 2; ++dir) {
    float lfv[16], cl[16];
#pragma unroll
    for (int i = 0; i < 16; ++i) lfv[i] = lfa[dir][i];
    float run = 0.f;
    if (dir == 0) {
#pragma unroll
      for (int i = 0; i < 16; ++i) { run += lfv[i]; cl[i] = run; }
    } else {
#pragma unroll
      for (int i = 15; i >= 0; --i) { run += lfv[i]; cl[i] = run; }
    }
    __syncthreads();
    ptot[part * 64 + k] = run;
    __syncthreads();
    float off = 0.f, total = 0.f;
#pragma unroll
    for (int q = 0; q < 4; ++q) {
      float t = ptot[q * 64 + k];
      total += t;
      if (dir == 0 ? (q < part) : (q > part)) off += t;
    }
#pragma unroll
    for (int i = 0; i < 16; ++i) {
      float cum = cl[i] + off;
      float kte = (1.f - __expf(lfv[i])) * __expf(total - cum);
      kteT[k * 72 + part * 16 + i] = (__bf16)kte;
    }
    const size_t sidx = ((size_t)bh * 2 + dir) * NCH + c;
    if (part == 0) p.dk()[sidx * 64 + k] = __expf(total);
    __syncthreads();
    f4 acc[4];
#pragma unroll
    for (int nt = 0; nt < 4; ++nt) acc[nt] = f4{0.f, 0.f, 0.f, 0.f};
#pragma unroll
    for (int ks = 0; ks < 2; ++ks) {
      bf8 af = *(const bf8*)(vT + (wave * 16 + r) * 72 + ks * 32 + g * 8);
#pragma unroll
      for (int nt = 0; nt < 4; ++nt) {
        bf8 bfr = *(const bf8*)(kteT + (nt * 16 + r) * 72 + ks * 32 + g * 8);
        acc[nt] = mfma16(af, bfr, acc[nt]);
      }
    }
    float* up = p.ut() + sidx * 4096;
#pragma unroll
    for (int nt = 0; nt < 4; ++nt)
#pragma unroll
      for (int q = 0; q < 4; ++q) up[(wave * 16 + 4 * g + q) * 64 + nt * 16 + r] = acc[nt][q];
  }
}

__device__ __forceinline__ void hgrn2_item(const Params& p, int item) {
  const int idx = item * 256 + tid_();
  const int e = idx & 4095, sd = idx >> 12;
  const int dir = sd & 1, kk = e & 63;
  const float* up = p.ut() + (size_t)sd * NCH * 4096 + e;
  const float* dp = p.dk() + (size_t)sd * NCH * 64 + kk;
  __bf16* sp = p.st() + (size_t)sd * NCH * 4096 + e;
  float S = 0.f;
  for (int jb = 0; jb < NCH; jb += 22) {
    float u[22], d[22];
    int cc[22];
#pragma unroll
    for (int q = 0; q < 22; ++q) {
      int j = jb + q;
      int c = dir == 0 ? j : (j < 4 ? 3 - j : 135 - j);
      cc[q] = c;
      u[q] = up[(size_t)c * 4096];
      d[q] = dp[c * 64];
    }
#pragma unroll
    for (int q = 0; q < 22; ++q) {
      sp[(size_t)cc[q] * 4096] = (__bf16)S;
      S = d[q] * S + u[q];
    }
  }
}

__device__ __forceinline__ void hgrn3_item(const Params& p, int l, int item, char* smem) {
  __bf16* qS = (__bf16*)smem;
  __bf16* kS = qS + 64 * 72;
  __bf16* vT = kS + 64 * 72;
  __bf16* stS = vT + 64 * 72;
  float* cumS = (float*)(stS + 64 * 72);
  float* ptot = cumS + 64 * 68;
  const int tid = tid_(), lane = tid & 63, wave = tid >> 6, r = lane & 15, g = lane >> 4;
  const int c = item % NCH, bh = item / NCH;
  const int b = bh >> 3, h = bh & 7;
  const int tok0 = b * PT + c * 64;
  __syncthreads();
#pragma unroll
  for (int i = 0; i < 2; ++i) {
    int row = (tid >> 3) + 32 * i;
    *(bf8*)(vT + row * 72 + (tid & 7) * 8) = *(const bf8*)(p.hvt() + ((size_t)bh * 64 + row) * PT + c * 64 + (tid & 7) * 8);
    *(bf8*)(qS + row * 72 + (tid & 7) * 8) = *(const bf8*)(p.hq() + (size_t)(tok0 + row) * 512 + h * 64 + (tid & 7) * 8);
  }
  f4 o[4];
#pragma unroll
  for (int d = 0; d < 4; ++d) o[d] = f4{0.f, 0.f, 0.f, 0.f};
  const int k = tid & 63, part = tid >> 6;
  const int t = 16 * wave + r;
  bf8 sta[2][2];
#pragma unroll
  for (int dd = 0; dd < 2; ++dd) {
    const __bf16* sp = p.st() + (((size_t)bh * 2 + dd) * NCH + c) * 4096;
#pragma unroll
    for (int i = 0; i < 2; ++i) sta[dd][i] = *(const bf8*)(sp + ((tid >> 3) + 32 * i) * 64 + (tid & 7) * 8);
  }
  float lfa[2][16];
#pragma unroll
  for (int dd = 0; dd < 2; ++dd) {
    const float* lfp = p.lf() + ((size_t)dd * NTOK + tok0 + part * 16) * 512 + h * 64 + k;
#pragma unroll
    for (int i = 0; i < 16; ++i) lfa[dd][i] = lfp[(size_t)i * 512];
  }
#pragma unroll
  for (int dir = 0; dir < 2; ++dir) {
    float lfv[16], cl[16];
#pragma unroll
    for (int i = 0; i < 16; ++i) lfv[i] = lfa[dir][i];
    float run = 0.f;
    if (dir == 0) {
#pragma unroll
      for (int i = 0; i < 16; ++i) { run += lfv[i]; cl[i] = run; }
    } else {
#pragma unroll
      for (int i = 15; i >= 0; --i) { run += lfv[i]; cl[i] = run; }
    }
    __syncthreads();
    ptot[part * 64 + k] = run;
#pragma unroll
    for (int i = 0; i < 16; ++i) kS[(part * 16 + i) * 72 + k] = (__bf16)((1.f - __expf(lfv[i])));
#pragma unroll
    for (int i = 0; i < 2; ++i) *(bf8*)(stS + ((tid >> 3) + 32 * i) * 72 + (tid & 7) * 8) = sta[dir][i];
    __syncthreads();
    float off = 0.f;
#pragma unroll
    for (int q = 0; q < 4; ++q) {
      float tt = ptot[q * 64 + k];
      if (dir == 0 ? (q < part) : (q > part)) off += tt;
    }
#pragma unroll
    for (int i = 0; i < 16; ++i) cumS[(part * 16 + i) * 68 + k] = cl[i] + off;
    __syncthreads();
    float cs[2][8];
    bf8 qtf[2], qhf[2];
#pragma unroll
    for (int ks = 0; ks < 2; ++ks) {
      const int dk0 = ks * 32 + 8 * g;
      bf8 qv = *(const bf8*)(qS + t * 72 + dk0);
#pragma unroll
      for (int j = 0; j < 8; ++j) {
        float cst;
        if (dir == 0) cst = wave > 0 ? cumS[(16 * wave - 1) * 68 + dk0 + j] : 0.f;
        else cst = wave < 3 ? cumS[(16 * wave + 16) * 68 + dk0 + j] : 0.f;
        cs[ks][j] = cst;
        float cv = cumS[t * 68 + dk0 + j];
        float qf_ = (float)qv[j];
        qtf[ks][j] = (__bf16)(qf_ * __expf(cv - cst));
        qhf[ks][j] = (__bf16)(qf_ * __expf(cv));
      }
    }
#pragma unroll
    for (int m = 0; m < 2; ++m) {
      const bool need = dir == 0 ? (m <= (wave >> 1)) : (m >= (wave >> 1));
      if (need) {
        bf8 pf;
#pragma unroll
        for (int tp = 0; tp < 2; ++tp) {
          const int srow = 32 * m + 8 * (r >> 2) + 4 * tp + (r & 3);
          f4 sc = f4{0.f, 0.f, 0.f, 0.f};
#pragma unroll
          for (int ks = 0; ks < 2; ++ks) {
            const int dk0 = ks * 32 + 8 * g;
            bf8 kv = *(const bf8*)(kS + srow * 72 + dk0);
            bf8 ktf;
#pragma unroll
            for (int j = 0; j < 8; ++j) {
              float ex = fminf(cs[ks][j] - cumS[srow * 68 + dk0 + j], 80.f);
              ktf[j] = (__bf16)((float)kv[j] * __expf(ex));
            }
            sc = mfma16(ktf, qtf[ks], sc);
          }
#pragma unroll
          for (int q = 0; q < 4; ++q) {
            const int s = 32 * m + 8 * g + 4 * tp + q;
            const bool keep = dir == 0 ? (s <= t) : (s >= t);
            pf[tp * 4 + q] = keep ? (__bf16)sc[q] : (__bf16)0.f;
          }
        }
#pragma unroll
        for (int d = 0; d < 4; ++d) {
          bf8 vf = *(const bf8*)(vT + (d * 16 + r) * 72 + 32 * m + 8 * g);
          o[d] = mfma16(vf, pf, o[d]);
        }
      }
    }
#pragma unroll
    for (int d = 0; d < 4; ++d)
#pragma unroll
      for (int ks = 0; ks < 2; ++ks) {
        bf8 sf = *(const bf8*)(stS + (d * 16 + r) * 72 + ks * 32 + 8 * g);
        o[d] = mfma16(sf, qhf[ks], o[d]);
      }
  }
  float ss = 0.f;
#pragma unroll
  for (int d = 0; d < 4; ++d) ss += o[d][0] * o[d][0] + o[d][1] * o[d][1] + o[d][2] * o[d][2] + o[d][3] * o[d][3];
  ss = rows_sum(ss);
  const float rs = rsqrtf(ss * (1.f / 64.f) + EPSN);
  f4 gn[4]; bf4 gate[4];
#pragma unroll
  for (int d = 0; d < 4; ++d) {
    gn[d] = *(const f4*)(p.g_hgrn_norm + l * 64 + d * 16 + 4 * g);
    gate[d] = *(const bf4*)(p.hg() + (size_t)(tok0 + t) * 512 + h * 64 + d * 16 + 4 * g);
  }
#pragma unroll
  for (int d = 0; d < 4; ++d) {
    f4 res;
#pragma unroll
    for (int q = 0; q < 4; ++q) res[q] = o[d][q] * rs * gn[d][q] * (float)gate[d][q];
    *(bf4*)(p.mix() + (size_t)(tok0 + t) * LDH + 512 + h * 64 + d * 16 + 4 * g) = pack4(res);
  }
}

#define NPHASE 38
#ifndef ONLY
#define ONLY -1
#endif
#define PHEN(x) (ONLY < 0 || ONLY == (x))
__device__ __forceinline__ void run_phase(const Params& p, int ph, char* smem) {
  const int bid = bid_(), G = gridDim.x;
  if (ph == 0) { if (PHEN(100)) phase0(p, smem); return; }
  if (ph == NPHASE - 1) {
    for (int it = bid; it < NB * SEQ / 16; it += G) final_norm_item(p, it);
    return;
  }
  const int l = (ph - 1) / 9, sp = (ph - 1) % 9;
  const int nmt = mtile_count(l);
  switch (sp) {
    case 0: if (PHEN(0)) {
      for (int i = bid * 256 + tid_(); i < (INWP - INW) * DM / 8; i += G * 256) {
        bf8 z;
#pragma unroll
        for (int j = 0; j < 8; ++j) z[j] = (__bf16)0.f;
        *(bf8*)(p.wt_in() + (size_t)(INW + (i >> 7)) * LDH + (size_t)(i & 127) * 8) = z;
      }
      for (int it = bid; it < 1056; it += G) norm_item(p, l, 0, it);
      conv_items(p, l, bid, G, smem);
    } break;
    case 1: if (PHEN(1)) {
      {
        int mt, nt, mtn = 0, ntn = 0;
        bool have = gemm_pick(0, bid, G, 132, 30, 10, mt, nt), pre = false;
        for (int st = 0; have; ++st) {
          const bool hn = gemm_pick(st + 1, bid, G, 132, 30, 10, mtn, ntn);
          gemm_tile<EPI_IN, false>(p, l, p.hb(), LDH, p.wt_in(), LDH, DM, mt * 128, nt * 128, smem, pre, hn, mtn * 128, ntn * 128);
          pre = hn; have = hn; mt = mtn; nt = ntn;
        }
      }
    } break;
    case 2: if (PHEN(2)) {
      const int natt = l < 3 ? 528 : 512;
      const int total = natt + 396 + 528 + 2112, K = (total + G - 1) / G;
      const bool flip = (bid >> 3) & 1;
      for (int kk = 0; kk < K; ++kk) {
        const int k = flip ? (kk + 1 == K ? 0 : kk + 1) : kk;
        const int it0 = bid + k * G;
        if (it0 >= total) continue;
        if (it0 < natt) { attn_dispatch<32, 2>(p, l, it0, p.qd(), p.kd(), p.vdt(), smem); continue; }
        const int it = it0 - natt;
        if (it < 396) gemm_tile<EPI_UQ, true>(p, l, p.cq(), 256, p.wt_uq(), 256, 256, (it / 3) * 128, (it % 3) * 128, smem);
        else if (it < 924) { int j = it - 396; gemm_tile<EPI_UKV, true>(p, l, p.ckv(), 128, p.wt_ukv(), 128, 128, (j / 4) * 128, (j % 4) * 128, smem); }
        else hgrn1_item(p, it - 924, smem);
      }
    } break;
    case 3: if (PHEN(3)) {
      const int natt = l < 3 ? 528 : 512;
      const int total = 512 + natt, K = (total + G - 1) / G;
      const bool flip = (bid >> 3) & 1;
      for (int kk = 0; kk < K; ++kk) {
        const int k = flip ? (kk + 1 == K ? 0 : kk + 1) : kk;
        const int it = bid + k * G;
        if (it >= total) continue;
        if (it < 512) hgrn2_item(p, it);
        else attn_dispatch<96, 1>(p, l, it - 512, p.qm(), p.km(), p.vmt(), smem);
      }
    } break;
    case 4: if (PHEN(4)) {
      for (int j = bid; j < 2112; j += G) {
        if (l == 3 && (j % NCH) < 4) continue;
        hgrn3_item(p, l, j, smem);
      }
    } break;
    case 5: if (PHEN(5)) {
      {
        int mt, nt, mtn = 0, ntn = 0;
        bool have = gemm_pick(0, bid, G, 128, 8, 8, mt, nt), pre = false;
        for (int st = 0; have; ++st) {
          const bool hn = gemm_pick(st + 1, bid, G, 128, 8, 8, mtn, ntn);
          gemm_tile<EPI_OUT, false>(p, l, p.mix(), LDH, p.wt_out(), LDH, DM, mtile_index(3, mt) * 128, nt * 128, smem, pre, hn,
                                    mtile_index(3, mtn) * 128, ntn * 128);
          pre = hn; have = hn; mt = mtn; nt = ntn;
        }
      }
      if (l < 3) {
        for (int u = bid; u < 32 * 8; u += G) {
          const int tile = u >> 3, sp = u & 7;
          const int cm = tile >> 3, nt = tile & 7;
          const int mt = (cm >> 1) * 66 + (cm & 1);
          gemm_tile<EPI_OUT_AT, false>(p, l, p.mix() + sp * 128, LDH, p.wt_out() + sp * 128, LDH, 128, mt * 128, nt * 128, smem);
        }
      }
    } break;
    case 6: if (PHEN(6)) {
      for (int it = bid; it < 1056; it += G) norm_item(p, l, 1, it);
    } break;
    case 7: if (PHEN(7)) {
      {
        int mt, nt, mtn = 0, ntn = 0;
        bool have = gemm_pick(0, bid, G, nmt, 44, 11, mt, nt), pre = false;
        for (int st = 0; have; ++st) {
          const bool hn = gemm_pick(st + 1, bid, G, nmt, 44, 11, mtn, ntn);
          gemm_tile<EPI_UP, false>(p, l, p.hb(), LDH, p.wt_gu(), LDH, DM, mtile_index(l, mt) * 128, nt * 128, smem, pre, hn,
                                   mtile_index(l, mtn) * 128, ntn * 128);
          pre = hn; have = hn; mt = mtn; nt = ntn;
        }
      }
    } break;
    case 8: if (PHEN(8)) {
      {
        int mt, nt, mtn = 0, ntn = 0;
        bool have = gemm_pick(0, bid, G, 128, 8, 8, mt, nt), pre = false;
        for (int st = 0; have; ++st) {
          const bool hn = gemm_pick(st + 1, bid, G, 128, 8, 8, mtn, ntn);
          gemm_tile<EPI_DOWN, false>(p, l, p.act(), LDF, p.wt_down(), LDF, DFF, mtile_index(3, mt) * 128, nt * 128, smem, pre, hn,
                                     mtile_index(3, mtn) * 128, ntn * 128);
          pre = hn; have = hn; mt = mtn; nt = ntn;
        }
      }
      if (l < 3) {
        for (int u = bid; u < 32 * 11; u += G) {
          const int tile = u / 11, sp = u - tile * 11;
          const int cm = tile >> 3, nt = tile & 7;
          const int mt = (cm >> 1) * 66 + (cm & 1);
          gemm_tile<EPI_DOWN_AT, false>(p, l, p.act() + sp * 256, LDF, p.wt_down() + sp * 256, LDF, 256, mt * 128, nt * 128, smem);
        }
      }
    } break;
  }
}

#define XB_TMO      128
#define XB_XCNT(j)  (256  + 64 * (j))
#define XB_XSUB(j)  (1280 + 64 * (j))
#define XB_XGEN(j)  (2304 + 64 * (j))
#define XB_TOP      3328
#define XB_TOPGEN   3392
#define XCD_BAR_WORDS 3456
#define XB_SPIN_CAP (1u << 22)
#define LAS __attribute__((address_space(3)))

__device__ __forceinline__ unsigned xb_ld(unsigned* p)              { return __hip_atomic_load(p, __ATOMIC_RELAXED, __HIP_MEMORY_SCOPE_AGENT); }
__device__ __forceinline__ unsigned xb_add(unsigned* p, unsigned v) { return __hip_atomic_fetch_add(p, v, __ATOMIC_RELAXED, __HIP_MEMORY_SCOPE_AGENT); }
__device__ __forceinline__ unsigned xb_xcc_id() { return (unsigned)__builtin_amdgcn_s_getreg((3 << 11) | 20) & 0xFu; }
#define XB_SPIN(cond, bar) do { unsigned _sp = 0; while (cond) { __builtin_amdgcn_s_sleep(1); \
    if ((++_sp & 255u) == 0u) { if (xb_ld(&(bar)[XB_TMO])) break; if (_sp > XB_SPIN_CAP) { atomicAdd(&(bar)[XB_TMO], 1u); break; } } } } while (0)

struct XcdBarrier {
    unsigned* bar; unsigned x;
    volatile LAS unsigned* st;
};

__device__ __forceinline__ XcdBarrier xcd_barrier_post(unsigned* bar, volatile LAS unsigned* st) {
    XcdBarrier b; b.bar = bar; b.x = xb_xcc_id(); b.st = st;
    if (threadIdx.x == 0) (void)xb_add(&bar[XB_XCNT(b.x)], 1u);
    return b;
}
__device__ __forceinline__ void xcd_barrier_complete(unsigned* bar, unsigned x, unsigned& nloc, unsigned& nx) {
    const unsigned G = gridDim.x * gridDim.y * gridDim.z;
    unsigned sum, cnt, mine, sp = 0u;
    for (;;) {
        sum = 0u; cnt = 0u; mine = 0u;
#pragma unroll
        for (unsigned j = 0; j < 16; ++j) { const unsigned c = xb_ld(&bar[XB_XCNT(j)]); sum += c; cnt += (c > 0u) ? 1u : 0u; mine = (j == x) ? c : mine; }
        if (sum == G) break;
        __builtin_amdgcn_s_sleep(1);
        if ((++sp & 255u) == 0u) { if (xb_ld(&bar[XB_TMO])) break; if (sp > XB_SPIN_CAP) { atomicAdd(&bar[XB_TMO], 1u); break; } }
    }
    nloc = mine > 0u ? mine : 1u; nx = cnt > 0u ? cnt : 1u;
}

__device__ __forceinline__ void xcd_barrier(const XcdBarrier& b) {
    asm volatile("s_waitcnt vmcnt(0)" ::: "memory");
    __syncthreads();
    if (threadIdx.x == 0) {
        unsigned* bar = b.bar;
        __builtin_amdgcn_s_waitcnt(0);
        unsigned nloc = b.st[0], nx = b.st[1];
        if (nloc == 0u) { xcd_barrier_complete(bar, b.x, nloc, nx); b.st[0] = nloc; b.st[1] = nx; }
        const unsigned old = xb_add(&bar[XB_XSUB(b.x)], 1u);
        const unsigned gen = old / nloc;
        if (old + 1u == (gen + 1u) * nloc) {
            __builtin_amdgcn_fence(__ATOMIC_RELEASE, "agent");
            asm volatile("s_waitcnt vmcnt(0)" ::: "memory");
            const unsigned og = xb_add(&bar[XB_TOP], 1u);
            const unsigned tg = og / nx;
            if (og + 1u == (tg + 1u) * nx) xb_add(&bar[XB_TOPGEN], 1u);
            else XB_SPIN(xb_ld(&bar[XB_TOPGEN]) == tg, bar);
            __builtin_amdgcn_fence(__ATOMIC_ACQUIRE, "agent");
            xb_add(&bar[XB_XGEN(b.x)], 1u);
            asm volatile("s_waitcnt vmcnt(0)" ::: "memory");
        } else {
            XB_SPIN(xb_ld(&bar[XB_XGEN(b.x)]) == gen, bar);
            __builtin_amdgcn_fence(__ATOMIC_ACQUIRE, "agent");
            asm volatile("s_waitcnt vmcnt(0)" ::: "memory");
        }
    }
    __syncthreads();
}


__device__ __forceinline__ void grid_barrier(unsigned* cnt, unsigned target) {
  asm volatile("s_waitcnt vmcnt(0)" ::: "memory");
  __syncthreads();
  if (tid_() == 0) {
    __builtin_amdgcn_fence(__ATOMIC_RELEASE, "agent");
    asm volatile("s_waitcnt vmcnt(0)" ::: "memory");
    __hip_atomic_fetch_add(cnt, 1u, __ATOMIC_RELAXED, __HIP_MEMORY_SCOPE_AGENT);
    unsigned spins = 0;
    while (__hip_atomic_load(cnt, __ATOMIC_RELAXED, __HIP_MEMORY_SCOPE_AGENT) < target) {
      __builtin_amdgcn_s_sleep(2);
      if (++spins > (1u << 24)) break;
    }
    __builtin_amdgcn_fence(__ATOMIC_ACQUIRE, "agent");
    asm volatile("s_waitcnt vmcnt(0)" ::: "memory");
  }
  __syncthreads();
}

__global__ void __launch_bounds__(256, 2) hybrid_megakernel(Params p, int ph0, int ph1) {
  __shared__ __attribute__((aligned(16))) char smem[SMEM_BYTES];
  cg::grid_group grid = cg::this_grid();
  volatile LAS unsigned* xst = (volatile LAS unsigned*)(smem + 66048);
  if (__builtin_amdgcn_workitem_id_x() == 0) { xst[0] = 0u; xst[1] = 0u; }
  __syncthreads();
  XcdBarrier xb; xb.bar = nullptr; xb.x = 0; xb.st = xst;
  for (int ph = ph0; ph < ph1; ++ph) {
    Params q = p;
    size_t zoff = 0;
    asm volatile("" : "+s"(zoff));
    q.ws = p.ws + zoff; q.out = p.out + zoff;
    run_phase(q, ph, smem);
#ifdef REPMASK
    if (ph > 0 && ph < NPHASE - 1 && ((REPMASK >> ((ph - 1) % 9)) & 1)) { grid.sync(); run_phase(q, ph, smem); }
#endif
    if (ph + 1 < ph1) {
      if (ph == ph0) { grid.sync(); xb = xcd_barrier_post((unsigned*)(p.ws + OFF_xbar), xst); }
      else xcd_barrier(xb);
    }
  }
}

extern "C" void kernel_launch(void* const* d_in, const int* in_sizes, int n_in, void* d_out, int out_size, void* d_ws,
                              size_t ws_size, hipStream_t stream) {
  static int grid_blocks = 0;
  if (!grid_blocks) {
    int dev = 0, cus = 0, per_cu = 0;
    hipGetDevice(&dev);
    hipDeviceGetAttribute(&cus, hipDeviceAttributeMultiprocessorCount, dev);
    hipOccupancyMaxActiveBlocksPerMultiprocessor(&per_cu, hybrid_megakernel, 256, 0);
    if (per_cu > 2) per_cu = 2;
    if (per_cu < 1) per_cu = 1;
    grid_blocks = cus * per_cu;
  }
  Params p{};
  const float* const* in = (const float* const*)d_in;
  p.x = in[0]; p.c = in[1]; p.ctx = in[2]; p.c_ctx = in[3]; p.w_ada = in[4]; p.b_ada = in[5]; p.g_norm1 = in[6];
  p.g_norm2 = in[7]; p.w_in = in[8]; p.g_q_norm = in[9]; p.w_uq = in[10]; p.g_kv_norm = in[11]; p.w_ukv = in[12];
  p.diff_lambda = in[13]; p.g_diff_norm = in[14]; p.hgrn_lb = in[15]; p.g_hgrn_norm = in[16]; p.w_out = in[17];
  p.w_gate = in[18]; p.w_up = in[19]; p.w_down = in[20]; p.g_final = in[21];
  p.out = (float*)d_out;
  p.ws = (char*)d_ws;
  if (WS_TOTAL > ws_size) { fprintf(stderr, "workspace too small: need %zu have %zu\n", (size_t)WS_TOTAL, ws_size); return; }
  int ph0 = 0, ph1 = NPHASE;
  void* args[] = {&p, &ph0, &ph1};
  hipError_t e = hipLaunchCooperativeKernel((void*)hybrid_megakernel, dim3(grid_blocks), dim3(256), args, 0, stream);
  if (e != hipSuccess) fprintf(stderr, "cooperative launch failed: %s (grid %d)\n", hipGetErrorString(e), grid_blocks);
}
```

```cpp
#include <hip/hip_runtime.h>
#include <hip/hip_cooperative_groups.h>
#include <cstdio>
namespace cg = cooperative_groups;

typedef __attribute__((ext_vector_type(8))) __bf16 bf8;
typedef __attribute__((ext_vector_type(4))) __bf16 bf4;
typedef __attribute__((ext_vector_type(4))) float f4;

#define XCD_BAR_WORDS_C 3456
#define NB 2
#define SEQ 8192
#define CTXL 256
#define PT 8448
#define NTOK 16896
#define DM 1024
#define INW 3744
#define INWP 3840
#define DFF 2816
#define NCH 132
#define LDH 1088
#define LDF 2880
#define LOG2E 1.4426950408889634f
#define EPSN 1e-6f
#define SMEM_BYTES 66064

constexpr size_t al256(size_t x) { return (x + 255) & ~(size_t)255; }
constexpr size_t OFF_xc = 0;
constexpr size_t OFF_mod = OFF_xc + al256((size_t)NB*CTXL*DM*4);
constexpr size_t OFF_rope = OFF_mod + al256((size_t)4*3*6144*4);
constexpr size_t OFF_llb = OFF_rope + al256(128*8*2*4);
constexpr size_t OFF_l1mlb = OFF_llb + al256(4*1024*4);
constexpr size_t OFF_lam = OFF_l1mlb + al256(4*1024*4);
constexpr size_t OFF_wt_in = OFF_lam + al256(256);
constexpr size_t OFF_wt_uq = OFF_wt_in + al256((size_t)INWP*LDH*2);
constexpr size_t OFF_wt_ukv = OFF_wt_uq + al256((size_t)384*256*2);
constexpr size_t OFF_wt_out = OFF_wt_ukv + al256((size_t)512*128*2);
constexpr size_t OFF_wt_gu = OFF_wt_out + al256((size_t)DM*LDH*2);
constexpr size_t OFF_wt_down = OFF_wt_gu + al256((size_t)2*DFF*LDH*2);
constexpr size_t OFF_hb = OFF_wt_down + al256((size_t)DM*LDF*2);
constexpr size_t OFF_cq = OFF_hb + al256((size_t)NTOK*LDH*2);
constexpr size_t OFF_ckv = OFF_cq + al256((size_t)NTOK*256*2);
constexpr size_t OFF_qm = OFF_ckv + al256((size_t)NTOK*128*2);
constexpr size_t OFF_km = OFF_qm + al256((size_t)NB*4*PT*96*2);
constexpr size_t OFF_vmt = OFF_km + al256((size_t)NB*4*PT*96*2);
constexpr size_t OFF_qd = OFF_vmt + al256((size_t)NB*4*64*PT*2);
constexpr size_t OFF_kd = OFF_qd + al256((size_t)NB*4*2*PT*32*2);
constexpr size_t OFF_vdt = OFF_kd + al256((size_t)NB*4*2*PT*32*2);
constexpr size_t OFF_hq = OFF_vdt + al256((size_t)NB*4*64*PT*2);
constexpr size_t OFF_hvt = OFF_hq + al256((size_t)NTOK*512*2);
constexpr size_t OFF_hg = OFF_hvt + al256((size_t)NB*8*64*PT*2);
constexpr size_t OFF_dk = OFF_hg + al256((size_t)NTOK*512*2);
constexpr size_t OFF_st = OFF_dk + al256((size_t)NB*8*2*NCH*64*4);
constexpr size_t OFF_lf = OFF_st + al256((size_t)NB*8*2*NCH*4096*2);
constexpr size_t OFF_ut = OFF_lf + al256((size_t)2*NTOK*512*4);
constexpr size_t OFF_xbar = OFF_ut + al256((size_t)NB*8*2*NCH*4096*4);
constexpr size_t WS_TOTAL_OLD = OFF_ut + al256((size_t)NB*8*2*NCH*4096*4);
constexpr size_t WS_TOTAL = OFF_xbar + al256((size_t)XCD_BAR_WORDS_C*4);
struct Params {
  const float *x, *c, *ctx, *c_ctx, *w_ada, *b_ada, *g_norm1, *g_norm2, *w_in, *g_q_norm, *w_uq, *g_kv_norm, *w_ukv,
      *diff_lambda, *g_diff_norm, *hgrn_lb, *g_hgrn_norm, *w_out, *w_gate, *w_up, *w_down, *g_final;
  float* out;
  char* ws;
  __device__ __forceinline__ float* xc() const { return (float*)(ws + OFF_xc); }
  __device__ __forceinline__ float* mod() const { return (float*)(ws + OFF_mod); }
  __device__ __forceinline__ float* rope() const { return (float*)(ws + OFF_rope); }
  __device__ __forceinline__ float* llb() const { return (float*)(ws + OFF_llb); }
  __device__ __forceinline__ float* l1mlb() const { return (float*)(ws + OFF_l1mlb); }
  __device__ __forceinline__ float* lam() const { return (float*)(ws + OFF_lam); }
  __device__ __forceinline__ __bf16* wt_in() const { return (__bf16*)(ws + OFF_wt_in); }
  __device__ __forceinline__ __bf16* wt_uq() const { return (__bf16*)(ws + OFF_wt_uq); }
  __device__ __forceinline__ __bf16* wt_ukv() const { return (__bf16*)(ws + OFF_wt_ukv); }
  __device__ __forceinline__ __bf16* wt_out() const { return (__bf16*)(ws + OFF_wt_out); }
  __device__ __forceinline__ __bf16* wt_gu() const { return (__bf16*)(ws + OFF_wt_gu); }
  __device__ __forceinline__ __bf16* wt_down() const { return (__bf16*)(ws + OFF_wt_down); }
  __device__ __forceinline__ __bf16* hb() const { return (__bf16*)(ws + OFF_hb); }
  __device__ __forceinline__ __bf16* cq() const { return (__bf16*)(ws + OFF_cq); }
  __device__ __forceinline__ __bf16* ckv() const { return (__bf16*)(ws + OFF_ckv); }
  __device__ __forceinline__ __bf16* qm() const { return (__bf16*)(ws + OFF_qm); }
  __device__ __forceinline__ __bf16* km() const { return (__bf16*)(ws + OFF_km); }
  __device__ __forceinline__ __bf16* vmt() const { return (__bf16*)(ws + OFF_vmt); }
  __device__ __forceinline__ __bf16* qd() const { return (__bf16*)(ws + OFF_qd); }
  __device__ __forceinline__ __bf16* kd() const { return (__bf16*)(ws + OFF_kd); }
  __device__ __forceinline__ __bf16* vdt() const { return (__bf16*)(ws + OFF_vdt); }
  __device__ __forceinline__ __bf16* hq() const { return (__bf16*)(ws + OFF_hq); }
  __device__ __forceinline__ __bf16* hvt() const { return (__bf16*)(ws + OFF_hvt); }
  __device__ __forceinline__ __bf16* hg() const { return (__bf16*)(ws + OFF_hg); }
  __device__ __forceinline__ float* dk() const { return (float*)(ws + OFF_dk); }
  __device__ __forceinline__ __bf16* st() const { return (__bf16*)(ws + OFF_st); }
  __device__ __forceinline__ float* lf() const { return (float*)(ws + OFF_lf); }
  __device__ __forceinline__ float* ut() const { return (float*)(ws + OFF_ut); }
  __device__ __forceinline__ __bf16* mix() const { return hb(); }
  __device__ __forceinline__ __bf16* act() const { return (__bf16*)lf(); }
};

__device__ __forceinline__ int tid_() { int t = __builtin_amdgcn_workitem_id_x(); asm volatile("" : "+v"(t)); return t; }
__device__ __forceinline__ int bid_() { int t = __builtin_amdgcn_workgroup_id_x(); asm volatile("" : "+s"(t)); return t; }
__device__ __forceinline__ float silu_f(float x) { return x * __builtin_amdgcn_rcpf(1.f + __expf(-x)); }
__device__ __forceinline__ float wave_sum(float v) {
  v += __uint_as_float(__builtin_amdgcn_update_dpp(0u, __float_as_uint(v), 0x128, 0xf, 0xf, false));
  v += __uint_as_float(__builtin_amdgcn_update_dpp(0u, __float_as_uint(v), 0x124, 0xf, 0xf, false));
  v += __uint_as_float(__builtin_amdgcn_update_dpp(0u, __float_as_uint(v), 0x122, 0xf, 0xf, false));
  v += __uint_as_float(__builtin_amdgcn_update_dpp(0u, __float_as_uint(v), 0x121, 0xf, 0xf, false));
  unsigned u = __float_as_uint(v);
  auto a = __builtin_amdgcn_permlane16_swap(u, u, false, false);
  float m = __uint_as_float(a[0]) + __uint_as_float(a[1]);
  unsigned w = __float_as_uint(m);
  auto b = __builtin_amdgcn_permlane32_swap(w, w, false, false);
  return __uint_as_float(b[0]) + __uint_as_float(b[1]);
}
__device__ __forceinline__ float* xrow(const Params& p, int tok) {
  int b = tok / PT, pp = tok - b * PT;
  return pp < CTXL ? p.xc() + (size_t)(b * CTXL + pp) * DM : p.out + (size_t)(b * SEQ + pp - CTXL) * DM;
}
__device__ __forceinline__ float log_forget(float z, float lb, float oml) {
  const float sg = __builtin_amdgcn_rcpf(1.f + __expf(-fmaxf(z, -80.f)));
  return __logf(lb + oml * sg);
}
__device__ __forceinline__ float rows_max(float x) {
  unsigned u = __float_as_uint(x);
  auto a = __builtin_amdgcn_permlane16_swap(u, u, false, false);
  float m = fmaxf(__uint_as_float(a[0]), __uint_as_float(a[1]));
  unsigned v = __float_as_uint(m);
  auto b = __builtin_amdgcn_permlane32_swap(v, v, false, false);
  return fmaxf(__uint_as_float(b[0]), __uint_as_float(b[1]));
}
__device__ __forceinline__ float rows_sum(float x) {
  unsigned u = __float_as_uint(x);
  auto a = __builtin_amdgcn_permlane16_swap(u, u, false, false);
  float m = __uint_as_float(a[0]) + __uint_as_float(a[1]);
  unsigned v = __float_as_uint(m);
  auto b = __builtin_amdgcn_permlane32_swap(v, v, false, false);
  return __uint_as_float(b[0]) + __uint_as_float(b[1]);
}
__device__ __forceinline__ f4 mfma16(bf8 a, bf8 b, f4 c) { return __builtin_amdgcn_mfma_f32_16x16x32_bf16(a, b, c, 0, 0, 0); }

__device__ __forceinline__ void phase0(const Params& p, char* smem) {
  const int tid = tid_();
  const int gsz = gridDim.x * 256, gtid = bid_() * 256 + tid;
  {
    const float4* xs = (const float4*)p.x; float4* xo = (float4*)p.out;
    for (int i = gtid; i < NB * SEQ * DM / 4; i += gsz) xo[i] = xs[i];
    const float4* cs = (const float4*)p.ctx; float4* co = (float4*)p.xc();
    for (int i = gtid; i < NB * CTXL * DM / 4; i += gsz) co[i] = cs[i];
  }
  if (gtid < 1024) {
    int pos = gtid >> 3, f = gtid & 7;
    float freq = powf(10000.f, -(float)f / 8.f);
    float ang = (float)pos * freq, s, c;
    sincosf(ang, &s, &c);
    p.rope()[gtid * 2] = c; p.rope()[gtid * 2 + 1] = s;
  } else if (gtid < 2048) {
    int n = gtid - 1024;
    float r0 = p.hgrn_lb[n], r1 = p.hgrn_lb[1024 + n], r2 = p.hgrn_lb[2048 + n], r3 = p.hgrn_lb[3072 + n];
    float m = fmaxf(fmaxf(r0, r1), fmaxf(r2, r3));
    float e0 = expf(r0 - m), e1 = expf(r1 - m), e2 = expf(r2 - m), e3 = expf(r3 - m);
    float s = e0 + e1 + e2 + e3;
    float p0 = e0 / s, p1 = e1 / s, p2 = e2 / s, p3 = e3 / s;
    float c0 = p0, c1 = c0 + p1, c2 = c1 + p2, c3 = c2 + p3;
    p.llb()[n] = 0.f; p.l1mlb()[n] = 1.f;
    p.llb()[1024 + n] = c1 - c0; p.l1mlb()[1024 + n] = 1.f - (c1 - c0);
    p.llb()[2048 + n] = c2 - c0; p.l1mlb()[2048 + n] = 1.f - (c2 - c0);
    p.llb()[3072 + n] = c3 - c0; p.l1mlb()[3072 + n] = 1.f - (c3 - c0);
  } else if (gtid >= 4096 && gtid < 4096 + XCD_BAR_WORDS_C) {
    ((unsigned*)(p.ws + OFF_xbar))[gtid - 4096] = 0u;
  } else if (gtid == 2052) {
    *(unsigned*)(p.ws + OFF_lam + 128) = 0u;
  } else if (gtid < 2052) {
    int l = gtid - 2048;
    const float* d = p.diff_lambda + l * 128;
    float s1 = 0.f, s2 = 0.f;
    for (int i = 0; i < 32; ++i) { s1 += d[i] * d[32 + i]; s2 += d[64 + i] * d[96 + i]; }
    float li = 0.8f - 0.6f * expf(-0.3f * (float)l);
    p.lam()[l] = expf(s1) - expf(s2) + li;
  }
  float* sl = (float*)smem;
  float* red = sl + 3072;
  bool have = false;
  for (int item = bid_(); item < 768; item += gridDim.x) {
    if (!have) {
      for (int i = tid; i < 1024; i += 256) {
        sl[i] = silu_f(p.c[i]); sl[1024 + i] = silu_f(p.c[1024 + i]); sl[2048 + i] = silu_f(p.c_ctx[i]);
      }
      have = true;
      __syncthreads();
    }
    int l = item / 192, n0 = (item % 192) * 32;
    int col = tid & 31, kg = tid >> 5;
    const float* W = p.w_ada + (size_t)l * DM * 6144 + n0 + col;
    float a0 = 0.f, a1 = 0.f, a2 = 0.f;
#pragma unroll 8
    for (int k = kg * 128; k < kg * 128 + 128; ++k) {
      float w = W[(size_t)k * 6144];
      a0 += sl[k] * w; a1 += sl[1024 + k] * w; a2 += sl[2048 + k] * w;
    }
    red[(kg * 3 + 0) * 32 + col] = a0; red[(kg * 3 + 1) * 32 + col] = a1; red[(kg * 3 + 2) * 32 + col] = a2;
    __syncthreads();
    if (tid < 96) {
      int v = tid >> 5, cc = tid & 31;
      float s = p.b_ada[l * 6144 + n0 + cc];
#pragma unroll
      for (int q = 0; q < 8; ++q) s += red[(q * 3 + v) * 32 + cc];
      p.mod()[(size_t)(l * 3 + v) * 6144 + n0 + cc] = s;
    }
    __syncthreads();
  }
}

struct ConvD { const float* srcp; size_t sstride; __bf16* dstp; const float* ksp; };

__device__ __forceinline__ ConvD conv_decode(const Params& p, int l, int it, int tid) {
  const float* src; int N, ntn, mode = 0, dld; __bf16* dst; const float* ks = nullptr;
  if (it < 1872) { src = p.w_in + (size_t)l * DM * INW; N = INW; ntn = 117; dst = p.wt_in(); dld = LDH; }
  else if (it < 1920) { it -= 1872; src = p.w_uq + (size_t)l * 256 * 384; N = 384; ntn = 12; dst = p.wt_uq(); dld = 256; ks = p.g_q_norm + l * 256; }
  else if (it < 1952) { it -= 1920; src = p.w_ukv + (size_t)l * 128 * 512; N = 512; ntn = 16; dst = p.wt_ukv(); dld = 128; ks = p.g_kv_norm + l * 128; }
  else if (it < 2464) { it -= 1952; src = p.w_out + (size_t)l * DM * DM; N = DM; ntn = 32; dst = p.wt_out(); dld = LDH; }
  else if (it < 3872) { it -= 2464; src = p.w_gate + (size_t)l * DM * DFF; N = DFF; ntn = 88; dst = p.wt_gu(); mode = 1; dld = LDH; }
  else if (it < 5280) { it -= 3872; src = p.w_up + (size_t)l * DM * DFF; N = DFF; ntn = 88; dst = p.wt_gu(); mode = 2; dld = LDH; }
  else { it -= 5280; src = p.w_down + (size_t)l * DFF * DM; N = DM; ntn = 32; dst = p.wt_down(); dld = LDF; }
  const int kt = it / ntn, nt = it - kt * ntn;
  ConvD d;
  d.srcp = src + (size_t)(kt * 64 + (tid >> 3)) * N + nt * 32 + (tid & 7) * 4;
  d.sstride = (size_t)32 * N;
  const int n = nt * 32 + (tid >> 3);
  int row = n;
  if (mode == 1) row = (n >> 4) * 32 + (n & 15);
  else if (mode == 2) row = (n >> 4) * 32 + 16 + (n & 15);
  d.dstp = dst + (size_t)row * dld + kt * 64 + (tid & 7) * 8;
  d.ksp = ks ? ks + kt * 64 + (tid & 7) * 8 : nullptr;
  return d;
}

__device__ __forceinline__ void conv_items(const Params& p, int l, int first, int step, char* smem) {
  float* tile = (float*)smem;
  const int tid = tid_();
  if (first >= 6688) return;
  ConvD cur = conv_decode(p, l, first, tid);
  float4 v0 = *(const float4*)(cur.srcp), v1 = *(const float4*)(cur.srcp + cur.sstride);
  for (int it = first; it < 6688; it += step) {
    const int itn = it + step < 6688 ? it + step : it;
    const ConvD nxt = conv_decode(p, l, itn, tid);
    const float4 n0 = *(const float4*)(nxt.srcp), n1 = *(const float4*)(nxt.srcp + nxt.sstride);
    __syncthreads();
    {
      const int r = tid >> 3, c4 = tid & 7;
      float* t = tile + r * 33 + c4 * 4;
      t[0] = v0.x; t[1] = v0.y; t[2] = v0.z; t[3] = v0.w;
      t += 32 * 33;
      t[0] = v1.x; t[1] = v1.y; t[2] = v1.z; t[3] = v1.w;
    }
    __syncthreads();
    {
      const int nr = tid >> 3, kc = tid & 7;
      bf8 o;
#pragma unroll
      for (int j = 0; j < 8; ++j) {
        float v = tile[(kc * 8 + j) * 33 + nr];
        if (cur.ksp) v *= cur.ksp[j];
        o[j] = (__bf16)v;
      }
      *(bf8*)cur.dstp = o;
    }
    cur = nxt; v0 = n0; v1 = n1;
  }
}

__device__ __forceinline__ void norm_item(const Params& p, int l, int which, int item) {
  const int lane = tid_() & 63, wave = tid_() >> 6;
  const int tok0 = item * 16 + wave * 4;
  const int b = tok0 / PT, pp = tok0 - b * PT;
  const int v = pp < CTXL ? 2 : b;
  const float* g = (which ? p.g_norm2 : p.g_norm1) + l * DM;
  const float* md = p.mod() + (size_t)(l * 3 + v) * 6144 + (which ? 3072 : 0);
  f4 a[4], sh[4];
#pragma unroll
  for (int i = 0; i < 4; ++i) {
    int k = i * 256 + lane * 4;
    f4 gg = *(const f4*)(g + k), sc = *(const f4*)(md + 1024 + k);
    sh[i] = *(const f4*)(md + k);
    a[i] = gg * (1.f + sc);
  }
  f4 xv[4][4];
#pragma unroll
  for (int r = 0; r < 4; ++r) {
    const float* xr = xrow(p, tok0 + r);
#pragma unroll
    for (int i = 0; i < 4; ++i) xv[r][i] = *(const f4*)(xr + i * 256 + lane * 4);
  }
#pragma unroll
  for (int r = 0; r < 4; ++r) {
    float ss = 0.f;
#pragma unroll
    for (int i = 0; i < 4; ++i)
      ss += xv[r][i][0] * xv[r][i][0] + xv[r][i][1] * xv[r][i][1] + xv[r][i][2] * xv[r][i][2] + xv[r][i][3] * xv[r][i][3];
    ss = wave_sum(ss);
    float rstd = rsqrtf(ss * (1.f / DM) + EPSN);
#pragma unroll
    for (int i = 0; i < 4; ++i) {
      f4 h = xv[r][i] * rstd * a[i] + sh[i];
      bf4 o; o[0] = (__bf16)h[0]; o[1] = (__bf16)h[1]; o[2] = (__bf16)h[2]; o[3] = (__bf16)h[3];
      *(bf4*)(p.hb() + (size_t)(tok0 + r) * LDH + i * 256 + lane * 4) = o;
    }
  }
}

__device__ __forceinline__ void final_norm_item(const Params& p, int item) {
  const int lane = tid_() & 63, wave = tid_() >> 6;
  const int row0 = item * 16 + wave * 4;
  f4 g[4];
#pragma unroll
  for (int i = 0; i < 4; ++i) g[i] = *(const f4*)(p.g_final + i * 256 + lane * 4);
  f4 xv[4][4];
#pragma unroll
  for (int r = 0; r < 4; ++r)
#pragma unroll
    for (int i = 0; i < 4; ++i) xv[r][i] = *(const f4*)(p.out + (size_t)(row0 + r) * DM + i * 256 + lane * 4);
#pragma unroll
  for (int r = 0; r < 4; ++r) {
    float ss = 0.f;
#pragma unroll
    for (int i = 0; i < 4; ++i)
      ss += xv[r][i][0] * xv[r][i][0] + xv[r][i][1] * xv[r][i][1] + xv[r][i][2] * xv[r][i][2] + xv[r][i][3] * xv[r][i][3];
    ss = wave_sum(ss);
    float rstd = rsqrtf(ss * (1.f / DM) + EPSN);
#pragma unroll
    for (int i = 0; i < 4; ++i) *(f4*)(p.out + (size_t)(row0 + r) * DM + i * 256 + lane * 4) = xv[r][i] * rstd * g[i];
  }
}

#define GLD 72
enum { EPI_IN = 0, EPI_UQ, EPI_UKV, EPI_OUT, EPI_UP, EPI_DOWN, EPI_OUT_AT, EPI_DOWN_AT };

__device__ __forceinline__ f4 rope4(const Params& p, f4 a, int prow, int axis, int r) {
  f4 o;
#pragma unroll
  for (int reg = 0; reg < 4; ++reg) {
    float pv = __uint_as_float(__builtin_amdgcn_update_dpp(0u, __float_as_uint(a[reg]), 0x128, 0xf, 0xf, false));
    int t = prow + reg - CTXL;
    int pos = axis ? (t & 63) : (t >> 6);
    float2 cs = ((const float2*)p.rope())[pos * 8 + (r & 7)];
    o[reg] = (r & 8) ? a[reg] * cs.x + pv * cs.y : a[reg] * cs.x - pv * cs.y;
  }
  return o;
}
__device__ __forceinline__ bf4 pack4(f4 a) {
  bf4 o; o[0] = (__bf16)a[0]; o[1] = (__bf16)a[1]; o[2] = (__bf16)a[2]; o[3] = (__bf16)a[3];
  return o;
}

template <int EPI>
__device__ __forceinline__ void gemm_epilogue(const Params& p, int l, f4 (&acc)[4][4], int m0, int n0, int wm, int wn, int lane,
                                              const float* rowss) {
  const int r = lane & 15, g = lane >> 4;
  const int b = m0 / PT;
  const int pp0 = m0 - b * PT;
  const bool lat = pp0 >= CTXL;
  const int v = lat ? b : 2;
  const float* md = p.mod() + (size_t)(l * 3 + v) * 6144;
  const int prow0 = pp0 + wm * 64 + 4 * g;
  const int tok0 = b * PT + prow0;
  constexpr int STEP = (EPI == EPI_UP) ? 2 : 1;
  if constexpr (EPI == EPI_OUT || EPI == EPI_DOWN) {
    float* xb = (lat ? p.out + (size_t)(b * SEQ + prow0 - CTXL) * DM : p.xc() + (size_t)(b * CTXL + prow0) * DM) + n0 + wn * 64 + r;
    float gt[4];
    f4 xin[4][4];
#pragma unroll
    for (int ni = 0; ni < 4; ++ni) gt[ni] = md[(EPI == EPI_OUT ? 2048 : 5120) + n0 + wn * 64 + ni * 16 + r];
#pragma unroll
    for (int mi = 0; mi < 4; ++mi)
#pragma unroll
      for (int ni = 0; ni < 4; ++ni)
#pragma unroll
        for (int q = 0; q < 4; ++q) xin[mi][ni][q] = xb[(size_t)(mi * 16 + q) * DM + ni * 16];
#pragma unroll
    for (int mi = 0; mi < 4; ++mi)
#pragma unroll
      for (int ni = 0; ni < 4; ++ni)
#pragma unroll
        for (int q = 0; q < 4; ++q) xb[(size_t)(mi * 16 + q) * DM + ni * 16] = xin[mi][ni][q] + gt[ni] * acc[mi][ni][q];
    return;
  }
  float tla[4] = {0.f, 0.f, 0.f, 0.f}, tl1[4] = {0.f, 0.f, 0.f, 0.f};
  if constexpr (EPI == EPI_IN) {
#pragma unroll
    for (int ni = 0; ni < 4; ++ni) {
      const int c0 = n0 + wn * 64 + ni * 16;
      if (c0 >= 1696 && c0 < 2720) {
        const int dir = c0 >= 2208;
        const int n1 = c0 + r - (dir ? 2208 : 1696);
        tla[ni] = p.llb()[(l * 2 + dir) * 512 + n1];
        tl1[ni] = p.l1mlb()[(l * 2 + dir) * 512 + n1];
      }
    }
  }
#pragma unroll 1
  for (int ni = 0; ni < 4; ni += STEP) {
    const int col0 = n0 + wn * 64 + ni * 16;
    const int col = col0 + r;
    if constexpr (EPI == EPI_IN) {
      if (col0 < 384) {
        __bf16* dst = col0 < 256 ? p.cq() + col : p.ckv() + (col - 256);
        const int ld = col0 < 256 ? 256 : 128;
#pragma unroll
        for (int mi = 0; mi < 4; ++mi)
#pragma unroll
          for (int q = 0; q < 4; ++q) dst[(size_t)(tok0 + mi * 16 + q) * ld] = (__bf16)acc[mi][0][q];
      } else if (col0 < 416) {
        f4 v[4];
#pragma unroll
        for (int mi = 0; mi < 4; ++mi) {
          v[mi] = acc[mi][0];
          if (lat) v[mi] = rope4(p, v[mi], prow0 + mi * 16, (col0 - 384) >> 4, r);
        }
#pragma unroll
        for (int mi = 0; mi < 4; ++mi)
#pragma unroll
          for (int h = 0; h < 4; ++h)
#pragma unroll
            for (int q = 0; q < 4; ++q) p.km()[((size_t)(b * 4 + h) * PT + prow0 + mi * 16 + q) * 96 + 64 + col - 384] = (__bf16)v[mi][q];
      } else if (col0 < 928) {
        const bool isq = col0 < 672;
        const int n1 = col - (isq ? 416 : 672);
        const int head = n1 >> 6, map = (n1 >> 5) & 1, d = n1 & 31;
        __bf16* dst = (isq ? p.qd() : p.kd()) + ((size_t)((b * 4 + head) * 2 + map) * PT) * 32 + d;
        const float sc = isq ? 0.17677669529663687f * LOG2E : 1.f;
        f4 v[4];
#pragma unroll
        for (int mi = 0; mi < 4; ++mi) {
          v[mi] = acc[mi][0];
          if (lat) v[mi] = rope4(p, v[mi], prow0 + mi * 16, (n1 >> 4) & 1, r);
        }
#pragma unroll
        for (int mi = 0; mi < 4; ++mi)
#pragma unroll
          for (int q = 0; q < 4; ++q) dst[(size_t)(prow0 + mi * 16 + q) * 32] = (__bf16)(v[mi][q] * sc);
      } else if (col0 < 1184 || (col0 >= 2720 && col0 < 3232)) {
        const bool isd = col0 < 1184;
        const int n1 = col - (isd ? 928 : 2720);
        __bf16* dst = isd ? p.vdt() + ((size_t)(b * 4 + (n1 >> 6)) * 64 + (n1 & 63)) * PT
                          : p.hvt() + ((size_t)(b * 8 + (n1 >> 6)) * 64 + (n1 & 63)) * PT;
#pragma unroll
        for (int mi = 0; mi < 4; ++mi) *(bf4*)(dst + prow0 + mi * 16) = pack4(acc[mi][0]);
      } else if (col0 < 1696 || (col0 >= 3232 && col0 < INW)) {
        const bool ish = col0 < 1696;
        __bf16* dst = ish ? p.hq() + (col - 1184) : p.hg() + (col - 3232);
#pragma unroll
        for (int mi = 0; mi < 4; ++mi)
#pragma unroll
          for (int q = 0; q < 4; ++q) dst[(size_t)(tok0 + mi * 16 + q) * 512] = (__bf16)silu_f(acc[mi][0][q]);
      } else if (col0 < 2720) {
        const int dir = col0 >= 2208;
        const int n1 = col - (dir ? 2208 : 1696);
        const float la = tla[0], l1m = tl1[0];
        float* dst = p.lf() + (size_t)dir * NTOK * 512 + n1;
#pragma unroll
        for (int mi = 0; mi < 4; ++mi)
#pragma unroll
          for (int q = 0; q < 4; ++q) dst[(size_t)(tok0 + mi * 16 + q) * 512] = log_forget(acc[mi][0][q], la, l1m);
      }
    } else if constexpr (EPI == EPI_UQ) {
      const int head = col0 / 96, d0 = col0 - head * 96;
      const float sc = 0.10206207261596577f * LOG2E;
      __bf16* dst = p.qm() + ((size_t)(b * 4 + head) * PT) * 96 + d0 + r;
      f4 v[4];
#pragma unroll
      for (int mi = 0; mi < 4; ++mi) {
        f4 a = acc[mi][0];
#pragma unroll
        for (int q = 0; q < 4; ++q) a[q] *= rsqrtf(rowss[wm * 64 + mi * 16 + 4 * g + q] * (1.f / 256.f) + EPSN);
        if (d0 >= 64 && lat) a = rope4(p, a, prow0 + mi * 16, (d0 - 64) >> 4, r);
        v[mi] = a;
      }
#pragma unroll
      for (int mi = 0; mi < 4; ++mi)
#pragma unroll
        for (int q = 0; q < 4; ++q) dst[(size_t)(prow0 + mi * 16 + q) * 96] = (__bf16)(v[mi][q] * sc);
    } else if constexpr (EPI == EPI_UKV) {
      const int head = col >> 7, d = col & 127;
#pragma unroll
      for (int mi = 0; mi < 4; ++mi) {
        f4 a = acc[mi][0];
        const int prow = prow0 + mi * 16;
#pragma unroll
        for (int q = 0; q < 4; ++q) a[q] *= rsqrtf(rowss[wm * 64 + mi * 16 + 4 * g + q] * (1.f / 128.f) + EPSN);
        if ((col0 & 127) < 64) {
#pragma unroll
          for (int q = 0; q < 4; ++q) p.km()[((size_t)(b * 4 + head) * PT + prow + q) * 96 + d] = (__bf16)a[q];
        } else {
          *(bf4*)(p.vmt() + ((size_t)(b * 4 + head) * 64 + d - 64) * PT + prow) = pack4(a);
        }
      }
    } else if constexpr (EPI == EPI_OUT || EPI == EPI_DOWN) {
    } else if constexpr (EPI == EPI_OUT_AT || EPI == EPI_DOWN_AT) {
      const float gt = md[(EPI == EPI_OUT_AT ? 2048 : 5120) + col];
      float* xb = (lat ? p.out + (size_t)(b * SEQ + prow0 - CTXL) * DM : p.xc() + (size_t)(b * CTXL + prow0) * DM) + col;
#pragma unroll
      for (int mi = 0; mi < 4; ++mi)
#pragma unroll
        for (int q = 0; q < 4; ++q) atomicAdd(xb + (size_t)(mi * 16 + q) * DM, gt * acc[mi][0][q]);
    } else if constexpr (EPI == EPI_UP) {
      const int n = (col0 >> 5) * 16 + r;
#pragma unroll
      for (int mi = 0; mi < 4; ++mi)
#pragma unroll
        for (int q = 0; q < 4; ++q)
          p.act()[(size_t)(tok0 + mi * 16 + q) * LDF + n] = (__bf16)(silu_f(acc[mi][0][q]) * acc[mi][1][q]);
    }
#pragma unroll
    for (int mi = 0; mi < 4; ++mi) {
      if constexpr (STEP == 1) { acc[mi][0] = acc[mi][1]; acc[mi][1] = acc[mi][2]; acc[mi][2] = acc[mi][3]; }
      else { acc[mi][0] = acc[mi][2]; acc[mi][1] = acc[mi][3]; }
    }
    tla[0] = tla[1]; tla[1] = tla[2]; tla[2] = tla[3]; tl1[0] = tl1[1]; tl1[1] = tl1[2]; tl1[2] = tl1[3];
  }
}

#define RAW_BARRIER() do { asm volatile("s_waitcnt lgkmcnt(0)" ::: "memory"); __builtin_amdgcn_s_barrier(); } while (0)

template <int EPI, bool ROWSS>
__device__ __forceinline__ void gemm_tile(const Params& p, int l, const __bf16* __restrict__ A, int lda, const __bf16* __restrict__ Bt, int ldb, int K,
                          int m0, int n0, char* smem, bool pre = false, bool has_next = false, int m0n = 0, int n0n = 0) {
  __bf16* S0 = (__bf16*)smem;
  float* rowss = (float*)(smem + 65536);
  const int tid = tid_(), lane = tid & 63, wave = tid >> 6;
  const int wm = wave >> 1, wn = wave & 1, r = lane & 15, g = lane >> 4;
  f4 acc[4][4];
#pragma unroll
  for (int i = 0; i < 4; ++i)
#pragma unroll
    for (int j = 0; j < 4; ++j) acc[i][j] = f4{0.f, 0.f, 0.f, 0.f};
  if constexpr (ROWSS) {
    const int row = tid >> 1, half = tid & 1;
    const __bf16* rp = A + (size_t)(m0 + row) * lda + half * (K >> 1);
    float sq = 0.f;
    for (int c = 0; c < (K >> 4); ++c) {
      bf8 v = *(const bf8*)(rp + c * 8);
#pragma unroll
      for (int j = 0; j < 8; ++j) { float f = (float)v[j]; sq += f * f; }
    }
    sq += __shfl_xor(sq, 1);
    __syncthreads();
    if (!half) rowss[row] = sq;
  }
  const int lrow = lane >> 3;
  const int sz = (lane >> 4);
  const __bf16* gaw[4]; const __bf16* gbw[4];
#pragma unroll
  for (int i = 0; i < 4; ++i) {
    const int rg = wave + 4 * i;
    const int row = rg * 8 + lrow;
    const int cl = (lane & 7) ^ (((rg & 1) * 4 + sz) & 7);
    gaw[i] = A + (size_t)(m0 + row) * lda + cl * 8;
    gbw[i] = Bt + (size_t)(n0 + row) * ldb + cl * 8;
  }
  const int aoff = (wm * 64 + r) * 64, boff = 8192 + (wn * 64 + r) * 64;
  const int sw = r >> 1;
  const int KT = K / 64;
  if (!pre) {
    __syncthreads();
#pragma unroll
    for (int i = 0; i < 4; ++i) {
      __builtin_amdgcn_global_load_lds((const unsigned*)(gaw[i]), (unsigned*)(S0 + (wave + 4 * i) * 512), 16, 0, 0);
      __builtin_amdgcn_global_load_lds((const unsigned*)(gbw[i]), (unsigned*)(S0 + 8192 + (wave + 4 * i) * 512), 16, 0, 0);
    }
  }
  asm volatile("s_waitcnt vmcnt(0)" ::: "memory");
  RAW_BARRIER();
  for (int kt = 0; kt < KT; ++kt) {
    const __bf16* Sc = S0 + (kt & 1) * 16384;
    __bf16* Sn = S0 + ((kt + 1) & 1) * 16384;
    __builtin_amdgcn_s_setprio(2);
    if (kt + 1 < KT) {
#pragma unroll
      for (int i = 0; i < 4; ++i) {
        __builtin_amdgcn_global_load_lds((const unsigned*)(gaw[i] + (kt + 1) * 64), (unsigned*)(Sn + (wave + 4 * i) * 512), 16, 0, 0);
        __builtin_amdgcn_global_load_lds((const unsigned*)(gbw[i] + (kt + 1) * 64), (unsigned*)(Sn + 8192 + (wave + 4 * i) * 512), 16, 0, 0);
      }
    }
    {
      bf8 af0[4], bf0[4], af1[4], bf1[4];
      const int ch0 = ((0 * 4 + g) ^ sw) * 8, ch1 = ((1 * 4 + g) ^ sw) * 8;
#pragma unroll
      for (int i = 0; i < 4; ++i) {
        af0[i] = *(const bf8*)(Sc + aoff + i * 1024 + ch0);
        bf0[i] = *(const bf8*)(Sc + boff + i * 1024 + ch0);
      }
#pragma unroll
      for (int i = 0; i < 4; ++i) {
        af1[i] = *(const bf8*)(Sc + aoff + i * 1024 + ch1);
        bf1[i] = *(const bf8*)(Sc + boff + i * 1024 + ch1);
      }
      __builtin_amdgcn_s_setprio(1);
#pragma unroll
      for (int i = 0; i < 4; ++i)
#pragma unroll
        for (int j = 0; j < 4; ++j) acc[i][j] = mfma16(af0[i], bf0[j], acc[i][j]);
#pragma unroll
      for (int i = 0; i < 4; ++i)
#pragma unroll
        for (int j = 0; j < 4; ++j) acc[i][j] = mfma16(af1[i], bf1[j], acc[i][j]);
      __builtin_amdgcn_s_setprio(0);
      __builtin_amdgcn_sched_group_barrier(0x100, 8, 0);
#pragma unroll
      for (int i = 0; i < 8; ++i) {
        __builtin_amdgcn_sched_group_barrier(0x008, 1, 0);
        __builtin_amdgcn_sched_group_barrier(0x100, 1, 0);
      }
      __builtin_amdgcn_sched_group_barrier(0x008, 24, 0);
    }
    asm volatile("s_waitcnt vmcnt(0)" ::: "memory");
    RAW_BARRIER();
  }
  if (has_next) {
#pragma unroll
    for (int i = 0; i < 4; ++i) {
      const int rg = wave + 4 * i;
      const int row = rg * 8 + lrow;
      const int cl = (lane & 7) ^ (((rg & 1) * 4 + sz) & 7);
      __builtin_amdgcn_global_load_lds((const unsigned*)(A + (size_t)(m0n + row) * lda + cl * 8), (unsigned*)(S0 + rg * 512), 16, 0, 0);
      __builtin_amdgcn_global_load_lds((const unsigned*)(Bt + (size_t)(n0n + row) * ldb + cl * 8), (unsigned*)(S0 + 8192 + rg * 512), 16, 0, 0);
    }
  }
  gemm_epilogue<EPI>(p, l, acc, m0, n0, wm, wn, lane, rowss);
}

__device__ __forceinline__ int mtile_count(int l) { return l < 3 ? 132 : 128; }
__device__ __forceinline__ int mtile_index(int l, int i) { return l < 3 ? i : (i >> 6) * 66 + 2 + (i & 63); }

__device__ __forceinline__ bool gemm_pick(int step, int bid, int G, int MT, int NT, int W, int& mt, int& nt) {
  const int C = G >> 3;
  const int L = (step * 8 + (bid & 7)) * C + (bid >> 3);
  if (L >= MT * NT) return false;
  const int s = L / (W * MT), rem = L - s * W * MT;
  mt = rem / W; nt = s * W + (rem - mt * W);
  return true;
}

template <int DQK, int NMAP>
__device__ __forceinline__ void attn_item(const Params& p, int l, const __bf16* __restrict__ Q, const __bf16* __restrict__ Kp,
                          const __bf16* __restrict__ Vt, int b, int h, int q0, int nkeys, char* smem) {
  constexpr int KLD = DQK;
  constexpr int KCH = DQK / 8;
  constexpr int NKC = NMAP * 64 * KCH / 256;
  constexpr int NKS = DQK / 32;
  __bf16* Ks = (__bf16*)smem;
  __bf16* Vs = Ks + NMAP * 64 * KLD;
  const int tid = tid_(), lane = tid & 63, wave = tid >> 6, r = lane & 15, g = lane >> 4;
  const __bf16* Qb = Q + (size_t)((b * 4 + h) * NMAP) * PT * DQK;
  const __bf16* Kb = Kp + (size_t)((b * 4 + h) * NMAP) * PT * DQK;
  const __bf16* Vb = Vt + (size_t)((b * 4 + h) * 64) * PT;

  bf8 qf[NMAP][2][NKS];
#pragma unroll
  for (int mp = 0; mp < NMAP; ++mp)
#pragma unroll
    for (int qt = 0; qt < 2; ++qt)
#pragma unroll
      for (int ks = 0; ks < NKS; ++ks)
        qf[mp][qt][ks] = *(const bf8*)(Qb + ((size_t)mp * PT + q0 + wave * 32 + qt * 16 + r) * DQK + ks * 32 + g * 8);

  f4 o[NMAP][2][4];
  float mrun[NMAP][2], lsum[NMAP][2];
  f4 negm[NMAP][2];
#pragma unroll
  for (int mp = 0; mp < NMAP; ++mp)
#pragma unroll
    for (int qt = 0; qt < 2; ++qt) {
      mrun[mp][qt] = 0.f; lsum[mp][qt] = 0.f; negm[mp][qt] = f4{0.f, 0.f, 0.f, 0.f};
#pragma unroll
      for (int d = 0; d < 4; ++d) o[mp][qt][d] = f4{0.f, 0.f, 0.f, 0.f};
    }

  int koff_g[NKC], koff_s[NKC];
#pragma unroll
  for (int i = 0; i < NKC; ++i) {
    int c = tid + 256 * i;
    int mp = c / (64 * KCH), rem = c - mp * 64 * KCH;
    int row = rem / KCH, kc = rem - row * KCH;
    koff_g[i] = (mp * PT + row) * DQK + kc * 8;
    koff_s[i] = (mp * 64 + row) * KLD + (((kc & ~3) | ((kc & 3) ^ ((-(row >> 3)) & 3))) * 8);
  }
  bf8 rk[NKC], rv[2];
  const int nkb = nkeys / 64;
#pragma unroll
  for (int i = 0; i < NKC; ++i) rk[i] = *(const bf8*)(Kb + koff_g[i]);
#pragma unroll
  for (int i = 0; i < 2; ++i) rv[i] = *(const bf8*)(Vb + (size_t)((tid >> 3) + 32 * i) * PT + (tid & 7) * 8);

  for (int kb = 0; kb < nkb; ++kb) {
    __syncthreads();
    __builtin_amdgcn_s_setprio(2);
#pragma unroll
    for (int i = 0; i < NKC; ++i) *(bf8*)(Ks + koff_s[i]) = rk[i];
#pragma unroll
    for (int i = 0; i < 2; ++i) *(bf8*)(Vs + ((tid >> 3) + 32 * i) * 64 + (((tid & 7) ^ ((tid >> 4) & 7)) * 8)) = rv[i];
    __syncthreads();
    if (kb + 1 < nkb) {
#pragma unroll
      for (int i = 0; i < NKC; ++i) rk[i] = *(const bf8*)(Kb + koff_g[i] + (size_t)(kb + 1) * 64 * DQK);
#pragma unroll
      for (int i = 0; i < 2; ++i) rv[i] = *(const bf8*)(Vb + (size_t)((tid >> 3) + 32 * i) * PT + (kb + 1) * 64 + (tid & 7) * 8);
    }
    __builtin_amdgcn_s_setprio(0);
    f4 s[NMAP][2][2][2];
    {
      bf8 kfr[NMAP][2][2][NKS];
#pragma unroll
      for (int mp = 0; mp < NMAP; ++mp)
#pragma unroll
        for (int m = 0; m < 2; ++m)
#pragma unroll
          for (int tp = 0; tp < 2; ++tp) {
            const int krow = 32 * m + 8 * (r >> 2) + 4 * tp + (r & 3);
#pragma unroll
            for (int ks = 0; ks < NKS; ++ks) kfr[mp][m][tp][ks] = *(const bf8*)(Ks + (mp * 64 + krow) * KLD + ks * 32 + ((g ^ ((-(r >> 2)) & 3)) * 8));
          }
      __builtin_amdgcn_s_setprio(1);
#pragma unroll
      for (int mp = 0; mp < NMAP; ++mp)
#pragma unroll
        for (int m = 0; m < 2; ++m)
#pragma unroll
          for (int tp = 0; tp < 2; ++tp) {
            f4 s0 = negm[mp][0], s1 = negm[mp][1];
#pragma unroll
            for (int ks = 0; ks < NKS; ++ks) {
              s0 = mfma16(kfr[mp][m][tp][ks], qf[mp][0][ks], s0);
              s1 = mfma16(kfr[mp][m][tp][ks], qf[mp][1][ks], s1);
            }
            s[mp][0][m][tp] = s0; s[mp][1][m][tp] = s1;
          }
      __builtin_amdgcn_s_setprio(0);
    }
    bf8 pf[NMAP][2][2];
#pragma unroll
    for (int mp = 0; mp < NMAP; ++mp)
#pragma unroll
      for (int qt = 0; qt < 2; ++qt) {
        float ps = 0.f;
#pragma unroll
        for (int m = 0; m < 2; ++m) {
          bf8 pk;
#pragma unroll
          for (int tp = 0; tp < 2; ++tp)
#pragma unroll
            for (int q = 0; q < 4; ++q) {
              float e = __builtin_amdgcn_exp2f(s[mp][qt][m][tp][q]);
              ps += e;
              pk[tp * 4 + q] = (__bf16)e;
            }
          pf[mp][qt][m] = pk;
        }
        const bool hi = __builtin_amdgcn_ballot_w64(!(ps < 65536.f)) != 0ull;
        const bool lo = __builtin_amdgcn_ballot_w64(ps > 0.f || lsum[mp][qt] > 0.f) == 0ull;
        if (hi || lo) {
          float bm = -INFINITY;
#pragma unroll
          for (int m = 0; m < 2; ++m)
#pragma unroll
            for (int tp = 0; tp < 2; ++tp)
#pragma unroll
              for (int q = 0; q < 4; ++q) bm = fmaxf(bm, s[mp][qt][m][tp][q]);
          bm = rows_max(bm);
          const float sh = lo ? bm : fmaxf(bm, 0.f);
          const float alpha = lo ? 1.f : __builtin_amdgcn_exp2f(-sh);
          mrun[mp][qt] += sh;
          const float nm = -mrun[mp][qt];
          negm[mp][qt] = f4{nm, nm, nm, nm};
          lsum[mp][qt] *= alpha;
#pragma unroll
          for (int d = 0; d < 4; ++d) o[mp][qt][d] *= alpha;
          ps = 0.f;
#pragma unroll
          for (int m = 0; m < 2; ++m) {
            bf8 pk;
#pragma unroll
            for (int tp = 0; tp < 2; ++tp)
#pragma unroll
              for (int q = 0; q < 4; ++q) {
                float e = __builtin_amdgcn_exp2f(s[mp][qt][m][tp][q] - sh);
                ps += e;
                pk[tp * 4 + q] = (__bf16)e;
              }
            pf[mp][qt][m] = pk;
          }
        }
        lsum[mp][qt] += ps;
      }
    {
      bf8 vfr[4][2];
#pragma unroll
      for (int d = 0; d < 4; ++d)
#pragma unroll
        for (int m = 0; m < 2; ++m) vfr[d][m] = *(const bf8*)(Vs + (d * 16 + r) * 64 + (((4 * m + g) ^ (r >> 1)) * 8));
      __builtin_amdgcn_s_setprio(1);
#pragma unroll
      for (int d = 0; d < 4; ++d)
#pragma unroll
        for (int m = 0; m < 2; ++m)
#pragma unroll
          for (int mp = 0; mp < NMAP; ++mp)
#pragma unroll
            for (int qt = 0; qt < 2; ++qt) o[mp][qt][d] = mfma16(vfr[d][m], pf[mp][qt][m], o[mp][qt][d]);
    }
    __builtin_amdgcn_s_setprio(0);
  }
#pragma unroll
  for (int qt = 0; qt < 2; ++qt) {
    const int tok = b * PT + q0 + wave * 32 + qt * 16 + r;
    float inv[NMAP];
#pragma unroll
    for (int mp = 0; mp < NMAP; ++mp) {
      float ls = lsum[mp][qt];
      ls = rows_sum(ls);
      inv[mp] = 1.f / ls;
    }
    if constexpr (NMAP == 1) {
#pragma unroll
      for (int d = 0; d < 4; ++d)
        *(bf4*)(p.mix() + (size_t)tok * LDH + h * 64 + d * 16 + 4 * g) = pack4(o[0][qt][d] * inv[0]);
    } else {
      const float lam = p.lam()[l];
      const float li = 0.8f - 0.6f * expf(-0.3f * (float)l);
      f4 val[4];
      float ss = 0.f;
#pragma unroll
      for (int d = 0; d < 4; ++d) {
        val[d] = o[0][qt][d] * inv[0] - o[NMAP - 1][qt][d] * (lam * inv[NMAP - 1]);
        ss += val[d][0] * val[d][0] + val[d][1] * val[d][1] + val[d][2] * val[d][2] + val[d][3] * val[d][3];
      }
      ss = rows_sum(ss);
      const float rs = rsqrtf(ss * (1.f / 64.f) + EPSN) * (1.f - li);
      f4 gd[4];
#pragma unroll
      for (int d = 0; d < 4; ++d) gd[d] = *(const f4*)(p.g_diff_norm + l * 64 + d * 16 + 4 * g);
#pragma unroll
      for (int d = 0; d < 4; ++d) *(bf4*)(p.mix() + (size_t)tok * LDH + 256 + h * 64 + d * 16 + 4 * g) = pack4(val[d] * rs * gd[d]);
    }
  }
}

template <int DQK, int NMAP>
__device__ __forceinline__ void attn_dispatch(const Params& p, int l, int item, const __bf16* Q, const __bf16* K, const __bf16* Vt, char* smem) {
  int b, h, q0, nk;
  if (item < 512) { b = (item >> 2) & 1; h = item & 3; q0 = CTXL + (item >> 3) * 128; nk = PT; }
  else { int it = item - 512; b = it >> 3; h = (it >> 1) & 3; q0 = (it & 1) * 128; nk = CTXL; }
  attn_item<DQK, NMAP>(p, l, Q, K, Vt, b, h, q0, nk, smem);
}

__device__ __forceinline__ void hgrn1_item(const Params& p, int item, char* smem) {
  __bf16* kteT = (__bf16*)smem;
  __bf16* vT = kteT + 64 * 72;
  float* ptot = (float*)(vT + 64 * 72);
  const int tid = tid_(), lane = tid & 63, wave = tid >> 6, r = lane & 15, g = lane >> 4;
  const int c = item % NCH, bh = item / NCH;
  const int b = bh >> 3, h = bh & 7;
  const int tok0 = b * PT + c * 64;
  __syncthreads();
#pragma unroll
  for (int i = 0; i < 2; ++i) {
    int dv = (tid >> 3) + 32 * i;
    *(bf8*)(vT + dv * 72 + (tid & 7) * 8) = *(const bf8*)(p.hvt() + ((size_t)bh * 64 + dv) * PT + c * 64 + (tid & 7) * 8);
  }
  const int k = tid & 63, part = tid >> 6;
  float lfa[2][16];
#pragma unroll
  for (int dd = 0; dd < 2; ++dd) {
    const float* lfp = p.lf() + ((size_t)dd * NTOK + tok0 + part * 16) * 512 + h * 64 + k;
#pragma unroll
    for (int i = 0; i < 16; ++i) lfa[dd][i] = lfp[(size_t)i * 512];
  }
#pragma unroll
  for (int dir = 0; dir < 2; ++dir) {
    float lfv[16], cl[16];
#pragma unroll
    for (int i = 0; i < 16; ++i) lfv[i] = lfa[dir][i];
    float run = 0.f;
    if (dir == 0) {
#pragma unroll
      for (int i = 0; i < 16; ++i) { run += lfv[i]; cl[i] = run; }
    } else {
#pragma unroll
      for (int i = 15; i >= 0; --i) { run += lfv[i]; cl[i] = run; }
    }
    __syncthreads();
    ptot[part * 64 + k] = run;
    __syncthreads();
    float off = 0.f, total = 0.f;
#pragma unroll
    for (int q = 0; q < 4; ++q) {
      float t = ptot[q * 64 + k];
      total += t;
      if (dir == 0 ? (q < part) : (q > part)) off += t;
    }
#pragma unroll
    for (int i = 0; i < 16; ++i) {
      float cum = cl[i] + off;
      float kte = (1.f - __expf(lfv[i])) * __expf(total - cum);
      kteT[k * 72 + part * 16 + i] = (__bf16)kte;
    }
    const size_t sidx = ((size_t)bh * 2 + dir) * NCH + c;
    if (part == 0) p.dk()[sidx * 64 + k] = __expf(total);
    __syncthreads();
    f4 acc[4];
#pragma unroll
    for (int nt = 0; nt < 4; ++nt) acc[nt] = f4{0.f, 0.f, 0.f, 0.f};
#pragma unroll
    for (int ks = 0; ks < 2; ++ks) {
      bf8 af = *(const bf8*)(vT + (wave * 16 + r) * 72 + ks * 32 + g * 8);
#pragma unroll
      for (int nt = 0; nt < 4; ++nt) {
        bf8 bfr = *(const bf8*)(kteT + (nt * 16 + r) * 72 + ks * 32 + g * 8);
        acc[nt] = mfma16(af, bfr, acc[nt]);
      }
    }
    float* up = p.ut() + sidx * 4096;
#pragma unroll
    for (int nt = 0; nt < 4; ++nt)
#pragma unroll
      for (int q = 0; q < 4; ++q) up[(wave * 16 + 4 * g + q) * 64 + nt * 16 + r] = acc[nt][q];
  }
}

__device__ __forceinline__ void hgrn2_item(const Params& p, int item) {
  const int idx = item * 256 + tid_();
  const int e = idx & 4095, sd = idx >> 12;
  const int dir = sd & 1, kk = e & 63;
  const float* up = p.ut() + (size_t)sd * NCH * 4096 + e;
  const float* dp = p.dk() + (size_t)sd * NCH * 64 + kk;
  __bf16* sp = p.st() + (size_t)sd * NCH * 4096 + e;
  float S = 0.f;
  for (int jb = 0; jb < NCH; jb += 22) {
    float u[22], d[22];
    int cc[22];
#pragma unroll
    for (int q = 0; q < 22; ++q) {
      int j = jb + q;
      int c = dir == 0 ? j : (j < 4 ? 3 - j : 135 - j);
      cc[q] = c;
      u[q] = up[(size_t)c * 4096];
      d[q] = dp[c * 64];
    }
#pragma unroll
    for (int q = 0; q < 22; ++q) {
      sp[(size_t)cc[q] * 4096] = (__bf16)S;
      S = d[q] * S + u[q];
    }
  }
}

__device__ __forceinline__ void hgrn3_item(const Params& p, int l, int item, char* smem) {
  __bf16* qS = (__bf16*)smem;
  __bf16* kS = qS + 64 * 72;
  __bf16* vT = kS + 64 * 72;
  __bf16* stS = vT + 64 * 72;
  float* cumS = (float*)(stS + 64 * 72);
  float* ptot = cumS + 64 * 68;
  const int tid = tid_(), lane = tid & 63, wave = tid >> 6, r = lane & 15, g = lane >> 4;
  const int c = item % NCH, bh = item / NCH;
  const int b = bh >> 3, h = bh & 7;
  const int tok0 = b * PT + c * 64;
  __syncthreads();
#pragma unroll
  for (int i = 0; i < 2; ++i) {
    int row = (tid >> 3) + 32 * i;
    *(bf8*)(vT + row * 72 + (tid & 7) * 8) = *(const bf8*)(p.hvt() + ((size_t)bh * 64 + row) * PT + c * 64 + (tid & 7) * 8);
    *(bf8*)(qS + row * 72 + (tid & 7) * 8) = *(const bf8*)(p.hq() + (size_t)(tok0 + row) * 512 + h * 64 + (tid & 7) * 8);
  }
  f4 o[4];
#pragma unroll
  for (int d = 0; d < 4; ++d) o[d] = f4{0.f, 0.f, 0.f, 0.f};
  const int k = tid & 63, part = tid >> 6;
  const int t = 16 * wave + r;
  bf8 sta[2][2];
#pragma unroll
  for (int dd = 0; dd < 2; ++dd) {
    const __bf16* sp = p.st() + (((size_t)bh * 2 + dd) * NCH + c) * 4096;
#pragma unroll
    for (int i = 0; i < 2; ++i) sta[dd][i] = *(const bf8*)(sp + ((tid >> 3) + 32 * i) * 64 + (tid & 7) * 8);
  }
  float lfa[2][16];
#pragma unroll
  for (int dd = 0; dd < 2; ++dd) {
    const float* lfp = p.lf() + ((size_t)dd * NTOK + tok0 + part * 16) * 512 + h * 64 + k;
#pragma unroll
    for (int i = 0; i < 16; ++i) lfa[dd][i] = lfp[(size_t)i * 512];
  }
#pragma unroll
  for (int dir = 0; dir < 2; ++dir) {
    float lfv[16], cl[16];
#pragma unroll
    for (int i = 0; i < 16; ++i) lfv[i] = lfa[dir][i];
    float run = 0.f;
    if (dir == 0) {
#pragma unroll
      for (int i = 0; i < 16; ++i) { run += lfv[i]; cl[i] = run; }
    } else {
#pragma unroll
      for (int i = 15; i >= 0; --i) { run += lfv[i]; cl[i] = run; }
    }
    __syncthreads();
    ptot[part * 64 + k] = run;
#pragma unroll
    for (int i = 0; i < 16; ++i) kS[(part * 16 + i) * 72 + k] = (__bf16)((1.f - __expf(lfv[i])));
#pragma unroll
    for (int i = 0; i < 2; ++i) *(bf8*)(stS + ((tid >> 3) + 32 * i) * 72 + (tid & 7) * 8) = sta[dir][i];
    __syncthreads();
    float off = 0.f;
#pragma unroll
    for (int q = 0; q < 4; ++q) {
      float tt = ptot[q * 64 + k];
      if (dir == 0 ? (q < part) : (q > part)) off += tt;
    }
#pragma unroll
    for (int i = 0; i < 16; ++i) cumS[(part * 16 + i) * 68 + k] = cl[i] + off;
    __syncthreads();
    float cs[2][8];
    bf8 qtf[2], qhf[2];
#pragma unroll
    for (int ks = 0; ks < 2; ++ks) {
      const int dk0 = ks * 32 + 8 * g;
      bf8 qv = *(const bf8*)(qS + t * 72 + dk0);
#pragma unroll
      for (int j = 0; j < 8; ++j) {
        float cst;
        if (dir == 0) cst = wave > 0 ? cumS[(16 * wave - 1) * 68 + dk0 + j] : 0.f;
        else cst = wave < 3 ? cumS[(16 * wave + 16) * 68 + dk0 + j] : 0.f;
        cs[ks][j] = cst;
        float cv = cumS[t * 68 + dk0 + j];
        float qf_ = (float)qv[j];
        qtf[ks][j] = (__bf16)(qf_ * __expf(cv - cst));
        qhf[ks][j] = (__bf16)(qf_ * __expf(cv));
      }
    }
#pragma unroll
    for (int m = 0; m < 2; ++m) {
      const bool need = dir == 0 ? (m <= (wave >> 1)) : (m >= (wave >> 1));
      if (need) {
        bf8 pf;
#pragma unroll
        for (int tp = 0; tp < 2; ++tp) {
          const int srow = 32 * m + 8 * (r >> 2) + 4 * tp + (r & 3);
          f4 sc = f4{0.f, 0.f, 0.f, 0.f};
#pragma unroll
          for (int ks = 0; ks < 2; ++ks) {
            const int dk0 = ks * 32 + 8 * g;
            bf8 kv = *(const bf8*)(kS + srow * 72 + dk0);
            bf8 ktf;
#pragma unroll
            for (int j = 0; j < 8; ++j) {
              float ex = fminf(cs[ks][j] - cumS[srow * 68 + dk0 + j], 80.f);
              ktf[j] = (__bf16)((float)kv[j] * __expf(ex));
            }
            sc = mfma16(ktf, qtf[ks], sc);
          }
#pragma unroll
          for (int q = 0; q < 4; ++q) {
            const int s = 32 * m + 8 * g + 4 * tp + q;
            const bool keep = dir == 0 ? (s <= t) : (s >= t);
            pf[tp * 4 + q] = keep ? (__bf16)sc[q] : (__bf16)0.f;
          }
        }
#pragma unroll
        for (int d = 0; d < 4; ++d) {
          bf8 vf = *(const bf8*)(vT + (d * 16 + r) * 72 + 32 * m + 8 * g);
          o[d] = mfma16(vf, pf, o[d]);
        }
      }
    }
#pragma unroll
    for (int d = 0; d < 4; ++d)
#pragma unroll
      for (int ks = 0; ks < 2; ++ks) {
        bf8 sf = *(const bf8*)(stS + (d * 16 + r) * 72 + ks * 32 + 8 * g);
        o[d] = mfma16(sf, qhf[ks], o[d]);
      }
  }
  float ss = 0.f;
#pragma unroll
  for (int d = 0; d < 4; ++d) ss += o[d][0] * o[d][0] + o[d][1] * o[d][1] + o[d][2] * o[d][2] + o[d][3] * o[d][3];
  ss = rows_sum(ss);
  const float rs = rsqrtf(ss * (1.f / 64.f) + EPSN);
  f4 gn[4]; bf4 gate[4];
#pragma unroll
  for (int d = 0; d < 4; ++d) {
    gn[d] = *(const f4*)(p.g_hgrn_norm + l * 64 + d * 16 + 4 * g);
    gate[d] = *(const bf4*)(p.hg() + (size_t)(tok0 + t) * 512 + h * 64 + d * 16 + 4 * g);
  }
#pragma unroll
  for (int d = 0; d < 4; ++d) {
    f4 res;
#pragma unroll
    for (int q = 0; q < 4; ++q) res[q] = o[d][q] * rs * gn[d][q] * (float)gate[d][q];
    *(bf4*)(p.mix() + (size_t)(tok0 + t) * LDH + 512 + h * 64 + d * 16 + 4 * g) = pack4(res);
  }
}

#define NPHASE 38
#ifndef ONLY
#define ONLY -1
#endif
#define PHEN(x) (ONLY < 0 || ONLY == (x))
__device__ __forceinline__ void run_phase(const Params& p, int ph, char* smem) {
  const int bid = bid_(), G = gridDim.x;
  if (ph == 0) { if (PHEN(100)) phase0(p, smem); return; }
  if (ph == NPHASE - 1) {
    for (int it = bid; it < NB * SEQ / 16; it += G) final_norm_item(p, it);
    return;
  }
  const int l = (ph - 1) / 9, sp = (ph - 1) % 9;
  const int nmt = mtile_count(l);
  switch (sp) {
    case 0: if (PHEN(0)) {
      for (int i = bid * 256 + tid_(); i < (INWP - INW) * DM / 8; i += G * 256) {
        bf8 z;
#pragma unroll
        for (int j = 0; j < 8; ++j) z[j] = (__bf16)0.f;
        *(bf8*)(p.wt_in() + (size_t)(INW + (i >> 7)) * LDH + (size_t)(i & 127) * 8) = z;
      }
      for (int it = bid; it < 1056; it += G) norm_item(p, l, 0, it);
      conv_items(p, l, bid, G, smem);
    } break;
    case 1: if (PHEN(1)) {
      {
        int mt, nt, mtn = 0, ntn = 0;
        bool have = gemm_pick(0, bid, G, 132, 30, 10, mt, nt), pre = false;
        for (int st = 0; have; ++st) {
          const bool hn = gemm_pick(st + 1, bid, G, 132, 30, 10, mtn, ntn);
          gemm_tile<EPI_IN, false>(p, l, p.hb(), LDH, p.wt_in(), LDH, DM, mt * 128, nt * 128, smem, pre, hn, mtn * 128, ntn * 128);
          pre = hn; have = hn; mt = mtn; nt = ntn;
        }
      }
    } break;
    case 2: if (PHEN(2)) {
      const int natt = l < 3 ? 528 : 512;
      const int total = natt + 396 + 528 + 2112, K = (total + G - 1) / G;
      const bool flip = (bid >> 3) & 1;
      for (int kk = 0; kk < K; ++kk) {
        const int k = flip ? (kk + 1 == K ? 0 : kk + 1) : kk;
        const int it0 = bid + k * G;
        if (it0 >= total) continue;
        if (it0 < natt) { attn_dispatch<32, 2>(p, l, it0, p.qd(), p.kd(), p.vdt(), smem); continue; }
        const int it = it0 - natt;
        if (it < 396) gemm_tile<EPI_UQ, true>(p, l, p.cq(), 256, p.wt_uq(), 256, 256, (it / 3) * 128, (it % 3) * 128, smem);
        else if (it < 924) { int j = it - 396; gemm_tile<EPI_UKV, true>(p, l, p.ckv(), 128, p.wt_ukv(), 128, 128, (j / 4) * 128, (j % 4) * 128, smem); }
        else hgrn1_item(p, it - 924, smem);
      }
    } break;
    case 3: if (PHEN(3)) {
      const int natt = l < 3 ? 528 : 512;
      const int total = 512 + natt, K = (total + G - 1) / G;
      const bool flip = (bid >> 3) & 1;
      for (int kk = 0; kk < K; ++kk) {
        const int k = flip ? (kk + 1 == K ? 0 : kk + 1) : kk;
        const int it = bid + k * G;
        if (it >= total) continue;
        if (it < 512) hgrn2_item(p, it);
        else attn_dispatch<96, 1>(p, l, it - 512, p.qm(), p.km(), p.vmt(), smem);
      }
    } break;
    case 4: if (PHEN(4)) {
      for (int j = bid; j < 2112; j += G) {
        if (l == 3 && (j % NCH) < 4) continue;
        hgrn3_item(p, l, j, smem);
      }
    } break;
    case 5: if (PHEN(5)) {
      {
        int mt, nt, mtn = 0, ntn = 0;
        bool have = gemm_pick(0, bid, G, 128, 8, 8, mt, nt), pre = false;
        for (int st = 0; have; ++st) {
          const bool hn = gemm_pick(st + 1, bid, G, 128, 8, 8, mtn, ntn);
          gemm_tile<EPI_OUT, false>(p, l, p.mix(), LDH, p.wt_out(), LDH, DM, mtile_index(3, mt) * 128, nt * 128, smem, pre, hn,
                                    mtile_index(3, mtn) * 128, ntn * 128);
          pre = hn; have = hn; mt = mtn; nt = ntn;
        }
      }
      if (l < 3) {
        for (int u = bid; u < 32 * 8; u += G) {
          const int tile = u >> 3, sp = u & 7;
          const int cm = tile >> 3, nt = tile & 7;
          const int mt = (cm >> 1) * 66 + (cm & 1);
          gemm_tile<EPI_OUT_AT, false>(p, l, p.mix() + sp * 128, LDH, p.wt_out() + sp * 128, LDH, 128, mt * 128, nt * 128, smem);
        }
      }
    } break;
    case 6: if (PHEN(6)) {
      for (int it = bid; it < 1056; it += G) norm_item(p, l, 1, it);
    } break;
    case 7: if (PHEN(7)) {
      {
        int mt, nt, mtn = 0, ntn = 0;
        bool have = gemm_pick(0, bid, G, nmt, 44, 11, mt, nt), pre = false;
        for (int st = 0; have; ++st) {
          const bool hn = gemm_pick(st + 1, bid, G, nmt, 44, 11, mtn, ntn);
          gemm_tile<EPI_UP, false>(p, l, p.hb(), LDH, p.wt_gu(), LDH, DM, mtile_index(l, mt) * 128, nt * 128, smem, pre, hn,
                                   mtile_index(l, mtn) * 128, ntn * 128);
          pre = hn; have = hn; mt = mtn; nt = ntn;
        }
      }
    } break;
    case 8: if (PHEN(8)) {
      {
        int mt, nt, mtn = 0, ntn = 0;
        bool have = gemm_pick(0, bid, G, 128, 8, 8, mt, nt), pre = false;
        for (int st = 0; have; ++st) {
          const bool hn = gemm_pick(st + 1, bid, G, 128, 8, 8, mtn, ntn);
          gemm_tile<EPI_DOWN, false>(p, l, p.act(), LDF, p.wt_down(), LDF, DFF, mtile_index(3, mt) * 128, nt * 128, smem, pre, hn,
                                     mtile_index(3, mtn) * 128, ntn * 128);
          pre = hn; have = hn; mt = mtn; nt = ntn;
        }
      }
      if (l < 3) {
        for (int u = bid; u < 32 * 11; u += G) {
          const int tile = u / 11, sp = u - tile * 11;
          const int cm = tile >> 3, nt = tile & 7;
          const int mt = (cm >> 1) * 66 + (cm & 1);
          gemm_tile<EPI_DOWN_AT, false>(p, l, p.act() + sp * 256, LDF, p.wt_down() + sp * 256, LDF, 256, mt * 128, nt * 128, smem);
        }
      }
    } break;
  }
}

#define XB_TMO      128
#define XB_XCNT(j)  (256  + 64 * (j))
#define XB_XSUB(j)  (1280 + 64 * (j))
#define XB_XGEN(j)  (2304 + 64 * (j))
#define XB_TOP      3328
#define XB_TOPGEN   3392
#define XCD_BAR_WORDS 3456
#define XB_SPIN_CAP (1u << 22)
#define LAS __attribute__((address_space(3)))

__device__ __forceinline__ unsigned xb_ld(unsigned* p)              { return __hip_atomic_load(p, __ATOMIC_RELAXED, __HIP_MEMORY_SCOPE_AGENT); }
__device__ __forceinline__ unsigned xb_add(unsigned* p, unsigned v) { return __hip_atomic_fetch_add(p, v, __ATOMIC_RELAXED, __HIP_MEMORY_SCOPE_AGENT); }
__device__ __forceinline__ unsigned xb_xcc_id() { return (unsigned)__builtin_amdgcn_s_getreg((3 << 11) | 20) & 0xFu; }
#define XB_SPIN(cond, bar) do { unsigned _sp = 0; while (cond) { __builtin_amdgcn_s_sleep(1); \
    if ((++_sp & 255u) == 0u) { if (xb_ld(&(bar)[XB_TMO])) break; if (_sp > XB_SPIN_CAP) { atomicAdd(&(bar)[XB_TMO], 1u); break; } } } } while (0)

struct XcdBarrier {
    unsigned* bar; unsigned x;
    volatile LAS unsigned* st;
};

__device__ __forceinline__ XcdBarrier xcd_barrier_post(unsigned* bar, volatile LAS unsigned* st) {
    XcdBarrier b; b.bar = bar; b.x = xb_xcc_id(); b.st = st;
    if (threadIdx.x == 0) (void)xb_add(&bar[XB_XCNT(b.x)], 1u);
    return b;
}
__device__ __forceinline__ void xcd_barrier_complete(unsigned* bar, unsigned x, unsigned& nloc, unsigned& nx) {
    const unsigned G = gridDim.x * gridDim.y * gridDim.z;
    unsigned sum, cnt, mine, sp = 0u;
    for (;;) {
        sum = 0u; cnt = 0u; mine = 0u;
#pragma unroll
        for (unsigned j = 0; j < 16; ++j) { const unsigned c = xb_ld(&bar[XB_XCNT(j)]); sum += c; cnt += (c > 0u) ? 1u : 0u; mine = (j == x) ? c : mine; }
        if (sum == G) break;
        __builtin_amdgcn_s_sleep(1);
        if ((++sp & 255u) == 0u) { if (xb_ld(&bar[XB_TMO])) break; if (sp > XB_SPIN_CAP) { atomicAdd(&bar[XB_TMO], 1u); break; } }
    }
    nloc = mine > 0u ? mine : 1u; nx = cnt > 0u ? cnt : 1u;
}

__device__ __forceinline__ void xcd_barrier(const XcdBarrier& b) {
    asm volatile("s_waitcnt vmcnt(0)" ::: "memory");
    __syncthreads();
    if (threadIdx.x == 0) {
        unsigned* bar = b.bar;
        __builtin_amdgcn_s_waitcnt(0);
        unsigned nloc = b.st[0], nx = b.st[1];
        if (nloc == 0u) { xcd_barrier_complete(bar, b.x, nloc, nx); b.st[0] = nloc; b.st[1] = nx; }
        const unsigned old = xb_add(&bar[XB_XSUB(b.x)], 1u);
        const unsigned gen = old / nloc;
        if (old + 1u == (gen + 1u) * nloc) {
            __builtin_amdgcn_fence(__ATOMIC_RELEASE, "agent");
            asm volatile("s_waitcnt vmcnt(0)" ::: "memory");
            const unsigned og = xb_add(&bar[XB_TOP], 1u);
            const unsigned tg = og / nx;
            if (og + 1u == (tg + 1u) * nx) xb_add(&bar[XB_TOPGEN], 1u);
            else XB_SPIN(xb_ld(&bar[XB_TOPGEN]) == tg, bar);
            __builtin_amdgcn_fence(__ATOMIC_ACQUIRE, "agent");
            xb_add(&bar[XB_XGEN(b.x)], 1u);
            asm volatile("s_waitcnt vmcnt(0)" ::: "memory");
        } else {
            XB_SPIN(xb_ld(&bar[XB_XGEN(b.x)]) == gen, bar);
            __builtin_amdgcn_fence(__ATOMIC_ACQUIRE, "agent");
            asm volatile("s_waitcnt vmcnt(0)" ::: "memory");
        }
    }
    __syncthreads();
}


__device__ __forceinline__ void grid_barrier(unsigned* cnt, unsigned target) {
  asm volatile("s_waitcnt vmcnt(0)" ::: "memory");
  __syncthreads();
  if (tid_() == 0) {
    __builtin_amdgcn_fence(__ATOMIC_RELEASE, "agent");
    asm volatile("s_waitcnt vmcnt(0)" ::: "memory");
    __hip_atomic_fetch_add(cnt, 1u, __ATOMIC_RELAXED, __HIP_MEMORY_SCOPE_AGENT);
    unsigned spins = 0;
    while (__hip_atomic_load(cnt, __ATOMIC_RELAXED, __HIP_MEMORY_SCOPE_AGENT) < target) {
      __builtin_amdgcn_s_sleep(2);
      if (++spins > (1u << 24)) break;
    }
    __builtin_amdgcn_fence(__ATOMIC_ACQUIRE, "agent");
    asm volatile("s_waitcnt vmcnt(0)" ::: "memory");
  }
  __syncthreads();
}

__global__ void __launch_bounds__(256, 2) hybrid_megakernel(Params p, int ph0, int ph1) {
  __shared__ __attribute__((aligned(16))) char smem[SMEM_BYTES];
  cg::grid_group grid = cg::this_grid();
  volatile LAS unsigned* xst = (volatile LAS unsigned*)(smem + 66048);
  if (__builtin_amdgcn_workitem_id_x() == 0) { xst[0] = 0u; xst[1] = 0u; }
  __syncthreads();
  XcdBarrier xb; xb.bar = nullptr; xb.x = 0; xb.st = xst;
  for (int ph = ph0; ph < ph1; ++ph) {
    Params q = p;
    size_t zoff = 0;
    asm volatile("" : "+s"(zoff));
    q.ws = p.ws + zoff; q.out = p.out + zoff;
    run_phase(q, ph, smem);
#ifdef REPMASK
    if (ph > 0 && ph < NPHASE - 1 && ((REPMASK >> ((ph - 1) % 9)) & 1)) { grid.sync(); run_phase(q, ph, smem); }
#endif
    if (ph + 1 < ph1) {
      if (ph == ph0) { grid.sync(); xb = xcd_barrier_post((unsigned*)(p.ws + OFF_xbar), xst); }
      else xcd_barrier(xb);
    }
  }
}

extern "C" void kernel_launch(void* const* d_in, const int* in_sizes, int n_in, void* d_out, int out_size, void* d_ws,
                              size_t ws_size, hipStream_t stream) {
  static int grid_blocks = 0;
  if (!grid_blocks) {
    int dev = 0, cus = 0, per_cu = 0;
    hipGetDevice(&dev);
    hipDeviceGetAttribute(&cus, hipDeviceAttributeMultiprocessorCount, dev);
    hipOccupancyMaxActiveBlocksPerMultiprocessor(&per_cu, hybrid_megakernel, 256, 0);
    if (per_cu > 2) per_cu = 2;
    if (per_cu < 1) per_cu = 1;
    grid_blocks = cus * per_cu;
  }
  Params p{};
  const float* const* in = (const float* const*)d_in;
  p.x = in[0]; p.c = in[1]; p.ctx = in[2]; p.c_ctx = in[3]; p.w_ada = in[4]; p.b_ada = in[5]; p.g_norm1 = in[6];
  p.g_norm2 = in[7]; p.w_in = in[8]; p.g_q_norm = in[9]; p.w_uq = in[10]; p.g_kv_norm = in[11]; p.w_ukv = in[12];
  p.diff_lambda = in[13]; p.g_diff_norm = in[14]; p.hgrn_lb = in[15]; p.g_hgrn_norm = in[16]; p.w_out = in[17];
  p.w_gate = in[18]; p.w_up = in[19]; p.w_down = in[20]; p.g_final = in[21];
  p.out = (float*)d_out;
  p.ws = (char*)d_ws;
  if (WS_TOTAL > ws_size) { fprintf(stderr, "workspace too small: need %zu have %zu\n", (size_t)WS_TOTAL, ws_size); return; }
  int ph0 = 0, ph1 = NPHASE;
  void* args[] = {&p, &ph0, &ph1};
  hipError_t e = hipLaunchCooperativeKernel((void*)hybrid_megakernel, dim3(grid_blocks), dim3(256), args, 0, stream);
  if (e != hipSuccess) fprintf(stderr, "cooperative launch failed: %s (grid %d)\n", hipGetErrorString(e), grid_blocks);
}
```

```cpp
#include <hip/hip_runtime.h>
#include <hip/hip_cooperative_groups.h>
#include <cstdio>
namespace cg = cooperative_groups;

typedef __attribute__((ext_vector_type(8))) __bf16 bf8;
typedef __attribute__((ext_vector_type(4))) __bf16 bf4;
typedef __attribute__((ext_vector_type(4))) float f4;

#define XCD_BAR_WORDS_C 3456
#define NB 2
#define SEQ 8192
#define CTXL 256
#define PT 8448
#define NTOK 16896
#define DM 1024
#define INW 3744
#define INWP 3840
#define DFF 2816
#define NCH 132
#define LDH 1088
#define LDF 2880
#define LOG2E 1.4426950408889634f
#define EPSN 1e-6f
#define SMEM_BYTES 66064

constexpr size_t al256(size_t x) { return (x + 255) & ~(size_t)255; }
constexpr size_t OFF_xc = 0;
constexpr size_t OFF_mod = OFF_xc + al256((size_t)NB*CTXL*DM*4);
constexpr size_t OFF_rope = OFF_mod + al256((size_t)4*3*6144*4);
constexpr size_t OFF_llb = OFF_rope + al256(128*8*2*4);
constexpr size_t OFF_l1mlb = OFF_llb + al256(4*1024*4);
constexpr size_t OFF_lam = OFF_l1mlb + al256(4*1024*4);
constexpr size_t OFF_wt_in = OFF_lam + al256(256);
constexpr size_t OFF_wt_uq = OFF_wt_in + al256((size_t)INWP*LDH*2);
constexpr size_t OFF_wt_ukv = OFF_wt_uq + al256((size_t)384*256*2);
constexpr size_t OFF_wt_out = OFF_wt_ukv + al256((size_t)512*128*2);
constexpr size_t OFF_wt_gu = OFF_wt_out + al256((size_t)DM*LDH*2);
constexpr size_t OFF_wt_down = OFF_wt_gu + al256((size_t)2*DFF*LDH*2);
constexpr size_t OFF_hb = OFF_wt_down + al256((size_t)DM*LDF*2);
constexpr size_t OFF_cq = OFF_hb + al256((size_t)NTOK*LDH*2);
constexpr size_t OFF_ckv = OFF_cq + al256((size_t)NTOK*256*2);
constexpr size_t OFF_qm = OFF_ckv + al256((size_t)NTOK*128*2);
constexpr size_t OFF_km = OFF_qm + al256((size_t)NB*4*PT*96*2);
constexpr size_t OFF_vmt = OFF_km + al256((size_t)NB*4*PT*96*2);
constexpr size_t OFF_qd = OFF_vmt + al256((size_t)NB*4*64*PT*2);
constexpr size_t OFF_kd = OFF_qd + al256((size_t)NB*4*2*PT*32*2);
constexpr size_t OFF_vdt = OFF_kd + al256((size_t)NB*4*2*PT*32*2);
constexpr size_t OFF_hq = OFF_vdt + al256((size_t)NB*4*64*PT*2);
constexpr size_t OFF_hvt = OFF_hq + al256((size_t)NTOK*512*2);
constexpr size_t OFF_hg = OFF_hvt + al256((size_t)NB*8*64*PT*2);
constexpr size_t OFF_dk = OFF_hg + al256((size_t)NTOK*512*2);
constexpr size_t OFF_st = OFF_dk + al256((size_t)NB*8*2*NCH*64*4);
constexpr size_t OFF_lf = OFF_st + al256((size_t)NB*8*2*NCH*4096*2);
constexpr size_t OFF_ut = OFF_lf + al256((size_t)2*NTOK*512*4);
constexpr size_t OFF_xbar = OFF_ut + al256((size_t)NB*8*2*NCH*4096*4);
constexpr size_t WS_TOTAL_OLD = OFF_ut + al256((size_t)NB*8*2*NCH*4096*4);
constexpr size_t WS_TOTAL = OFF_xbar + al256((size_t)XCD_BAR_WORDS_C*4);
struct Params {
  const float *x, *c, *ctx, *c_ctx, *w_ada, *b_ada, *g_norm1, *g_norm2, *w_in, *g_q_norm, *w_uq, *g_kv_norm, *w_ukv,
      *diff_lambda, *g_diff_norm, *hgrn_lb, *g_hgrn_norm, *w_out, *w_gate, *w_up, *w_down, *g_final;
  float* out;
  char* ws;
  __device__ __forceinline__ float* xc() const { return (float*)(ws + OFF_xc); }
  __device__ __forceinline__ float* mod() const { return (float*)(ws + OFF_mod); }
  __device__ __forceinline__ float* rope() const { return (float*)(ws + OFF_rope); }
  __device__ __forceinline__ float* llb() const { return (float*)(ws + OFF_llb); }
  __device__ __forceinline__ float* l1mlb() const { return (float*)(ws + OFF_l1mlb); }
  __device__ __forceinline__ float* lam() const { return (float*)(ws + OFF_lam); }
  __device__ __forceinline__ __bf16* wt_in() const { return (__bf16*)(ws + OFF_wt_in); }
  __device__ __forceinline__ __bf16* wt_uq() const { return (__bf16*)(ws + OFF_wt_uq); }
  __device__ __forceinline__ __bf16* wt_ukv() const { return (__bf16*)(ws + OFF_wt_ukv); }
  __device__ __forceinline__ __bf16* wt_out() const { return (__bf16*)(ws + OFF_wt_out); }
  __device__ __forceinline__ __bf16* wt_gu() const { return (__bf16*)(ws + OFF_wt_gu); }
  __device__ __forceinline__ __bf16* wt_down() const { return (__bf16*)(ws + OFF_wt_down); }
  __device__ __forceinline__ __bf16* hb() const { return (__bf16*)(ws + OFF_hb); }
  __device__ __forceinline__ __bf16* cq() const { return (__bf16*)(ws + OFF_cq); }
  __device__ __forceinline__ __bf16* ckv() const { return (__bf16*)(ws + OFF_ckv); }
  __device__ __forceinline__ __bf16* qm() const { return (__bf16*)(ws + OFF_qm); }
  __device__ __forceinline__ __bf16* km() const { return (__bf16*)(ws + OFF_km); }
  __device__ __forceinline__ __bf16* vmt() const { return (__bf16*)(ws + OFF_vmt); }
  __device__ __forceinline__ __bf16* qd() const { return (__bf16*)(ws + OFF_qd); }
  __device__ __forceinline__ __bf16* kd() const { return (__bf16*)(ws + OFF_kd); }
  __device__ __forceinline__ __bf16* vdt() const { return (__bf16*)(ws + OFF_vdt); }
  __device__ __forceinline__ __bf16* hq() const { return (__bf16*)(ws + OFF_hq); }
  __device__ __forceinline__ __bf16* hvt() const { return (__bf16*)(ws + OFF_hvt); }
  __device__ __forceinline__ __bf16* hg() const { return (__bf16*)(ws + OFF_hg); }
  __device__ __forceinline__ float* dk() const { return (float*)(ws + OFF_dk); }
  __device__ __forceinline__ __bf16* st() const { return (__bf16*)(ws + OFF_st); }
  __device__ __forceinline__ float* lf() const { return (float*)(ws + OFF_lf); }
  __device__ __forceinline__ float* ut() const { return (float*)(ws + OFF_ut); }
  __device__ __forceinline__ __bf16* mix() const { return hb(); }
  __device__ __forceinline__ __bf16* act() const { return (__bf16*)lf(); }
};

__device__ __forceinline__ int tid_() { int t = __builtin_amdgcn_workitem_id_x(); asm volatile("" : "+v"(t)); return t; }
__device__ __forceinline__ int bid_() { int t = __builtin_amdgcn_workgroup_id_x(); asm volatile("" : "+s"(t)); return t; }
__device__ __forceinline__ float silu_f(float x) { return x * __builtin_amdgcn_rcpf(1.f + __expf(-x)); }
__device__ __forceinline__ float wave_sum(float v) {
  v += __uint_as_float(__builtin_amdgcn_update_dpp(0u, __float_as_uint(v), 0x128, 0xf, 0xf, false));
  v += __uint_as_float(__builtin_amdgcn_update_dpp(0u, __float_as_uint(v), 0x124, 0xf, 0xf, false));
  v += __uint_as_float(__builtin_amdgcn_update_dpp(0u, __float_as_uint(v), 0x122, 0xf, 0xf, false));
  v += __uint_as_float(__builtin_amdgcn_update_dpp(0u, __float_as_uint(v), 0x121, 0xf, 0xf, false));
  unsigned u = __float_as_uint(v);
  auto a = __builtin_amdgcn_permlane16_swap(u, u, false, false);
  float m = __uint_as_float(a[0]) + __uint_as_float(a[1]);
  unsigned w = __float_as_uint(m);
  auto b = __builtin_amdgcn_permlane32_swap(w, w, false, false);
  return __uint_as_float(b[0]) + __uint_as_float(b[1]);
}
__device__ __forceinline__ float* xrow(const Params& p, int tok) {
  int b = tok / PT, pp = tok - b * PT;
  return pp < CTXL ? p.xc() + (size_t)(b * CTXL + pp) * DM : p.out + (size_t)(b * SEQ + pp - CTXL) * DM;
}
__device__ __forceinline__ float log_forget(float z, float lb, float oml) {
  const float sg = __builtin_amdgcn_rcpf(1.f + __expf(-fmaxf(z, -80.f)));
  return __logf(lb + oml * sg);
}
__device__ __forceinline__ float rows_max(float x) {
  unsigned u = __float_as_uint(x);
  auto a = __builtin_amdgcn_permlane16_swap(u, u, false, false);
  float m = fmaxf(__uint_as_float(a[0]), __uint_as_float(a[1]));
  unsigned v = __float_as_uint(m);
  auto b = __builtin_amdgcn_permlane32_swap(v, v, false, false);
  return fmaxf(__uint_as_float(b[0]), __uint_as_float(b[1]));
}
__device__ __forceinline__ float rows_sum(float x) {
  unsigned u = __float_as_uint(x);
  auto a = __builtin_amdgcn_permlane16_swap(u, u, false, false);
  float m = __uint_as_float(a[0]) + __uint_as_float(a[1]);
  unsigned v = __float_as_uint(m);
  auto b = __builtin_amdgcn_permlane32_swap(v, v, false, false);
  return __uint_as_float(b[0]) + __uint_as_float(b[1]);
}
__device__ __forceinline__ f4 mfma16(bf8 a, bf8 b, f4 c) { return __builtin_amdgcn_mfma_f32_16x16x32_bf16(a, b, c, 0, 0, 0); }

__device__ __forceinline__ void phase0(const Params& p, char* smem) {
  const int tid = tid_();
  const int gsz = gridDim.x * 256, gtid = bid_() * 256 + tid;
  {
    const float4* xs = (const float4*)p.x; float4* xo = (float4*)p.out;
    for (int i = gtid; i < NB * SEQ * DM / 4; i += gsz) xo[i] = xs[i];
    const float4* cs = (const float4*)p.ctx; float4* co = (float4*)p.xc();
    for (int i = gtid; i < NB * CTXL * DM / 4; i += gsz) co[i] = cs[i];
  }
  if (gtid < 1024) {
    int pos = gtid >> 3, f = gtid & 7;
    float freq = powf(10000.f, -(float)f / 8.f);
    float ang = (float)pos * freq, s, c;
    sincosf(ang, &s, &c);
    p.rope()[gtid * 2] = c; p.rope()[gtid * 2 + 1] = s;
  } else if (gtid < 2048) {
    int n = gtid - 1024;
    float r0 = p.hgrn_lb[n], r1 = p.hgrn_lb[1024 + n], r2 = p.hgrn_lb[2048 + n], r3 = p.hgrn_lb[3072 + n];
    float m = fmaxf(fmaxf(r0, r1), fmaxf(r2, r3));
    float e0 = expf(r0 - m), e1 = expf(r1 - m), e2 = expf(r2 - m), e3 = expf(r3 - m);
    float s = e0 + e1 + e2 + e3;
    float p0 = e0 / s, p1 = e1 / s, p2 = e2 / s, p3 = e3 / s;
    float c0 = p0, c1 = c0 + p1, c2 = c1 + p2, c3 = c2 + p3;
    p.llb()[n] = 0.f; p.l1mlb()[n] = 1.f;
    p.llb()[1024 + n] = c1 - c0; p.l1mlb()[1024 + n] = 1.f - (c1 - c0);
    p.llb()[2048 + n] = c2 - c0; p.l1mlb()[2048 + n] = 1.f - (c2 - c0);
    p.llb()[3072 + n] = c3 - c0; p.l1mlb()[3072 + n] = 1.f - (c3 - c0);
  } else if (gtid >= 4096 && gtid < 4096 + XCD_BAR_WORDS_C) {
    ((unsigned*)(p.ws + OFF_xbar))[gtid - 4096] = 0u;
  } else if (gtid == 2052) {
    *(unsigned*)(p.ws + OFF_lam + 128) = 0u;
  } else if (gtid < 2052) {
    int l = gtid - 2048;
    const float* d = p.diff_lambda + l * 128;
    float s1 = 0.f, s2 = 0.f;
    for (int i = 0; i < 32; ++i) { s1 += d[i] * d[32 + i]; s2 += d[64 + i] * d[96 + i]; }
    float li = 0.8f - 0.6f * expf(-0.3f * (float)l);
    p.lam()[l] = expf(s1) - expf(s2) + li;
  }
  float* sl = (float*)smem;
  float* red = sl + 3072;
  bool have = false;
  for (int item = bid_(); item < 768; item += gridDim.x) {
    if (!have) {
      for (int i = tid; i < 1024; i += 256) {
        sl[i] = silu_f(p.c[i]); sl[1024 + i] = silu_f(p.c[1024 + i]); sl[2048 + i] = silu_f(p.c_ctx[i]);
      }
      have = true;
      __syncthreads();
    }
    int l = item / 192, n0 = (item % 192) * 32;
    int col = tid & 31, kg = tid >> 5;
    const float* W = p.w_ada + (size_t)l * DM * 6144 + n0 + col;
    float a0 = 0.f, a1 = 0.f, a2 = 0.f;
#pragma unroll 8
    for (int k = kg * 128; k < kg * 128 + 128; ++k) {
      float w = W[(size_t)k * 6144];
      a0 += sl[k] * w; a1 += sl[1024 + k] * w; a2 += sl[2048 + k] * w;
    }
    red[(kg * 3 + 0) * 32 + col] = a0; red[(kg * 3 + 1) * 32 + col] = a1; red[(kg * 3 + 2) * 32 + col] = a2;
    __syncthreads();
    if (tid < 96) {
      int v = tid >> 5, cc = tid & 31;
      float s = p.b_ada[l * 6144 + n0 + cc];
#pragma unroll
      for (int q = 0; q < 8; ++q) s += red[(q * 3 + v) * 32 + cc];
      p.mod()[(size_t)(l * 3 + v) * 6144 + n0 + cc] = s;
    }
    __syncthreads();
  }
}

struct ConvD { const float* srcp; size_t sstride; __bf16* dstp; const float* ksp; };

__device__ __forceinline__ ConvD conv_decode(const Params& p, int l, int it, int tid) {
  const float* src; int N, ntn, mode = 0, dld; __bf16* dst; const float* ks = nullptr;
  if (it < 1872) { src = p.w_in + (size_t)l * DM * INW; N = INW; ntn = 117; dst = p.wt_in(); dld = LDH; }
  else if (it < 1920) { it -= 1872; src = p.w_uq + (size_t)l * 256 * 384; N = 384; ntn = 12; dst = p.wt_uq(); dld = 256; ks = p.g_q_norm + l * 256; }
  else if (it < 1952) { it -= 1920; src = p.w_ukv + (size_t)l * 128 * 512; N = 512; ntn = 16; dst = p.wt_ukv(); dld = 128; ks = p.g_kv_norm + l * 128; }
  else if (it < 2464) { it -= 1952; src = p.w_out + (size_t)l * DM * DM; N = DM; ntn = 32; dst = p.wt_out(); dld = LDH; }
  else if (it < 3872) { it -= 2464; src = p.w_gate + (size_t)l * DM * DFF; N = DFF; ntn = 88; dst = p.wt_gu(); mode = 1; dld = LDH; }
  else if (it < 5280) { it -= 3872; src = p.w_up + (size_t)l * DM * DFF; N = DFF; ntn = 88; dst = p.wt_gu(); mode = 2; dld = LDH; }
  else { it -= 5280; src = p.w_down + (size_t)l * DFF * DM; N = DM; ntn = 32; dst = p.wt_down(); dld = LDF; }
  const int kt = it / ntn, nt = it - kt * ntn;
  ConvD d;
  d.srcp = src + (size_t)(kt * 64 + (tid >> 3)) * N + nt * 32 + (tid & 7) * 4;
  d.sstride = (size_t)32 * N;
  const int n = nt * 32 + (tid >> 3);
  int row = n;
  if (mode == 1) row = (n >> 4) * 32 + (n & 15);
  else if (mode == 2) row = (n >> 4) * 32 + 16 + (n & 15);
  d.dstp = dst + (size_t)row * dld + kt * 64 + (tid & 7) * 8;
  d.ksp = ks ? ks + kt * 64 + (tid & 7) * 8 : nullptr;
  return d;
}

__device__ __forceinline__ void conv_items(const Params& p, int l, int first, int step, char* smem) {
  float* tile = (float*)smem;
  const int tid = tid_();
  if (first >= 6688) return;
  ConvD cur = conv_decode(p, l, first, tid);
  float4 v0 = *(const float4*)(cur.srcp), v1 = *(const float4*)(cur.srcp + cur.sstride);
  for (int it = first; it < 6688; it += step) {
    const int itn = it + step < 6688 ? it + step : it;
    const ConvD nxt = conv_decode(p, l, itn, tid);
    const float4 n0 = *(const float4*)(nxt.srcp), n1 = *(const float4*)(nxt.srcp + nxt.sstride);
    __syncthreads();
    {
      const int r = tid >> 3, c4 = tid & 7;
      float* t = tile + r * 33 + c4 * 4;
      t[0] = v0.x; t[1] = v0.y; t[2] = v0.z; t[3] = v0.w;
      t += 32 * 33;
      t[0] = v1.x; t[1] = v1.y; t[2] = v1.z; t[3] = v1.w;
    }
    __syncthreads();
    {
      const int nr = tid >> 3, kc = tid & 7;
      bf8 o;
#pragma unroll
      for (int j = 0; j < 8; ++j) {
        float v = tile[(kc * 8 + j) * 33 + nr];
        if (cur.ksp) v *= cur.ksp[j];
        o[j] = (__bf16)v;
      }
      *(bf8*)cur.dstp = o;
    }
    cur = nxt; v0 = n0; v1 = n1;
  }
}

__device__ __forceinline__ void norm_item(const Params& p, int l, int which, int item) {
  const int lane = tid_() & 63, wave = tid_() >> 6;
  const int tok0 = item * 16 + wave * 4;
  const int b = tok0 / PT, pp = tok0 - b * PT;
  const int v = pp < CTXL ? 2 : b;
  const float* g = (which ? p.g_norm2 : p.g_norm1) + l * DM;
  const float* md = p.mod() + (size_t)(l * 3 + v) * 6144 + (which ? 3072 : 0);
  f4 a[4], sh[4];
#pragma unroll
  for (int i = 0; i < 4; ++i) {
    int k = i * 256 + lane * 4;
    f4 gg = *(const f4*)(g + k), sc = *(const f4*)(md + 1024 + k);
    sh[i] = *(const f4*)(md + k);
    a[i] = gg * (1.f + sc);
  }
  f4 xv[4][4];
#pragma unroll
  for (int r = 0; r < 4; ++r) {
    const float* xr = xrow(p, tok0 + r);
#pragma unroll
    for (int i = 0; i < 4; ++i) xv[r][i] = *(const f4*)(xr + i * 256 + lane * 4);
  }
#pragma unroll
  for (int r = 0; r < 4; ++r) {
    float ss = 0.f;
#pragma unroll
    for (int i = 0; i < 4; ++i)
      ss += xv[r][i][0] * xv[r][i][0] + xv[r][i][1] * xv[r][i][1] + xv[r][i][2] * xv[r][i][2] + xv[r][i][3] * xv[r][i][3];
    ss = wave_sum(ss);
    float rstd = rsqrtf(ss * (1.f / DM) + EPSN);
#pragma unroll
    for (int i = 0; i < 4; ++i) {
      f4 h = xv[r][i] * rstd * a[i] + sh[i];
      bf4 o; o[0] = (__bf16)h[0]; o[1] = (__bf16)h[1]; o[2] = (__bf16)h[2]; o[3] = (__bf16)h[3];
      *(bf4*)(p.hb() + (size_t)(tok0 + r) * LDH + i * 256 + lane * 4) = o;
    }
  }
}

__device__ __forceinline__ void final_norm_item(const Params& p, int item) {
  const int lane = tid_() & 63, wave = tid_() >> 6;
  const int row0 = item * 16 + wave * 4;
  f4 g[4];
#pragma unroll
  for (int i = 0; i < 4; ++i) g[i] = *(const f4*)(p.g_final + i * 256 + lane * 4);
  f4 xv[4][4];
#pragma unroll
  for (int r = 0; r < 4; ++r)
#pragma unroll
    for (int i = 0; i < 4; ++i) xv[r][i] = *(const f4*)(p.out + (size_t)(row0 + r) * DM + i * 256 + lane * 4);
#pragma unroll
  for (int r = 0; r < 4; ++r) {
    float ss = 0.f;
#pragma unroll
    for (int i = 0; i < 4; ++i)
      ss += xv[r][i][0] * xv[r][i][0] + xv[r][i][1] * xv[r][i][1] + xv[r][i][2] * xv[r][i][2] + xv[r][i][3] * xv[r][i][3];
    ss = wave_sum(ss);
    float rstd = rsqrtf(ss * (1.f / DM) + EPSN);
#pragma unroll
    for (int i = 0; i < 4; ++i) *(f4*)(p.out + (size_t)(row0 + r) * DM + i * 256 + lane * 4) = xv[r][i] * rstd * g[i];
  }
}

#define GLD 72
enum { EPI_IN = 0, EPI_UQ, EPI_UKV, EPI_OUT, EPI_UP, EPI_DOWN, EPI_OUT_AT, EPI_DOWN_AT };

__device__ __forceinline__ f4 rope4(const Params& p, f4 a, int prow, int axis, int r) {
  f4 o;
#pragma unroll
  for (int reg = 0; reg < 4; ++reg) {
    float pv = __uint_as_float(__builtin_amdgcn_update_dpp(0u, __float_as_uint(a[reg]), 0x128, 0xf, 0xf, false));
    int t = prow + reg - CTXL;
    int pos = axis ? (t & 63) : (t >> 6);
    float2 cs = ((const float2*)p.rope())[pos * 8 + (r & 7)];
    o[reg] = (r & 8) ? a[reg] * cs.x + pv * cs.y : a[reg] * cs.x - pv * cs.y;
  }
  return o;
}
__device__ __forceinline__ bf4 pack4(f4 a) {
  bf4 o; o[0] = (__bf16)a[0]; o[1] = (__bf16)a[1]; o[2] = (__bf16)a[2]; o[3] = (__bf16)a[3];
  return o;
}

template <int EPI>
__device__ __forceinline__ void gemm_epilogue(const Params& p, int l, f4 (&acc)[4][4], int m0, int n0, int wm, int wn, int lane,
                                              const float* rowss) {
  const int r = lane & 15, g = lane >> 4;
  const int b = m0 / PT;
  const int pp0 = m0 - b * PT;
  const bool lat = pp0 >= CTXL;
  const int v = lat ? b : 2;
  const float* md = p.mod() + (size_t)(l * 3 + v) * 6144;
  const int prow0 = pp0 + wm * 64 + 4 * g;
  const int tok0 = b * PT + prow0;
  constexpr int STEP = (EPI == EPI_UP) ? 2 : 1;
  if constexpr (EPI == EPI_OUT || EPI == EPI_DOWN) {
    float* xb = (lat ? p.out + (size_t)(b * SEQ + prow0 - CTXL) * DM : p.xc() + (size_t)(b * CTXL + prow0) * DM) + n0 + wn * 64 + r;
    float gt[4];
    f4 xin[4][4];
#pragma unroll
    for (int ni = 0; ni < 4; ++ni) gt[ni] = md[(EPI == EPI_OUT ? 2048 : 5120) + n0 + wn * 64 + ni * 16 + r];
#pragma unroll
    for (int mi = 0; mi < 4; ++mi)
#pragma unroll
      for (int ni = 0; ni < 4; ++ni)
#pragma unroll
        for (int q = 0; q < 4; ++q) xin[mi][ni][q] = xb[(size_t)(mi * 16 + q) * DM + ni * 16];
#pragma unroll
    for (int mi = 0; mi < 4; ++mi)
#pragma unroll
      for (int ni = 0; ni < 4; ++ni)
#pragma unroll
        for (int q = 0; q < 4; ++q) xb[(size_t)(mi * 16 + q) * DM + ni * 16] = xin[mi][ni][q] + gt[ni] * acc[mi][ni][q];
    return;
  }
  float tla[4] = {0.f, 0.f, 0.f, 0.f}, tl1[4] = {0.f, 0.f, 0.f, 0.f};
  if constexpr (EPI == EPI_IN) {
#pragma unroll
    for (int ni = 0; ni < 4; ++ni) {
      const int c0 = n0 + wn * 64 + ni * 16;
      if (c0 >= 1696 && c0 < 2720) {
        const int dir = c0 >= 2208;
        const int n1 = c0 + r - (dir ? 2208 : 1696);
        tla[ni] = p.llb()[(l * 2 + dir) * 512 + n1];
        tl1[ni] = p.l1mlb()[(l * 2 + dir) * 512 + n1];
      }
    }
  }
#pragma unroll 1
  for (int ni = 0; ni < 4; ni += STEP) {
    const int col0 = n0 + wn * 64 + ni * 16;
    const int col = col0 + r;
    if constexpr (EPI == EPI_IN) {
      if (col0 < 384) {
        __bf16* dst = col0 < 256 ? p.cq() + col : p.ckv() + (col - 256);
        const int ld = col0 < 256 ? 256 : 128;
#pragma unroll
        for (int mi = 0; mi < 4; ++mi)
#pragma unroll
          for (int q = 0; q < 4; ++q) dst[(size_t)(tok0 + mi * 16 + q) * ld] = (__bf16)acc[mi][0][q];
      } else if (col0 < 416) {
        f4 v[4];
#pragma unroll
        for (int mi = 0; mi < 4; ++mi) {
          v[mi] = acc[mi][0];
          if (lat) v[mi] = rope4(p, v[mi], prow0 + mi * 16, (col0 - 384) >> 4, r);
        }
#pragma unroll
        for (int mi = 0; mi < 4; ++mi)
#pragma unroll
          for (int h = 0; h < 4; ++h)
#pragma unroll
            for (int q = 0; q < 4; ++q) p.km()[((size_t)(b * 4 + h) * PT + prow0 + mi * 16 + q) * 96 + 64 + col - 384] = (__bf16)v[mi][q];
      } else if (col0 < 928) {
        const bool isq = col0 < 672;
        const int n1 = col - (isq ? 416 : 672);
        const int head = n1 >> 6, map = (n1 >> 5) & 1, d = n1 & 31;
        __bf16* dst = (isq ? p.qd() : p.kd()) + ((size_t)((b * 4 + head) * 2 + map) * PT) * 32 + d;
        const float sc = isq ? 0.17677669529663687f * LOG2E : 1.f;
        f4 v[4];
#pragma unroll
        for (int mi = 0; mi < 4; ++mi) {
          v[mi] = acc[mi][0];
          if (lat) v[mi] = rope4(p, v[mi], prow0 + mi * 16, (n1 >> 4) & 1, r);
        }
#pragma unroll
        for (int mi = 0; mi < 4; ++mi)
#pragma unroll
          for (int q = 0; q < 4; ++q) dst[(size_t)(prow0 + mi * 16 + q) * 32] = (__bf16)(v[mi][q] * sc);
      } else if (col0 < 1184 || (col0 >= 2720 && col0 < 3232)) {
        const bool isd = col0 < 1184;
        const int n1 = col - (isd ? 928 : 2720);
        __bf16* dst = isd ? p.vdt() + ((size_t)(b * 4 + (n1 >> 6)) * 64 + (n1 & 63)) * PT
                          : p.hvt() + ((size_t)(b * 8 + (n1 >> 6)) * 64 + (n1 & 63)) * PT;
#pragma unroll
        for (int mi = 0; mi < 4; ++mi) *(bf4*)(dst + prow0 + mi * 16) = pack4(acc[mi][0]);
      } else if (col0 < 1696 || (col0 >= 3232 && col0 < INW)) {
        const bool ish = col0 < 1696;
        __bf16* dst = ish ? p.hq() + (col - 1184) : p.hg() + (col - 3232);
#pragma unroll
        for (int mi = 0; mi < 4; ++mi)
#pragma unroll
          for (int q = 0; q < 4; ++q) dst[(size_t)(tok0 + mi * 16 + q) * 512] = (__bf16)silu_f(acc[mi][0][q]);
      } else if (col0 < 2720) {
        const int dir = col0 >= 2208;
        const int n1 = col - (dir ? 2208 : 1696);
        const float la = tla[0], l1m = tl1[0];
        float* dst = p.lf() + (size_t)dir * NTOK * 512 + n1;
#pragma unroll
        for (int mi = 0; mi < 4; ++mi)
#pragma unroll
          for (int q = 0; q < 4; ++q) dst[(size_t)(tok0 + mi * 16 + q) * 512] = log_forget(acc[mi][0][q], la, l1m);
      }
    } else if constexpr (EPI == EPI_UQ) {
      const int head = col0 / 96, d0 = col0 - head * 96;
      const float sc = 0.10206207261596577f * LOG2E;
      __bf16* dst = p.qm() + ((size_t)(b * 4 + head) * PT) * 96 + d0 + r;
      f4 v[4];
#pragma unroll
      for (int mi = 0; mi < 4; ++mi) {
        f4 a = acc[mi][0];
#pragma unroll
        for (int q = 0; q < 4; ++q) a[q] *= rsqrtf(rowss[wm * 64 + mi * 16 + 4 * g + q] * (1.f / 256.f) + EPSN);
        if (d0 >= 64 && lat) a = rope4(p, a, prow0 + mi * 16, (d0 - 64) >> 4, r);
        v[mi] = a;
      }
#pragma unroll
      for (int mi = 0; mi < 4; ++mi)
#pragma unroll
        for (int q = 0; q < 4; ++q) dst[(size_t)(prow0 + mi * 16 + q) * 96] = (__bf16)(v[mi][q] * sc);
    } else if constexpr (EPI == EPI_UKV) {
      const int head = col >> 7, d = col & 127;
#pragma unroll
      for (int mi = 0; mi < 4; ++mi) {
        f4 a = acc[mi][0];
        const int prow = prow0 + mi * 16;
#pragma unroll
        for (int q = 0; q < 4; ++q) a[q] *= rsqrtf(rowss[wm * 64 + mi * 16 + 4 * g + q] * (1.f / 128.f) + EPSN);
        if ((col0 & 127) < 64) {
#pragma unroll
          for (int q = 0; q < 4; ++q) p.km()[((size_t)(b * 4 + head) * PT + prow + q) * 96 + d] = (__bf16)a[q];
        } else {
          *(bf4*)(p.vmt() + ((size_t)(b * 4 + head) * 64 + d - 64) * PT + prow) = pack4(a);
        }
      }
    } else if constexpr (EPI == EPI_OUT || EPI == EPI_DOWN) {
    } else if constexpr (EPI == EPI_OUT_AT || EPI == EPI_DOWN_AT) {
      const float gt = md[(EPI == EPI_OUT_AT ? 2048 : 5120) + col];
      float* xb = (lat ? p.out + (size_t)(b * SEQ + prow0 - CTXL) * DM : p.xc() + (size_t)(b * CTXL + prow0) * DM) + col;
#pragma unroll
      for (int mi = 0; mi < 4; ++mi)
#pragma unroll
        for (int q = 0; q < 4; ++q) atomicAdd(xb + (size_t)(mi * 16 + q) * DM, gt * acc[mi][0][q]);
    } else if constexpr (EPI == EPI_UP) {
      const int n = (col0 >> 5) * 16 + r;
#pragma unroll
      for (int mi = 0; mi < 4; ++mi)
#pragma unroll
        for (int q = 0; q < 4; ++q)
          p.act()[(size_t)(tok0 + mi * 16 + q) * LDF + n] = (__bf16)(silu_f(acc[mi][0][q]) * acc[mi][1][q]);
    }
#pragma unroll
    for (int mi = 0; mi < 4; ++mi) {
      if constexpr (STEP == 1) { acc[mi][0] = acc[mi][1]; acc[mi][1] = acc[mi][2]; acc[mi][2] = acc[mi][3]; }
      else { acc[mi][0] = acc[mi][2]; acc[mi][1] = acc[mi][3]; }
    }
    tla[0] = tla[1]; tla[1] = tla[2]; tla[2] = tla[3]; tl1[0] = tl1[1]; tl1[1] = tl1[2]; tl1[2] = tl1[3];
  }
}

#define RAW_BARRIER() do { asm volatile("s_waitcnt lgkmcnt(0)" ::: "memory"); __builtin_amdgcn_s_barrier(); } while (0)

template <int EPI, bool ROWSS>
__device__ __forceinline__ void gemm_tile(const Params& p, int l, const __bf16* __restrict__ A, int lda, const __bf16* __restrict__ Bt, int ldb, int K,
                          int m0, int n0, char* smem, bool pre = false, bool has_next = false, int m0n = 0, int n0n = 0) {
  __bf16* S0 = (__bf16*)smem;
  float* rowss = (float*)(smem + 65536);
  const int tid = tid_(), lane = tid & 63, wave = tid >> 6;
  const int wm = wave >> 1, wn = wave & 1, r = lane & 15, g = lane >> 4;
  f4 acc[4][4];
#pragma unroll
  for (int i = 0; i < 4; ++i)
#pragma unroll
    for (int j = 0; j < 4; ++j) acc[i][j] = f4{0.f, 0.f, 0.f, 0.f};
  if constexpr (ROWSS) {
    const int row = tid >> 1, half = tid & 1;
    const __bf16* rp = A + (size_t)(m0 + row) * lda + half * (K >> 1);
    float sq = 0.f;
    for (int c = 0; c < (K >> 4); ++c) {
      bf8 v = *(const bf8*)(rp + c * 8);
#pragma unroll
      for (int j = 0; j < 8; ++j) { float f = (float)v[j]; sq += f * f; }
    }
    sq += __shfl_xor(sq, 1);
    __syncthreads();
    if (!half) rowss[row] = sq;
  }
  const int lrow = lane >> 3;
  const int sz = (lane >> 4);
  const __bf16* gaw[4]; const __bf16* gbw[4];
#pragma unroll
  for (int i = 0; i < 4; ++i) {
    const int rg = wave + 4 * i;
    const int row = rg * 8 + lrow;
    const int cl = (lane & 7) ^ (((rg & 1) * 4 + sz) & 7);
    gaw[i] = A + (size_t)(m0 + row) * lda + cl * 8;
    gbw[i] = Bt + (size_t)(n0 + row) * ldb + cl * 8;
  }
  const int aoff = (wm * 64 + r) * 64, boff = 8192 + (wn * 64 + r) * 64;
  const int sw = r >> 1;
  const int KT = K / 64;
  if (!pre) {
    __syncthreads();
#pragma unroll
    for (int i = 0; i < 4; ++i) {
      __builtin_amdgcn_global_load_lds((const unsigned*)(gaw[i]), (unsigned*)(S0 + (wave + 4 * i) * 512), 16, 0, 0);
      __builtin_amdgcn_global_load_lds((const unsigned*)(gbw[i]), (unsigned*)(S0 + 8192 + (wave + 4 * i) * 512), 16, 0, 0);
    }
  }
  asm volatile("s_waitcnt vmcnt(0)" ::: "memory");
  RAW_BARRIER();
  for (int kt = 0; kt < KT; ++kt) {
    const __bf16* Sc = S0 + (kt & 1) * 16384;
    __bf16* Sn = S0 + ((kt + 1) & 1) * 16384;
    __builtin_amdgcn_s_setprio(2);
    if (kt + 1 < KT) {
#pragma unroll
      for (int i = 0; i < 4; ++i) {
        __builtin_amdgcn_global_load_lds((const unsigned*)(gaw[i] + (kt + 1) * 64), (unsigned*)(Sn + (wave + 4 * i) * 512), 16, 0, 0);
        __builtin_amdgcn_global_load_lds((const unsigned*)(gbw[i] + (kt + 1) * 64), (unsigned*)(Sn + 8192 + (wave + 4 * i) * 512), 16, 0, 0);
      }
    }
    {
      bf8 af0[4], bf0[4], af1[4], bf1[4];
      const int ch0 = ((0 * 4 + g) ^ sw) * 8, ch1 = ((1 * 4 + g) ^ sw) * 8;
#pragma unroll
      for (int i = 0; i < 4; ++i) {
        af0[i] = *(const bf8*)(Sc + aoff + i * 1024 + ch0);
        bf0[i] = *(const bf8*)(Sc + boff + i * 1024 + ch0);
      }
#pragma unroll
      for (int i = 0; i < 4; ++i) {
        af1[i] = *(const bf8*)(Sc + aoff + i * 1024 + ch1);
        bf1[i] = *(const bf8*)(Sc + boff + i * 1024 + ch1);
      }
      __builtin_amdgcn_s_setprio(1);
#pragma unroll
      for (int i = 0; i < 4; ++i)
#pragma unroll
        for (int j = 0; j < 4; ++j) acc[i][j] = mfma16(af0[i], bf0[j], acc[i][j]);
#pragma unroll
      for (int i = 0; i < 4; ++i)
#pragma unroll
        for (int j = 0; j < 4; ++j) acc[i][j] = mfma16(af1[i], bf1[j], acc[i][j]);
      __builtin_amdgcn_s_setprio(0);
      __builtin_amdgcn_sched_group_barrier(0x100, 8, 0);
#pragma unroll
      for (int i = 0; i < 8; ++i) {
        __builtin_amdgcn_sched_group_barrier(0x008, 1, 0);
        __builtin_amdgcn_sched_group_barrier(0x100, 1, 0);
      }
      __builtin_amdgcn_sched_group_barrier(0x008, 24, 0);
    }
    asm volatile("s_waitcnt vmcnt(0)" ::: "memory");
    RAW_BARRIER();
  }
  if (has_next) {
#pragma unroll
    for (int i = 0; i < 4; ++i) {
      const int rg = wave + 4 * i;
      const int row = rg * 8 + lrow;
      const int cl = (lane & 7) ^ (((rg & 1) * 4 + sz) & 7);
      __builtin_amdgcn_global_load_lds((const unsigned*)(A + (size_t)(m0n + row) * lda + cl * 8), (unsigned*)(S0 + rg * 512), 16, 0, 0);
      __builtin_amdgcn_global_load_lds((const unsigned*)(Bt + (size_t)(n0n + row) * ldb + cl * 8), (unsigned*)(S0 + 8192 + rg * 512), 16, 0, 0);
    }
  }
  gemm_epilogue<EPI>(p, l, acc, m0, n0, wm, wn, lane, rowss);
}

__device__ __forceinline__ int mtile_count(int l) { return l < 3 ? 132 : 128; }
__device__ __forceinline__ int mtile_index(int l, int i) { return l < 3 ? i : (i >> 6) * 66 + 2 + (i & 63); }

__device__ __forceinline__ bool gemm_pick(int step, int bid, int G, int MT, int NT, int W, int& mt, int& nt) {
  const int C = G >> 3;
  const int L = (step * 8 + (bid & 7)) * C + (bid >> 3);
  if (L >= MT * NT) return false;
  const int s = L / (W * MT), rem = L - s * W * MT;
  mt = rem / W; nt = s * W + (rem - mt * W);
  return true;
}

template <int DQK, int NMAP>
__device__ __forceinline__ void attn_item(const Params& p, int l, const __bf16* __restrict__ Q, const __bf16* __restrict__ Kp,
                          const __bf16* __restrict__ Vt, int b, int h, int q0, int nkeys, char* smem) {
  constexpr int KLD = DQK;
  constexpr int KCH = DQK / 8;
  constexpr int NKC = NMAP * 64 * KCH / 256;
  constexpr int NKS = DQK / 32;
  __bf16* Ks = (__bf16*)smem;
  __bf16* Vs = Ks + NMAP * 64 * KLD;
  const int tid = tid_(), lane = tid & 63, wave = tid >> 6, r = lane & 15, g = lane >> 4;
  const __bf16* Qb = Q + (size_t)((b * 4 + h) * NMAP) * PT * DQK;
  const __bf16* Kb = Kp + (size_t)((b * 4 + h) * NMAP) * PT * DQK;
  const __bf16* Vb = Vt + (size_t)((b * 4 + h) * 64) * PT;

  bf8 qf[NMAP][2][NKS];
#pragma unroll
  for (int mp = 0; mp < NMAP; ++mp)
#pragma unroll
    for (int qt = 0; qt < 2; ++qt)
#pragma unroll
      for (int ks = 0; ks < NKS; ++ks)
        qf[mp][qt][ks] = *(const bf8*)(Qb + ((size_t)mp * PT + q0 + wave * 32 + qt * 16 + r) * DQK + ks * 32 + g * 8);

  f4 o[NMAP][2][4];
  float mrun[NMAP][2], lsum[NMAP][2];
  f4 negm[NMAP][2];
#pragma unroll
  for (int mp = 0; mp < NMAP; ++mp)
#pragma unroll
    for (int qt = 0; qt < 2; ++qt) {
      mrun[mp][qt] = 0.f; lsum[mp][qt] = 0.f; negm[mp][qt] = f4{0.f, 0.f, 0.f, 0.f};
#pragma unroll
      for (int d = 0; d < 4; ++d) o[mp][qt][d] = f4{0.f, 0.f, 0.f, 0.f};
    }

  int koff_g[NKC], koff_s[NKC];
#pragma unroll
  for (int i = 0; i < NKC; ++i) {
    int c = tid + 256 * i;
    int mp = c / (64 * KCH), rem = c - mp * 64 * KCH;
    int row = rem / KCH, kc = rem - row * KCH;
    koff_g[i] = (mp * PT + row) * DQK + kc * 8;
    koff_s[i] = (mp * 64 + row) * KLD + (((kc & ~3) | ((kc & 3) ^ ((-(row >> 3)) & 3))) * 8);
  }
  bf8 rk[NKC], rv[2];
  const int nkb = nkeys / 64;
#pragma unroll
  for (int i = 0; i < NKC; ++i) rk[i] = *(const bf8*)(Kb + koff_g[i]);
#pragma unroll
  for (int i = 0; i < 2; ++i) rv[i] = *(const bf8*)(Vb + (size_t)((tid >> 3) + 32 * i) * PT + (tid & 7) * 8);

  for (int kb = 0; kb < nkb; ++kb) {
    __syncthreads();
    __builtin_amdgcn_s_setprio(2);
#pragma unroll
    for (int i = 0; i < NKC; ++i) *(bf8*)(Ks + koff_s[i]) = rk[i];
#pragma unroll
    for (int i = 0; i < 2; ++i) *(bf8*)(Vs + ((tid >> 3) + 32 * i) * 64 + (((tid & 7) ^ ((tid >> 4) & 7)) * 8)) = rv[i];
    __syncthreads();
    if (kb + 1 < nkb) {
#pragma unroll
      for (int i = 0; i < NKC; ++i) rk[i] = *(const bf8*)(Kb + koff_g[i] + (size_t)(kb + 1) * 64 * DQK);
#pragma unroll
      for (int i = 0; i < 2; ++i) rv[i] = *(const bf8*)(Vb + (size_t)((tid >> 3) + 32 * i) * PT + (kb + 1) * 64 + (tid & 7) * 8);
    }
    __builtin_amdgcn_s_setprio(0);
    f4 s[NMAP][2][2][2];
    {
      bf8 kfr[NMAP][2][2][NKS];
#pragma unroll
      for (int mp = 0; mp < NMAP; ++mp)
#pragma unroll
        for (int m = 0; m < 2; ++m)
#pragma unroll
          for (int tp = 0; tp < 2; ++tp) {
            const int krow = 32 * m + 8 * (r >> 2) + 4 * tp + (r & 3);
#pragma unroll
            for (int ks = 0; ks < NKS; ++ks) kfr[mp][m][tp][ks] = *(const bf8*)(Ks + (mp * 64 + krow) * KLD + ks * 32 + ((g ^ ((-(r >> 2)) & 3)) * 8));
          }
      __builtin_amdgcn_s_setprio(1);
#pragma unroll
      for (int mp = 0; mp < NMAP; ++mp)
#pragma unroll
        for (int m = 0; m < 2; ++m)
#pragma unroll
          for (int tp = 0; tp < 2; ++tp) {
            f4 s0 = negm[mp][0], s1 = negm[mp][1];
#pragma unroll
            for (int ks = 0; ks < NKS; ++ks) {
              s0 = mfma16(kfr[mp][m][tp][ks], qf[mp][0][ks], s0);
              s1 = mfma16(kfr[mp][m][tp][ks], qf[mp][1][ks], s1);
            }
            s[mp][0][m][tp] = s0; s[mp][1][m][tp] = s1;
          }
      __builtin_amdgcn_s_setprio(0);
    }
    bf8 vfr[4][2];
    if constexpr (NMAP == 1) {
#pragma unroll
      for (int d = 0; d < 4; ++d)
#pragma unroll
        for (int m = 0; m < 2; ++m) vfr[d][m] = *(const bf8*)(Vs + (d * 16 + r) * 64 + (((4 * m + g) ^ (r >> 1)) * 8));
    }
    bf8 pf[NMAP][2][2];
#pragma unroll
    for (int mp = 0; mp < NMAP; ++mp)
#pragma unroll
      for (int qt = 0; qt < 2; ++qt) {
        float ps = 0.f;
#pragma unroll
        for (int m = 0; m < 2; ++m) {
          bf8 pk;
#pragma unroll
          for (int tp = 0; tp < 2; ++tp)
#pragma unroll
            for (int q = 0; q < 4; ++q) {
              float e = __builtin_amdgcn_exp2f(s[mp][qt][m][tp][q]);
              ps += e;
              pk[tp * 4 + q] = (__bf16)e;
            }
          pf[mp][qt][m] = pk;
        }
        const bool hi = __builtin_amdgcn_ballot_w64(!(ps < 65536.f)) != 0ull;
        const bool lo = __builtin_amdgcn_ballot_w64(ps > 0.f || lsum[mp][qt] > 0.f) == 0ull;
        if (hi || lo) {
          float bm = -INFINITY;
#pragma unroll
          for (int m = 0; m < 2; ++m)
#pragma unroll
            for (int tp = 0; tp < 2; ++tp)
#pragma unroll
              for (int q = 0; q < 4; ++q) bm = fmaxf(bm, s[mp][qt][m][tp][q]);
          bm = rows_max(bm);
          const float sh = lo ? bm : fmaxf(bm, 0.f);
          const float alpha = lo ? 1.f : __builtin_amdgcn_exp2f(-sh);
          mrun[mp][qt] += sh;
          const float nm = -mrun[mp][qt];
          negm[mp][qt] = f4{nm, nm, nm, nm};
          lsum[mp][qt] *= alpha;
#pragma unroll
          for (int d = 0; d < 4; ++d) o[mp][qt][d] *= alpha;
          ps = 0.f;
#pragma unroll
          for (int m = 0; m < 2; ++m) {
            bf8 pk;
#pragma unroll
            for (int tp = 0; tp < 2; ++tp)
#pragma unroll
              for (int q = 0; q < 4; ++q) {
                float e = __builtin_amdgcn_exp2f(s[mp][qt][m][tp][q] - sh);
                ps += e;
                pk[tp * 4 + q] = (__bf16)e;
              }
            pf[mp][qt][m] = pk;
          }
        }
        lsum[mp][qt] += ps;
      }
    {
      if constexpr (NMAP != 1) {
#pragma unroll
        for (int d = 0; d < 4; ++d)
#pragma unroll
          for (int m = 0; m < 2; ++m) vfr[d][m] = *(const bf8*)(Vs + (d * 16 + r) * 64 + (((4 * m + g) ^ (r >> 1)) * 8));
      }
      __builtin_amdgcn_s_setprio(1);
#pragma unroll
      for (int d = 0; d < 4; ++d)
#pragma unroll
        for (int m = 0; m < 2; ++m)
#pragma unroll
          for (int mp = 0; mp < NMAP; ++mp)
#pragma unroll
            for (int qt = 0; qt < 2; ++qt) o[mp][qt][d] = mfma16(vfr[d][m], pf[mp][qt][m], o[mp][qt][d]);
    }
    __builtin_amdgcn_s_setprio(0);
  }
#pragma unroll
  for (int qt = 0; qt < 2; ++qt) {
    const int tok = b * PT + q0 + wave * 32 + qt * 16 + r;
    float inv[NMAP];
#pragma unroll
    for (int mp = 0; mp < NMAP; ++mp) {
      float ls = lsum[mp][qt];
      ls = rows_sum(ls);
      inv[mp] = 1.f / ls;
    }
    if constexpr (NMAP == 1) {
#pragma unroll
      for (int d = 0; d < 4; ++d)
        *(bf4*)(p.mix() + (size_t)tok * LDH + h * 64 + d * 16 + 4 * g) = pack4(o[0][qt][d] * inv[0]);
    } else {
      const float lam = p.lam()[l];
      const float li = 0.8f - 0.6f * expf(-0.3f * (float)l);
      f4 val[4];
      float ss = 0.f;
#pragma unroll
      for (int d = 0; d < 4; ++d) {
        val[d] = o[0][qt][d] * inv[0] - o[NMAP - 1][qt][d] * (lam * inv[NMAP - 1]);
        ss += val[d][0] * val[d][0] + val[d][1] * val[d][1] + val[d][2] * val[d][2] + val[d][3] * val[d][3];
      }
      ss = rows_sum(ss);
      const float rs = rsqrtf(ss * (1.f / 64.f) + EPSN) * (1.f - li);
      f4 gd[4];
#pragma unroll
      for (int d = 0; d < 4; ++d) gd[d] = *(const f4*)(p.g_diff_norm + l * 64 + d * 16 + 4 * g);
#pragma unroll
      for (int d = 0; d < 4; ++d) *(bf4*)(p.mix() + (size_t)tok * LDH + 256 + h * 64 + d * 16 + 4 * g) = pack4(val[d] * rs * gd[d]);
    }
  }
}

template <int DQK, int NMAP>
__device__ __forceinline__ void attn_dispatch(const Params& p, int l, int item, const __bf16* Q, const __bf16* K, const __bf16* Vt, char* smem) {
  int b, h, q0, nk;
  if (item < 512) { b = (item >> 2) & 1; h = item & 3; q0 = CTXL + (item >> 3) * 128; nk = PT; }
  else { int it = item - 512; b = it >> 3; h = (it >> 1) & 3; q0 = (it & 1) * 128; nk = CTXL; }
  attn_item<DQK, NMAP>(p, l, Q, K, Vt, b, h, q0, nk, smem);
}

__device__ __forceinline__ void hgrn1_item(const Params& p, int item, char* smem) {
  __bf16* kteT = (__bf16*)smem;
  __bf16* vT = kteT + 64 * 72;
  float* ptot = (float*)(vT + 64 * 72);
  const int tid = tid_(), lane = tid & 63, wave = tid >> 6, r = lane & 15, g = lane >> 4;
  const int c = item % NCH, bh = item / NCH;
  const int b = bh >> 3, h = bh & 7;
  const int tok0 = b * PT + c * 64;
  __syncthreads();
#pragma unroll
  for (int i = 0; i < 2; ++i) {
    int dv = (tid >> 3) + 32 * i;
    *(bf8*)(vT + dv * 72 + (tid & 7) * 8) = *(const bf8*)(p.hvt() + ((size_t)bh * 64 + dv) * PT + c * 64 + (tid & 7) * 8);
  }
  const int k = tid & 63, part = tid >> 6;
  float lfa[2][16];
#pragma unroll
  for (int dd = 0; dd < 2; ++dd) {
    const float* lfp = p.lf() + ((size_t)dd * NTOK + tok0 + part * 16) * 512 + h * 64 + k;
#pragma unroll
    for (int i = 0; i < 16; ++i) lfa[dd][i] = lfp[(size_t)i * 512];
  }
#pragma unroll
  for (int dir = 0; dir < 2; ++dir) {
    float lfv[16], cl[16];
#pragma unroll
    for (int i = 0; i < 16; ++i) lfv[i] = lfa[dir][i];
    float run = 0.f;
    if (dir == 0) {
#pragma unroll
      for (int i = 0; i < 16; ++i) { run += lfv[i]; cl[i] = run; }
    } else {
#pragma unroll
      for (int i = 15; i >= 0; --i) { run += lfv[i]; cl[i] = run; }
    }
    __syncthreads();
    ptot[part * 64 + k] = run;
    __syncthreads();
    float off = 0.f, total = 0.f;
#pragma unroll
    for (int q = 0; q < 4; ++q) {
      float t = ptot[q * 64 + k];
      total += t;
      if (dir == 0 ? (q < part) : (q > part)) off += t;
    }
#pragma unroll
    for (int i = 0; i < 16; ++i) {
      float cum = cl[i] + off;
      float kte = (1.f - __expf(lfv[i])) * __expf(total - cum);
      kteT[k * 72 + part * 16 + i] = (__bf16)kte;
    }
    const size_t sidx = ((size_t)bh * 2 + dir) * NCH + c;
    if (part == 0) p.dk()[sidx * 64 + k] = __expf(total);
    __syncthreads();
    f4 acc[4];
#pragma unroll
    for (int nt = 0; nt < 4; ++nt) acc[nt] = f4{0.f, 0.f, 0.f, 0.f};
#pragma unroll
    for (int ks = 0; ks < 2; ++ks) {
      bf8 af = *(const bf8*)(vT + (wave * 16 + r) * 72 + ks * 32 + g * 8);
#pragma unroll
      for (int nt = 0; nt < 4; ++nt) {
        bf8 bfr = *(const bf8*)(kteT + (nt * 16 + r) * 72 + ks * 32 + g * 8);
        acc[nt] = mfma16(af, bfr, acc[nt]);
      }
    }
    float* up = p.ut() + sidx * 4096;
#pragma unroll
    for (int nt = 0; nt < 4; ++nt)
#pragma unroll
      for (int q = 0; q < 4; ++q) up[(wave * 16 + 4 * g + q) * 64 + nt * 16 + r] = acc[nt][q];
  }
}

__device__ __forceinline__ void hgrn2_item(const Params& p, int item) {
  const int idx = item * 256 + tid_();
  const int e = idx & 4095, sd = idx >> 12;
  const int dir = sd & 1, kk = e & 63;
  const float* up = p.ut() + (size_t)sd * NCH * 4096 + e;
  const float* dp = p.dk() + (size_t)sd * NCH * 64 + kk;
  __bf16* sp = p.st() + (size_t)sd * NCH * 4096 + e;
  float S = 0.f;
  for (int jb = 0; jb < NCH; jb += 22) {
    float u[22], d[22];
    int cc[22];
#pragma unroll
    for (int q = 0; q < 22; ++q) {
      int j = jb + q;
      int c = dir == 0 ? j : (j < 4 ? 3 - j : 135 - j);
      cc[q] = c;
      u[q] = up[(size_t)c * 4096];
      d[q] = dp[c * 64];
    }
#pragma unroll
    for (int q = 0; q < 22; ++q) {
      sp[(size_t)cc[q] * 4096] = (__bf16)S;
      S = d[q] * S + u[q];
    }
  }
}

__device__ __forceinline__ void hgrn3_item(const Params& p, int l, int item, char* smem) {
  __bf16* qS = (__bf16*)smem;
  __bf16* kS = qS + 64 * 72;
  __bf16* vT = kS + 64 * 72;
  __bf16* stS = vT + 64 * 72;
  float* cumS = (float*)(stS + 64 * 72);
  float* ptot = cumS + 64 * 68;
  const int tid = tid_(), lane = tid & 63, wave = tid >> 6, r = lane & 15, g = lane >> 4;
  const int c = item % NCH, bh = item / NCH;
  const int b = bh >> 3, h = bh & 7;
  const int tok0 = b * PT + c * 64;
  __syncthreads();
#pragma unroll
  for (int i = 0; i < 2; ++i) {
    int row = (tid >> 3) + 32 * i;
    *(bf8*)(vT + row * 72 + (tid & 7) * 8) = *(const bf8*)(p.hvt() + ((size_t)bh * 64 + row) * PT + c * 64 + (tid & 7) * 8);
    *(bf8*)(qS + row * 72 + (tid & 7) * 8) = *(const bf8*)(p.hq() + (size_t)(tok0 + row) * 512 + h * 64 + (tid & 7) * 8);
  }
  f4 o[4];
#pragma unroll
  for (int d = 0; d < 4; ++d) o[d] = f4{0.f, 0.f, 0.f, 0.f};
  const int k = tid & 63, part = tid >> 6;
  const int t = 16 * wave + r;
  bf8 sta[2][2];
#pragma unroll
  for (int dd = 0; dd < 2; ++dd) {
    const __bf16* sp = p.st() + (((size_t)bh * 2 + dd) * NCH + c) * 4096;
#pragma unroll
    for (int i = 0; i < 2; ++i) sta[dd][i] = *(const bf8*)(sp + ((tid >> 3) + 32 * i) * 64 + (tid & 7) * 8);
  }
  float lfa[2][16];
#pragma unroll
  for (int dd = 0; dd < 2; ++dd) {
    const float* lfp = p.lf() + ((size_t)dd * NTOK + tok0 + part * 16) * 512 + h * 64 + k;
#pragma unroll
    for (int i = 0; i < 16; ++i) lfa[dd][i] = lfp[(size_t)i * 512];
  }
#pragma unroll
  for (int dir = 0; dir < 2; ++dir) {
    float lfv[16], cl[16];
#pragma unroll
    for (int i = 0; i < 16; ++i) lfv[i] = lfa[dir][i];
    float run = 0.f;
    if (dir == 0) {
#pragma unroll
      for (int i = 0; i < 16; ++i) { run += lfv[i]; cl[i] = run; }
    } else {
#pragma unroll
      for (int i = 15; i >= 0; --i) { run += lfv[i]; cl[i] = run; }
    }
    __syncthreads();
    ptot[part * 64 + k] = run;
#pragma unroll
    for (int i = 0; i < 16; ++i) kS[(part * 16 + i) * 72 + k] = (__bf16)((1.f - __expf(lfv[i])));
#pragma unroll
    for (int i = 0; i < 2; ++i) *(bf8*)(stS + ((tid >> 3) + 32 * i) * 72 + (tid & 7) * 8) = sta[dir][i];
    __syncthreads();
    float off = 0.f;
#pragma unroll
    for (int q = 0; q < 4; ++q) {
      float tt = ptot[q * 64 + k];
      if (dir == 0 ? (q < part) : (q > part)) off += tt;
    }
#pragma unroll
    for (int i = 0; i < 16; ++i) cumS[(part * 16 + i) * 68 + k] = cl[i] + off;
    __syncthreads();
    float cs[2][8];
    bf8 qtf[2], qhf[2];
#pragma unroll
    for (int ks = 0; ks < 2; ++ks) {
      const int dk0 = ks * 32 + 8 * g;
      bf8 qv = *(const bf8*)(qS + t * 72 + dk0);
#pragma unroll
      for (int j = 0; j < 8; ++j) {
        float cst;
        if (dir == 0) cst = wave > 0 ? cumS[(16 * wave - 1) * 68 + dk0 + j] : 0.f;
        else cst = wave < 3 ? cumS[(16 * wave + 16) * 68 + dk0 + j] : 0.f;
        cs[ks][j] = cst;
        float cv = cumS[t * 68 + dk0 + j];
        float qf_ = (float)qv[j];
        qtf[ks][j] = (__bf16)(qf_ * __expf(cv - cst));
        qhf[ks][j] = (__bf16)(qf_ * __expf(cv));
      }
    }
#pragma unroll
    for (int m = 0; m < 2; ++m) {
      const bool need = dir == 0 ? (m <= (wave >> 1)) : (m >= (wave >> 1));
      if (need) {
        bf8 pf;
#pragma unroll
        for (int tp = 0; tp < 2; ++tp) {
          const int srow = 32 * m + 8 * (r >> 2) + 4 * tp + (r & 3);
          f4 sc = f4{0.f, 0.f, 0.f, 0.f};
#pragma unroll
          for (int ks = 0; ks < 2; ++ks) {
            const int dk0 = ks * 32 + 8 * g;
            bf8 kv = *(const bf8*)(kS + srow * 72 + dk0);
            bf8 ktf;
#pragma unroll
            for (int j = 0; j < 8; ++j) {
              float ex = fminf(cs[ks][j] - cumS[srow * 68 + dk0 + j], 80.f);
              ktf[j] = (__bf16)((float)kv[j] * __expf(ex));
            }
            sc = mfma16(ktf, qtf[ks], sc);
          }
#pragma unroll
          for (int q = 0; q < 4; ++q) {
            const int s = 32 * m + 8 * g + 4 * tp + q;
            const bool keep = dir == 0 ? (s <= t) : (s >= t);
            pf[tp * 4 + q] = keep ? (__bf16)sc[q] : (__bf16)0.f;
          }
        }
#pragma unroll
        for (int d = 0; d < 4; ++d) {
          bf8 vf = *(const bf8*)(vT + (d * 16 + r) * 72 + 32 * m + 8 * g);
          o[d] = mfma16(vf, pf, o[d]);
        }
      }
    }
#pragma unroll
    for (int d = 0; d < 4; ++d)
#pragma unroll
      for (int ks = 0; ks < 2; ++ks) {
        bf8 sf = *(const bf8*)(stS + (d * 16 + r) * 72 + ks * 32 + 8 * g);
        o[d] = mfma16(sf, qhf[ks], o[d]);
      }
  }
  float ss = 0.f;
#pragma unroll
  for (int d = 0; d < 4; ++d) ss += o[d][0] * o[d][0] + o[d][1] * o[d][1] + o[d][2] * o[d][2] + o[d][3] * o[d][3];
  ss = rows_sum(ss);
  const float rs = rsqrtf(ss * (1.f / 64.f) + EPSN);
  f4 gn[4]; bf4 gate[4];
#pragma unroll
  for (int d = 0; d < 4; ++d) {
    gn[d] = *(const f4*)(p.g_hgrn_norm + l * 64 + d * 16 + 4 * g);
    gate[d] = *(const bf4*)(p.hg() + (size_t)(tok0 + t) * 512 + h * 64 + d * 16 + 4 * g);
  }
#pragma unroll
  for (int d = 0; d < 4; ++d) {
    f4 res;
#pragma unroll
    for (int q = 0; q < 4; ++q) res[q] = o[d][q] * rs * gn[d][q] * (float)gate[d][q];
    *(bf4*)(p.mix() + (size_t)(tok0 + t) * LDH + 512 + h * 64 + d * 16 + 4 * g) = pack4(res);
  }
}

#define NPHASE 38
#ifndef ONLY
#define ONLY -1
#endif
#define PHEN(x) (ONLY < 0 || ONLY == (x))
__device__ __forceinline__ void run_phase(const Params& p, int ph, char* smem) {
  const int bid = bid_(), G = gridDim.x;
  if (ph == 0) { if (PHEN(100)) phase0(p, smem); return; }
  if (ph == NPHASE - 1) {
    for (int it = bid; it < NB * SEQ / 16; it += G) final_norm_item(p, it);
    return;
  }
  const int l = (ph - 1) / 9, sp = (ph - 1) % 9;
  const int nmt = mtile_count(l);
  switch (sp) {
    case 0: if (PHEN(0)) {
      for (int i = bid * 256 + tid_(); i < (INWP - INW) * DM / 8; i += G * 256) {
        bf8 z;
#pragma unroll
        for (int j = 0; j < 8; ++j) z[j] = (__bf16)0.f;
        *(bf8*)(p.wt_in() + (size_t)(INW + (i >> 7)) * LDH + (size_t)(i & 127) * 8) = z;
      }
      for (int it = bid; it < 1056; it += G) norm_item(p, l, 0, it);
      conv_items(p, l, bid, G, smem);
    } break;
    case 1: if (PHEN(1)) {
      {
        int mt, nt, mtn = 0, ntn = 0;
        bool have = gemm_pick(0, bid, G, 132, 30, 10, mt, nt), pre = false;
        for (int st = 0; have; ++st) {
          const bool hn = gemm_pick(st + 1, bid, G, 132, 30, 10, mtn, ntn);
          gemm_tile<EPI_IN, false>(p, l, p.hb(), LDH, p.wt_in(), LDH, DM, mt * 128, nt * 128, smem, pre, hn, mtn * 128, ntn * 128);
          pre = hn; have = hn; mt = mtn; nt = ntn;
        }
      }
    } break;
    case 2: if (PHEN(2)) {
      const int natt = l < 3 ? 528 : 512;
      const int total = natt + 396 + 528 + 2112, K = (total + G - 1) / G;
      const bool flip = (bid >> 3) & 1;
      for (int kk = 0; kk < K; ++kk) {
        const int k = flip ? (kk + 1 == K ? 0 : kk + 1) : kk;
        const int it0 = bid + k * G;
        if (it0 >= total) continue;
        if (it0 < natt) { attn_dispatch<32, 2>(p, l, it0, p.qd(), p.kd(), p.vdt(), smem); continue; }
        const int it = it0 - natt;
        if (it < 396) gemm_tile<EPI_UQ, true>(p, l, p.cq(), 256, p.wt_uq(), 256, 256, (it / 3) * 128, (it % 3) * 128, smem);
        else if (it < 924) { int j = it - 396; gemm_tile<EPI_UKV, true>(p, l, p.ckv(), 128, p.wt_ukv(), 128, 128, (j / 4) * 128, (j % 4) * 128, smem); }
        else hgrn1_item(p, it - 924, smem);
      }
    } break;
    case 3: if (PHEN(3)) {
      const int natt = l < 3 ? 528 : 512;
      const int total = 512 + natt, K = (total + G - 1) / G;
      const bool flip = (bid >> 3) & 1;
      for (int kk = 0; kk < K; ++kk) {
        const int k = flip ? (kk + 1 == K ? 0 : kk + 1) : kk;
        const int it = bid + k * G;
        if (it >= total) continue;
        if (it < 512) hgrn2_item(p, it);
        else attn_dispatch<96, 1>(p, l, it - 512, p.qm(), p.km(), p.vmt(), smem);
      }
    } break;
    case 4: if (PHEN(4)) {
      for (int j = bid; j < 2112; j += G) {
        if (l == 3 && (j % NCH) < 4) continue;
        hgrn3_item(p, l, j, smem);
      }
    } break;
    case 5: if (PHEN(5)) {
      {
        int mt, nt, mtn = 0, ntn = 0;
        bool have = gemm_pick(0, bid, G, 128, 8, 8, mt, nt), pre = false;
        for (int st = 0; have; ++st) {
          const bool hn = gemm_pick(st + 1, bid, G, 128, 8, 8, mtn, ntn);
          gemm_tile<EPI_OUT, false>(p, l, p.mix(), LDH, p.wt_out(), LDH, DM, mtile_index(3, mt) * 128, nt * 128, smem, pre, hn,
                                    mtile_index(3, mtn) * 128, ntn * 128);
          pre = hn; have = hn; mt = mtn; nt = ntn;
        }
      }
      if (l < 3) {
        for (int u = bid; u < 32 * 8; u += G) {
          const int tile = u >> 3, sp = u & 7;
          const int cm = tile >> 3, nt = tile & 7;
          const int mt = (cm >> 1) * 66 + (cm & 1);
          gemm_tile<EPI_OUT_AT, false>(p, l, p.mix() + sp * 128, LDH, p.wt_out() + sp * 128, LDH, 128, mt * 128, nt * 128, smem);
        }
      }
    } break;
    case 6: if (PHEN(6)) {
      for (int it = bid; it < 1056; it += G) norm_item(p, l, 1, it);
    } break;
    case 7: if (PHEN(7)) {
      {
        int mt, nt, mtn = 0, ntn = 0;
        bool have = gemm_pick(0, bid, G, nmt, 44, 11, mt, nt), pre = false;
        for (int st = 0; have; ++st) {
          const bool hn = gemm_pick(st + 1, bid, G, nmt, 44, 11, mtn, ntn);
          gemm_tile<EPI_UP, false>(p, l, p.hb(), LDH, p.wt_gu(), LDH, DM, mtile_index(l, mt) * 128, nt * 128, smem, pre, hn,
                                   mtile_index(l, mtn) * 128, ntn * 128);
          pre = hn; have = hn; mt = mtn; nt = ntn;
        }
      }
    } break;
    case 8: if (PHEN(8)) {
      {
        int mt, nt, mtn = 0, ntn = 0;
        bool have = gemm_pick(0, bid, G, 128, 8, 8, mt, nt), pre = false;
        for (int st = 0; have; ++st) {
          const bool hn = gemm_pick(st + 1, bid, G, 128, 8, 8, mtn, ntn);
          gemm_tile<EPI_DOWN, false>(p, l, p.act(), LDF, p.wt_down(), LDF, DFF, mtile_index(3, mt) * 128, nt * 128, smem, pre, hn,
                                     mtile_index(3, mtn) * 128, ntn * 128);
          pre = hn; have = hn; mt = mtn; nt = ntn;
        }
      }
      if (l < 3) {
        for (int u = bid; u < 32 * 11; u += G) {
          const int tile = u / 11, sp = u - tile * 11;
          const int cm = tile >> 3, nt = tile & 7;
          const int mt = (cm >> 1) * 66 + (cm & 1);
          gemm_tile<EPI_DOWN_AT, false>(p, l, p.act() + sp * 256, LDF, p.wt_down() + sp * 256, LDF, 256, mt * 128, nt * 128, smem);
        }
      }
    } break;
  }
}

#define XB_TMO      128
#define XB_XCNT(j)  (256  + 64 * (j))
#define XB_XSUB(j)  (1280 + 64 * (j))
#define XB_XGEN(j)  (2304 + 64 * (j))
#define XB_TOP      3328
#define XB_TOPGEN   3392
#define XCD_BAR_WORDS 3456
#define XB_SPIN_CAP (1u << 22)
#define LAS __attribute__((address_space(3)))

__device__ __forceinline__ unsigned xb_ld(unsigned* p)              { return __hip_atomic_load(p, __ATOMIC_RELAXED, __HIP_MEMORY_SCOPE_AGENT); }
__device__ __forceinline__ unsigned xb_add(unsigned* p, unsigned v) { return __hip_atomic_fetch_add(p, v, __ATOMIC_RELAXED, __HIP_MEMORY_SCOPE_AGENT); }
__device__ __forceinline__ unsigned xb_xcc_id() { return (unsigned)__builtin_amdgcn_s_getreg((3 << 11) | 20) & 0xFu; }
#define XB_SPIN(cond, bar) do { unsigned _sp = 0; while (cond) { __builtin_amdgcn_s_sleep(1); \
    if ((++_sp & 255u) == 0u) { if (xb_ld(&(bar)[XB_TMO])) break; if (_sp > XB_SPIN_CAP) { atomicAdd(&(bar)[XB_TMO], 1u); break; } } } } while (0)

struct XcdBarrier {
    unsigned* bar; unsigned x;
    volatile LAS unsigned* st;
};

__device__ __forceinline__ XcdBarrier xcd_barrier_post(unsigned* bar, volatile LAS unsigned* st) {
    XcdBarrier b; b.bar = bar; b.x = xb_xcc_id(); b.st = st;
    if (threadIdx.x == 0) (void)xb_add(&bar[XB_XCNT(b.x)], 1u);
    return b;
}
__device__ __forceinline__ void xcd_barrier_complete(unsigned* bar, unsigned x, unsigned& nloc, unsigned& nx) {
    const unsigned G = gridDim.x * gridDim.y * gridDim.z;
    unsigned sum, cnt, mine, sp = 0u;
    for (;;) {
        sum = 0u; cnt = 0u; mine = 0u;
#pragma unroll
        for (unsigned j = 0; j < 16; ++j) { const unsigned c = xb_ld(&bar[XB_XCNT(j)]); sum += c; cnt += (c > 0u) ? 1u : 0u; mine = (j == x) ? c : mine; }
        if (sum == G) break;
        __builtin_amdgcn_s_sleep(1);
        if ((++sp & 255u) == 0u) { if (xb_ld(&bar[XB_TMO])) break; if (sp > XB_SPIN_CAP) { atomicAdd(&bar[XB_TMO], 1u); break; } }
    }
    nloc = mine > 0u ? mine : 1u; nx = cnt > 0u ? cnt : 1u;
}

__device__ __forceinline__ void xcd_barrier(const XcdBarrier& b) {
    asm volatile("s_waitcnt vmcnt(0)" ::: "memory");
    __syncthreads();
    if (threadIdx.x == 0) {
        unsigned* bar = b.bar;
        __builtin_amdgcn_s_waitcnt(0);
        unsigned nloc = b.st[0], nx = b.st[1];
        if (nloc == 0u) { xcd_barrier_complete(bar, b.x, nloc, nx); b.st[0] = nloc; b.st[1] = nx; }
        const unsigned old = xb_add(&bar[XB_XSUB(b.x)], 1u);
        const unsigned gen = old / nloc;
        if (old + 1u == (gen + 1u) * nloc) {
            __builtin_amdgcn_fence(__ATOMIC_RELEASE, "agent");
            asm volatile("s_waitcnt vmcnt(0)" ::: "memory");
            const unsigned og = xb_add(&bar[XB_TOP], 1u);
            const unsigned tg = og / nx;
            if (og + 1u == (tg + 1u) * nx) xb_add(&bar[XB_TOPGEN], 1u);
            else XB_SPIN(xb_ld(&bar[XB_TOPGEN]) == tg, bar);
            __builtin_amdgcn_fence(__ATOMIC_ACQUIRE, "agent");
            xb_add(&bar[XB_XGEN(b.x)], 1u);
            asm volatile("s_waitcnt vmcnt(0)" ::: "memory");
        } else {
            XB_SPIN(xb_ld(&bar[XB_XGEN(b.x)]) == gen, bar);
            __builtin_amdgcn_fence(__ATOMIC_ACQUIRE, "agent");
            asm volatile("s_waitcnt vmcnt(0)" ::: "memory");
        }
    }
    __syncthreads();
}


__device__ __forceinline__ void grid_barrier(unsigned* cnt, unsigned target) {
  asm volatile("s_waitcnt vmcnt(0)" ::: "memory");
  __syncthreads();
  if (tid_() == 0) {
    __builtin_amdgcn_fence(__ATOMIC_RELEASE, "agent");
    asm volatile("s_waitcnt vmcnt(0)" ::: "memory");
    __hip_atomic_fetch_add(cnt, 1u, __ATOMIC_RELAXED, __HIP_MEMORY_SCOPE_AGENT);
    unsigned spins = 0;
    while (__hip_atomic_load(cnt, __ATOMIC_RELAXED, __HIP_MEMORY_SCOPE_AGENT) < target) {
      __builtin_amdgcn_s_sleep(2);
      if (++spins > (1u << 24)) break;
    }
    __builtin_amdgcn_fence(__ATOMIC_ACQUIRE, "agent");
    asm volatile("s_waitcnt vmcnt(0)" ::: "memory");
  }
  __syncthreads();
}

__global__ void __launch_bounds__(256, 2) hybrid_megakernel(Params p, int ph0, int ph1) {
  __shared__ __attribute__((aligned(16))) char smem[SMEM_BYTES];
  cg::grid_group grid = cg::this_grid();
  volatile LAS unsigned* xst = (volatile LAS unsigned*)(smem + 66048);
  if (__builtin_amdgcn_workitem_id_x() == 0) { xst[0] = 0u; xst[1] = 0u; }
  __syncthreads();
  XcdBarrier xb; xb.bar = nullptr; xb.x = 0; xb.st = xst;
  for (int ph = ph0; ph < ph1; ++ph) {
    Params q = p;
    size_t zoff = 0;
    asm volatile("" : "+s"(zoff));
    q.ws = p.ws + zoff; q.out = p.out + zoff;
    run_phase(q, ph, smem);
#ifdef REPMASK
    if (ph > 0 && ph < NPHASE - 1 && ((REPMASK >> ((ph - 1) % 9)) & 1)) { grid.sync(); run_phase(q, ph, smem); }
#endif
    if (ph + 1 < ph1) {
      if (ph == ph0) { grid.sync(); xb = xcd_barrier_post((unsigned*)(p.ws + OFF_xbar), xst); }
      else xcd_barrier(xb);
    }
  }
}

extern "C" void kernel_launch(void* const* d_in, const int* in_sizes, int n_in, void* d_out, int out_size, void* d_ws,
                              size_t ws_size, hipStream_t stream) {
  static int grid_blocks = 0;
  if (!grid_blocks) {
    int dev = 0, cus = 0, per_cu = 0;
    hipGetDevice(&dev);
    hipDeviceGetAttribute(&cus, hipDeviceAttributeMultiprocessorCount, dev);
    hipOccupancyMaxActiveBlocksPerMultiprocessor(&per_cu, hybrid_megakernel, 256, 0);
    if (per_cu > 2) per_cu = 2;
    if (per_cu < 1) per_cu = 1;
    grid_blocks = cus * per_cu;
  }
  Params p{};
  const float* const* in = (const float* const*)d_in;
  p.x = in[0]; p.c = in[1]; p.ctx = in[2]; p.c_ctx = in[3]; p.w_ada = in[4]; p.b_ada = in[5]; p.g_norm1 = in[6];
  p.g_norm2 = in[7]; p.w_in = in[8]; p.g_q_norm = in[9]; p.w_uq = in[10]; p.g_kv_norm = in[11]; p.w_ukv = in[12];
  p.diff_lambda = in[13]; p.g_diff_norm = in[14]; p.hgrn_lb = in[15]; p.g_hgrn_norm = in[16]; p.w_out = in[17];
  p.w_gate = in[18]; p.w_up = in[19]; p.w_down = in[20]; p.g_final = in[21];
  p.out = (float*)d_out;
  p.ws = (char*)d_ws;
  if (WS_TOTAL > ws_size) { fprintf(stderr, "workspace too small: need %zu have %zu\n", (size_t)WS_TOTAL, ws_size); return; }
  int ph0 = 0, ph1 = NPHASE;
  void* args[] = {&p, &ph0, &ph1};
  hipError_t e = hipLaunchCooperativeKernel((void*)hybrid_megakernel, dim3(grid_blocks), dim3(256), args, 0, stream);
  if (e != hipSuccess) fprintf(stderr, "cooperative launch failed: %s (grid %d)\n", hipGetErrorString(e), grid_blocks);
}
```
